# Optimizing an MI355X kernel written in HIP

```python
import jax, jax.numpy as jnp
from jax import lax
import numpy as np

D_MODEL = 1024
BATCH = 2
SEQ = 8192
DEPTH = 4

GRID_W = 64
CTX_LEN = 256
N_MIXERS = 2
D_INNER = D_MODEL
HEAD_DIM = 64
N_HEADS = D_INNER // HEAD_DIM
N_FGROUPS = 8
FGROUP_DIM = D_INNER // N_FGROUPS
LORA_DECAY = 64
LORA_ICLR = 64
LORA_VRES = 32
N_DIR = 2
N_TSHIFT = 6
N_FOURIER = (DEPTH + 1) // 2
N_RWKV = DEPTH // 2
RMS_EPS = 1e-6
GN_EPS = 64e-5

kernel_name = "fnet_rwkv7_sandwich_adaln_prefix_trunk"


def rmsnorm(x, g):
    x32 = x.astype(jnp.float32)
    y = x32 * lax.rsqrt(jnp.mean(x32 * x32, axis=-1, keepdims=True) + RMS_EPS)
    return (y * g.astype(jnp.float32)).astype(x.dtype)


def modulation(cond, w, b):
    return jnp.split(jax.nn.silu(cond) @ w + b, 3, axis=-1)


def shift_grid(h):
    b_, t, d = h.shape
    g = h.reshape(b_, t // GRID_W, GRID_W, d)
    p = jnp.pad(g, ((0, 0), (1, 1), (1, 1), (0, 0)))
    nb = (p[:, :-2, 1:-1] + p[:, 2:, 1:-1] + p[:, 1:-1, :-2] + p[:, 1:-1, 2:]) * 0.25
    return nb.reshape(b_, t, d)


def shift_seq(h):
    p = jnp.pad(h, ((0, 0), (1, 1), (0, 0)))
    return (p[:, :-2] + p[:, 2:]) * 0.5


def fourier_mixer(h, w_in, w_mix, b_mix, w_out):
    b_, t, _ = h.shape
    u, z = jnp.split(h @ w_in, 2, axis=-1)
    ug = u.reshape(b_, t, N_FGROUPS, FGROUP_DIM).astype(jnp.float32)
    f = jnp.fft.fftn(ug, axes=(1, 3), norm="ortho").real.astype(h.dtype)
    f = jnp.einsum('btgc,gce->btge', f, w_mix).reshape(b_, t, D_INNER) + b_mix
    return (f * jax.nn.silu(z)) @ w_out


def rwkv_features(h, shift_fn, mu, w_in, w0, w1, w2, a0, a1, a2, k_k, k_a, v_res):
    heads = lambda t: t.reshape(t.shape[:-1] + (N_HEADS, HEAD_DIM))
    xs = h[None] + (shift_fn(h) - h)[None] * mu[:, None, None, :]
    r, k, v, gz = jnp.einsum('pbtd,pde->pbte', xs[:4], w_in)
    xv, xw, xa = xs[2], xs[4], xs[5]
    if v_res is not None:
        v_first, v0, v1, v2 = v_res
        v = v + (v_first - v) * jax.nn.sigmoid(v0 + (xv @ v1) @ v2)
    kk = heads(k * k_k).astype(jnp.float32)
    kk = kk / jnp.maximum(jnp.linalg.norm(kk, axis=-1, keepdims=True), 1e-12)
    wz = w0[:, None, None, :] + jnp.einsum('nbtl,nle->nbte', jnp.tanh(jnp.einsum('btd,ndl->nbtl', xw, w1)), w2)
    decay = jnp.exp(-jnp.exp(-jax.nn.softplus(-wz.astype(jnp.float32)) - 0.5))
    a = jax.nn.sigmoid(a0[:, None, None, :] + jnp.einsum('nbtl,nle->nbte', jnp.einsum('btd,ndl->nbtl', xa, a1), a2))
    k_dir = k[None] * (1 + (a - 1) * k_a)
    b = kk[None] * heads(a)
    return heads(r), heads(k_dir), heads(v), kk, heads(decay), b, gz, v


def wkv_scan(state, r, w, k, v, a, b, reverse):
    def step(s, inp):
        r_t, w_t, k_t, v_t, a_t, b_t = inp
        sa = jnp.einsum('bhij,bhj->bhi', s, a_t)
        s = s * w_t[:, :, None, :] + sa[..., None] * b_t[:, :, None, :] + v_t[..., None] * k_t[:, :, None, :]
        return s, jnp.einsum('bhij,bhj->bhi', s, r_t)
    tm = lambda t: jnp.swapaxes(t, 0, 1).astype(jnp.float32)
    state, y = lax.scan(step, state, tuple(tm(t) for t in (r, w, k, v, a, b)), reverse=reverse)
    return state, jnp.swapaxes(y, 0, 1)


def run_scan(state, feats, n, reverse):
    r, k_dir, v, kk, decay, b = feats[:6]
    return wkv_scan(state, r, decay[n], k_dir[n], v, -kk, b[n], reverse)


def rwkv_output(y, feats, r_k, ln_w, ln_b, w_out):
    r, k_dir, v, gz = feats[0], feats[1], feats[2], feats[6]
    b_, t = y.shape[:2]
    mean = jnp.mean(y, axis=-1, keepdims=True)
    var = jnp.mean(jnp.square(y - mean), axis=-1, keepdims=True)
    yn = ((y - mean) * lax.rsqrt(var + GN_EPS)).reshape(b_, t, D_INNER).astype(gz.dtype) * ln_w + ln_b
    bonus = jnp.sum(jnp.sum(r[None] * k_dir * r_k, axis=-1, keepdims=True), axis=0) * v
    return ((yn + bonus.reshape(b_, t, D_INNER)) * jax.nn.silu(gz)) @ w_out


def rwkv_mixer(h_ctx, h_lat, mu, w_in, w0, w1, w2, a0, a1, a2, k_k, k_a, r_k, ln_w, ln_b, w_out,
               v_res_ctx, v_res_lat, ctx_out):
    fc = rwkv_features(h_ctx, shift_seq, mu, w_in, w0, w1, w2, a0, a1, a2, k_k, k_a, v_res_ctx)
    fl = rwkv_features(h_lat, shift_grid, mu, w_in, w0, w1, w2, a0, a1, a2, k_k, k_a, v_res_lat)
    state0 = jnp.zeros((h_lat.shape[0], N_HEADS, HEAD_DIM, HEAD_DIM), jnp.float32)
    y_ctx = 0.0
    y_lat = 0.0
    for n, rev in enumerate((False, True)):
        s_ctx, yc = run_scan(state0, fc, n, rev)
        _, yl = run_scan(s_ctx, fl, n, rev)
        y_ctx = y_ctx + yc
        y_lat = y_lat + yl
    out_lat = rwkv_output(y_lat, fl, r_k, ln_w, ln_b, w_out)
    out_ctx = rwkv_output(y_ctx, fc, r_k, ln_w, ln_b, w_out) if ctx_out else None
    return out_ctx, out_lat, fc[7], fl[7]


def setup_inputs(seed: int = 0) -> dict:
    key = jax.random.key(seed)
    ks = iter(jax.random.split(key, 40))
    nrm = lambda shape, s: jax.random.normal(next(ks), shape, jnp.float32) * s
    nv = max(N_RWKV - 1, 0)
    return {
        "x": nrm((BATCH, SEQ, D_MODEL), 1.0),
        "c": nrm((BATCH, D_MODEL), 1.0),
        "ctx": nrm((BATCH, CTX_LEN, D_MODEL), 1.0),
        "c_ctx": nrm((D_MODEL,), 1.0),
        "mod_w": nrm((DEPTH, D_MODEL, 3 * D_MODEL), D_MODEL ** -0.5),
        "mod_b": nrm((DEPTH, 3 * D_MODEL), 0.02),
        "norm_pre": 1.0 + nrm((DEPTH, D_MODEL), 0.05),
        "norm_post": 1.0 + nrm((DEPTH, D_MODEL), 0.05),
        "f_w_in": nrm((N_FOURIER, D_MODEL, 2 * D_INNER), D_MODEL ** -0.5),
        "f_w_mix": nrm((N_FOURIER, N_FGROUPS, FGROUP_DIM, FGROUP_DIM), FGROUP_DIM ** -0.5),
        "f_b_mix": nrm((N_FOURIER, D_INNER), 0.02),
        "f_w_out": nrm((N_FOURIER, D_INNER, D_MODEL), D_INNER ** -0.5),
        "r_mu": jax.random.uniform(next(ks), (N_RWKV, N_TSHIFT, D_MODEL), jnp.float32),
        "r_w_in": nrm((N_RWKV, 4, D_MODEL, D_INNER), D_MODEL ** -0.5),
        "r_w0": jax.random.uniform(next(ks), (N_RWKV, N_DIR, D_INNER), jnp.float32, minval=-3.0, maxval=0.5),
        "r_w1": nrm((N_RWKV, N_DIR, D_MODEL, LORA_DECAY), D_MODEL ** -0.5),
        "r_w2": nrm((N_RWKV, N_DIR, LORA_DECAY, D_INNER), 0.5 * LORA_DECAY ** -0.5),
        "r_a0": nrm((N_RWKV, N_DIR, D_INNER), 0.5),
        "r_a1": nrm((N_RWKV, N_DIR, D_MODEL, LORA_ICLR), D_MODEL ** -0.5),
        "r_a2": nrm((N_RWKV, N_DIR, LORA_ICLR, D_INNER), LORA_ICLR ** -0.5),
        "r_v0": nrm((nv, D_INNER), 0.5),
        "r_v1": nrm((nv, D_MODEL, LORA_VRES), D_MODEL ** -0.5),
        "r_v2": nrm((nv, LORA_VRES, D_INNER), LORA_VRES ** -0.5),
        "r_k_k": 1.0 + nrm((N_RWKV, D_INNER), 0.1),
        "r_k_a": 1.0 + nrm((N_RWKV, D_INNER), 0.1),
        "r_r_k": nrm((N_RWKV, N_HEADS, HEAD_DIM), 0.1),
        "r_ln_w": 1.0 + nrm((N_RWKV, D_INNER), 0.05),
        "r_ln_b": nrm((N_RWKV, D_INNER), 0.01),
        "r_w_out": nrm((N_RWKV, D_INNER, D_MODEL), D_INNER ** -0.5),
    }


def reference(x, c, ctx, c_ctx, mod_w, mod_b, norm_pre, norm_post, f_w_in, f_w_mix, f_b_mix, f_w_out,
              r_mu, r_w_in, r_w0, r_w1, r_w2, r_a0, r_a1, r_a2, r_v0, r_v1, r_v2,
              r_k_k, r_k_a, r_r_k, r_ln_w, r_ln_b, r_w_out):
    cond_lat = c[:, None, :]
    cond_ctx = c_ctx[None, None, :]
    v_first_ctx = None
    v_first_lat = None
    for i in range(DEPTH):
        last = i == DEPTH - 1
        kind = i % N_MIXERS
        j = i // N_MIXERS
        need_ctx = (not last) or kind == 1
        sh, sc, gt = modulation(cond_lat, mod_w[i], mod_b[i])
        h_lat = rmsnorm(x, norm_pre[i]) * (1 + sc) + sh
        if need_ctx:
            sh_c, sc_c, gt_c = modulation(cond_ctx, mod_w[i], mod_b[i])
            h_ctx = rmsnorm(ctx, norm_pre[i]) * (1 + sc_c) + sh_c
        if kind == 0:
            o_lat = fourier_mixer(h_lat, f_w_in[j], f_w_mix[j], f_b_mix[j], f_w_out[j])
            o_ctx = None if last else fourier_mixer(h_ctx, f_w_in[j], f_w_mix[j], f_b_mix[j], f_w_out[j])
        else:
            if j == 0:
                vres_c = None
                vres_l = None
            else:
                vres_c = (v_first_ctx, r_v0[j - 1], r_v1[j - 1], r_v2[j - 1])
                vres_l = (v_first_lat, r_v0[j - 1], r_v1[j - 1], r_v2[j - 1])
            o_ctx, o_lat, v_c, v_l = rwkv_mixer(
                h_ctx, h_lat, r_mu[j], r_w_in[j], r_w0[j], r_w1[j], r_w2[j], r_a0[j], r_a1[j], r_a2[j],
                r_k_k[j], r_k_a[j], r_r_k[j], r_ln_w[j], r_ln_b[j], r_w_out[j], vres_c, vres_l, not last)
            if j == 0:
                v_first_ctx = v_c
                v_first_lat = v_l
        x = x + gt * rmsnorm(o_lat, norm_post[i])
        if not last:
            ctx = ctx + gt_c * rmsnorm(o_ctx, norm_post[i])
    return x
```

```cpp
#include <hip/hip_runtime.h>
#include <hip/hip_cooperative_groups.h>
#include <cstdio>
#include <cstring>
namespace cg = cooperative_groups;

#ifndef DBG_MASK
#define DBG_MASK 0
#endif
#ifndef SINGLE_LAUNCH
#define SINGLE_LAUNCH 1
#endif

typedef unsigned short bf16_t;
typedef short s16x8 __attribute__((ext_vector_type(8)));
typedef short s16x4 __attribute__((ext_vector_type(4)));
typedef float f32x16 __attribute__((ext_vector_type(16)));
#define DI __device__ __forceinline__
#define MFMA(a, b, c) __builtin_amdgcn_mfma_f32_32x32x16_bf16((a), (b), (c), 0, 0, 0)

constexpr int NR = 16896;
constexpr int NLAT = 16384;
constexpr int D = 1024;
constexpr size_t SLOT = (size_t)NR * D * 2;
constexpr float RMS_EPS = 1e-6f;
constexpr float GN_EPS = 64e-5f;

constexpr size_t OFF_T0 = 0;
constexpr size_t OFF_VF = 6 * SLOT;
constexpr size_t OFF_XCTX = OFF_VF + SLOT;
constexpr size_t OFF_W = OFF_XCTX + (size_t)512 * D * 4;
constexpr size_t W_BYTES = (size_t)(4384 + 1024) * 1024 * 2;
constexpr size_t OFF_LW = OFF_W + W_BYTES;
constexpr size_t OFF_LA = OFF_LW + (size_t)NR * 128 * 2;
constexpr size_t OFF_LV = OFF_LA + (size_t)NR * 128 * 2;
constexpr size_t OFF_MOD = OFF_LV + (size_t)NR * 32 * 2;
constexpr size_t OFF_F1 = OFF_MOD + (size_t)4 * 3 * 3072 * 4;
constexpr size_t OFF_F2 = OFF_F1 + 128 * 128 * 2;
constexpr size_t OFF_FC = OFF_F2 + 128 * 256 * 2;
constexpr size_t OFF_TW = OFF_FC + 256 * 512 * 2;
constexpr size_t OFF_BON = OFF_TW + 64 * 128 * 8;
constexpr size_t OFF_BAR = OFF_BON + (size_t)2 * NR * 16 * 4;
constexpr size_t WS_END = OFF_BAR + 3456 * 4;
static_assert(WS_END <= 268435456ull, "workspace overflow");

enum { PH_PREP0 = 0, PH_PRE0, PH_FGEMM1, PH_FDFT1, PH_FDFT3, PH_FOUT, PH_POSTPRE, PH_RSHIFT, PH_RINPROJ, PH_RVUPD, PH_RSCAN, PH_ROUTPUT, PH_ROUTPROJ, PH_POSTLAST, PH_DUMP, PH_RSCANA };

struct Params {
  const float *x, *c, *ctx, *c_ctx, *mod_w, *mod_b, *norm_pre, *norm_post, *f_w_in, *f_w_mix, *f_b_mix, *f_w_out,
      *r_mu, *r_w_in, *r_w0, *r_w1, *r_w2, *r_a0, *r_a1, *r_a2, *r_v0, *r_v1, *r_v2, *r_k_k, *r_k_a, *r_r_k, *r_ln_w, *r_ln_b, *r_w_out;
  float* out;
  char* ws;
  int phase_lo, phase_hi;
  unsigned char ptype[32];
  unsigned char player[32];
};

DI float bf2f(bf16_t u) { return __uint_as_float(((unsigned)u) << 16); }
DI bf16_t f2bf(float f) { unsigned r; asm("v_cvt_pk_bf16_f32 %0, %1, %1" : "=v"(r) : "v"(f)); return (bf16_t)r; }
DI unsigned pack2(float a, float b) { unsigned r; asm("v_cvt_pk_bf16_f32 %0, %1, %2" : "=v"(r) : "v"(a), "v"(b)); return r; }
DI float lo2f(unsigned u) { return __uint_as_float(u << 16); }
DI float hi2f(unsigned u) { return __uint_as_float(u & 0xffff0000u); }
DI float silu_f(float x) { return x * __builtin_amdgcn_rcpf(1.f + __expf(-x)); }
DI float sigmoid_f(float x) { return __builtin_amdgcn_rcpf(1.f + __expf(-x)); }
DI float fsig(float x) { return __builtin_amdgcn_rcpf(1.f + __expf(-x)); }
DI float softplus_f(float x) { return fmaxf(x, 0.f) + log1pf(__expf(-fabsf(x))); }
template <int CTRL>
DI float dpp_add(float v) { return v + __int_as_float(__builtin_amdgcn_update_dpp(0, __float_as_int(v), CTRL, 0xf, 0xf, true)); }
DI float wave_sum(float v) {
  v = dpp_add<0xB1>(v);
  v = dpp_add<0x4E>(v);
  v = dpp_add<0x141>(v);
  v = dpp_add<0x140>(v);
  const int iv = __float_as_int(v);
  return __int_as_float(__builtin_amdgcn_readlane(iv, 0)) + __int_as_float(__builtin_amdgcn_readlane(iv, 16)) +
         __int_as_float(__builtin_amdgcn_readlane(iv, 32)) + __int_as_float(__builtin_amdgcn_readlane(iv, 48));
}
DI int crow(int r, int h) { return (r & 3) + 8 * (r >> 2) + 4 * h; }

template <bool MIX>
DI uint4 mix_chunk(uint4 va, uint4 vs, const float4 m0v, const float4 m1v) {
  if (!MIX) return va;
  float h, sv;
  h = lo2f(va.x); sv = lo2f(vs.x); const float e0 = h + (sv - h) * m0v.x;
  h = hi2f(va.x); sv = hi2f(vs.x); const float e1 = h + (sv - h) * m0v.y;
  h = lo2f(va.y); sv = lo2f(vs.y); const float e2 = h + (sv - h) * m0v.z;
  h = hi2f(va.y); sv = hi2f(vs.y); const float e3 = h + (sv - h) * m0v.w;
  h = lo2f(va.z); sv = lo2f(vs.z); const float e4 = h + (sv - h) * m1v.x;
  h = hi2f(va.z); sv = hi2f(vs.z); const float e5 = h + (sv - h) * m1v.y;
  h = lo2f(va.w); sv = lo2f(vs.w); const float e6 = h + (sv - h) * m1v.z;
  h = hi2f(va.w); sv = hi2f(vs.w); const float e7 = h + (sv - h) * m1v.w;
  return make_uint4(pack2(e0, e1), pack2(e2, e3), pack2(e4, e5), pack2(e6, e7));
}
template <bool MIX, int NJ, class Epi>
DI void gemm_tile_n(const bf16_t* __restrict__ A, const bf16_t* __restrict__ A2, const float* __restrict__ mu, int lda,
                    const bf16_t* __restrict__ BT, int ldb, int K, int m0, int n0, int N, char* smem, const int TID, Epi epi) {
  constexpr int BN = 64 * NJ, NB = BN / 32, NBQ = NB / 4;
  constexpr int STAGE = (128 + BN) * 144;
  const int tid = TID, lane = tid & 63, w = tid >> 6, wm = w & 1, wn = w >> 1;
  f32x16 acc[2][NJ];
#pragma unroll
  for (int i = 0; i < 2; ++i)
#pragma unroll
    for (int j = 0; j < NJ; ++j)
#pragma unroll
      for (int r = 0; r < 16; ++r) acc[i][j][r] = 0.f;
  uint4 ra[2][4], ra2[2][4], rb[2][NB];
  const int KT = K >> 6;
  const int lrow = tid >> 3, kc = tid & 7;
  const bf16_t* Ap = A + (size_t)(m0 + lrow) * lda + kc * 8;
  const bf16_t* A2p = MIX ? (A2 + (size_t)(m0 + lrow) * lda + kc * 8) : nullptr;
  const bf16_t* Bp = BT + (size_t)(n0 + lrow) * ldb + kc * 8;
  const bool nfull = (n0 + BN <= N);
#define GEMM_LOAD(ST_, KT_) { \
    _Pragma("unroll") for (int i = 0; i < 4; ++i) { \
      ra[ST_][i] = *(const uint4*)(Ap + (size_t)(32 * i) * lda + (KT_) * 64); \
      if (MIX) ra2[ST_][i] = *(const uint4*)(A2p + (size_t)(32 * i) * lda + (KT_) * 64); } \
    _Pragma("unroll") for (int i = 0; i < NB; ++i) \
      rb[ST_][i] = (nfull || (n0 + lrow + 32 * i) < N) ? *(const uint4*)(Bp + (size_t)(32 * i) * ldb + (KT_) * 64) : make_uint4(0, 0, 0, 0); }
#define GEMM_STAGE_SLICE(ST_, KT_, Q_, BUF_) { \
    bf16_t* As_ = (bf16_t*)(smem + (BUF_) * STAGE); bf16_t* Bs_ = As_ + 128 * 72; \
    float4 m0v_ = make_float4(0, 0, 0, 0), m1v_ = m0v_; \
    if (MIX) { m0v_ = *(const float4*)(mu + (KT_) * 64 + kc * 8); m1v_ = *(const float4*)(mu + (KT_) * 64 + kc * 8 + 4); } \
    *(uint4*)(As_ + (lrow + 32 * (Q_)) * 72 + kc * 8) = mix_chunk<MIX>(ra[ST_][Q_], ra2[ST_][Q_], m0v_, m1v_); \
    _Pragma("unroll") for (int u = 0; u < NBQ; ++u) *(uint4*)(Bs_ + (lrow + 32 * ((Q_) * NBQ + u)) * 72 + kc * 8) = rb[ST_][(Q_) * NBQ + u]; }
  GEMM_LOAD(0, 0)
  if (KT > 1) GEMM_LOAD(1, 1)
  __syncthreads();
#pragma unroll
  for (int qq = 0; qq < 4; ++qq) GEMM_STAGE_SLICE(0, 0, qq, 0)
  if (KT > 2) GEMM_LOAD(0, 2)
  __syncthreads();
  for (int kt0 = 0; kt0 < KT; kt0 += 2) {
#pragma unroll
    for (int st = 0; st < 2; ++st) {
      const int kt = kt0 + st;
      if (kt < KT) {
        const bf16_t* As = (const bf16_t*)(smem + st * STAGE);
        const bf16_t* Bs = As + 128 * 72;
        const bool more = (kt + 1 < KT);
        s16x8 fa[2][2], fb[2][NJ];
#pragma unroll
        for (int i = 0; i < 2; ++i) fa[0][i] = *(const s16x8*)(As + (64 * wm + 32 * i + (lane & 31)) * 72 + (lane >> 5) * 8);
#pragma unroll
        for (int j = 0; j < NJ; ++j) fb[0][j] = *(const s16x8*)(Bs + (32 * NJ * wn + 32 * j + (lane & 31)) * 72 + (lane >> 5) * 8);
#pragma unroll
        for (int kk = 0; kk < 4; ++kk) {
          if (kk < 3) {
#pragma unroll
            for (int i = 0; i < 2; ++i) fa[(kk + 1) & 1][i] = *(const s16x8*)(As + (64 * wm + 32 * i + (lane & 31)) * 72 + (kk + 1) * 16 + (lane >> 5) * 8);
#pragma unroll
            for (int j = 0; j < NJ; ++j) fb[(kk + 1) & 1][j] = *(const s16x8*)(Bs + (32 * NJ * wn + 32 * j + (lane & 31)) * 72 + (kk + 1) * 16 + (lane >> 5) * 8);
          }
#pragma unroll
          for (int i = 0; i < 2; ++i)
#pragma unroll
            for (int j = 0; j < NJ; ++j) acc[i][j] = MFMA(fa[kk & 1][i], fb[kk & 1][j], acc[i][j]);
          if (more) GEMM_STAGE_SLICE(st ^ 1, kt + 1, kk, st ^ 1)
        }
        if (kt + 3 < KT) GEMM_LOAD(st ^ 1, kt + 3)
        __syncthreads();
      }
    }
  }
#undef GEMM_LOAD
#undef GEMM_STAGE_SLICE
#pragma unroll
  for (int i = 0; i < 2; ++i)
#pragma unroll
    for (int j = 0; j < NJ; ++j) {
      const int col = n0 + 32 * NJ * wn + 32 * j + (lane & 31);
      if (col < N) {
#pragma unroll
        for (int r = 0; r < 16; ++r) {
          const int row = m0 + 64 * wm + 32 * i + crow(r, lane >> 5);
          epi(row, col, acc[i][j][r]);
        }
      }
    }
}
template <bool MIX, class Epi>
DI void gemm_tile(const bf16_t* __restrict__ A, const bf16_t* __restrict__ A2, const float* __restrict__ mu, int lda,
                  const bf16_t* __restrict__ BT, int ldb, int K, int m0, int n0, int N, char* smem, const int TID, Epi epi) {
  gemm_tile_n<MIX, 2>(A, A2, mu, lda, BT, ldb, K, m0, n0, N, smem, TID, epi);
}

template <class Epi>
DI void dft_tile(const bf16_t* __restrict__ A, int lda, int arow0, int KH, const bf16_t* __restrict__ Bre,
                 const bf16_t* __restrict__ Bim, int ldb, int tstride, char* smem, const int TID, Epi epi) {
  const int tid = TID, lane = tid & 63, w = tid >> 6;
  const int rt0 = w & 1, ctb = 2 * (w >> 1);
  f32x16 acc[2][2];
#pragma unroll
  for (int i = 0; i < 2; ++i)
#pragma unroll
    for (int j = 0; j < 2; ++j)
#pragma unroll
      for (int r = 0; r < 16; ++r) acc[i][j][r] = 0.f;
  const int nch = (2 * KH) >> 7;
  const int g = lane >> 4, li = lane & 15, q = li >> 2, pp = li & 3;
  const int tr_base = (8 * (g >> 1) + q) * 320 + (16 * (g & 1) + 4 * pp) * 2;
  for (int ch = 0; ch < nch; ++ch) {
    __syncthreads();
#pragma unroll
    for (int i = 0; i < 8; ++i) {
      const int c = tid + 256 * i, r = c >> 4, cc = c & 15;
      const int kr = ch * 128 + r;
      const bf16_t* src = (kr < KH ? Bre + (size_t)kr * tstride * ldb : Bim + (size_t)(kr - KH) * tstride * ldb) + cc * 8;
      *(uint4*)(smem + r * 320 + cc * 16) = *(const uint4*)src;
    }
    __syncthreads();
#pragma unroll
    for (int kh = 0; kh < 2; ++kh) {
      asm volatile("" ::: "memory");
      s16x8 af[4][2];
#pragma unroll
      for (int k4 = 0; k4 < 4; ++k4)
#pragma unroll
        for (int h = 0; h < 2; ++h)
          af[k4][h] = *(const s16x8*)(A + (size_t)(arow0 + 32 * (rt0 + 2 * h) + (lane & 31)) * lda + ch * 128 + (kh * 4 + k4) * 16 + (lane >> 5) * 8);
#pragma unroll
      for (int k4 = 0; k4 < 4; ++k4) {
        const int ks = kh * 4 + k4;
#pragma unroll
        for (int c2 = 0; c2 < 2; ++c2) {
          const int off = tr_base + ks * 16 * 320 + (ctb + c2) * 64;
#ifdef NO_TR
          s16x8 b;
          {
            const int n = 32 * (ctb + c2) + (lane & 31), k0 = ks * 16 + 8 * (lane >> 5);
#pragma unroll
            for (int e = 0; e < 8; ++e) b[e] = *(const short*)(smem + (k0 + e) * 320 + n * 2);
          }
#else
          const s16x4 lo = __builtin_amdgcn_ds_read_tr16_b64_v4i16((__attribute__((address_space(3))) s16x4*)(smem + off));
          const s16x4 hi = __builtin_amdgcn_ds_read_tr16_b64_v4i16((__attribute__((address_space(3))) s16x4*)(smem + off + 4 * 320));
          const s16x8 b = __builtin_shufflevector(lo, hi, 0, 1, 2, 3, 4, 5, 6, 7);
#endif
#pragma unroll
          for (int h = 0; h < 2; ++h) acc[h][c2] = MFMA(af[k4][h], b, acc[h][c2]);
        }
      }
    }
  }
#pragma unroll
  for (int c2 = 0; c2 < 2; ++c2) {
    const int col = 32 * (ctb + c2) + (lane & 31);
#pragma unroll
    for (int r = 0; r < 16; ++r) {
      const int rowA = 32 * rt0 + crow(r, lane >> 5);
      if ((r & 3) == 0) asm volatile("" ::: "memory");
      epi(rowA, rowA + 64, col, acc[0][c2][r], acc[1][c2][r]);
    }
  }
}

DI void transpose_tile(const float* __restrict__ src, int lds_, bf16_t* __restrict__ dst, int ldd, int K, int N, int tk, int tn, char* smem, const int TID) {
  float* t = (float*)smem;
  const int tid = TID;
  __syncthreads();
#pragma unroll
  for (int i = 0; i < 16; ++i) {
    const int kk = (tid >> 6) + 4 * i, nn = tid & 63;
    const int k = tk * 64 + kk, n = tn * 64 + nn;
    t[kk * 65 + nn] = (k < K && n < N) ? src[(size_t)k * lds_ + n] : 0.f;
  }
  __syncthreads();
#pragma unroll
  for (int i = 0; i < 16; ++i) {
    const int nn = (tid >> 6) + 4 * i, kk = tid & 63;
    const int k = tk * 64 + kk, n = tn * 64 + nn;
    if (k < K && n < N) dst[(size_t)n * ldd + k] = f2bf(t[kk * 65 + nn]);
  }
}

DI void fourier_wprep(const Params& p, int j, int it, char* smem, const int TID) {
  bf16_t* W = (bf16_t*)(p.ws + OFF_W);
  const int job = it >> 8, t = it & 255;
  if (job == 0) transpose_tile(p.f_w_in + (size_t)j * 1024 * 2048 + 1024, 2048, W + (size_t)2048 * 1024, 1024, 1024, 1024, t >> 4, t & 15, smem, TID);
  else transpose_tile(p.f_w_out + (size_t)j * 1024 * 1024, 1024, W + (size_t)3072 * 1024, 1024, 1024, 1024, t >> 4, t & 15, smem, TID);
}
DI void rwkv_wprep(const Params& p, int j, int it, char* smem, const int TID) {
  bf16_t* W = (bf16_t*)(p.ws + OFF_W);
  if (it < 1024) {
    const int pi = it >> 8, t = it & 255;
    transpose_tile(p.r_w_in + (size_t)(j * 4 + pi) * 1024 * 1024, 1024, W + (size_t)pi * 1024 * 1024, 1024, 1024, 1024, t >> 4, t & 15, smem, TID);
  } else if (it < 1024 + 32) {
    const int u = it - 1024, n = u >> 4, t = u & 15;
    transpose_tile(p.r_w1 + (size_t)(j * 2 + n) * 1024 * 64, 64, W + (size_t)(4096 + 64 * n) * 1024, 1024, 1024, 64, t, 0, smem, TID);
  } else if (it < 1024 + 64) {
    const int u = it - 1056, n = u >> 4, t = u & 15;
    transpose_tile(p.r_a1 + (size_t)(j * 2 + n) * 1024 * 64, 64, W + (size_t)(4224 + 64 * n) * 1024, 1024, 1024, 64, t, 0, smem, TID);
  } else if (it < 1024 + 80) {
    const int t = it - 1088;
    if (j >= 1) transpose_tile(p.r_v1 + (size_t)(j - 1) * 1024 * 32, 32, W + (size_t)4352 * 1024, 1024, 1024, 32, t, 0, smem, TID);
  } else {
    const int t = it - 1104;
    transpose_tile(p.r_w_out + (size_t)j * 1024 * 1024, 1024, W + (size_t)4384 * 1024, 1024, 1024, 1024, t >> 4, t & 15, smem, TID);
  }
}
constexpr int N_FWPREP = 512, N_RWPREP = 1360;

DI void fourier_cw_prep(const Params& p, int j, int it, char* smem, const int TID) {
  bf16_t* FWU = (bf16_t*)(p.ws + 5 * SLOT);
  bf16_t* CWT = FWU + 1024 * 1024;
  const int tid = TID;
  if (it < 256) {
#pragma unroll
    for (int i = 0; i < 4; ++i) {
      const int row = it * 4 + i;
      const float4 v = *(const float4*)(p.f_w_in + (size_t)j * 1024 * 2048 + (size_t)row * 2048 + tid * 4);
      *(uint2*)(FWU + (size_t)row * 1024 + tid * 4) = make_uint2(pack2(v.x, v.y), pack2(v.z, v.w));
    }
  } else {
    float* tab = (float*)smem;
    __syncthreads();
    if (tid < 128) tab[tid] = cospif((float)tid / 64.f);
    __syncthreads();
    const int u = it - 256, pq = u >> 7, g = (u >> 4) & 7, cb = u & 15;
    const int e = tid & 127, cbase = cb * 8 + (tid >> 7) * 4;
    const float* wm = p.f_w_mix + ((size_t)j * 8 + g) * 128 * 128;
    const int off = pq ? 32 : 0;
    float a0 = 0.f, a1 = 0.f, a2 = 0.f, a3 = 0.f;
#pragma unroll 8
    for (int c2 = 0; c2 < 128; ++c2) {
      const float wv = wm[c2 * 128 + e];
      a0 += tab[((cbase + 0) * c2 - off) & 127] * wv;
      a1 += tab[((cbase + 1) * c2 - off) & 127] * wv;
      a2 += tab[((cbase + 2) * c2 - off) & 127] * wv;
      a3 += tab[((cbase + 3) * c2 - off) & 127] * wv;
    }
    *(uint2*)(CWT + (((size_t)pq * 8 + g) * 128 + e) * 128 + cbase) = make_uint2(pack2(a0, a1), pack2(a2, a3));
  }
}
constexpr int N_CWPREP = 256 + 256;

DI void fourier_precompose(const Params& p, int it, char* smem, const int TID) {
  const bf16_t* FWU = (const bf16_t*)(p.ws + 5 * SLOT);
  const bf16_t* CWT = FWU + 1024 * 1024;
  bf16_t* W = (bf16_t*)(p.ws + OFF_W);
  const int pg = it >> 3, nt = it & 7;
  const int g = pg & 7;
  bf16_t* dst = W + (size_t)pg * 128 * 1024;
  gemm_tile<false>(CWT + (size_t)pg * 128 * 128, nullptr, nullptr, 128, FWU + g * 128, 1024, 128, 0, nt * 128, 1024, smem, TID,
                   [=](int row, int col, float v) { dst[(size_t)row * 1024 + col] = f2bf(v); });
}

DI void phase_prep0(const Params& p, char* smem, const int TID) {
  const int tid = TID;

  float* MOD = (float*)(p.ws + OFF_MOD);
  const int N_MOD = 192, N_TAB = (128 * 128 + 128 * 256 + 256 * 512 + 64 * 128) / 256;
  const int total = N_MOD + N_TAB + N_CWPREP + N_FWPREP;
  for (int it = blockIdx.x; it < total; it += gridDim.x) {
    if (it < N_MOD) {
      const int layer = it / 48, chunk = it % 48;
      const int kp = tid >> 4, cgp = tid & 15;
      const float* wbase = p.mod_w + (size_t)layer * 1024 * 3072 + chunk * 64 + cgp * 4;
      float a0[4] = {0, 0, 0, 0}, a1[4] = {0, 0, 0, 0}, a2[4] = {0, 0, 0, 0};
      float* sc = (float*)(smem + 16384);
      __syncthreads();
      for (int e = tid; e < 1024; e += 256) { sc[e] = silu_f(p.c[e]); sc[1024 + e] = silu_f(p.c[1024 + e]); sc[2048 + e] = silu_f(p.c_ctx[e]); }
      __syncthreads();
#pragma unroll 8
      for (int k = kp * 64; k < kp * 64 + 64; ++k) {
        const float4 wv = *(const float4*)(wbase + (size_t)k * 3072);
        const float s0 = sc[k], s1 = sc[1024 + k], s2 = sc[2048 + k];
        a0[0] += s0 * wv.x; a0[1] += s0 * wv.y; a0[2] += s0 * wv.z; a0[3] += s0 * wv.w;
        a1[0] += s1 * wv.x; a1[1] += s1 * wv.y; a1[2] += s1 * wv.z; a1[3] += s1 * wv.w;
        a2[0] += s2 * wv.x; a2[1] += s2 * wv.y; a2[2] += s2 * wv.z; a2[3] += s2 * wv.w;
      }
      float* red = (float*)smem;
      __syncthreads();
#pragma unroll
      for (int e = 0; e < 4; ++e) {
        red[(kp * 3 + 0) * 64 + cgp * 4 + e] = a0[e];
        red[(kp * 3 + 1) * 64 + cgp * 4 + e] = a1[e];
        red[(kp * 3 + 2) * 64 + cgp * 4 + e] = a2[e];
      }
      __syncthreads();
      if (tid < 192) {
        const int v = tid >> 6, col = tid & 63;
        float s = 0.f;
#pragma unroll
        for (int k = 0; k < 16; ++k) s += red[(k * 3 + v) * 64 + col];
        const int cidx = chunk * 64 + col;
        MOD[((size_t)layer * 3 + v) * 3072 + cidx] = s + p.mod_b[(size_t)layer * 3072 + cidx];
      }
    } else if (it < N_MOD + N_TAB) {
      int e = (it - N_MOD) * 256 + tid;
      bf16_t* F1 = (bf16_t*)(p.ws + OFF_F1);
      bf16_t* F2 = (bf16_t*)(p.ws + OFF_F2);
      bf16_t* FC = (bf16_t*)(p.ws + OFF_FC);
      float2* TW = (float2*)(p.ws + OFF_TW);
      if (e < 128 * 128) {
        const int m = e >> 7, k = e & 127;
        const int mm = m & 63, kk = k & 63;
        const float ang = (float)((mm * kk) & 63) / 32.f;
        const float cv = cospif(ang), sv = sinpif(ang);
        float val;
        if (m < 64) val = (k < 64) ? cv : -sv; else val = (k < 64) ? sv : cv;
        F1[e] = f2bf(val);
      } else if ((e -= 128 * 128) < 128 * 256) {
        const int m = e >> 8, k = e & 255, kk = k & 127;
        const float ang = (float)((m * kk) & 127) / 64.f;
        F2[e] = f2bf(k < 128 ? cospif(ang) : -sinpif(ang));
      } else if ((e -= 128 * 256) < 256 * 512) {
        const int m = e >> 9, k = e & 511, kk = k & 255;
        const float ang = (float)((m * kk) & 255) / 128.f;
        FC[e] = f2bf(k < 256 ? cospif(ang) : -sinpif(ang));
      } else {
        e -= 256 * 512;
        const int k1 = e >> 7, t2 = e & 127;
        const float ang = (float)(k1 * t2) / 4096.f;
        TW[e] = make_float2(cospif(ang), sinpif(ang));
      }
    } else if (it < N_MOD + N_TAB + N_CWPREP) {
      fourier_cw_prep(p, 0, it - N_MOD - N_TAB, smem, TID);
    } else {
      fourier_wprep(p, 0, it - N_MOD - N_TAB - N_CWPREP, smem, TID);
    }
  }
}

DI void row_items(const Params& p, int layer, bool do_post, bool do_pre, int nrows, const bf16_t* O, bf16_t* H, int it0, int nit, const int TID) {
  const int wave = TID >> 6, lane = TID & 63;
  const float* MOD = (const float*)(p.ws + OFF_MOD);
  float* XCTX = (float*)(p.ws + OFF_XCTX);
  float4 nx0, nx1, nx2, nx3;
  uint2 no0 = make_uint2(0, 0), no1 = no0, no2 = no0, no3 = no0;
#define ROW_XIN(ROW_) ((layer == 0) ? ((ROW_) < NLAT ? p.x + (size_t)(ROW_) * D : p.ctx + (size_t)((ROW_) - NLAT) * D) \
                                    : ((ROW_) < NLAT ? p.out + (size_t)(ROW_) * D : XCTX + (size_t)((ROW_) - NLAT) * D))
#define ROW_PREFETCH(ROW_) { const float* xi_ = ROW_XIN(ROW_); \
    nx0 = *(const float4*)(xi_ + lane * 4); nx1 = *(const float4*)(xi_ + 256 + lane * 4); nx2 = *(const float4*)(xi_ + 512 + lane * 4); nx3 = *(const float4*)(xi_ + 768 + lane * 4); \
    if (do_post) { const bf16_t* oi_ = O + (size_t)(ROW_) * D + lane * 4; \
      no0 = *(const uint2*)(oi_); no1 = *(const uint2*)(oi_ + 256); no2 = *(const uint2*)(oi_ + 512); no3 = *(const uint2*)(oi_ + 768); } }
  if (it0 < nit) ROW_PREFETCH(it0 * 4 + wave)
  for (int it = it0; it < nit; it += gridDim.x) {
    const int row = it * 4 + wave;
    const int v = row < 8192 ? 0 : (row < 16384 ? 1 : 2);
    float* xout = row < NLAT ? p.out + (size_t)row * D : XCTX + (size_t)(row - NLAT) * D;
    float4 xv[4] = {nx0, nx1, nx2, nx3};
    const uint2 ou[4] = {no0, no1, no2, no3};
    if (it + (int)gridDim.x < nit) ROW_PREFETCH((it + (int)gridDim.x) * 4 + wave)
    if (do_post) {
      float ov[4][4];
      float ss = 0.f;
#pragma unroll
      for (int qd = 0; qd < 4; ++qd) {
        const uint2 u = ou[qd];
        ov[qd][0] = lo2f(u.x); ov[qd][1] = hi2f(u.x); ov[qd][2] = lo2f(u.y); ov[qd][3] = hi2f(u.y);
#pragma unroll
        for (int e = 0; e < 4; ++e) ss += ov[qd][e] * ov[qd][e];
      }
      ss = wave_sum(ss);
      const float rstd = rsqrtf(ss * (1.f / 1024.f) + RMS_EPS);
      const float* gate = MOD + ((size_t)layer * 3 + v) * 3072 + 2048;
      const float* np = p.norm_post + (size_t)layer * D;
#pragma unroll
      for (int qd = 0; qd < 4; ++qd) {
        const float4 gv = *(const float4*)(gate + qd * 256 + lane * 4);
        const float4 nv = *(const float4*)(np + qd * 256 + lane * 4);
        xv[qd].x += gv.x * (ov[qd][0] * rstd * nv.x);
        xv[qd].y += gv.y * (ov[qd][1] * rstd * nv.y);
        xv[qd].z += gv.z * (ov[qd][2] * rstd * nv.z);
        xv[qd].w += gv.w * (ov[qd][3] * rstd * nv.w);
        *(float4*)(xout + qd * 256 + lane * 4) = xv[qd];
      }
    }
    if (do_pre) {
      const int L = layer + (do_post ? 1 : 0);
      float ss = 0.f;
#pragma unroll
      for (int qd = 0; qd < 4; ++qd) ss += xv[qd].x * xv[qd].x + xv[qd].y * xv[qd].y + xv[qd].z * xv[qd].z + xv[qd].w * xv[qd].w;
      ss = wave_sum(ss);
      const float rstd = rsqrtf(ss * (1.f / 1024.f) + RMS_EPS);
      const float* sh = MOD + ((size_t)L * 3 + v) * 3072;
      const float* sc = sh + 1024;
      const float* np = p.norm_pre + (size_t)L * D;
#pragma unroll
      for (int qd = 0; qd < 4; ++qd) {
        const float4 a = *(const float4*)(sh + qd * 256 + lane * 4);
        const float4 b = *(const float4*)(sc + qd * 256 + lane * 4);
        const float4 n = *(const float4*)(np + qd * 256 + lane * 4);
        const float h0 = xv[qd].x * rstd * n.x * (1.f + b.x) + a.x;
        const float h1 = xv[qd].y * rstd * n.y * (1.f + b.y) + a.y;
        const float h2 = xv[qd].z * rstd * n.z * (1.f + b.z) + a.z;
        const float h3 = xv[qd].w * rstd * n.w * (1.f + b.w) + a.w;
        *(uint2*)(H + (size_t)row * D + qd * 256 + lane * 4) = make_uint2(pack2(h0, h1), pack2(h2, h3));
      }
    }
  }
}

#undef ROW_XIN
#undef ROW_PREFETCH
DI int seq_row(int n, int b, int s) {
  if (s < 256) { const int t = n ? 255 - s : s; return NLAT + b * 256 + t; }
  const int u = s - 256; const int t = n ? 8191 - u : u; return b * 8192 + t;
}
DI void scan_chain(const Params& p, int j, int cid, const bf16_t* R, const bf16_t* Kb, const bf16_t* V, bf16_t* Y0, bf16_t* Y1, char* smem, const int TID) {
  const int n = cid >> 5, b = (cid >> 4) & 1, h = cid & 15;
  const int tid = TID;
  float* rS = (float*)smem;
  float* wS = rS + 1024; float* kS = wS + 1024; float* vS = kS + 1024; float* aS = vS + 1024; float* bS = aS + 1024;
  float* lwS = bS + 1024; float* laS = lwS + 1024;
  float* w2S = laS + 1024;
  float* a2S = w2S + 4096;
  float* yS = lwS;
  const bf16_t* LW = (const bf16_t*)(p.ws + OFF_LW);
  const bf16_t* LA = (const bf16_t*)(p.ws + OFF_LA);
  float* BON = (float*)(p.ws + OFF_BON);
  bf16_t* Y = n ? Y1 : Y0;
  __syncthreads();
  {
    const float* w2 = p.r_w2 + (size_t)(j * 2 + n) * 64 * 1024 + h * 64;
    const float* a2 = p.r_a2 + (size_t)(j * 2 + n) * 64 * 1024 + h * 64;
    for (int e = tid; e < 4096; e += 256) { w2S[e] = w2[(size_t)(e >> 6) * 1024 + (e & 63)]; a2S[e] = a2[(size_t)(e >> 6) * 1024 + (e & 63)]; }
  }
  const int ltok = tid >> 4, cq = tid & 15, c4 = cq * 4;
  const int gc = h * 64 + c4;
  const float4 w0v = *(const float4*)(p.r_w0 + (size_t)(j * 2 + n) * 1024 + gc);
  const float4 a0v = *(const float4*)(p.r_a0 + (size_t)(j * 2 + n) * 1024 + gc);
  const float4 kkv = *(const float4*)(p.r_k_k + (size_t)j * 1024 + gc);
  const float4 kav = *(const float4*)(p.r_k_a + (size_t)j * 1024 + gc);
  const float4 rkv = *(const float4*)(p.r_r_k + (size_t)j * 1024 + gc);
  const int si = tid >> 2, jq = tid & 3;
  float S[16];
#pragma unroll
  for (int e = 0; e < 16; ++e) S[e] = 0.f;
  for (int ck = 0; ck < 528; ++ck) {
    const int s = ck * 16 + ltok;
    const int row = seq_row(n, b, s);
    const uint2 ur = *(const uint2*)(R + (size_t)row * D + gc);
    const uint2 uk = *(const uint2*)(Kb + (size_t)row * D + gc);
    const uint2 uv = *(const uint2*)(V + (size_t)row * D + gc);
    const uint2 ulw = *(const uint2*)(LW + (size_t)row * 128 + n * 64 + c4);
    const uint2 ula = *(const uint2*)(LA + (size_t)row * 128 + n * 64 + c4);
    __syncthreads();
    *(float4*)(lwS + ltok * 64 + c4) = make_float4(lo2f(ulw.x), hi2f(ulw.x), lo2f(ulw.y), hi2f(ulw.y));
    *(float4*)(laS + ltok * 64 + c4) = make_float4(lo2f(ula.x), hi2f(ula.x), lo2f(ula.y), hi2f(ula.y));
    __syncthreads();
    float wz[4] = {w0v.x, w0v.y, w0v.z, w0v.w}, az[4] = {a0v.x, a0v.y, a0v.z, a0v.w};
    for (int l = 0; l < 64; ++l) {
      const float lw = lwS[ltok * 64 + l], la = laS[ltok * 64 + l];
      const float4 w2v = *(const float4*)(w2S + l * 64 + c4);
      const float4 a2v = *(const float4*)(a2S + l * 64 + c4);
      wz[0] += lw * w2v.x; wz[1] += lw * w2v.y; wz[2] += lw * w2v.z; wz[3] += lw * w2v.w;
      az[0] += la * a2v.x; az[1] += la * a2v.y; az[2] += la * a2v.z; az[3] += la * a2v.w;
    }
    const float rr[4] = {lo2f(ur.x), hi2f(ur.x), lo2f(ur.y), hi2f(ur.y)};
    const float kr[4] = {lo2f(uk.x), hi2f(uk.x), lo2f(uk.y), hi2f(uk.y)};
    const float vr[4] = {lo2f(uv.x), hi2f(uv.x), lo2f(uv.y), hi2f(uv.y)};
    const float kkw[4] = {kkv.x, kkv.y, kkv.z, kkv.w}, kaw[4] = {kav.x, kav.y, kav.z, kav.w}, rkw[4] = {rkv.x, rkv.y, rkv.z, rkv.w};
    float kk[4], ss = 0.f;
#pragma unroll
    for (int e = 0; e < 4; ++e) { kk[e] = kr[e] * kkw[e]; ss += kk[e] * kk[e]; }
#pragma unroll
    for (int o = 8; o > 0; o >>= 1) ss += __shfl_xor(ss, o, 64);
    const float inv = 1.f / fmaxf(sqrtf(ss), 1e-12f);
    float dec[4], as[4], kd[4], bb[4], bon = 0.f;
#pragma unroll
    for (int e = 0; e < 4; ++e) {
      kk[e] *= inv;
      dec[e] = __expf(-__expf(-softplus_f(-wz[e]) - 0.5f));
      as[e] = sigmoid_f(az[e]);
      kd[e] = kr[e] * (1.f + (as[e] - 1.f) * kaw[e]);
      bb[e] = kk[e] * as[e];
      bon += rr[e] * kd[e] * rkw[e];
    }
#pragma unroll
    for (int o = 8; o > 0; o >>= 1) bon += __shfl_xor(bon, o, 64);
    if (cq == 0) BON[((size_t)n * NR + row) * 16 + h] = bon;
    *(float4*)(rS + ltok * 64 + c4) = make_float4(rr[0], rr[1], rr[2], rr[3]);
    *(float4*)(wS + ltok * 64 + c4) = make_float4(dec[0], dec[1], dec[2], dec[3]);
    *(float4*)(kS + ltok * 64 + c4) = make_float4(kd[0], kd[1], kd[2], kd[3]);
    *(float4*)(vS + ltok * 64 + c4) = make_float4(vr[0], vr[1], vr[2], vr[3]);
    *(float4*)(aS + ltok * 64 + c4) = make_float4(-kk[0], -kk[1], -kk[2], -kk[3]);
    *(float4*)(bS + ltok * 64 + c4) = make_float4(bb[0], bb[1], bb[2], bb[3]);
    __syncthreads();
    for (int t = 0; t < 16; ++t) {
      float av[16], sa = 0.f;
#pragma unroll
      for (int m = 0; m < 4; ++m) {
        const float4 a4 = *(const float4*)(aS + t * 64 + jq * 16 + m * 4);
        av[m * 4] = a4.x; av[m * 4 + 1] = a4.y; av[m * 4 + 2] = a4.z; av[m * 4 + 3] = a4.w;
      }
#pragma unroll
      for (int e = 0; e < 16; ++e) sa += S[e] * av[e];
      sa += __shfl_xor(sa, 1, 64);
      sa += __shfl_xor(sa, 2, 64);
      const float vi = vS[t * 64 + si];
      float y = 0.f;
#pragma unroll
      for (int m = 0; m < 4; ++m) {
        const float4 w4 = *(const float4*)(wS + t * 64 + jq * 16 + m * 4);
        const float4 b4 = *(const float4*)(bS + t * 64 + jq * 16 + m * 4);
        const float4 k4 = *(const float4*)(kS + t * 64 + jq * 16 + m * 4);
        const float4 r4 = *(const float4*)(rS + t * 64 + jq * 16 + m * 4);
        S[m * 4 + 0] = S[m * 4 + 0] * w4.x + sa * b4.x + vi * k4.x; y += S[m * 4 + 0] * r4.x;
        S[m * 4 + 1] = S[m * 4 + 1] * w4.y + sa * b4.y + vi * k4.y; y += S[m * 4 + 1] * r4.y;
        S[m * 4 + 2] = S[m * 4 + 2] * w4.z + sa * b4.z + vi * k4.z; y += S[m * 4 + 2] * r4.z;
        S[m * 4 + 3] = S[m * 4 + 3] * w4.w + sa * b4.w + vi * k4.w; y += S[m * 4 + 3] * r4.w;
      }
      y += __shfl_xor(y, 1, 64);
      y += __shfl_xor(y, 2, 64);
      if (jq == 0) yS[t * 64 + si] = y;
    }
    __syncthreads();
    {
      const float4 yv = *(const float4*)(yS + ltok * 64 + c4);
      *(uint2*)(Y + (size_t)row * D + gc) = make_uint2(pack2(yv.x, yv.y), pack2(yv.z, yv.w));
    }
  }
}


constexpr int CS_W2T = 0, CS_A2T = 9216, CS_R1 = 18432, CS_R2 = 27648, CS_R3 = 36864, CS_WZ = 46080, CS_AZ = 62464,
              CS_AT = 78848, CS_RT = 88064, CS_BT = 97280, CS_KT = 106496, CS_VT = 115712, CS_AAB = 124928, CS_UV = 142336,
              CS_S0T = 151552, CS_TOT = 160768, CS_CL = 161792, CS_CST = 162048, CS_END = 163328;
DI s16x8 lds_row8(const char* base, int row, int col) { return *(const s16x8*)(base + row * 144 + col * 2); }
DI s16x8 lds_tr8(const char* base, int krow0, int ncol0, int lane) {
  const int g = lane >> 4, li = lane & 15, qq = li >> 2, pp = li & 3;
  const int off = (krow0 + 8 * (g >> 1) + qq) * 144 + (ncol0 + 16 * (g & 1) + 4 * pp) * 2;
  const s16x4 lo = __builtin_amdgcn_ds_read_tr16_b64_v4i16((__attribute__((address_space(3))) s16x4*)(base + off));
  const s16x4 hi = __builtin_amdgcn_ds_read_tr16_b64_v4i16((__attribute__((address_space(3))) s16x4*)(base + off + 4 * 144));
  return __builtin_shufflevector(lo, hi, 0, 1, 2, 3, 4, 5, 6, 7);
}
DI void unpack16(const uint4 a, const uint4 b, float* f) {
  f[0] = lo2f(a.x); f[1] = hi2f(a.x); f[2] = lo2f(a.y); f[3] = hi2f(a.y); f[4] = lo2f(a.z); f[5] = hi2f(a.z); f[6] = lo2f(a.w); f[7] = hi2f(a.w);
  f[8] = lo2f(b.x); f[9] = hi2f(b.x); f[10] = lo2f(b.y); f[11] = hi2f(b.y); f[12] = lo2f(b.z); f[13] = hi2f(b.z); f[14] = lo2f(b.w); f[15] = hi2f(b.w);
}
DI void store16bf(char* dst, const float* f) {
  *(uint4*)dst = make_uint4(pack2(f[0], f[1]), pack2(f[2], f[3]), pack2(f[4], f[5]), pack2(f[6], f[7]));
  *(uint4*)(dst + 16) = make_uint4(pack2(f[8], f[9]), pack2(f[10], f[11]), pack2(f[12], f[13]), pack2(f[14], f[15]));
}
constexpr int NSEG = 4, SEGCH = 33;
template <int MODE>
DI void scan_chain_chunked(const Params& p, int j, int cid, int seg, float* SCR, const bf16_t* R, const bf16_t* Kb, const bf16_t* V, bf16_t* Y0, bf16_t* Y1, char* smem, const int TID) {
  const int n = cid >> 5, b = (cid >> 4) & 1, hd = cid & 15;
  const int tid = TID, lane = tid & 63, w = tid >> 6, l31 = lane & 31, hh = lane >> 5;
  const int mi = w >> 1, ni = w & 1;
  const int tok = tid >> 2, q = tid & 3, c0 = 16 * q;
  const bf16_t* LW = (const bf16_t*)(p.ws + OFF_LW);
  const bf16_t* LA = (const bf16_t*)(p.ws + OFF_LA);
  float* BON = (float*)(p.ws + OFF_BON);
  bf16_t* Y = n ? Y1 : Y0;
  float* WZ = (float*)(smem + CS_WZ);
  float* AZ = (float*)(smem + CS_AZ);
  float* AABD = (float*)(smem + CS_AAB + 9216);
  float* TOT = (float*)(smem + CS_TOT);
  float* CL = (float*)(smem + CS_CL);
  float* CST = (float*)(smem + CS_CST);
  __syncthreads();
  {
    const float* w2 = p.r_w2 + (size_t)(j * 2 + n) * 64 * 1024 + hd * 64;
    const float* a2 = p.r_a2 + (size_t)(j * 2 + n) * 64 * 1024 + hd * 64;
    for (int e = tid; e < 4096; e += 256) {
      const int l = e >> 6, col = e & 63;
      *(bf16_t*)(smem + CS_W2T + col * 144 + l * 2) = f2bf(w2[(size_t)l * 1024 + col]);
      *(bf16_t*)(smem + CS_A2T + col * 144 + l * 2) = f2bf(a2[(size_t)l * 1024 + col]);
    }
    for (int e = tid; e < 64 * 72; e += 256) *(bf16_t*)(smem + CS_S0T + e * 2) = 0;
    if (tid < 64) {
      CST[tid] = p.r_w0[(size_t)(j * 2 + n) * 1024 + hd * 64 + tid];
      CST[64 + tid] = p.r_a0[(size_t)(j * 2 + n) * 1024 + hd * 64 + tid];
      CST[128 + tid] = p.r_k_k[(size_t)j * 1024 + hd * 64 + tid];
      CST[192 + tid] = p.r_k_a[(size_t)j * 1024 + hd * 64 + tid];
      CST[256 + tid] = p.r_r_k[(size_t)j * 1024 + hd * 64 + tid];
    }
  }
  f32x16 Sacc, Pacc;
#pragma unroll
  for (int r = 0; r < 16; ++r) { Sacc[r] = 0.f; Pacc[r] = 0.f; }
  if (MODE == 0) {
    for (int e = tid; e < 64 * 72; e += 256) *(bf16_t*)(smem + CS_RT + e * 2) = ((e / 72) == (e % 72)) ? (bf16_t)0x3f80 : (bf16_t)0;
#pragma unroll
    for (int r = 0; r < 16; ++r) Pacc[r] = ((32 * mi + crow(r, hh)) == (32 * ni + l31)) ? 1.f : 0.f;
  } else if (seg > 0) {
    const int jr = tid >> 2, ib = (tid & 3) * 16;
    const float* PQ = SCR + (size_t)(cid * 3) * 8192;
    float nv[16];
#pragma unroll
    for (int e = 0; e < 16; ++e) nv[e] = PQ[4096 + jr * 64 + ib + e];
    for (int sg = 1; sg < seg; ++sg) {
      __syncthreads();
#pragma unroll
      for (int e = 0; e < 16; ++e) WZ[jr * 64 + ib + e] = nv[e];
      __syncthreads();
      const float* Pm = PQ + (size_t)sg * 8192;
#pragma unroll
      for (int e = 0; e < 16; ++e) nv[e] = Pm[4096 + jr * 64 + ib + e];
      for (int jp = 0; jp < 64; jp += 4) {
        const float4 pv = *(const float4*)(Pm + jr * 64 + jp);
#pragma unroll
        for (int e = 0; e < 16; ++e)
          nv[e] += pv.x * WZ[(jp + 0) * 64 + ib + e] + pv.y * WZ[(jp + 1) * 64 + ib + e] + pv.z * WZ[(jp + 2) * 64 + ib + e] + pv.w * WZ[(jp + 3) * 64 + ib + e];
      }
    }
    __syncthreads();
#pragma unroll
    for (int e = 0; e < 16; ++e) WZ[jr * 64 + ib + e] = nv[e];
    __syncthreads();
#pragma unroll
    for (int r = 0; r < 16; ++r) {
      const int rrow = 32 * mi + crow(r, hh), ccol = 32 * ni + l31;
      Sacc[r] = WZ[rrow * 64 + ccol];
      *(bf16_t*)(smem + CS_S0T + rrow * 144 + ccol * 2) = f2bf(Sacc[r]);
    }
    __syncthreads();
  }
  const int ck0 = seg * SEGCH, ck1 = ck0 + SEGCH;
  uint4 ur0, ur1, uk0, uk1, uv0, uv1, l0, l1, m0, m1;
#define SCAN_LOAD(CK) { const int row_ = seq_row(n, b, (CK) * 64 + tok); const size_t g_ = (size_t)row_ * D + hd * 64 + c0; \
    ur0 = *(const uint4*)(R + g_); ur1 = *(const uint4*)(R + g_ + 8); uk0 = *(const uint4*)(Kb + g_); uk1 = *(const uint4*)(Kb + g_ + 8); \
    uv0 = *(const uint4*)(V + g_); uv1 = *(const uint4*)(V + g_ + 8); \
    l0 = *(const uint4*)(LW + (size_t)row_ * 128 + n * 64 + c0); l1 = *(const uint4*)(LW + (size_t)row_ * 128 + n * 64 + c0 + 8); \
    m0 = *(const uint4*)(LA + (size_t)row_ * 128 + n * 64 + c0); m1 = *(const uint4*)(LA + (size_t)row_ * 128 + n * 64 + c0 + 8); }
  SCAN_LOAD(ck0)
  for (int ck = ck0; ck < ck1; ++ck) {
    const int row = seq_row(n, b, ck * 64 + tok);
    *(uint4*)(smem + CS_R1 + tok * 144 + c0 * 2) = l0; *(uint4*)(smem + CS_R1 + tok * 144 + c0 * 2 + 16) = l1;
    *(uint4*)(smem + CS_R2 + tok * 144 + c0 * 2) = m0; *(uint4*)(smem + CS_R2 + tok * 144 + c0 * 2 + 16) = m1;
    __syncthreads();
    {
      f32x16 awz, aaz;
#pragma unroll
      for (int r = 0; r < 16; ++r) { awz[r] = 0.f; aaz[r] = 0.f; }
#pragma unroll
      for (int kk = 0; kk < 4; ++kk) {
        const s16x8 alw = lds_row8(smem + CS_R1, 32 * mi + l31, kk * 16 + 8 * hh);
        const s16x8 ala = lds_row8(smem + CS_R2, 32 * mi + l31, kk * 16 + 8 * hh);
        const s16x8 bw = lds_row8(smem + CS_W2T, 32 * ni + l31, kk * 16 + 8 * hh);
        const s16x8 ba = lds_row8(smem + CS_A2T, 32 * ni + l31, kk * 16 + 8 * hh);
        awz = MFMA(alw, bw, awz);
        aaz = MFMA(ala, ba, aaz);
      }
#pragma unroll
      for (int r = 0; r < 16; ++r) {
        const int t = 32 * mi + crow(r, hh), col = 32 * ni + l31;
        WZ[t * 64 + col] = awz[r];
        AZ[t * 64 + col] = aaz[r];
      }
    }
    __syncthreads();
    float lw[16], rr[16], kd[16], av[16], bb[16];
    {
      float kr[16], cw0[16], ca0[16], ckk[16], cka[16], crk[16], wzv[16], azv[16];
      unpack16(ur0, ur1, rr);
      unpack16(uk0, uk1, kr);
#pragma unroll
      for (int e4 = 0; e4 < 4; ++e4) {
        const float4 v0 = *(const float4*)(CST + c0 + e4 * 4), v1 = *(const float4*)(CST + 64 + c0 + e4 * 4), v2 = *(const float4*)(CST + 128 + c0 + e4 * 4);
        const float4 v3 = *(const float4*)(CST + 192 + c0 + e4 * 4), v4 = *(const float4*)(CST + 256 + c0 + e4 * 4);
        const float4 v5 = *(const float4*)(WZ + tok * 64 + c0 + e4 * 4), v6 = *(const float4*)(AZ + tok * 64 + c0 + e4 * 4);
        cw0[e4 * 4] = v0.x; cw0[e4 * 4 + 1] = v0.y; cw0[e4 * 4 + 2] = v0.z; cw0[e4 * 4 + 3] = v0.w;
        ca0[e4 * 4] = v1.x; ca0[e4 * 4 + 1] = v1.y; ca0[e4 * 4 + 2] = v1.z; ca0[e4 * 4 + 3] = v1.w;
        ckk[e4 * 4] = v2.x; ckk[e4 * 4 + 1] = v2.y; ckk[e4 * 4 + 2] = v2.z; ckk[e4 * 4 + 3] = v2.w;
        cka[e4 * 4] = v3.x; cka[e4 * 4 + 1] = v3.y; cka[e4 * 4 + 2] = v3.z; cka[e4 * 4 + 3] = v3.w;
        crk[e4 * 4] = v4.x; crk[e4 * 4 + 1] = v4.y; crk[e4 * 4 + 2] = v4.z; crk[e4 * 4 + 3] = v4.w;
        wzv[e4 * 4] = v5.x; wzv[e4 * 4 + 1] = v5.y; wzv[e4 * 4 + 2] = v5.z; wzv[e4 * 4 + 3] = v5.w;
        azv[e4 * 4] = v6.x; azv[e4 * 4 + 1] = v6.y; azv[e4 * 4 + 2] = v6.z; azv[e4 * 4 + 3] = v6.w;
      }
      float ss = 0.f;
#pragma unroll
      for (int e = 0; e < 16; ++e) { av[e] = kr[e] * ckk[e]; ss += av[e] * av[e]; }
      ss += __shfl_xor(ss, 1, 64);
      ss += __shfl_xor(ss, 2, 64);
      const float inv = __frsqrt_rn(fmaxf(ss, 1e-24f));
      float bon = 0.f;
#pragma unroll
      for (int e = 0; e < 16; ++e) {
        const float wz = wzv[e] + cw0[e];
        const float az = azv[e] + ca0[e];
        lw[e] = -0.60653066f * fsig(wz);
        const float as = fsig(az);
        const float kkn = av[e] * inv;
        kd[e] = kr[e] * (1.f + (as - 1.f) * cka[e]);
        bb[e] = kkn * as;
        av[e] = -kkn;
        bon += rr[e] * kd[e] * crk[e];
      }
#pragma unroll
      for (int e4 = 0; e4 < 4; ++e4) *(float4*)(WZ + tok * 64 + c0 + e4 * 4) = make_float4(lw[e4 * 4], lw[e4 * 4 + 1], lw[e4 * 4 + 2], lw[e4 * 4 + 3]);
      bon += __shfl_xor(bon, 1, 64);
      bon += __shfl_xor(bon, 2, 64);
      if (MODE == 1 && q == 0) BON[((size_t)n * NR + row) * 16 + hd] = bon;
    }
    __syncthreads();
    {
      const int col = tid & 63, qt = tid >> 6;
      float pv[16];
#pragma unroll
      for (int t = 0; t < 16; ++t) pv[t] = WZ[(16 * qt + t) * 64 + col];
      float sacc = 0.f;
#pragma unroll
      for (int t = 0; t < 16; ++t) { sacc += pv[t]; WZ[(16 * qt + t) * 64 + col] = sacc; }
      TOT[qt * 64 + col] = sacc;
    }
    __syncthreads();
    {
      float fa[16], fr[16], fb[16], fk[16], fv[16];
      unpack16(uv0, uv1, fv);
      const int qt = tok >> 4;
      float tb[16], tt[16], cum[16];
#pragma unroll
      for (int e4 = 0; e4 < 4; ++e4) {
        const float4 t0 = *(const float4*)(TOT + c0 + e4 * 4), t1 = *(const float4*)(TOT + 64 + c0 + e4 * 4);
        const float4 t2 = *(const float4*)(TOT + 128 + c0 + e4 * 4), t3 = *(const float4*)(TOT + 192 + c0 + e4 * 4);
        const float4 cv = *(const float4*)(WZ + tok * 64 + c0 + e4 * 4);
        const float m0_ = qt > 0 ? 1.f : 0.f, m1_ = qt > 1 ? 1.f : 0.f, m2_ = qt > 2 ? 1.f : 0.f;
        tb[e4 * 4] = m0_ * t0.x + m1_ * t1.x + m2_ * t2.x; tb[e4 * 4 + 1] = m0_ * t0.y + m1_ * t1.y + m2_ * t2.y;
        tb[e4 * 4 + 2] = m0_ * t0.z + m1_ * t1.z + m2_ * t2.z; tb[e4 * 4 + 3] = m0_ * t0.w + m1_ * t1.w + m2_ * t2.w;
        tt[e4 * 4] = t0.x + t1.x + t2.x + t3.x; tt[e4 * 4 + 1] = t0.y + t1.y + t2.y + t3.y;
        tt[e4 * 4 + 2] = t0.z + t1.z + t2.z + t3.z; tt[e4 * 4 + 3] = t0.w + t1.w + t2.w + t3.w;
        cum[e4 * 4] = cv.x; cum[e4 * 4 + 1] = cv.y; cum[e4 * 4 + 2] = cv.z; cum[e4 * 4 + 3] = cv.w;
      }
#pragma unroll
      for (int e = 0; e < 16; ++e) {
        const float incl = cum[e] + tb[e];
        const float excl = incl - lw[e];
        const float ei = __expf(incl), ee = __expf(excl), nin = __builtin_amdgcn_rcpf(ei);
        fa[e] = av[e] * ee; fr[e] = rr[e] * ei; fb[e] = bb[e] * nin; fk[e] = kd[e] * nin;
      }
#pragma unroll
      for (int e4 = 0; e4 < 4; ++e4) {
        *(float4*)(WZ + tok * 64 + c0 + e4 * 4) = make_float4(fa[e4 * 4], fa[e4 * 4 + 1], fa[e4 * 4 + 2], fa[e4 * 4 + 3]);
        if (tok == 0) *(float4*)(CL + c0 + e4 * 4) = make_float4(__expf(tt[e4 * 4]), __expf(tt[e4 * 4 + 1]), __expf(tt[e4 * 4 + 2]), __expf(tt[e4 * 4 + 3]));
      }
      store16bf(smem + CS_AT + tok * 144 + c0 * 2, fa);
      if (MODE == 1) store16bf(smem + CS_RT + tok * 144 + c0 * 2, fr);
      store16bf(smem + CS_BT + tok * 144 + c0 * 2, fb);
      store16bf(smem + CS_KT + tok * 144 + c0 * 2, fk);
      *(uint4*)(smem + CS_VT + tok * 144 + c0 * 2) = uv0;
      *(uint4*)(smem + CS_VT + tok * 144 + c0 * 2 + 16) = uv1;
    }
    if (ck + 1 < ck1) SCAN_LOAD(ck + 1)
    __syncthreads();
    {
      f32x16 ab, ak, rb, rk;
#pragma unroll
      for (int r = 0; r < 16; ++r) { ab[r] = 0.f; ak[r] = 0.f; rb[r] = 0.f; rk[r] = 0.f; }
      if (mi >= ni) {
#pragma unroll
        for (int kk = 0; kk < 4; ++kk) {
          const s16x8 aA = lds_row8(smem + CS_AT, 32 * mi + l31, kk * 16 + 8 * hh);
          const s16x8 aR = lds_row8(smem + CS_RT, 32 * mi + l31, kk * 16 + 8 * hh);
          const s16x8 bB = lds_row8(smem + CS_BT, 32 * ni + l31, kk * 16 + 8 * hh);
          const s16x8 bK = lds_row8(smem + CS_KT, 32 * ni + l31, kk * 16 + 8 * hh);
          ab = MFMA(aA, bB, ab); ak = MFMA(aA, bK, ak);
          if (MODE == 1) { rb = MFMA(aR, bB, rb); rk = MFMA(aR, bK, rk); }
        }
      }
#pragma unroll
      for (int r = 0; r < 16; ++r) {
        const int t = 32 * mi + crow(r, hh), sx = 32 * ni + l31;
        const bool lo_s = sx < t, lo_i = sx <= t;
        *(bf16_t*)(smem + CS_AAB + t * 144 + sx * 2) = f2bf(lo_s ? ab[r] : 0.f);
        if ((t >> 4) == (sx >> 4)) AABD[(t >> 4) * 256 + (t & 15) * 16 + (sx & 15)] = lo_s ? ab[r] : 0.f;
        *(bf16_t*)(smem + CS_R1 + t * 144 + sx * 2) = f2bf(lo_s ? ak[r] : 0.f);
        if (MODE == 1) {
          *(bf16_t*)(smem + CS_R2 + t * 144 + sx * 2) = f2bf(lo_i ? rb[r] : 0.f);
          *(bf16_t*)(smem + CS_R3 + t * 144 + sx * 2) = f2bf(lo_i ? rk[r] : 0.f);
        }
      }
    }
    __syncthreads();
    {
      f32x16 xu;
#pragma unroll
      for (int r = 0; r < 16; ++r) xu[r] = 0.f;
#pragma unroll
      for (int kk = 0; kk < 4; ++kk) {
        const s16x8 a = lds_row8(smem + CS_R1, 32 * mi + l31, kk * 16 + 8 * hh);
        const s16x8 bv = lds_tr8(smem + CS_VT, kk * 16, 32 * ni, lane);
        xu = MFMA(a, bv, xu);
      }
#pragma unroll
      for (int r = 0; r < 16; ++r) AZ[(32 * mi + crow(r, hh)) * 64 + 32 * ni + l31] = xu[r];
    }
    __syncthreads();
#pragma unroll
    for (int bk = 0; bk < 4; ++bk) {
      if (tid < 128) {
        float* rhs = (tid < 64) ? (WZ + tid) : (AZ + (tid - 64));
        float x[16], am[16][16];
#pragma unroll
        for (int r = 0; r < 16; ++r) x[r] = rhs[(16 * bk + r) * 64];
#pragma unroll
        for (int tp = 1; tp < 16; ++tp) {
#pragma unroll
          for (int s4 = 0; s4 < (tp + 3) / 4; ++s4) {
            const float4 v = *(const float4*)(AABD + bk * 256 + tp * 16 + s4 * 4);
            am[tp][s4 * 4] = v.x; am[tp][s4 * 4 + 1] = v.y; am[tp][s4 * 4 + 2] = v.z; am[tp][s4 * 4 + 3] = v.w;
          }
        }
#pragma unroll
        for (int sx = 0; sx < 15; ++sx) {
          const float xs = x[sx];
#pragma unroll
          for (int tp = sx + 1; tp < 16; ++tp) x[tp] = fmaf(am[tp][sx], xs, x[tp]);
        }
        char* dst = (tid < 64) ? (smem + CS_AT + tid * 2) : (smem + CS_UV + (tid - 64) * 2);
#pragma unroll
        for (int r = 0; r < 16; ++r) *(bf16_t*)(dst + (16 * bk + r) * 144) = f2bf(x[r]);
      }
      __syncthreads();
      if (bk < 3) {
        const char* xsrc = (w < 2) ? (smem + CS_AT) : (smem + CS_UV);
        float* rdst = (w < 2) ? WZ : AZ;
        const s16x8 bx = lds_tr8(xsrc, 16 * bk, 32 * (w & 1), lane);
#pragma unroll
        for (int rt = 0; rt < 2; ++rt) {
          if (32 * rt + 31 >= 16 * (bk + 1)) {
            f32x16 up;
#pragma unroll
            for (int r = 0; r < 16; ++r) up[r] = 0.f;
            const s16x8 aa = lds_row8(smem + CS_AAB, 32 * rt + l31, 16 * bk + 8 * hh);
            up = MFMA(aa, bx, up);
#pragma unroll
            for (int r = 0; r < 16; ++r) rdst[(32 * rt + crow(r, hh)) * 64 + 32 * (w & 1) + l31] += up[r];
          }
        }
        __syncthreads();
      }
    }
    f32x16 rh, yl, mm, cc;
#pragma unroll
    for (int r = 0; r < 16; ++r) { rh[r] = 0.f; yl[r] = 0.f; mm[r] = 0.f; cc[r] = 0.f; }
#pragma unroll
    for (int kk = 0; kk < 4; ++kk) {
      const s16x8 aRB = lds_row8(smem + CS_R2, 32 * mi + l31, kk * 16 + 8 * hh);
      const s16x8 aRK = lds_row8(smem + CS_R3, 32 * mi + l31, kk * 16 + 8 * hh);
      const s16x8 tAH = lds_tr8(smem + CS_AT, kk * 16, 32 * ni, lane);
      const s16x8 tUV = lds_tr8(smem + CS_UV, kk * 16, 32 * ni, lane);
      const s16x8 tVT = lds_tr8(smem + CS_VT, kk * 16, 32 * ni, lane);
      const s16x8 tBT = lds_tr8(smem + CS_BT, kk * 16, 32 * mi, lane);
      const s16x8 tKT = lds_tr8(smem + CS_KT, kk * 16, 32 * mi, lane);
      if (MODE == 1) {
        rh = MFMA(aRB, tAH, rh);
        yl = MFMA(aRB, tUV, yl);
        yl = MFMA(aRK, tVT, yl);
      }
      mm = MFMA(tBT, tAH, mm);
      cc = MFMA(tBT, tUV, cc);
      cc = MFMA(tKT, tVT, cc);
    }
#pragma unroll
    for (int r = 0; r < 16; ++r) if (MODE == 1) rh[r] += bf2f(*(const bf16_t*)(smem + CS_RT + (32 * mi + crow(r, hh)) * 144 + (32 * ni + l31) * 2));
    __syncthreads();
#pragma unroll
    for (int r = 0; r < 16; ++r) {
      const int rrow = 32 * mi + crow(r, hh), ccol = 32 * ni + l31;
      if (MODE == 1) *(bf16_t*)(smem + CS_R2 + rrow * 144 + ccol * 2) = f2bf(rh[r]);
      *(bf16_t*)(smem + CS_R3 + rrow * 144 + ccol * 2) = f2bf(mm[r]);
    }
    __syncthreads();
    f32x16 pp;
#pragma unroll
    for (int r = 0; r < 16; ++r) pp[r] = 0.f;
#pragma unroll
    for (int kk = 0; kk < 4; ++kk) {
      const s16x8 aMM = lds_row8(smem + CS_R3, 32 * mi + l31, kk * 16 + 8 * hh);
      const s16x8 tS = lds_tr8(smem + CS_S0T, kk * 16, 32 * ni, lane);
      if (MODE == 1) {
        const s16x8 aRH = lds_row8(smem + CS_R2, 32 * mi + l31, kk * 16 + 8 * hh);
        yl = MFMA(aRH, tS, yl);
      } else {
        const s16x8 tP = lds_tr8(smem + CS_RT, kk * 16, 32 * ni, lane);
        pp = MFMA(aMM, tP, pp);
      }
      cc = MFMA(aMM, tS, cc);
    }
#pragma unroll
    for (int r = 0; r < 16; ++r) {
      const float clv = CL[32 * mi + crow(r, hh)];
      Sacc[r] = clv * (Sacc[r] + cc[r]);
      if (MODE == 0) Pacc[r] = clv * (Pacc[r] + pp[r]);
    }
    __syncthreads();
#pragma unroll
    for (int r = 0; r < 16; ++r) {
      const int rrow = 32 * mi + crow(r, hh), ccol = 32 * ni + l31;
      *(bf16_t*)(smem + CS_S0T + rrow * 144 + ccol * 2) = f2bf(Sacc[r]);
      if (MODE == 0) *(bf16_t*)(smem + CS_RT + rrow * 144 + ccol * 2) = f2bf(Pacc[r]);
      if (MODE == 1) {
        const int yrow = seq_row(n, b, ck * 64 + rrow);
        Y[(size_t)yrow * D + hd * 64 + ccol] = f2bf(yl[r]);
      }
    }
  }
  if (MODE == 0) {
    float* PQ = SCR + (size_t)(cid * 3 + seg) * 8192;
#pragma unroll
    for (int r = 0; r < 16; ++r) {
      const int rrow = 32 * mi + crow(r, hh), ccol = 32 * ni + l31;
      PQ[rrow * 64 + ccol] = Pacc[r];
      PQ[4096 + rrow * 64 + ccol] = Sacc[r];
    }
  }
}

DI void run_phase(const Params& p, int ph, char* smem, const int TID) {
  bf16_t* T0 = (bf16_t*)(p.ws + 0 * SLOT);
  bf16_t* T1 = (bf16_t*)(p.ws + 1 * SLOT);
  bf16_t* T2 = (bf16_t*)(p.ws + 2 * SLOT);
  bf16_t* T3 = (bf16_t*)(p.ws + 3 * SLOT);
  bf16_t* T4 = (bf16_t*)(p.ws + 4 * SLOT);
  bf16_t* T5 = (bf16_t*)(p.ws + 5 * SLOT);
  bf16_t* VF = (bf16_t*)(p.ws + OFF_VF);
  bf16_t* W = (bf16_t*)(p.ws + OFF_W);
  const int tid = TID;
#ifdef ONLY_PHASE
    const int type = ONLY_PHASE, layer = p.player[ph];
#else
    const int type = p.ptype[ph], layer = p.player[ph];
#endif
    const int j = layer >> 1;
    switch (type) {
#ifdef DBG_PREPFILL
      case PH_PREP0: {
        for (size_t i = (size_t)blockIdx.x * 256 + tid; i < (size_t)(1 << 20); i += (size_t)gridDim.x * 256)
          *(uint4*)(T4 + (size_t)(2 << 20) * 8 + i * 8) = make_uint4(0x3f803f80u, 0x3f803f80u, 0x3f803f80u, 0x3f803f80u);
      } break;
#else
      case PH_PREP0: phase_prep0(p, smem, TID); break;
#endif
      case PH_PRE0: {
        for (int it = blockIdx.x; it < 128; it += gridDim.x) fourier_precompose(p, it, smem, TID);
        row_items(p, 0, false, true, NR, nullptr, T0, blockIdx.x, NR / 4, TID);
      } break;
      case PH_FGEMM1: {
        const int MT = NR / 128, NT = 12;
        for (int t = blockIdx.x; t < MT * NT; t += gridDim.x) {
          const int mt = t / NT, nt = t % NT;
          gemm_tile_n<false, 4>(T0, nullptr, nullptr, 1024, W, 1024, 1024, mt * 128, nt * 256, 3072, smem, TID, [=](int row, int col, float v) {
            bf16_t* dst = col < 1024 ? T1 : (col < 2048 ? T2 : T3);
            dst[(size_t)row * D + (col & 1023)] = f2bf(v);
          });
        }
      } break;
      case PH_FDFT1: {
        const bf16_t* F1 = (const bf16_t*)(p.ws + OFF_F1);
        const bf16_t* FC = (const bf16_t*)(p.ws + OFF_FC);
        const float2* TW = (const float2*)(p.ws + OFF_TW);
        bf16_t* YB = T4;
        const float* bmix = p.f_b_mix + (size_t)j * 1024;
        const int nctx = (layer == 3) ? 0 : 32;
        {
          constexpr int L_B = 0, L_F1 = 40960, L_TW = L_F1 + 128 * 272;
          const int lane = tid & 63, w = tid >> 6, l31 = lane & 31, hh = lane >> 5;
          const int rt0 = w & 1, ctb = 2 * (w >> 1);
          __syncthreads();
#pragma unroll
          for (int i = 0; i < 8; ++i) {
            const int c = tid + 256 * i, r = c >> 4, cc = c & 15;
            *(uint4*)(smem + L_F1 + r * 272 + cc * 16) = *(const uint4*)(F1 + r * 128 + cc * 8);
          }
#pragma unroll
          for (int i = 0; i < 16; ++i) *(uint4*)(smem + L_TW + (tid + 256 * i) * 16) = *(const uint4*)((const char*)TW + (size_t)(tid + 256 * i) * 16);
          uint4 bp0, bp1, bp2, bp3, bp4, bp5, bp6, bp7;
          const int br = tid >> 4, bcc = tid & 15;
          int it = blockIdx.x;
          if (it < 2048) {
              const int itn_ = it;
              const int b_ = itn_ >> 10, t2_ = (itn_ >> 3) & 127, cb_ = itn_ & 7;
              const size_t tok0_ = (size_t)b_ * 8192 + t2_;
              { const int kr = br + 0; bp0 = *(const uint4*)((kr < 64 ? T1 + (tok0_ + (size_t)kr * 128) * D : T2 + (tok0_ + (size_t)(kr - 64) * 128) * D) + cb_ * 128 + bcc * 8); }
              { const int kr = br + 16; bp1 = *(const uint4*)((kr < 64 ? T1 + (tok0_ + (size_t)kr * 128) * D : T2 + (tok0_ + (size_t)(kr - 64) * 128) * D) + cb_ * 128 + bcc * 8); }
              { const int kr = br + 32; bp2 = *(const uint4*)((kr < 64 ? T1 + (tok0_ + (size_t)kr * 128) * D : T2 + (tok0_ + (size_t)(kr - 64) * 128) * D) + cb_ * 128 + bcc * 8); }
              { const int kr = br + 48; bp3 = *(const uint4*)((kr < 64 ? T1 + (tok0_ + (size_t)kr * 128) * D : T2 + (tok0_ + (size_t)(kr - 64) * 128) * D) + cb_ * 128 + bcc * 8); }
              { const int kr = br + 64; bp4 = *(const uint4*)((kr < 64 ? T1 + (tok0_ + (size_t)kr * 128) * D : T2 + (tok0_ + (size_t)(kr - 64) * 128) * D) + cb_ * 128 + bcc * 8); }
              { const int kr = br + 80; bp5 = *(const uint4*)((kr < 64 ? T1 + (tok0_ + (size_t)kr * 128) * D : T2 + (tok0_ + (size_t)(kr - 64) * 128) * D) + cb_ * 128 + bcc * 8); }
              { const int kr = br + 96; bp6 = *(const uint4*)((kr < 64 ? T1 + (tok0_ + (size_t)kr * 128) * D : T2 + (tok0_ + (size_t)(kr - 64) * 128) * D) + cb_ * 128 + bcc * 8); }
              { const int kr = br + 112; bp7 = *(const uint4*)((kr < 64 ? T1 + (tok0_ + (size_t)kr * 128) * D : T2 + (tok0_ + (size_t)(kr - 64) * 128) * D) + cb_ * 128 + bcc * 8); }
            }
          for (; it < 2048; it += gridDim.x) {
            const int b = it >> 10, t2 = (it >> 3) & 127, cb = it & 7;
            __syncthreads();
            *(uint4*)(smem + L_B + (br + 0) * 320 + bcc * 16) = bp0;
            *(uint4*)(smem + L_B + (br + 16) * 320 + bcc * 16) = bp1;
            *(uint4*)(smem + L_B + (br + 32) * 320 + bcc * 16) = bp2;
            *(uint4*)(smem + L_B + (br + 48) * 320 + bcc * 16) = bp3;
            *(uint4*)(smem + L_B + (br + 64) * 320 + bcc * 16) = bp4;
            *(uint4*)(smem + L_B + (br + 80) * 320 + bcc * 16) = bp5;
            *(uint4*)(smem + L_B + (br + 96) * 320 + bcc * 16) = bp6;
            *(uint4*)(smem + L_B + (br + 112) * 320 + bcc * 16) = bp7;
            __syncthreads();
            if (it + (int)gridDim.x < 2048) {
              const int itn_ = it + (int)gridDim.x;
              const int b_ = itn_ >> 10, t2_ = (itn_ >> 3) & 127, cb_ = itn_ & 7;
              const size_t tok0_ = (size_t)b_ * 8192 + t2_;
              { const int kr = br + 0; bp0 = *(const uint4*)((kr < 64 ? T1 + (tok0_ + (size_t)kr * 128) * D : T2 + (tok0_ + (size_t)(kr - 64) * 128) * D) + cb_ * 128 + bcc * 8); }
              { const int kr = br + 16; bp1 = *(const uint4*)((kr < 64 ? T1 + (tok0_ + (size_t)kr * 128) * D : T2 + (tok0_ + (size_t)(kr - 64) * 128) * D) + cb_ * 128 + bcc * 8); }
              { const int kr = br + 32; bp2 = *(const uint4*)((kr < 64 ? T1 + (tok0_ + (size_t)kr * 128) * D : T2 + (tok0_ + (size_t)(kr - 64) * 128) * D) + cb_ * 128 + bcc * 8); }
              { const int kr = br + 48; bp3 = *(const uint4*)((kr < 64 ? T1 + (tok0_ + (size_t)kr * 128) * D : T2 + (tok0_ + (size_t)(kr - 64) * 128) * D) + cb_ * 128 + bcc * 8); }
              { const int kr = br + 64; bp4 = *(const uint4*)((kr < 64 ? T1 + (tok0_ + (size_t)kr * 128) * D : T2 + (tok0_ + (size_t)(kr - 64) * 128) * D) + cb_ * 128 + bcc * 8); }
              { const int kr = br + 80; bp5 = *(const uint4*)((kr < 64 ? T1 + (tok0_ + (size_t)kr * 128) * D : T2 + (tok0_ + (size_t)(kr - 64) * 128) * D) + cb_ * 128 + bcc * 8); }
              { const int kr = br + 96; bp6 = *(const uint4*)((kr < 64 ? T1 + (tok0_ + (size_t)kr * 128) * D : T2 + (tok0_ + (size_t)(kr - 64) * 128) * D) + cb_ * 128 + bcc * 8); }
              { const int kr = br + 112; bp7 = *(const uint4*)((kr < 64 ? T1 + (tok0_ + (size_t)kr * 128) * D : T2 + (tok0_ + (size_t)(kr - 64) * 128) * D) + cb_ * 128 + bcc * 8); }
            }
            f32x16 acc[2][2];
#pragma unroll
            for (int i = 0; i < 2; ++i)
#pragma unroll
              for (int jj = 0; jj < 2; ++jj)
#pragma unroll
                for (int r = 0; r < 16; ++r) acc[i][jj][r] = 0.f;
            const int g = lane >> 4, li = lane & 15, qq = li >> 2, pp = li & 3;
            const int tr_base = (8 * (g >> 1) + qq) * 320 + (16 * (g & 1) + 4 * pp) * 2;
#pragma unroll
            for (int ks = 0; ks < 8; ++ks) {
              s16x8 af[2];
#pragma unroll
              for (int h = 0; h < 2; ++h) af[h] = *(const s16x8*)(smem + L_F1 + (32 * (rt0 + 2 * h) + l31) * 272 + (ks * 16 + hh * 8) * 2);
#pragma unroll
              for (int c2 = 0; c2 < 2; ++c2) {
                const int off = L_B + tr_base + ks * 16 * 320 + (ctb + c2) * 64;
                const s16x4 lo = __builtin_amdgcn_ds_read_tr16_b64_v4i16((__attribute__((address_space(3))) s16x4*)(smem + off));
                const s16x4 hi = __builtin_amdgcn_ds_read_tr16_b64_v4i16((__attribute__((address_space(3))) s16x4*)(smem + off + 4 * 320));
                const s16x8 bq = __builtin_shufflevector(lo, hi, 0, 1, 2, 3, 4, 5, 6, 7);
#pragma unroll
                for (int h = 0; h < 2; ++h) acc[h][c2] = MFMA(af[h], bq, acc[h][c2]);
              }
            }
#pragma unroll
            for (int c2 = 0; c2 < 2; ++c2) {
              const int col = 32 * (ctb + c2) + l31;
#pragma unroll
              for (int r = 0; r < 16; ++r) {
                const int k1 = 32 * rt0 + crow(r, hh);
                const float2 tw = *(const float2*)(smem + L_TW + (k1 * 128 + t2) * 8);
                const float va = acc[0][c2][r], vb = acc[1][c2][r];
                const float yr = va * tw.x - vb * tw.y, yi = va * tw.y + vb * tw.x;
                bf16_t* d = YB + ((size_t)b * 8192 + k1 * 128 + t2) * 2048 + cb * 128 + col;
                d[0] = f2bf(yr); d[1024] = f2bf(yi);
              }
            }
          }
        }
        for (int it = 2048 + blockIdx.x; it < 2048 + nctx; it += gridDim.x) {
          {
            const int u = it - 2048, b = u >> 4, cb = (u >> 1) & 7, mh = u & 1;
            const size_t tok0 = (size_t)NLAT + b * 256;
            const float scale = 0.005524271728019903f;
            dft_tile(FC, 512, mh * 128, 256, T1 + tok0 * D + cb * 128, T2 + tok0 * D + cb * 128, D, 1, smem, TID,
                     [=](int rowA, int rowB, int col, float va, float vb) {
                       const int cc = cb * 128 + col;
                       bf16_t* z0 = T3 + (tok0 + mh * 128 + rowA) * D + cc;
                       bf16_t* z1 = T3 + (tok0 + mh * 128 + rowB) * D + cc;
                       const float bm = bmix[cc];
                       z0[0] = f2bf((va * scale + bm) * silu_f(bf2f(z0[0])));
                       z1[0] = f2bf((vb * scale + bm) * silu_f(bf2f(z1[0])));
                     });
          }
        }
      } break;
      case PH_FDFT3: {
        const bf16_t* F2 = (const bf16_t*)(p.ws + OFF_F2);
        const bf16_t* YB = T4;
        const float* bmix = p.f_b_mix + (size_t)j * 1024;
        const float scale = 0.0009765625f;
        constexpr int L_B = 0, L_F2 = 256 * 320;
        const int lane = tid & 63, w = tid >> 6, l31 = lane & 31, hh = lane >> 5;
        const int rt0 = w & 1, ctb = 2 * (w >> 1);
        const int br = tid >> 4, bcc = tid & 15;
        __syncthreads();
#pragma unroll
        for (int i = 0; i < 16; ++i) {
          const int c = tid + 256 * i, r = c >> 5, cc = c & 31;
          *(uint4*)(smem + L_F2 + r * 528 + cc * 16) = *(const uint4*)(F2 + r * 256 + cc * 8);
        }
        uint4 bp0, bp1, bp2, bp3, bp4, bp5, bp6, bp7, bp8, bp9, bp10, bp11, bp12, bp13, bp14, bp15;
        int it = blockIdx.x;
        if (it < 1024) {
          const int b_ = it >> 9, k1_ = (it >> 3) & 63, cb_ = it & 7;
          const size_t tok0_ = (size_t)b_ * 8192 + k1_ * 128;
              bp0 = *(const uint4*)(YB + (tok0_ + (size_t)(br + 0)) * 2048 + 0 + cb_ * 128 + bcc * 8);
              bp1 = *(const uint4*)(YB + (tok0_ + (size_t)(br + 16)) * 2048 + 0 + cb_ * 128 + bcc * 8);
              bp2 = *(const uint4*)(YB + (tok0_ + (size_t)(br + 32)) * 2048 + 0 + cb_ * 128 + bcc * 8);
              bp3 = *(const uint4*)(YB + (tok0_ + (size_t)(br + 48)) * 2048 + 0 + cb_ * 128 + bcc * 8);
              bp4 = *(const uint4*)(YB + (tok0_ + (size_t)(br + 64)) * 2048 + 0 + cb_ * 128 + bcc * 8);
              bp5 = *(const uint4*)(YB + (tok0_ + (size_t)(br + 80)) * 2048 + 0 + cb_ * 128 + bcc * 8);
              bp6 = *(const uint4*)(YB + (tok0_ + (size_t)(br + 96)) * 2048 + 0 + cb_ * 128 + bcc * 8);
              bp7 = *(const uint4*)(YB + (tok0_ + (size_t)(br + 112)) * 2048 + 0 + cb_ * 128 + bcc * 8);
              bp8 = *(const uint4*)(YB + (tok0_ + (size_t)(br + 0)) * 2048 + 1024 + cb_ * 128 + bcc * 8);
              bp9 = *(const uint4*)(YB + (tok0_ + (size_t)(br + 16)) * 2048 + 1024 + cb_ * 128 + bcc * 8);
              bp10 = *(const uint4*)(YB + (tok0_ + (size_t)(br + 32)) * 2048 + 1024 + cb_ * 128 + bcc * 8);
              bp11 = *(const uint4*)(YB + (tok0_ + (size_t)(br + 48)) * 2048 + 1024 + cb_ * 128 + bcc * 8);
              bp12 = *(const uint4*)(YB + (tok0_ + (size_t)(br + 64)) * 2048 + 1024 + cb_ * 128 + bcc * 8);
              bp13 = *(const uint4*)(YB + (tok0_ + (size_t)(br + 80)) * 2048 + 1024 + cb_ * 128 + bcc * 8);
              bp14 = *(const uint4*)(YB + (tok0_ + (size_t)(br + 96)) * 2048 + 1024 + cb_ * 128 + bcc * 8);
              bp15 = *(const uint4*)(YB + (tok0_ + (size_t)(br + 112)) * 2048 + 1024 + cb_ * 128 + bcc * 8);
        }
        for (; it < 1024; it += gridDim.x) {
          const int b = it >> 9, k1 = (it >> 3) & 63, cb = it & 7;
          __syncthreads();
            *(uint4*)(smem + L_B + (0 + br + 0) * 320 + bcc * 16) = bp0;
            *(uint4*)(smem + L_B + (0 + br + 16) * 320 + bcc * 16) = bp1;
            *(uint4*)(smem + L_B + (0 + br + 32) * 320 + bcc * 16) = bp2;
            *(uint4*)(smem + L_B + (0 + br + 48) * 320 + bcc * 16) = bp3;
            *(uint4*)(smem + L_B + (0 + br + 64) * 320 + bcc * 16) = bp4;
            *(uint4*)(smem + L_B + (0 + br + 80) * 320 + bcc * 16) = bp5;
            *(uint4*)(smem + L_B + (0 + br + 96) * 320 + bcc * 16) = bp6;
            *(uint4*)(smem + L_B + (0 + br + 112) * 320 + bcc * 16) = bp7;
            *(uint4*)(smem + L_B + (128 + br + 0) * 320 + bcc * 16) = bp8;
            *(uint4*)(smem + L_B + (128 + br + 16) * 320 + bcc * 16) = bp9;
            *(uint4*)(smem + L_B + (128 + br + 32) * 320 + bcc * 16) = bp10;
            *(uint4*)(smem + L_B + (128 + br + 48) * 320 + bcc * 16) = bp11;
            *(uint4*)(smem + L_B + (128 + br + 64) * 320 + bcc * 16) = bp12;
            *(uint4*)(smem + L_B + (128 + br + 80) * 320 + bcc * 16) = bp13;
            *(uint4*)(smem + L_B + (128 + br + 96) * 320 + bcc * 16) = bp14;
            *(uint4*)(smem + L_B + (128 + br + 112) * 320 + bcc * 16) = bp15;
          __syncthreads();
          if (it + (int)gridDim.x < 1024) {
            const int itn_ = it + (int)gridDim.x;
            const int b_ = itn_ >> 9, k1_ = (itn_ >> 3) & 63, cb_ = itn_ & 7;
            const size_t tok0_ = (size_t)b_ * 8192 + k1_ * 128;
              bp0 = *(const uint4*)(YB + (tok0_ + (size_t)(br + 0)) * 2048 + 0 + cb_ * 128 + bcc * 8);
              bp1 = *(const uint4*)(YB + (tok0_ + (size_t)(br + 16)) * 2048 + 0 + cb_ * 128 + bcc * 8);
              bp2 = *(const uint4*)(YB + (tok0_ + (size_t)(br + 32)) * 2048 + 0 + cb_ * 128 + bcc * 8);
              bp3 = *(const uint4*)(YB + (tok0_ + (size_t)(br + 48)) * 2048 + 0 + cb_ * 128 + bcc * 8);
              bp4 = *(const uint4*)(YB + (tok0_ + (size_t)(br + 64)) * 2048 + 0 + cb_ * 128 + bcc * 8);
              bp5 = *(const uint4*)(YB + (tok0_ + (size_t)(br + 80)) * 2048 + 0 + cb_ * 128 + bcc * 8);
              bp6 = *(const uint4*)(YB + (tok0_ + (size_t)(br + 96)) * 2048 + 0 + cb_ * 128 + bcc * 8);
              bp7 = *(const uint4*)(YB + (tok0_ + (size_t)(br + 112)) * 2048 + 0 + cb_ * 128 + bcc * 8);
              bp8 = *(const uint4*)(YB + (tok0_ + (size_t)(br + 0)) * 2048 + 1024 + cb_ * 128 + bcc * 8);
              bp9 = *(const uint4*)(YB + (tok0_ + (size_t)(br + 16)) * 2048 + 1024 + cb_ * 128 + bcc * 8);
              bp10 = *(const uint4*)(YB + (tok0_ + (size_t)(br + 32)) * 2048 + 1024 + cb_ * 128 + bcc * 8);
              bp11 = *(const uint4*)(YB + (tok0_ + (size_t)(br + 48)) * 2048 + 1024 + cb_ * 128 + bcc * 8);
              bp12 = *(const uint4*)(YB + (tok0_ + (size_t)(br + 64)) * 2048 + 1024 + cb_ * 128 + bcc * 8);
              bp13 = *(const uint4*)(YB + (tok0_ + (size_t)(br + 80)) * 2048 + 1024 + cb_ * 128 + bcc * 8);
              bp14 = *(const uint4*)(YB + (tok0_ + (size_t)(br + 96)) * 2048 + 1024 + cb_ * 128 + bcc * 8);
              bp15 = *(const uint4*)(YB + (tok0_ + (size_t)(br + 112)) * 2048 + 1024 + cb_ * 128 + bcc * 8);
          }
          f32x16 acc[2][2];
#pragma unroll
          for (int i = 0; i < 2; ++i)
#pragma unroll
            for (int jj = 0; jj < 2; ++jj)
#pragma unroll
              for (int r = 0; r < 16; ++r) acc[i][jj][r] = 0.f;
          const int g = lane >> 4, li = lane & 15, qq = li >> 2, pp = li & 3;
          const int tr_base = (8 * (g >> 1) + qq) * 320 + (16 * (g & 1) + 4 * pp) * 2;
#pragma unroll
          for (int ks = 0; ks < 16; ++ks) {
            s16x8 af[2];
#pragma unroll
            for (int h = 0; h < 2; ++h) af[h] = *(const s16x8*)(smem + L_F2 + (32 * (rt0 + 2 * h) + l31) * 528 + (ks * 16 + hh * 8) * 2);
#pragma unroll
            for (int c2 = 0; c2 < 2; ++c2) {
              const int off = L_B + tr_base + ks * 16 * 320 + (ctb + c2) * 64;
              const s16x4 lo = __builtin_amdgcn_ds_read_tr16_b64_v4i16((__attribute__((address_space(3))) s16x4*)(smem + off));
              const s16x4 hi = __builtin_amdgcn_ds_read_tr16_b64_v4i16((__attribute__((address_space(3))) s16x4*)(smem + off + 4 * 320));
              const s16x8 bq = __builtin_shufflevector(lo, hi, 0, 1, 2, 3, 4, 5, 6, 7);
#pragma unroll
              for (int h = 0; h < 2; ++h) acc[h][c2] = MFMA(af[h], bq, acc[h][c2]);
            }
          }
#pragma unroll
          for (int c2 = 0; c2 < 2; ++c2) {
            const int cc = cb * 128 + 32 * (ctb + c2) + l31;
            const float bm = bmix[cc];
#pragma unroll
            for (int r = 0; r < 16; ++r) {
              const int rowA = 32 * rt0 + crow(r, hh);
              if ((r & 3) == 0) asm volatile("" ::: "memory");
              bf16_t* z0 = T3 + ((size_t)b * 8192 + k1 + 64 * rowA) * D + cc;
              bf16_t* z1 = T3 + ((size_t)b * 8192 + k1 + 64 * (rowA + 64)) * D + cc;
              z0[0] = f2bf((acc[0][c2][r] * scale + bm) * silu_f(bf2f(z0[0])));
              z1[0] = f2bf((acc[1][c2][r] * scale + bm) * silu_f(bf2f(z1[0])));
            }
          }
        }
      } break;
      case PH_FOUT: {
        const int NBIG = 512, NSMALL = (NR / 128 * 4 - NBIG) * 2;
        for (int t = blockIdx.x; t < NBIG + NSMALL; t += gridDim.x) {
          if (t < NBIG) {
            const int mt = t / 4, nt = t % 4;
            gemm_tile_n<false, 4>(T3, nullptr, nullptr, 1024, W + (size_t)3072 * 1024, 1024, 1024, mt * 128, nt * 256, 1024, smem, TID,
                                  [=](int row, int col, float v) { T1[(size_t)row * D + col] = f2bf(v); });
          } else {
            const int u = t - NBIG, mt = 128 + u / 8, nt = u % 8;
            gemm_tile_n<false, 2>(T3, nullptr, nullptr, 1024, W + (size_t)3072 * 1024, 1024, 1024, mt * 128, nt * 128, 1024, smem, TID,
                                  [=](int row, int col, float v) { T1[(size_t)row * D + col] = f2bf(v); });
          }
        }
      } break;
      case PH_POSTPRE: {
        const int nl = layer + 1;
        if (nl & 1) { for (int it = blockIdx.x; it < N_RWPREP; it += gridDim.x) rwkv_wprep(p, nl >> 1, it, smem, TID); }
        else {
          for (int it = blockIdx.x; it < 128 + N_FWPREP; it += gridDim.x) {
            if (it < 128) fourier_precompose(p, it, smem, TID); else fourier_wprep(p, nl >> 1, it - 128, smem, TID);
          }
        }
        const bf16_t* O = (layer & 1) ? T2 : T1;
        row_items(p, layer, true, true, NR, O, T0, blockIdx.x, NR / 4, TID);
      } break;
      case PH_RSHIFT: {
        for (int idx = blockIdx.x * 256 + tid; idx < NR * 128; idx += gridDim.x * 256) {
          const int row = idx >> 7, cc = (idx & 127) * 8;
          bool ok0, ok1, ok2, ok3; float wgt;
          if (row < NLAT) {
            const int t = row & 8191, gy = t >> 6, gx = t & 63;
            wgt = 0.25f;
            ok0 = gy > 0; ok1 = gy < 127; ok2 = gx > 0; ok3 = gx < 63;
          } else {
            const int t = (row - NLAT) & 255;
            wgt = 0.5f;
            ok0 = false; ok1 = false; ok2 = t > 0; ok3 = t < 255;
          }
          float a[8] = {0, 0, 0, 0, 0, 0, 0, 0};
#pragma unroll
          for (int q = 0; q < 4; ++q) {
            const bool ok = q == 0 ? ok0 : (q == 1 ? ok1 : (q == 2 ? ok2 : ok3));
            const int nrow = q == 0 ? row - 64 : (q == 1 ? row + 64 : (q == 2 ? row - 1 : row + 1));
            if (ok) {
              const uint4 u = *(const uint4*)(T0 + (size_t)nrow * D + cc);
              a[0] += lo2f(u.x); a[1] += hi2f(u.x); a[2] += lo2f(u.y); a[3] += hi2f(u.y);
              a[4] += lo2f(u.z); a[5] += hi2f(u.z); a[6] += lo2f(u.w); a[7] += hi2f(u.w);
            }
          }
          *(uint4*)(T1 + (size_t)row * D + cc) = make_uint4(pack2(a[0] * wgt, a[1] * wgt), pack2(a[2] * wgt, a[3] * wgt),
                                                            pack2(a[4] * wgt, a[5] * wgt), pack2(a[6] * wgt, a[7] * wgt));
        }
        if (layer == 1) {
          for (int it = blockIdx.x; it < N_CWPREP; it += gridDim.x) fourier_cw_prep(p, 1, it, smem, TID);
        }
      } break;
      case PH_RINPROJ: {
        const int N = (j >= 1) ? 4384 : 4352;
        const int MT = NR / 128;
        const int NT_MAIN = 16, NT_TAIL = (N - 4096 + 127) / 128, NT = NT_MAIN + NT_TAIL;
        bf16_t* Vd = (j == 0) ? VF : T5;
        bf16_t* LW = (bf16_t*)(p.ws + OFF_LW);
        bf16_t* LA = (bf16_t*)(p.ws + OFF_LA);
        bf16_t* LV = (bf16_t*)(p.ws + OFF_LV);
        for (int t = blockIdx.x; t < MT * NT; t += gridDim.x) {
          const int mt = t / NT, nt = t % NT;
          if (nt < NT_MAIN) {
            const int n0 = nt * 256;
            const float* mu = p.r_mu + (size_t)(j * 6 + (n0 >> 10)) * 1024;
            gemm_tile_n<true, 4>(T0, T1, mu, 1024, W, 1024, 1024, mt * 128, n0, 4096, smem, TID, [=](int row, int col, float v) {
              bf16_t* dst = col < 1024 ? T2 : (col < 2048 ? T3 : (col < 3072 ? Vd : T4));
              dst[(size_t)row * D + (col & 1023)] = f2bf(v);
            });
          } else {
            const int n0 = 4096 + (nt - NT_MAIN) * 128;
            const int pi = n0 < 4224 ? 4 : (n0 < 4352 ? 5 : 2);
            const float* mu = p.r_mu + (size_t)(j * 6 + pi) * 1024;
            gemm_tile_n<true, 2>(T0, T1, mu, 1024, W, 1024, 1024, mt * 128, n0, N, smem, TID, [=](int row, int col, float v) {
              if (col < 4224) LW[(size_t)row * 128 + (col - 4096)] = f2bf(tanhf(v));
              else if (col < 4352) LA[(size_t)row * 128 + (col - 4224)] = f2bf(v);
              else LV[(size_t)row * 32 + (col - 4352)] = f2bf(v);
            });
          }
        }
      } break;
      case PH_RVUPD: {
        const bf16_t* LV = (const bf16_t*)(p.ws + OFF_LV);
        const float* v2 = p.r_v2 + (size_t)(j - 1) * 32 * 1024;
        const float* v0 = p.r_v0 + (size_t)(j - 1) * 1024;
        float* v2s = (float*)smem;
        __syncthreads();
        for (int e = tid; e < 32 * 256; e += 256) *(float4*)(v2s + e * 4) = *(const float4*)(v2 + e * 4);
        __syncthreads();
        const int wave = tid >> 6, lane = tid & 63;
        for (int row = blockIdx.x * 4 + wave; row < NR; row += gridDim.x * 4) {
          const float lvl = bf2f(LV[(size_t)row * 32 + (lane & 31)]);
          float acc[16];
#pragma unroll
          for (int qd = 0; qd < 4; ++qd) {
            const float4 t = *(const float4*)(v0 + qd * 256 + lane * 4);
            acc[qd * 4] = t.x; acc[qd * 4 + 1] = t.y; acc[qd * 4 + 2] = t.z; acc[qd * 4 + 3] = t.w;
          }
#pragma unroll 4
          for (int l = 0; l < 32; ++l) {
            const float a = __int_as_float(__builtin_amdgcn_readlane(__float_as_int(lvl), l));
#pragma unroll
            for (int qd = 0; qd < 4; ++qd) {
              const float4 wv = *(const float4*)(v2s + l * 1024 + qd * 256 + lane * 4);
              acc[qd * 4] += a * wv.x; acc[qd * 4 + 1] += a * wv.y; acc[qd * 4 + 2] += a * wv.z; acc[qd * 4 + 3] += a * wv.w;
            }
          }
#pragma unroll
          for (int qd = 0; qd < 4; ++qd) {
            const size_t idx = (size_t)row * D + qd * 256 + lane * 4;
            const uint2 uv = *(const uint2*)(T5 + idx);
            const uint2 uf = *(const uint2*)(VF + idx);
            float v[4] = {lo2f(uv.x), hi2f(uv.x), lo2f(uv.y), hi2f(uv.y)};
            const float f[4] = {lo2f(uf.x), hi2f(uf.x), lo2f(uf.y), hi2f(uf.y)};
#pragma unroll
            for (int e = 0; e < 4; ++e) v[e] = v[e] + (f[e] - v[e]) * fsig(acc[qd * 4 + e]);
            *(uint2*)(T5 + idx) = make_uint2(pack2(v[0], v[1]), pack2(v[2], v[3]));
          }
        }
      } break;
      case PH_RSCANA: {
        const bf16_t* V = (j == 0) ? VF : T5;
        float* SCR = (j == 0) ? (float*)(p.ws + 5 * SLOT + (8u << 20)) : (float*)(p.ws + OFF_VF);
        for (int it = blockIdx.x; it < 64 * (NSEG - 1); it += gridDim.x)
          scan_chain_chunked<0>(p, j, it / (NSEG - 1), it % (NSEG - 1), SCR, T2, T3, V, T0, T1, smem, TID);
      } break;
      case PH_RSCAN: {
        const bf16_t* V = (j == 0) ? VF : T5;
        float* SCR = (j == 0) ? (float*)(p.ws + 5 * SLOT + (8u << 20)) : (float*)(p.ws + OFF_VF);
        for (int it = blockIdx.x; it < 64 * NSEG; it += gridDim.x)
          scan_chain_chunked<1>(p, j, it / NSEG, it % NSEG, SCR, T2, T3, V, T0, T1, smem, TID);
      } break;
      case PH_ROUTPUT: {
        const bf16_t* V = (j == 0) ? VF : T5;
        const float* BON = (const float*)(p.ws + OFF_BON);
        const int wave = tid >> 6, lane = tid & 63;
        const int nrows = (layer == 3) ? NLAT : NR;
        for (int wi = blockIdx.x * 4 + wave; wi < nrows * 2; wi += gridDim.x * 4) {
          const int row = wi >> 1, c = (wi & 1) * 512 + lane * 8, h = c >> 6;
          const size_t idx = (size_t)row * D + c;
          const uint4 u0 = *(const uint4*)(T0 + idx), u1 = *(const uint4*)(T1 + idx), uv = *(const uint4*)(V + idx), ug = *(const uint4*)(T4 + idx);
          const float4 w0 = *(const float4*)(p.r_ln_w + (size_t)j * 1024 + c), w1 = *(const float4*)(p.r_ln_w + (size_t)j * 1024 + c + 4);
          const float4 b0 = *(const float4*)(p.r_ln_b + (size_t)j * 1024 + c), b1 = *(const float4*)(p.r_ln_b + (size_t)j * 1024 + c + 4);
          const float bon = BON[((size_t)0 * NR + row) * 16 + h] + BON[((size_t)1 * NR + row) * 16 + h];
          float y[8] = {lo2f(u0.x) + lo2f(u1.x), hi2f(u0.x) + hi2f(u1.x), lo2f(u0.y) + lo2f(u1.y), hi2f(u0.y) + hi2f(u1.y),
                        lo2f(u0.z) + lo2f(u1.z), hi2f(u0.z) + hi2f(u1.z), lo2f(u0.w) + lo2f(u1.w), hi2f(u0.w) + hi2f(u1.w)};
          const float vf[8] = {lo2f(uv.x), hi2f(uv.x), lo2f(uv.y), hi2f(uv.y), lo2f(uv.z), hi2f(uv.z), lo2f(uv.w), hi2f(uv.w)};
          const float gf[8] = {lo2f(ug.x), hi2f(ug.x), lo2f(ug.y), hi2f(ug.y), lo2f(ug.z), hi2f(ug.z), lo2f(ug.w), hi2f(ug.w)};
          const float lw8[8] = {w0.x, w0.y, w0.z, w0.w, w1.x, w1.y, w1.z, w1.w};
          const float lb8[8] = {b0.x, b0.y, b0.z, b0.w, b1.x, b1.y, b1.z, b1.w};
          float sm = 0.f;
#pragma unroll
          for (int e = 0; e < 8; ++e) sm += y[e];
          sm += __shfl_xor(sm, 1, 64); sm += __shfl_xor(sm, 2, 64); sm += __shfl_xor(sm, 4, 64);
          const float mean = sm * (1.f / 64.f);
          float vr = 0.f;
#pragma unroll
          for (int e = 0; e < 8; ++e) { y[e] -= mean; vr += y[e] * y[e]; }
          vr += __shfl_xor(vr, 1, 64); vr += __shfl_xor(vr, 2, 64); vr += __shfl_xor(vr, 4, 64);
          const float rstd = rsqrtf(vr * (1.f / 64.f) + GN_EPS);
          float o[8];
#pragma unroll
          for (int e = 0; e < 8; ++e) o[e] = (y[e] * rstd * lw8[e] + lb8[e] + bon * vf[e]) * silu_f(gf[e]);
          *(uint4*)(T4 + idx) = make_uint4(pack2(o[0], o[1]), pack2(o[2], o[3]), pack2(o[4], o[5]), pack2(o[6], o[7]));
        }
      } break;
      case PH_ROUTPROJ: {
        const int MT = ((layer == 3) ? NLAT : NR) / 128;
        const int NBIG = 512, NSMALL = (MT * 4 - NBIG) * 2;
        for (int t = blockIdx.x; t < NBIG + NSMALL; t += gridDim.x) {
          if (t < NBIG) {
            const int mt = t / 4, nt = t % 4;
            gemm_tile_n<false, 4>(T4, nullptr, nullptr, 1024, W + (size_t)4384 * 1024, 1024, 1024, mt * 128, nt * 256, 1024, smem, TID,
                                  [=](int row, int col, float v) { T2[(size_t)row * D + col] = f2bf(v); });
          } else {
            const int u = t - NBIG, mt = 128 + u / 8, nt = u % 8;
            gemm_tile_n<false, 2>(T4, nullptr, nullptr, 1024, W + (size_t)4384 * 1024, 1024, 1024, mt * 128, nt * 128, 1024, smem, TID,
                                  [=](int row, int col, float v) { T2[(size_t)row * D + col] = f2bf(v); });
          }
        }
      } break;
      case PH_POSTLAST: {
        row_items(p, layer, true, false, NLAT, T2, nullptr, blockIdx.x, NLAT / 4, TID);
      } break;
    }
}

#define XB_TMO      128
#define XB_XCNT(j)  (256  + 64 * (j))
#define XB_XSUB(j)  (1280 + 64 * (j))
#define XB_XGEN(j)  (2304 + 64 * (j))
#define XB_TOP      3328
#define XB_TOPGEN   3392
#define XCD_BAR_WORDS 3456
#define XB_SPIN_CAP (1u << 23)
#define LAS __attribute__((address_space(3)))

__device__ __forceinline__ unsigned xb_ld(unsigned* p)              { return __hip_atomic_load(p, __ATOMIC_RELAXED, __HIP_MEMORY_SCOPE_AGENT); }
__device__ __forceinline__ unsigned xb_add(unsigned* p, unsigned v) { return __hip_atomic_fetch_add(p, v, __ATOMIC_RELAXED, __HIP_MEMORY_SCOPE_AGENT); }
__device__ __forceinline__ unsigned xb_xcc_id() { return (unsigned)__builtin_amdgcn_s_getreg((3 << 11) | 20) & 0xFu; }
#define XB_SPIN(cond, bar) do { unsigned _sp = 0; while (cond) { __builtin_amdgcn_s_sleep(1); \
    if ((++_sp & 255u) == 0u) { if (xb_ld(&(bar)[XB_TMO])) break; if (_sp > XB_SPIN_CAP) { atomicAdd(&(bar)[XB_TMO], 1u); break; } } } } while (0)

struct XcdBarrier {
    unsigned* bar; unsigned x;
    volatile LAS unsigned* st;
};

__device__ __forceinline__ XcdBarrier xcd_barrier_post(unsigned* bar, volatile LAS unsigned* st) {
    XcdBarrier b; b.bar = bar; b.x = xb_xcc_id(); b.st = st;
    if (threadIdx.x == 0) (void)xb_add(&bar[XB_XCNT(b.x)], 1u);
    return b;
}
__device__ __forceinline__ void xcd_barrier_complete(unsigned* bar, unsigned x, unsigned& nloc, unsigned& nx) {
    const unsigned G = gridDim.x * gridDim.y * gridDim.z;
    unsigned sum, cnt, mine, sp = 0u;
    for (;;) {
        sum = 0u; cnt = 0u; mine = 0u;
#pragma unroll
        for (unsigned j = 0; j < 16; ++j) { const unsigned c = xb_ld(&bar[XB_XCNT(j)]); sum += c; cnt += (c > 0u) ? 1u : 0u; mine = (j == x) ? c : mine; }
        if (sum == G) break;
        __builtin_amdgcn_s_sleep(1);
        if ((++sp & 255u) == 0u) { if (xb_ld(&bar[XB_TMO])) break; if (sp > XB_SPIN_CAP) { atomicAdd(&bar[XB_TMO], 1u); break; } }
    }
    nloc = mine > 0u ? mine : 1u; nx = cnt > 0u ? cnt : 1u;
}

__device__ __forceinline__ void xcd_barrier(const XcdBarrier& b) {
    asm volatile("s_waitcnt vmcnt(0)" ::: "memory");
    __syncthreads();
    if (threadIdx.x == 0) {
        unsigned* bar = b.bar;
        __builtin_amdgcn_s_waitcnt(0);
        unsigned nloc = b.st[0], nx = b.st[1];
        if (nloc == 0u) { xcd_barrier_complete(bar, b.x, nloc, nx); b.st[0] = nloc; b.st[1] = nx; }
        const unsigned old = xb_add(&bar[XB_XSUB(b.x)], 1u);
        const unsigned gen = old / nloc;
        if (old + 1u == (gen + 1u) * nloc) {
            __builtin_amdgcn_fence(__ATOMIC_RELEASE, "agent");
            asm volatile("s_waitcnt vmcnt(0)" ::: "memory");
            const unsigned og = xb_add(&bar[XB_TOP], 1u);
            const unsigned tg = og / nx;
            if (og + 1u == (tg + 1u) * nx) xb_add(&bar[XB_TOPGEN], 1u);
            else XB_SPIN(xb_ld(&bar[XB_TOPGEN]) == tg, bar);
            __builtin_amdgcn_fence(__ATOMIC_ACQUIRE, "agent");
            xb_add(&bar[XB_XGEN(b.x)], 1u);
            asm volatile("s_waitcnt vmcnt(0)" ::: "memory");
        } else {
            XB_SPIN(xb_ld(&bar[XB_XGEN(b.x)]) == gen, bar);
            __builtin_amdgcn_fence(__ATOMIC_ACQUIRE, "agent");
            asm volatile("s_waitcnt vmcnt(0)" ::: "memory");
        }
    }
    __syncthreads();
}


__global__ void __launch_bounds__(256, 1) mega(Params p) {
  __shared__ __attribute__((aligned(16))) char smem[CS_END];
  cg::grid_group grid = cg::this_grid();
  __shared__ uint4 xb_words;
  if (threadIdx.x == 0) xb_words = make_uint4(0u, 0u, 0u, 0u);
  __syncthreads();
  XcdBarrier xb = xcd_barrier_post((unsigned*)(p.ws + OFF_BAR), (volatile LAS unsigned*)&xb_words);
  for (int ph = p.phase_lo; ph < p.phase_hi; ++ph) {
    int tid_l = threadIdx.x;
    asm volatile("" : "+v"(tid_l));
    run_phase(p, ph, smem, tid_l);
#ifdef REP_MASK
    if ((REP_MASK >> p.ptype[ph]) & 1) { asm volatile("s_waitcnt vmcnt(0) lgkmcnt(0)" ::: "memory"); grid.sync(); asm volatile("" : "+v"(tid_l)); run_phase(p, ph, smem, tid_l); }
#endif
    if (ph + 1 < p.phase_hi) {
      asm volatile("s_waitcnt vmcnt(0) lgkmcnt(0)" ::: "memory");
      if (ph == p.phase_lo) grid.sync();
      else xcd_barrier(xb);
    }
  }
}

extern "C" void kernel_launch(void* const* d_in, const int* in_sizes, int n_in, void* d_out, int out_size, void* d_ws, size_t ws_size,
                              hipStream_t stream) {
  static int grid_blocks = 0;
  if (!grid_blocks) {
    int dev = 0, cus = 0, per_cu = 0;
    hipGetDevice(&dev);
    hipDeviceGetAttribute(&cus, hipDeviceAttributeMultiprocessorCount, dev);
    hipOccupancyMaxActiveBlocksPerMultiprocessor(&per_cu, mega, 256, 0);
    if (per_cu > 2) per_cu = 2;
    if (per_cu < 1) per_cu = 1;
    grid_blocks = cus * per_cu;
  }
  Params p;
  memset(&p, 0, sizeof(p));
  const float** fp = (const float**)&p;
  for (int i = 0; i < 29; ++i) fp[i] = (const float*)d_in[i];
  p.out = (float*)d_out;
  p.ws = (char*)d_ws;
  int n = 0;
  auto add = [&](int t, int l) { p.ptype[n] = (unsigned char)t; p.player[n] = (unsigned char)l; ++n; };
  add(PH_PREP0, 0);
  add(PH_PRE0, 0);
  for (int l = 0; l < 4; ++l) {
    if ((l & 1) == 0) {
      add(PH_FGEMM1, l); add(PH_FDFT1, l); add(PH_FDFT3, l); add(PH_FOUT, l); add(PH_POSTPRE, l);
    } else {
      add(PH_RSHIFT, l); add(PH_RINPROJ, l);
      if (l == 3) add(PH_RVUPD, l);
      add(PH_RSCANA, l); add(PH_RSCAN, l); add(PH_ROUTPUT, l); add(PH_ROUTPROJ, l);
      add(l == 3 ? PH_POSTLAST : PH_POSTPRE, l);
    }
  }
#ifdef DBG_STOP
  n = DBG_STOP; add(PH_DUMP, 0);
#endif
#if SINGLE_LAUNCH
  hipMemsetAsync((char*)d_ws + OFF_BAR, 0, 3456 * 4, stream);
  p.phase_lo = 0; p.phase_hi = n;
  void* args[] = {&p};
  hipError_t e = hipLaunchCooperativeKernel((void*)mega, dim3(grid_blocks), dim3(256), args, 0, stream);
  if (e != hipSuccess) fprintf(stderr, "cooperative launch failed: %s (grid %d)\n", hipGetErrorString(e), grid_blocks);
#else
  for (int i = 0; i < n; ++i) {
    p.phase_lo = i; p.phase_hi = i + 1;
    hipLaunchKernelGGL(mega, dim3(grid_blocks), dim3(256), 0, stream, p);
  }
#endif
}
```

```cpp
#include <hip/hip_runtime.h>
#include <hip/hip_cooperative_groups.h>
#include <cstdio>
#include <cstring>
namespace cg = cooperative_groups;

#ifndef DBG_MASK
#define DBG_MASK 0
#endif
#ifndef SINGLE_LAUNCH
#define SINGLE_LAUNCH 1
#endif

typedef unsigned short bf16_t;
typedef short s16x8 __attribute__((ext_vector_type(8)));
typedef short s16x4 __attribute__((ext_vector_type(4)));
typedef float f32x16 __attribute__((ext_vector_type(16)));
#define DI __device__ __forceinline__
#define MFMA(a, b, c) __builtin_amdgcn_mfma_f32_32x32x16_bf16((a), (b), (c), 0, 0, 0)

constexpr int NR = 16896;
constexpr int NLAT = 16384;
constexpr int D = 1024;
constexpr size_t SLOT = (size_t)NR * D * 2;
constexpr float RMS_EPS = 1e-6f;
constexpr float GN_EPS = 64e-5f;

constexpr size_t OFF_T0 = 0;
constexpr size_t OFF_VF = 6 * SLOT;
constexpr size_t OFF_XCTX = OFF_VF + SLOT;
constexpr size_t OFF_W = OFF_XCTX + (size_t)512 * D * 4;
constexpr size_t W_BYTES = (size_t)(4384 + 1024) * 1024 * 2;
constexpr size_t OFF_LW = OFF_W + W_BYTES;
constexpr size_t OFF_LA = OFF_LW + (size_t)NR * 128 * 2;
constexpr size_t OFF_LV = OFF_LA + (size_t)NR * 128 * 2;
constexpr size_t OFF_MOD = OFF_LV + (size_t)NR * 32 * 2;
constexpr size_t OFF_F1 = OFF_MOD + (size_t)4 * 3 * 3072 * 4;
constexpr size_t OFF_F2 = OFF_F1 + 128 * 128 * 2;
constexpr size_t OFF_FC = OFF_F2 + 128 * 256 * 2;
constexpr size_t OFF_TW = OFF_FC + 256 * 512 * 2;
constexpr size_t OFF_BON = OFF_TW + 64 * 128 * 8;
constexpr size_t OFF_BAR = OFF_BON + (size_t)2 * NR * 16 * 4;
constexpr size_t WS_END = OFF_BAR + 3456 * 4;
static_assert(WS_END <= 268435456ull, "workspace overflow");

enum { PH_PREP0 = 0, PH_PRE0, PH_FGEMM1, PH_FDFT1, PH_FDFT3, PH_FOUT, PH_POSTPRE, PH_RSHIFT, PH_RINPROJ, PH_RVUPD, PH_RSCAN, PH_ROUTPUT, PH_ROUTPROJ, PH_POSTLAST, PH_DUMP, PH_RSCANA };

struct Params {
  const float *x, *c, *ctx, *c_ctx, *mod_w, *mod_b, *norm_pre, *norm_post, *f_w_in, *f_w_mix, *f_b_mix, *f_w_out,
      *r_mu, *r_w_in, *r_w0, *r_w1, *r_w2, *r_a0, *r_a1, *r_a2, *r_v0, *r_v1, *r_v2, *r_k_k, *r_k_a, *r_r_k, *r_ln_w, *r_ln_b, *r_w_out;
  float* out;
  char* ws;
  int phase_lo, phase_hi;
  unsigned char ptype[32];
  unsigned char player[32];
};

DI float bf2f(bf16_t u) { return __uint_as_float(((unsigned)u) << 16); }
DI bf16_t f2bf(float f) { unsigned r; asm("v_cvt_pk_bf16_f32 %0, %1, %1" : "=v"(r) : "v"(f)); return (bf16_t)r; }
DI unsigned pack2(float a, float b) { unsigned r; asm("v_cvt_pk_bf16_f32 %0, %1, %2" : "=v"(r) : "v"(a), "v"(b)); return r; }
DI float lo2f(unsigned u) { return __uint_as_float(u << 16); }
DI float hi2f(unsigned u) { return __uint_as_float(u & 0xffff0000u); }
DI float silu_f(float x) { return x * __builtin_amdgcn_rcpf(1.f + __expf(-x)); }
DI float sigmoid_f(float x) { return __builtin_amdgcn_rcpf(1.f + __expf(-x)); }
DI float fsig(float x) { return __builtin_amdgcn_rcpf(1.f + __expf(-x)); }
DI float softplus_f(float x) { return fmaxf(x, 0.f) + log1pf(__expf(-fabsf(x))); }
template <int CTRL>
DI float dpp_add(float v) { return v + __int_as_float(__builtin_amdgcn_update_dpp(0, __float_as_int(v), CTRL, 0xf, 0xf, true)); }
DI float wave_sum(float v) {
  v = dpp_add<0xB1>(v);
  v = dpp_add<0x4E>(v);
  v = dpp_add<0x141>(v);
  v = dpp_add<0x140>(v);
  const int iv = __float_as_int(v);
  return __int_as_float(__builtin_amdgcn_readlane(iv, 0)) + __int_as_float(__builtin_amdgcn_readlane(iv, 16)) +
         __int_as_float(__builtin_amdgcn_readlane(iv, 32)) + __int_as_float(__builtin_amdgcn_readlane(iv, 48));
}
DI int crow(int r, int h) { return (r & 3) + 8 * (r >> 2) + 4 * h; }

template <bool MIX>
DI uint4 mix_chunk(uint4 va, uint4 vs, const float4 m0v, const float4 m1v) {
  if (!MIX) return va;
  float h, sv;
  h = lo2f(va.x); sv = lo2f(vs.x); const float e0 = h + (sv - h) * m0v.x;
  h = hi2f(va.x); sv = hi2f(vs.x); const float e1 = h + (sv - h) * m0v.y;
  h = lo2f(va.y); sv = lo2f(vs.y); const float e2 = h + (sv - h) * m0v.z;
  h = hi2f(va.y); sv = hi2f(vs.y); const float e3 = h + (sv - h) * m0v.w;
  h = lo2f(va.z); sv = lo2f(vs.z); const float e4 = h + (sv - h) * m1v.x;
  h = hi2f(va.z); sv = hi2f(vs.z); const float e5 = h + (sv - h) * m1v.y;
  h = lo2f(va.w); sv = lo2f(vs.w); const float e6 = h + (sv - h) * m1v.z;
  h = hi2f(va.w); sv = hi2f(vs.w); const float e7 = h + (sv - h) * m1v.w;
  return make_uint4(pack2(e0, e1), pack2(e2, e3), pack2(e4, e5), pack2(e6, e7));
}
template <bool MIX, int NJ, class Epi>
DI void gemm_tile_n(const bf16_t* __restrict__ A, const bf16_t* __restrict__ A2, const float* __restrict__ mu, int lda,
                    const bf16_t* __restrict__ BT, int ldb, int K, int m0, int n0, int N, char* smem, const int TID, Epi epi) {
  constexpr int BN = 64 * NJ, NB = BN / 32, NBQ = NB / 4;
  constexpr int STAGE = (128 + BN) * 144;
  const int tid = TID, lane = tid & 63, w = tid >> 6, wm = w & 1, wn = w >> 1;
  f32x16 acc[2][NJ];
#pragma unroll
  for (int i = 0; i < 2; ++i)
#pragma unroll
    for (int j = 0; j < NJ; ++j)
#pragma unroll
      for (int r = 0; r < 16; ++r) acc[i][j][r] = 0.f;
  uint4 ra[2][4], ra2[2][4], rb[2][NB];
  const int KT = K >> 6;
  const int lrow = tid >> 3, kc = tid & 7;
  const bf16_t* Ap = A + (size_t)(m0 + lrow) * lda + kc * 8;
  const bf16_t* A2p = MIX ? (A2 + (size_t)(m0 + lrow) * lda + kc * 8) : nullptr;
  const bf16_t* Bp = BT + (size_t)(n0 + lrow) * ldb + kc * 8;
  const bool nfull = (n0 + BN <= N);
#define GEMM_LOAD(ST_, KT_) { \
    _Pragma("unroll") for (int i = 0; i < 4; ++i) { \
      ra[ST_][i] = *(const uint4*)(Ap + (size_t)(32 * i) * lda + (KT_) * 64); \
      if (MIX) ra2[ST_][i] = *(const uint4*)(A2p + (size_t)(32 * i) * lda + (KT_) * 64); } \
    _Pragma("unroll") for (int i = 0; i < NB; ++i) \
      rb[ST_][i] = (nfull || (n0 + lrow + 32 * i) < N) ? *(const uint4*)(Bp + (size_t)(32 * i) * ldb + (KT_) * 64) : make_uint4(0, 0, 0, 0); }
#define GEMM_STAGE_SLICE(ST_, KT_, Q_, BUF_) { \
    bf16_t* As_ = (bf16_t*)(smem + (BUF_) * STAGE); bf16_t* Bs_ = As_ + 128 * 72; \
    float4 m0v_ = make_float4(0, 0, 0, 0), m1v_ = m0v_; \
    if (MIX) { m0v_ = *(const float4*)(mu + (KT_) * 64 + kc * 8); m1v_ = *(const float4*)(mu + (KT_) * 64 + kc * 8 + 4); } \
    *(uint4*)(As_ + (lrow + 32 * (Q_)) * 72 + kc * 8) = mix_chunk<MIX>(ra[ST_][Q_], ra2[ST_][Q_], m0v_, m1v_); \
    _Pragma("unroll") for (int u = 0; u < NBQ; ++u) *(uint4*)(Bs_ + (lrow + 32 * ((Q_) * NBQ + u)) * 72 + kc * 8) = rb[ST_][(Q_) * NBQ + u]; }
  GEMM_LOAD(0, 0)
  if (KT > 1) GEMM_LOAD(1, 1)
  __syncthreads();
#pragma unroll
  for (int qq = 0; qq < 4; ++qq) GEMM_STAGE_SLICE(0, 0, qq, 0)
  if (KT > 2) GEMM_LOAD(0, 2)
  __syncthreads();
  for (int kt0 = 0; kt0 < KT; kt0 += 2) {
#pragma unroll
    for (int st = 0; st < 2; ++st) {
      const int kt = kt0 + st;
      if (kt < KT) {
        const bf16_t* As = (const bf16_t*)(smem + st * STAGE);
        const bf16_t* Bs = As + 128 * 72;
        const bool more = (kt + 1 < KT);
        s16x8 fa[2][2], fb[2][NJ];
#pragma unroll
        for (int i = 0; i < 2; ++i) fa[0][i] = *(const s16x8*)(As + (64 * wm + 32 * i + (lane & 31)) * 72 + (lane >> 5) * 8);
#pragma unroll
        for (int j = 0; j < NJ; ++j) fb[0][j] = *(const s16x8*)(Bs + (32 * NJ * wn + 32 * j + (lane & 31)) * 72 + (lane >> 5) * 8);
#pragma unroll
        for (int kk = 0; kk < 4; ++kk) {
          if (kk < 3) {
#pragma unroll
            for (int i = 0; i < 2; ++i) fa[(kk + 1) & 1][i] = *(const s16x8*)(As + (64 * wm + 32 * i + (lane & 31)) * 72 + (kk + 1) * 16 + (lane >> 5) * 8);
#pragma unroll
            for (int j = 0; j < NJ; ++j) fb[(kk + 1) & 1][j] = *(const s16x8*)(Bs + (32 * NJ * wn + 32 * j + (lane & 31)) * 72 + (kk + 1) * 16 + (lane >> 5) * 8);
          }
#pragma unroll
          for (int i = 0; i < 2; ++i)
#pragma unroll
            for (int j = 0; j < NJ; ++j) acc[i][j] = MFMA(fa[kk & 1][i], fb[kk & 1][j], acc[i][j]);
          if (more) GEMM_STAGE_SLICE(st ^ 1, kt + 1, kk, st ^ 1)
        }
        if (kt + 3 < KT) GEMM_LOAD(st ^ 1, kt + 3)
        __syncthreads();
      }
    }
  }
#undef GEMM_LOAD
#undef GEMM_STAGE_SLICE
#pragma unroll
  for (int i = 0; i < 2; ++i)
#pragma unroll
    for (int j = 0; j < NJ; ++j) {
      const int col = n0 + 32 * NJ * wn + 32 * j + (lane & 31);
      if (col < N) {
#pragma unroll
        for (int r = 0; r < 16; ++r) {
          const int row = m0 + 64 * wm + 32 * i + crow(r, lane >> 5);
          epi(row, col, acc[i][j][r]);
        }
      }
    }
}
template <bool MIX, class Epi>
DI void gemm_tile(const bf16_t* __restrict__ A, const bf16_t* __restrict__ A2, const float* __restrict__ mu, int lda,
                  const bf16_t* __restrict__ BT, int ldb, int K, int m0, int n0, int N, char* smem, const int TID, Epi epi) {
  gemm_tile_n<MIX, 2>(A, A2, mu, lda, BT, ldb, K, m0, n0, N, smem, TID, epi);
}

template <class Epi>
DI void dft_tile(const bf16_t* __restrict__ A, int lda, int arow0, int KH, const bf16_t* __restrict__ Bre,
                 const bf16_t* __restrict__ Bim, int ldb, int tstride, char* smem, const int TID, Epi epi) {
  const int tid = TID, lane = tid & 63, w = tid >> 6;
  const int rt0 = w & 1, ctb = 2 * (w >> 1);
  f32x16 acc[2][2];
#pragma unroll
  for (int i = 0; i < 2; ++i)
#pragma unroll
    for (int j = 0; j < 2; ++j)
#pragma unroll
      for (int r = 0; r < 16; ++r) acc[i][j][r] = 0.f;
  const int nch = (2 * KH) >> 7;
  const int g = lane >> 4, li = lane & 15, q = li >> 2, pp = li & 3;
  const int tr_base = (8 * (g >> 1) + q) * 320 + (16 * (g & 1) + 4 * pp) * 2;
  for (int ch = 0; ch < nch; ++ch) {
    __syncthreads();
#pragma unroll
    for (int i = 0; i < 8; ++i) {
      const int c = tid + 256 * i, r = c >> 4, cc = c & 15;
      const int kr = ch * 128 + r;
      const bf16_t* src = (kr < KH ? Bre + (size_t)kr * tstride * ldb : Bim + (size_t)(kr - KH) * tstride * ldb) + cc * 8;
      *(uint4*)(smem + r * 320 + cc * 16) = *(const uint4*)src;
    }
    __syncthreads();
#pragma unroll
    for (int kh = 0; kh < 2; ++kh) {
      asm volatile("" ::: "memory");
      s16x8 af[4][2];
#pragma unroll
      for (int k4 = 0; k4 < 4; ++k4)
#pragma unroll
        for (int h = 0; h < 2; ++h)
          af[k4][h] = *(const s16x8*)(A + (size_t)(arow0 + 32 * (rt0 + 2 * h) + (lane & 31)) * lda + ch * 128 + (kh * 4 + k4) * 16 + (lane >> 5) * 8);
#pragma unroll
      for (int k4 = 0; k4 < 4; ++k4) {
        const int ks = kh * 4 + k4;
#pragma unroll
        for (int c2 = 0; c2 < 2; ++c2) {
          const int off = tr_base + ks * 16 * 320 + (ctb + c2) * 64;
#ifdef NO_TR
          s16x8 b;
          {
            const int n = 32 * (ctb + c2) + (lane & 31), k0 = ks * 16 + 8 * (lane >> 5);
#pragma unroll
            for (int e = 0; e < 8; ++e) b[e] = *(const short*)(smem + (k0 + e) * 320 + n * 2);
          }
#else
          const s16x4 lo = __builtin_amdgcn_ds_read_tr16_b64_v4i16((__attribute__((address_space(3))) s16x4*)(smem + off));
          const s16x4 hi = __builtin_amdgcn_ds_read_tr16_b64_v4i16((__attribute__((address_space(3))) s16x4*)(smem + off + 4 * 320));
          const s16x8 b = __builtin_shufflevector(lo, hi, 0, 1, 2, 3, 4, 5, 6, 7);
#endif
#pragma unroll
          for (int h = 0; h < 2; ++h) acc[h][c2] = MFMA(af[k4][h], b, acc[h][c2]);
        }
      }
    }
  }
#pragma unroll
  for (int c2 = 0; c2 < 2; ++c2) {
    const int col = 32 * (ctb + c2) + (lane & 31);
#pragma unroll
    for (int r = 0; r < 16; ++r) {
      const int rowA = 32 * rt0 + crow(r, lane >> 5);
      if ((r & 3) == 0) asm volatile("" ::: "memory");
      epi(rowA, rowA + 64, col, acc[0][c2][r], acc[1][c2][r]);
    }
  }
}

DI void transpose_tile(const float* __restrict__ src, int lds_, bf16_t* __restrict__ dst, int ldd, int K, int N, int tk, int tn, char* smem, const int TID) {
  float* t = (float*)smem;
  const int tid = TID;
  __syncthreads();
#pragma unroll
  for (int i = 0; i < 16; ++i) {
    const int kk = (tid >> 6) + 4 * i, nn = tid & 63;
    const int k = tk * 64 + kk, n = tn * 64 + nn;
    t[kk * 65 + nn] = (k < K && n < N) ? src[(size_t)k * lds_ + n] : 0.f;
  }
  __syncthreads();
#pragma unroll
  for (int i = 0; i < 16; ++i) {
    const int nn = (tid >> 6) + 4 * i, kk = tid & 63;
    const int k = tk * 64 + kk, n = tn * 64 + nn;
    if (k < K && n < N) dst[(size_t)n * ldd + k] = f2bf(t[kk * 65 + nn]);
  }
}

DI void fourier_wprep(const Params& p, int j, int it, char* smem, const int TID) {
  bf16_t* W = (bf16_t*)(p.ws + OFF_W);
  const int job = it >> 8, t = it & 255;
  if (job == 0) transpose_tile(p.f_w_in + (size_t)j * 1024 * 2048 + 1024, 2048, W + (size_t)2048 * 1024, 1024, 1024, 1024, t >> 4, t & 15, smem, TID);
  else transpose_tile(p.f_w_out + (size_t)j * 1024 * 1024, 1024, W + (size_t)3072 * 1024, 1024, 1024, 1024, t >> 4, t & 15, smem, TID);
}
DI void rwkv_wprep(const Params& p, int j, int it, char* smem, const int TID) {
  bf16_t* W = (bf16_t*)(p.ws + OFF_W);
  if (it < 1024) {
    const int pi = it >> 8, t = it & 255;
    transpose_tile(p.r_w_in + (size_t)(j * 4 + pi) * 1024 * 1024, 1024, W + (size_t)pi * 1024 * 1024, 1024, 1024, 1024, t >> 4, t & 15, smem, TID);
  } else if (it < 1024 + 32) {
    const int u = it - 1024, n = u >> 4, t = u & 15;
    transpose_tile(p.r_w1 + (size_t)(j * 2 + n) * 1024 * 64, 64, W + (size_t)(4096 + 64 * n) * 1024, 1024, 1024, 64, t, 0, smem, TID);
  } else if (it < 1024 + 64) {
    const int u = it - 1056, n = u >> 4, t = u & 15;
    transpose_tile(p.r_a1 + (size_t)(j * 2 + n) * 1024 * 64, 64, W + (size_t)(4224 + 64 * n) * 1024, 1024, 1024, 64, t, 0, smem, TID);
  } else if (it < 1024 + 80) {
    const int t = it - 1088;
    if (j >= 1) transpose_tile(p.r_v1 + (size_t)(j - 1) * 1024 * 32, 32, W + (size_t)4352 * 1024, 1024, 1024, 32, t, 0, smem, TID);
  } else {
    const int t = it - 1104;
    transpose_tile(p.r_w_out + (size_t)j * 1024 * 1024, 1024, W + (size_t)4384 * 1024, 1024, 1024, 1024, t >> 4, t & 15, smem, TID);
  }
}
constexpr int N_FWPREP = 512, N_RWPREP = 1360;

DI void fourier_cw_prep(const Params& p, int j, int it, char* smem, const int TID) {
  bf16_t* FWU = (bf16_t*)(p.ws + 5 * SLOT);
  bf16_t* CWT = FWU + 1024 * 1024;
  const int tid = TID;
  if (it < 256) {
#pragma unroll
    for (int i = 0; i < 4; ++i) {
      const int row = it * 4 + i;
      const float4 v = *(const float4*)(p.f_w_in + (size_t)j * 1024 * 2048 + (size_t)row * 2048 + tid * 4);
      *(uint2*)(FWU + (size_t)row * 1024 + tid * 4) = make_uint2(pack2(v.x, v.y), pack2(v.z, v.w));
    }
  } else {
    float* tab = (float*)smem;
    __syncthreads();
    if (tid < 128) tab[tid] = cospif((float)tid / 64.f);
    __syncthreads();
    const int u = it - 256, pq = u >> 7, g = (u >> 4) & 7, cb = u & 15;
    const int e = tid & 127, cbase = cb * 8 + (tid >> 7) * 4;
    const float* wm = p.f_w_mix + ((size_t)j * 8 + g) * 128 * 128;
    const int off = pq ? 32 : 0;
    float a0 = 0.f, a1 = 0.f, a2 = 0.f, a3 = 0.f;
#pragma unroll 8
    for (int c2 = 0; c2 < 128; ++c2) {
      const float wv = wm[c2 * 128 + e];
      a0 += tab[((cbase + 0) * c2 - off) & 127] * wv;
      a1 += tab[((cbase + 1) * c2 - off) & 127] * wv;
      a2 += tab[((cbase + 2) * c2 - off) & 127] * wv;
      a3 += tab[((cbase + 3) * c2 - off) & 127] * wv;
    }
    *(uint2*)(CWT + (((size_t)pq * 8 + g) * 128 + e) * 128 + cbase) = make_uint2(pack2(a0, a1), pack2(a2, a3));
  }
}
constexpr int N_CWPREP = 256 + 256;

DI void fourier_precompose(const Params& p, int it, char* smem, const int TID) {
  const bf16_t* FWU = (const bf16_t*)(p.ws + 5 * SLOT);
  const bf16_t* CWT = FWU + 1024 * 1024;
  bf16_t* W = (bf16_t*)(p.ws + OFF_W);
  const int pg = it >> 3, nt = it & 7;
  const int g = pg & 7;
  bf16_t* dst = W + (size_t)pg * 128 * 1024;
  gemm_tile<false>(CWT + (size_t)pg * 128 * 128, nullptr, nullptr, 128, FWU + g * 128, 1024, 128, 0, nt * 128, 1024, smem, TID,
                   [=](int row, int col, float v) { dst[(size_t)row * 1024 + col] = f2bf(v); });
}

DI void phase_prep0(const Params& p, char* smem, const int TID) {
  const int tid = TID;

  float* MOD = (float*)(p.ws + OFF_MOD);
  const int N_MOD = 192, N_TAB = (128 * 128 + 128 * 256 + 256 * 512 + 64 * 128) / 256;
  const int total = N_MOD + N_TAB + N_CWPREP + N_FWPREP;
  for (int it = blockIdx.x; it < total; it += gridDim.x) {
    if (it < N_MOD) {
      const int layer = it / 48, chunk = it % 48;
      const int kp = tid >> 4, cgp = tid & 15;
      const float* wbase = p.mod_w + (size_t)layer * 1024 * 3072 + chunk * 64 + cgp * 4;
      float a0[4] = {0, 0, 0, 0}, a1[4] = {0, 0, 0, 0}, a2[4] = {0, 0, 0, 0};
      float* sc = (float*)(smem + 16384);
      __syncthreads();
      for (int e = tid; e < 1024; e += 256) { sc[e] = silu_f(p.c[e]); sc[1024 + e] = silu_f(p.c[1024 + e]); sc[2048 + e] = silu_f(p.c_ctx[e]); }
      __syncthreads();
#pragma unroll 8
      for (int k = kp * 64; k < kp * 64 + 64; ++k) {
        const float4 wv = *(const float4*)(wbase + (size_t)k * 3072);
        const float s0 = sc[k], s1 = sc[1024 + k], s2 = sc[2048 + k];
        a0[0] += s0 * wv.x; a0[1] += s0 * wv.y; a0[2] += s0 * wv.z; a0[3] += s0 * wv.w;
        a1[0] += s1 * wv.x; a1[1] += s1 * wv.y; a1[2] += s1 * wv.z; a1[3] += s1 * wv.w;
        a2[0] += s2 * wv.x; a2[1] += s2 * wv.y; a2[2] += s2 * wv.z; a2[3] += s2 * wv.w;
      }
      float* red = (float*)smem;
      __syncthreads();
#pragma unroll
      for (int e = 0; e < 4; ++e) {
        red[(kp * 3 + 0) * 64 + cgp * 4 + e] = a0[e];
        red[(kp * 3 + 1) * 64 + cgp * 4 + e] = a1[e];
        red[(kp * 3 + 2) * 64 + cgp * 4 + e] = a2[e];
      }
      __syncthreads();
      if (tid < 192) {
        const int v = tid >> 6, col = tid & 63;
        float s = 0.f;
#pragma unroll
        for (int k = 0; k < 16; ++k) s += red[(k * 3 + v) * 64 + col];
        const int cidx = chunk * 64 + col;
        MOD[((size_t)layer * 3 + v) * 3072 + cidx] = s + p.mod_b[(size_t)layer * 3072 + cidx];
      }
    } else if (it < N_MOD + N_TAB) {
      int e = (it - N_MOD) * 256 + tid;
      bf16_t* F1 = (bf16_t*)(p.ws + OFF_F1);
      bf16_t* F2 = (bf16_t*)(p.ws + OFF_F2);
      bf16_t* FC = (bf16_t*)(p.ws + OFF_FC);
      float2* TW = (float2*)(p.ws + OFF_TW);
      if (e < 128 * 128) {
        const int m = e >> 7, k = e & 127;
        const int mm = m & 63, kk = k & 63;
        const float ang = (float)((mm * kk) & 63) / 32.f;
        const float cv = cospif(ang), sv = sinpif(ang);
        float val;
        if (m < 64) val = (k < 64) ? cv : -sv; else val = (k < 64) ? sv : cv;
        F1[e] = f2bf(val);
      } else if ((e -= 128 * 128) < 128 * 256) {
        const int m = e >> 8, k = e & 255, kk = k & 127;
        const float ang = (float)((m * kk) & 127) / 64.f;
        F2[e] = f2bf(k < 128 ? cospif(ang) : -sinpif(ang));
      } else if ((e -= 128 * 256) < 256 * 512) {
        const int m = e >> 9, k = e & 511, kk = k & 255;
        const float ang = (float)((m * kk) & 255) / 128.f;
        FC[e] = f2bf(k < 256 ? cospif(ang) : -sinpif(ang));
      } else {
        e -= 256 * 512;
        const int k1 = e >> 7, t2 = e & 127;
        const float ang = (float)(k1 * t2) / 4096.f;
        TW[e] = make_float2(cospif(ang), sinpif(ang));
      }
    } else if (it < N_MOD + N_TAB + N_CWPREP) {
      fourier_cw_prep(p, 0, it - N_MOD - N_TAB, smem, TID);
    } else {
      fourier_wprep(p, 0, it - N_MOD - N_TAB - N_CWPREP, smem, TID);
    }
  }
}

DI void row_items(const Params& p, int layer, bool do_post, bool do_pre, int nrows, const bf16_t* O, bf16_t* H, int it0, int nit, const int TID) {
  const int wave = TID >> 6, lane = TID & 63;
  const float* MOD = (const float*)(p.ws + OFF_MOD);
  float* XCTX = (float*)(p.ws + OFF_XCTX);
  float4 nx0, nx1, nx2, nx3;
  uint2 no0 = make_uint2(0, 0), no1 = no0, no2 = no0, no3 = no0;
#define ROW_XIN(ROW_) ((layer == 0) ? ((ROW_) < NLAT ? p.x + (size_t)(ROW_) * D : p.ctx + (size_t)((ROW_) - NLAT) * D) \
                                    : ((ROW_) < NLAT ? p.out + (size_t)(ROW_) * D : XCTX + (size_t)((ROW_) - NLAT) * D))
#define ROW_PREFETCH(ROW_) { const float* xi_ = ROW_XIN(ROW_); \
    nx0 = *(const float4*)(xi_ + lane * 4); nx1 = *(const float4*)(xi_ + 256 + lane * 4); nx2 = *(const float4*)(xi_ + 512 + lane * 4); nx3 = *(const float4*)(xi_ + 768 + lane * 4); \
    if (do_post) { const bf16_t* oi_ = O + (size_t)(ROW_) * D + lane * 4; \
      no0 = *(const uint2*)(oi_); no1 = *(const uint2*)(oi_ + 256); no2 = *(const uint2*)(oi_ + 512); no3 = *(const uint2*)(oi_ + 768); } }
  if (it0 < nit) ROW_PREFETCH(it0 * 4 + wave)
  for (int it = it0; it < nit; it += gridDim.x) {
    const int row = it * 4 + wave;
    const int v = row < 8192 ? 0 : (row < 16384 ? 1 : 2);
    float* xout = row < NLAT ? p.out + (size_t)row * D : XCTX + (size_t)(row - NLAT) * D;
    float4 xv[4] = {nx0, nx1, nx2, nx3};
    const uint2 ou[4] = {no0, no1, no2, no3};
    if (it + (int)gridDim.x < nit) ROW_PREFETCH((it + (int)gridDim.x) * 4 + wave)
    if (do_post) {
      float ov[4][4];
      float ss = 0.f;
#pragma unroll
      for (int qd = 0; qd < 4; ++qd) {
        const uint2 u = ou[qd];
        ov[qd][0] = lo2f(u.x); ov[qd][1] = hi2f(u.x); ov[qd][2] = lo2f(u.y); ov[qd][3] = hi2f(u.y);
#pragma unroll
        for (int e = 0; e < 4; ++e) ss += ov[qd][e] * ov[qd][e];
      }
      ss = wave_sum(ss);
      const float rstd = rsqrtf(ss * (1.f / 1024.f) + RMS_EPS);
      const float* gate = MOD + ((size_t)layer * 3 + v) * 3072 + 2048;
      const float* np = p.norm_post + (size_t)layer * D;
#pragma unroll
      for (int qd = 0; qd < 4; ++qd) {
        const float4 gv = *(const float4*)(gate + qd * 256 + lane * 4);
        const float4 nv = *(const float4*)(np + qd * 256 + lane * 4);
        xv[qd].x += gv.x * (ov[qd][0] * rstd * nv.x);
        xv[qd].y += gv.y * (ov[qd][1] * rstd * nv.y);
        xv[qd].z += gv.z * (ov[qd][2] * rstd * nv.z);
        xv[qd].w += gv.w * (ov[qd][3] * rstd * nv.w);
        *(float4*)(xout + qd * 256 + lane * 4) = xv[qd];
      }
    }
    if (do_pre) {
      const int L = layer + (do_post ? 1 : 0);
      float ss = 0.f;
#pragma unroll
      for (int qd = 0; qd < 4; ++qd) ss += xv[qd].x * xv[qd].x + xv[qd].y * xv[qd].y + xv[qd].z * xv[qd].z + xv[qd].w * xv[qd].w;
      ss = wave_sum(ss);
      const float rstd = rsqrtf(ss * (1.f / 1024.f) + RMS_EPS);
      const float* sh = MOD + ((size_t)L * 3 + v) * 3072;
      const float* sc = sh + 1024;
      const float* np = p.norm_pre + (size_t)L * D;
#pragma unroll
      for (int qd = 0; qd < 4; ++qd) {
        const float4 a = *(const float4*)(sh + qd * 256 + lane * 4);
        const float4 b = *(const float4*)(sc + qd * 256 + lane * 4);
        const float4 n = *(const float4*)(np + qd * 256 + lane * 4);
        const float h0 = xv[qd].x * rstd * n.x * (1.f + b.x) + a.x;
        const float h1 = xv[qd].y * rstd * n.y * (1.f + b.y) + a.y;
        const float h2 = xv[qd].z * rstd * n.z * (1.f + b.z) + a.z;
        const float h3 = xv[qd].w * rstd * n.w * (1.f + b.w) + a.w;
        *(uint2*)(H + (size_t)row * D + qd * 256 + lane * 4) = make_uint2(pack2(h0, h1), pack2(h2, h3));
      }
    }
  }
}

#undef ROW_XIN
#undef ROW_PREFETCH
DI int seq_row(int n, int b, int s) {
  if (s < 256) { const int t = n ? 255 - s : s; return NLAT + b * 256 + t; }
  const int u = s - 256; const int t = n ? 8191 - u : u; return b * 8192 + t;
}
DI void scan_chain(const Params& p, int j, int cid, const bf16_t* R, const bf16_t* Kb, const bf16_t* V, bf16_t* Y0, bf16_t* Y1, char* smem, const int TID) {
  const int n = cid >> 5, b = (cid >> 4) & 1, h = cid & 15;
  const int tid = TID;
  float* rS = (float*)smem;
  float* wS = rS + 1024; float* kS = wS + 1024; float* vS = kS + 1024; float* aS = vS + 1024; float* bS = aS + 1024;
  float* lwS = bS + 1024; float* laS = lwS + 1024;
  float* w2S = laS + 1024;
  float* a2S = w2S + 4096;
  float* yS = lwS;
  const bf16_t* LW = (const bf16_t*)(p.ws + OFF_LW);
  const bf16_t* LA = (const bf16_t*)(p.ws + OFF_LA);
  float* BON = (float*)(p.ws + OFF_BON);
  bf16_t* Y = n ? Y1 : Y0;
  __syncthreads();
  {
    const float* w2 = p.r_w2 + (size_t)(j * 2 + n) * 64 * 1024 + h * 64;
    const float* a2 = p.r_a2 + (size_t)(j * 2 + n) * 64 * 1024 + h * 64;
    for (int e = tid; e < 4096; e += 256) { w2S[e] = w2[(size_t)(e >> 6) * 1024 + (e & 63)]; a2S[e] = a2[(size_t)(e >> 6) * 1024 + (e & 63)]; }
  }
  const int ltok = tid >> 4, cq = tid & 15, c4 = cq * 4;
  const int gc = h * 64 + c4;
  const float4 w0v = *(const float4*)(p.r_w0 + (size_t)(j * 2 + n) * 1024 + gc);
  const float4 a0v = *(const float4*)(p.r_a0 + (size_t)(j * 2 + n) * 1024 + gc);
  const float4 kkv = *(const float4*)(p.r_k_k + (size_t)j * 1024 + gc);
  const float4 kav = *(const float4*)(p.r_k_a + (size_t)j * 1024 + gc);
  const float4 rkv = *(const float4*)(p.r_r_k + (size_t)j * 1024 + gc);
  const int si = tid >> 2, jq = tid & 3;
  float S[16];
#pragma unroll
  for (int e = 0; e < 16; ++e) S[e] = 0.f;
  for (int ck = 0; ck < 528; ++ck) {
    const int s = ck * 16 + ltok;
    const int row = seq_row(n, b, s);
    const uint2 ur = *(const uint2*)(R + (size_t)row * D + gc);
    const uint2 uk = *(const uint2*)(Kb + (size_t)row * D + gc);
    const uint2 uv = *(const uint2*)(V + (size_t)row * D + gc);
    const uint2 ulw = *(const uint2*)(LW + (size_t)row * 128 + n * 64 + c4);
    const uint2 ula = *(const uint2*)(LA + (size_t)row * 128 + n * 64 + c4);
    __syncthreads();
    *(float4*)(lwS + ltok * 64 + c4) = make_float4(lo2f(ulw.x), hi2f(ulw.x), lo2f(ulw.y), hi2f(ulw.y));
    *(float4*)(laS + ltok * 64 + c4) = make_float4(lo2f(ula.x), hi2f(ula.x), lo2f(ula.y), hi2f(ula.y));
    __syncthreads();
    float wz[4] = {w0v.x, w0v.y, w0v.z, w0v.w}, az[4] = {a0v.x, a0v.y, a0v.z, a0v.w};
    for (int l = 0; l < 64; ++l) {
      const float lw = lwS[ltok * 64 + l], la = laS[ltok * 64 + l];
      const float4 w2v = *(const float4*)(w2S + l * 64 + c4);
      const float4 a2v = *(const float4*)(a2S + l * 64 + c4);
      wz[0] += lw * w2v.x; wz[1] += lw * w2v.y; wz[2] += lw * w2v.z; wz[3] += lw * w2v.w;
      az[0] += la * a2v.x; az[1] += la * a2v.y; az[2] += la * a2v.z; az[3] += la * a2v.w;
    }
    const float rr[4] = {lo2f(ur.x), hi2f(ur.x), lo2f(ur.y), hi2f(ur.y)};
    const float kr[4] = {lo2f(uk.x), hi2f(uk.x), lo2f(uk.y), hi2f(uk.y)};
    const float vr[4] = {lo2f(uv.x), hi2f(uv.x), lo2f(uv.y), hi2f(uv.y)};
    const float kkw[4] = {kkv.x, kkv.y, kkv.z, kkv.w}, kaw[4] = {kav.x, kav.y, kav.z, kav.w}, rkw[4] = {rkv.x, rkv.y, rkv.z, rkv.w};
    float kk[4], ss = 0.f;
#pragma unroll
    for (int e = 0; e < 4; ++e) { kk[e] = kr[e] * kkw[e]; ss += kk[e] * kk[e]; }
#pragma unroll
    for (int o = 8; o > 0; o >>= 1) ss += __shfl_xor(ss, o, 64);
    const float inv = 1.f / fmaxf(sqrtf(ss), 1e-12f);
    float dec[4], as[4], kd[4], bb[4], bon = 0.f;
#pragma unroll
    for (int e = 0; e < 4; ++e) {
      kk[e] *= inv;
      dec[e] = __expf(-__expf(-softplus_f(-wz[e]) - 0.5f));
      as[e] = sigmoid_f(az[e]);
      kd[e] = kr[e] * (1.f + (as[e] - 1.f) * kaw[e]);
      bb[e] = kk[e] * as[e];
      bon += rr[e] * kd[e] * rkw[e];
    }
#pragma unroll
    for (int o = 8; o > 0; o >>= 1) bon += __shfl_xor(bon, o, 64);
    if (cq == 0) BON[((size_t)n * NR + row) * 16 + h] = bon;
    *(float4*)(rS + ltok * 64 + c4) = make_float4(rr[0], rr[1], rr[2], rr[3]);
    *(float4*)(wS + ltok * 64 + c4) = make_float4(dec[0], dec[1], dec[2], dec[3]);
    *(float4*)(kS + ltok * 64 + c4) = make_float4(kd[0], kd[1], kd[2], kd[3]);
    *(float4*)(vS + ltok * 64 + c4) = make_float4(vr[0], vr[1], vr[2], vr[3]);
    *(float4*)(aS + ltok * 64 + c4) = make_float4(-kk[0], -kk[1], -kk[2], -kk[3]);
    *(float4*)(bS + ltok * 64 + c4) = make_float4(bb[0], bb[1], bb[2], bb[3]);
    __syncthreads();
    for (int t = 0; t < 16; ++t) {
      float av[16], sa = 0.f;
#pragma unroll
      for (int m = 0; m < 4; ++m) {
        const float4 a4 = *(const float4*)(aS + t * 64 + jq * 16 + m * 4);
        av[m * 4] = a4.x; av[m * 4 + 1] = a4.y; av[m * 4 + 2] = a4.z; av[m * 4 + 3] = a4.w;
      }
#pragma unroll
      for (int e = 0; e < 16; ++e) sa += S[e] * av[e];
      sa += __shfl_xor(sa, 1, 64);
      sa += __shfl_xor(sa, 2, 64);
      const float vi = vS[t * 64 + si];
      float y = 0.f;
#pragma unroll
      for (int m = 0; m < 4; ++m) {
        const float4 w4 = *(const float4*)(wS + t * 64 + jq * 16 + m * 4);
        const float4 b4 = *(const float4*)(bS + t * 64 + jq * 16 + m * 4);
        const float4 k4 = *(const float4*)(kS + t * 64 + jq * 16 + m * 4);
        const float4 r4 = *(const float4*)(rS + t * 64 + jq * 16 + m * 4);
        S[m * 4 + 0] = S[m * 4 + 0] * w4.x + sa * b4.x + vi * k4.x; y += S[m * 4 + 0] * r4.x;
        S[m * 4 + 1] = S[m * 4 + 1] * w4.y + sa * b4.y + vi * k4.y; y += S[m * 4 + 1] * r4.y;
        S[m * 4 + 2] = S[m * 4 + 2] * w4.z + sa * b4.z + vi * k4.z; y += S[m * 4 + 2] * r4.z;
        S[m * 4 + 3] = S[m * 4 + 3] * w4.w + sa * b4.w + vi * k4.w; y += S[m * 4 + 3] * r4.w;
      }
      y += __shfl_xor(y, 1, 64);
      y += __shfl_xor(y, 2, 64);
      if (jq == 0) yS[t * 64 + si] = y;
    }
    __syncthreads();
    {
      const float4 yv = *(const float4*)(yS + ltok * 64 + c4);
      *(uint2*)(Y + (size_t)row * D + gc) = make_uint2(pack2(yv.x, yv.y), pack2(yv.z, yv.w));
    }
  }
}


constexpr int CS_W2T = 0, CS_A2T = 9216, CS_R1 = 18432, CS_R2 = 27648, CS_R3 = 36864, CS_WZ = 46080, CS_AZ = 62464,
              CS_AT = 78848, CS_RT = 88064, CS_BT = 97280, CS_KT = 106496, CS_VT = 115712, CS_AAB = 124928, CS_UV = 142336,
              CS_S0T = 151552, CS_TOT = 160768, CS_CL = 161792, CS_CST = 162048, CS_END = 163328;
DI s16x8 lds_row8(const char* base, int row, int col) { return *(const s16x8*)(base + row * 144 + col * 2); }
DI s16x8 lds_tr8(const char* base, int krow0, int ncol0, int lane) {
  const int g = lane >> 4, li = lane & 15, qq = li >> 2, pp = li & 3;
  const int off = (krow0 + 8 * (g >> 1) + qq) * 144 + (ncol0 + 16 * (g & 1) + 4 * pp) * 2;
  const s16x4 lo = __builtin_amdgcn_ds_read_tr16_b64_v4i16((__attribute__((address_space(3))) s16x4*)(base + off));
  const s16x4 hi = __builtin_amdgcn_ds_read_tr16_b64_v4i16((__attribute__((address_space(3))) s16x4*)(base + off + 4 * 144));
  return __builtin_shufflevector(lo, hi, 0, 1, 2, 3, 4, 5, 6, 7);
}
DI void unpack16(const uint4 a, const uint4 b, float* f) {
  f[0] = lo2f(a.x); f[1] = hi2f(a.x); f[2] = lo2f(a.y); f[3] = hi2f(a.y); f[4] = lo2f(a.z); f[5] = hi2f(a.z); f[6] = lo2f(a.w); f[7] = hi2f(a.w);
  f[8] = lo2f(b.x); f[9] = hi2f(b.x); f[10] = lo2f(b.y); f[11] = hi2f(b.y); f[12] = lo2f(b.z); f[13] = hi2f(b.z); f[14] = lo2f(b.w); f[15] = hi2f(b.w);
}
DI void store16bf(char* dst, const float* f) {
  *(uint4*)dst = make_uint4(pack2(f[0], f[1]), pack2(f[2], f[3]), pack2(f[4], f[5]), pack2(f[6], f[7]));
  *(uint4*)(dst + 16) = make_uint4(pack2(f[8], f[9]), pack2(f[10], f[11]), pack2(f[12], f[13]), pack2(f[14], f[15]));
}
constexpr int NSEG = 4, SEGCH = 33;
template <int MODE>
DI void scan_chain_chunked(const Params& p, int j, int cid, int seg, float* SCR, const bf16_t* R, const bf16_t* Kb, const bf16_t* V, bf16_t* Y0, bf16_t* Y1, char* smem, const int TID) {
  const int n = cid >> 5, b = (cid >> 4) & 1, hd = cid & 15;
  const int tid = TID, lane = tid & 63, w = tid >> 6, l31 = lane & 31, hh = lane >> 5;
  const int mi = w >> 1, ni = w & 1;
  const int tok = tid >> 2, q = tid & 3, c0 = 16 * q;
  const bf16_t* LW = (const bf16_t*)(p.ws + OFF_LW);
  const bf16_t* LA = (const bf16_t*)(p.ws + OFF_LA);
  float* BON = (float*)(p.ws + OFF_BON);
  bf16_t* Y = n ? Y1 : Y0;
  float* WZ = (float*)(smem + CS_WZ);
  float* AZ = (float*)(smem + CS_AZ);
  float* AABD = (float*)(smem + CS_AAB + 9216);
  float* TOT = (float*)(smem + CS_TOT);
  float* CL = (float*)(smem + CS_CL);
  float* CST = (float*)(smem + CS_CST);
  __syncthreads();
  {
    const float* w2 = p.r_w2 + (size_t)(j * 2 + n) * 64 * 1024 + hd * 64;
    const float* a2 = p.r_a2 + (size_t)(j * 2 + n) * 64 * 1024 + hd * 64;
    for (int e = tid; e < 4096; e += 256) {
      const int l = e >> 6, col = e & 63;
      *(bf16_t*)(smem + CS_W2T + col * 144 + l * 2) = f2bf(w2[(size_t)l * 1024 + col]);
      *(bf16_t*)(smem + CS_A2T + col * 144 + l * 2) = f2bf(a2[(size_t)l * 1024 + col]);
    }
    for (int e = tid; e < 64 * 72; e += 256) *(bf16_t*)(smem + CS_S0T + e * 2) = 0;
    if (tid < 64) {
      CST[tid] = p.r_w0[(size_t)(j * 2 + n) * 1024 + hd * 64 + tid];
      CST[64 + tid] = p.r_a0[(size_t)(j * 2 + n) * 1024 + hd * 64 + tid];
      CST[128 + tid] = p.r_k_k[(size_t)j * 1024 + hd * 64 + tid];
      CST[192 + tid] = p.r_k_a[(size_t)j * 1024 + hd * 64 + tid];
      CST[256 + tid] = p.r_r_k[(size_t)j * 1024 + hd * 64 + tid];
    }
  }
  f32x16 Sacc, Pacc;
#pragma unroll
  for (int r = 0; r < 16; ++r) { Sacc[r] = 0.f; Pacc[r] = 0.f; }
  if (MODE == 0) {
    for (int e = tid; e < 64 * 72; e += 256) *(bf16_t*)(smem + CS_RT + e * 2) = ((e / 72) == (e % 72)) ? (bf16_t)0x3f80 : (bf16_t)0;
#pragma unroll
    for (int r = 0; r < 16; ++r) Pacc[r] = ((32 * mi + crow(r, hh)) == (32 * ni + l31)) ? 1.f : 0.f;
  } else if (seg > 0) {
    const int jr = tid >> 2, ib = (tid & 3) * 16;
    const float* PQ = SCR + (size_t)(cid * 3) * 8192;
    float nv[16];
#pragma unroll
    for (int e = 0; e < 16; ++e) nv[e] = PQ[4096 + jr * 64 + ib + e];
    for (int sg = 1; sg < seg; ++sg) {
      __syncthreads();
#pragma unroll
      for (int e = 0; e < 16; ++e) WZ[jr * 64 + ib + e] = nv[e];
      __syncthreads();
      const float* Pm = PQ + (size_t)sg * 8192;
#pragma unroll
      for (int e = 0; e < 16; ++e) nv[e] = Pm[4096 + jr * 64 + ib + e];
      for (int jp = 0; jp < 64; jp += 4) {
        const float4 pv = *(const float4*)(Pm + jr * 64 + jp);
#pragma unroll
        for (int e = 0; e < 16; ++e)
          nv[e] += pv.x * WZ[(jp + 0) * 64 + ib + e] + pv.y * WZ[(jp + 1) * 64 + ib + e] + pv.z * WZ[(jp + 2) * 64 + ib + e] + pv.w * WZ[(jp + 3) * 64 + ib + e];
      }
    }
    __syncthreads();
#pragma unroll
    for (int e = 0; e < 16; ++e) WZ[jr * 64 + ib + e] = nv[e];
    __syncthreads();
#pragma unroll
    for (int r = 0; r < 16; ++r) {
      const int rrow = 32 * mi + crow(r, hh), ccol = 32 * ni + l31;
      Sacc[r] = WZ[rrow * 64 + ccol];
      *(bf16_t*)(smem + CS_S0T + rrow * 144 + ccol * 2) = f2bf(Sacc[r]);
    }
    __syncthreads();
  }
  const int ck0 = seg * SEGCH, ck1 = ck0 + SEGCH;
  uint4 ur0, ur1, uk0, uk1, uv0, uv1, l0, l1, m0, m1;
#define SCAN_LOAD(CK) { const int row_ = seq_row(n, b, (CK) * 64 + tok); const size_t g_ = (size_t)row_ * D + hd * 64 + c0; \
    ur0 = *(const uint4*)(R + g_); ur1 = *(const uint4*)(R + g_ + 8); uk0 = *(const uint4*)(Kb + g_); uk1 = *(const uint4*)(Kb + g_ + 8); \
    uv0 = *(const uint4*)(V + g_); uv1 = *(const uint4*)(V + g_ + 8); \
    l0 = *(const uint4*)(LW + (size_t)row_ * 128 + n * 64 + c0); l1 = *(const uint4*)(LW + (size_t)row_ * 128 + n * 64 + c0 + 8); \
    m0 = *(const uint4*)(LA + (size_t)row_ * 128 + n * 64 + c0); m1 = *(const uint4*)(LA + (size_t)row_ * 128 + n * 64 + c0 + 8); }
  SCAN_LOAD(ck0)
  for (int ck = ck0; ck < ck1; ++ck) {
    const int row = seq_row(n, b, ck * 64 + tok);
    *(uint4*)(smem + CS_R1 + tok * 144 + c0 * 2) = l0; *(uint4*)(smem + CS_R1 + tok * 144 + c0 * 2 + 16) = l1;
    *(uint4*)(smem + CS_R2 + tok * 144 + c0 * 2) = m0; *(uint4*)(smem + CS_R2 + tok * 144 + c0 * 2 + 16) = m1;
    __syncthreads();
    {
      f32x16 awz, aaz;
#pragma unroll
      for (int r = 0; r < 16; ++r) { awz[r] = 0.f; aaz[r] = 0.f; }
#pragma unroll
      for (int kk = 0; kk < 4; ++kk) {
        const s16x8 alw = lds_row8(smem + CS_R1, 32 * mi + l31, kk * 16 + 8 * hh);
        const s16x8 ala = lds_row8(smem + CS_R2, 32 * mi + l31, kk * 16 + 8 * hh);
        const s16x8 bw = lds_row8(smem + CS_W2T, 32 * ni + l31, kk * 16 + 8 * hh);
        const s16x8 ba = lds_row8(smem + CS_A2T, 32 * ni + l31, kk * 16 + 8 * hh);
        awz = MFMA(alw, bw, awz);
        aaz = MFMA(ala, ba, aaz);
      }
#pragma unroll
      for (int r = 0; r < 16; ++r) {
        const int t = 32 * mi + crow(r, hh), col = 32 * ni + l31;
        WZ[t * 64 + col] = awz[r];
        AZ[t * 64 + col] = aaz[r];
      }
    }
    __syncthreads();
    float lw[16], rr[16], kd[16], av[16], bb[16];
    {
      float kr[16], cw0[16], ca0[16], ckk[16], cka[16], crk[16], wzv[16], azv[16];
      unpack16(ur0, ur1, rr);
      unpack16(uk0, uk1, kr);
#pragma unroll
      for (int e4 = 0; e4 < 4; ++e4) {
        const float4 v0 = *(const float4*)(CST + c0 + e4 * 4), v1 = *(const float4*)(CST + 64 + c0 + e4 * 4), v2 = *(const float4*)(CST + 128 + c0 + e4 * 4);
        const float4 v3 = *(const float4*)(CST + 192 + c0 + e4 * 4), v4 = *(const float4*)(CST + 256 + c0 + e4 * 4);
        const float4 v5 = *(const float4*)(WZ + tok * 64 + c0 + e4 * 4), v6 = *(const float4*)(AZ + tok * 64 + c0 + e4 * 4);
        cw0[e4 * 4] = v0.x; cw0[e4 * 4 + 1] = v0.y; cw0[e4 * 4 + 2] = v0.z; cw0[e4 * 4 + 3] = v0.w;
        ca0[e4 * 4] = v1.x; ca0[e4 * 4 + 1] = v1.y; ca0[e4 * 4 + 2] = v1.z; ca0[e4 * 4 + 3] = v1.w;
        ckk[e4 * 4] = v2.x; ckk[e4 * 4 + 1] = v2.y; ckk[e4 * 4 + 2] = v2.z; ckk[e4 * 4 + 3] = v2.w;
        cka[e4 * 4] = v3.x; cka[e4 * 4 + 1] = v3.y; cka[e4 * 4 + 2] = v3.z; cka[e4 * 4 + 3] = v3.w;
        crk[e4 * 4] = v4.x; crk[e4 * 4 + 1] = v4.y; crk[e4 * 4 + 2] = v4.z; crk[e4 * 4 + 3] = v4.w;
        wzv[e4 * 4] = v5.x; wzv[e4 * 4 + 1] = v5.y; wzv[e4 * 4 + 2] = v5.z; wzv[e4 * 4 + 3] = v5.w;
        azv[e4 * 4] = v6.x; azv[e4 * 4 + 1] = v6.y; azv[e4 * 4 + 2] = v6.z; azv[e4 * 4 + 3] = v6.w;
      }
      float ss = 0.f;
#pragma unroll
      for (int e = 0; e < 16; ++e) { av[e] = kr[e] * ckk[e]; ss += av[e] * av[e]; }
      ss = dpp_add<0xB1>(ss);
      ss = dpp_add<0x4E>(ss);
      const float inv = __frsqrt_rn(fmaxf(ss, 1e-24f));
      float bon = 0.f;
#pragma unroll
      for (int e = 0; e < 16; ++e) {
        const float wz = wzv[e] + cw0[e];
        const float az = azv[e] + ca0[e];
        lw[e] = -0.60653066f * fsig(wz);
        const float as = fsig(az);
        const float kkn = av[e] * inv;
        kd[e] = kr[e] * (1.f + (as - 1.f) * cka[e]);
        bb[e] = kkn * as;
        av[e] = -kkn;
        bon += rr[e] * kd[e] * crk[e];
      }
#pragma unroll
      for (int e4 = 0; e4 < 4; ++e4) *(float4*)(WZ + tok * 64 + c0 + e4 * 4) = make_float4(lw[e4 * 4], lw[e4 * 4 + 1], lw[e4 * 4 + 2], lw[e4 * 4 + 3]);
      bon = dpp_add<0xB1>(bon);
      bon = dpp_add<0x4E>(bon);
      if (MODE == 1 && q == 0) BON[((size_t)n * NR + row) * 16 + hd] = bon;
    }
    __syncthreads();
    {
      const int col = tid & 63, qt = tid >> 6;
      float pv[16];
#pragma unroll
      for (int t = 0; t < 16; ++t) pv[t] = WZ[(16 * qt + t) * 64 + col];
      float sacc = 0.f;
#pragma unroll
      for (int t = 0; t < 16; ++t) { sacc += pv[t]; WZ[(16 * qt + t) * 64 + col] = sacc; }
      TOT[qt * 64 + col] = sacc;
    }
    __syncthreads();
    {
      float fa[16], fr[16], fb[16], fk[16], fv[16];
      unpack16(uv0, uv1, fv);
      const int qt = tok >> 4;
      float tb[16], tt[16], cum[16];
#pragma unroll
      for (int e4 = 0; e4 < 4; ++e4) {
        const float4 t0 = *(const float4*)(TOT + c0 + e4 * 4), t1 = *(const float4*)(TOT + 64 + c0 + e4 * 4);
        const float4 t2 = *(const float4*)(TOT + 128 + c0 + e4 * 4), t3 = *(const float4*)(TOT + 192 + c0 + e4 * 4);
        const float4 cv = *(const float4*)(WZ + tok * 64 + c0 + e4 * 4);
        const float m0_ = qt > 0 ? 1.f : 0.f, m1_ = qt > 1 ? 1.f : 0.f, m2_ = qt > 2 ? 1.f : 0.f;
        tb[e4 * 4] = m0_ * t0.x + m1_ * t1.x + m2_ * t2.x; tb[e4 * 4 + 1] = m0_ * t0.y + m1_ * t1.y + m2_ * t2.y;
        tb[e4 * 4 + 2] = m0_ * t0.z + m1_ * t1.z + m2_ * t2.z; tb[e4 * 4 + 3] = m0_ * t0.w + m1_ * t1.w + m2_ * t2.w;
        tt[e4 * 4] = t0.x + t1.x + t2.x + t3.x; tt[e4 * 4 + 1] = t0.y + t1.y + t2.y + t3.y;
        tt[e4 * 4 + 2] = t0.z + t1.z + t2.z + t3.z; tt[e4 * 4 + 3] = t0.w + t1.w + t2.w + t3.w;
        cum[e4 * 4] = cv.x; cum[e4 * 4 + 1] = cv.y; cum[e4 * 4 + 2] = cv.z; cum[e4 * 4 + 3] = cv.w;
      }
#pragma unroll
      for (int e = 0; e < 16; ++e) {
        const float incl = cum[e] + tb[e];
        const float excl = incl - lw[e];
        const float ei = __expf(incl), ee = __expf(excl), nin = __builtin_amdgcn_rcpf(ei);
        fa[e] = av[e] * ee; fr[e] = rr[e] * ei; fb[e] = bb[e] * nin; fk[e] = kd[e] * nin;
      }
#pragma unroll
      for (int e4 = 0; e4 < 4; ++e4) {
        *(float4*)(WZ + tok * 64 + c0 + e4 * 4) = make_float4(fa[e4 * 4], fa[e4 * 4 + 1], fa[e4 * 4 + 2], fa[e4 * 4 + 3]);
        if (tok == 0) *(float4*)(CL + c0 + e4 * 4) = make_float4(__expf(tt[e4 * 4]), __expf(tt[e4 * 4 + 1]), __expf(tt[e4 * 4 + 2]), __expf(tt[e4 * 4 + 3]));
      }
      store16bf(smem + CS_AT + tok * 144 + c0 * 2, fa);
      if (MODE == 1) store16bf(smem + CS_RT + tok * 144 + c0 * 2, fr);
      store16bf(smem + CS_BT + tok * 144 + c0 * 2, fb);
      store16bf(smem + CS_KT + tok * 144 + c0 * 2, fk);
      *(uint4*)(smem + CS_VT + tok * 144 + c0 * 2) = uv0;
      *(uint4*)(smem + CS_VT + tok * 144 + c0 * 2 + 16) = uv1;
    }
    if (ck + 1 < ck1) SCAN_LOAD(ck + 1)
    __syncthreads();
    {
      f32x16 ab, ak, rb, rk;
#pragma unroll
      for (int r = 0; r < 16; ++r) { ab[r] = 0.f; ak[r] = 0.f; rb[r] = 0.f; rk[r] = 0.f; }
      if (mi >= ni) {
#pragma unroll
        for (int kk = 0; kk < 4; ++kk) {
          const s16x8 aA = lds_row8(smem + CS_AT, 32 * mi + l31, kk * 16 + 8 * hh);
          const s16x8 aR = lds_row8(smem + CS_RT, 32 * mi + l31, kk * 16 + 8 * hh);
          const s16x8 bB = lds_row8(smem + CS_BT, 32 * ni + l31, kk * 16 + 8 * hh);
          const s16x8 bK = lds_row8(smem + CS_KT, 32 * ni + l31, kk * 16 + 8 * hh);
          ab = MFMA(aA, bB, ab); ak = MFMA(aA, bK, ak);
          if (MODE == 1) { rb = MFMA(aR, bB, rb); rk = MFMA(aR, bK, rk); }
        }
      }
#pragma unroll
      for (int r = 0; r < 16; ++r) {
        const int t = 32 * mi + crow(r, hh), sx = 32 * ni + l31;
        const bool lo_s = sx < t, lo_i = sx <= t;
        *(bf16_t*)(smem + CS_AAB + t * 144 + sx * 2) = f2bf(lo_s ? ab[r] : 0.f);
        if ((t >> 4) == (sx >> 4)) AABD[(t >> 4) * 256 + (t & 15) * 16 + (sx & 15)] = lo_s ? ab[r] : 0.f;
        *(bf16_t*)(smem + CS_R1 + t * 144 + sx * 2) = f2bf(lo_s ? ak[r] : 0.f);
        if (MODE == 1) {
          *(bf16_t*)(smem + CS_R2 + t * 144 + sx * 2) = f2bf(lo_i ? rb[r] : 0.f);
          *(bf16_t*)(smem + CS_R3 + t * 144 + sx * 2) = f2bf(lo_i ? rk[r] : 0.f);
        }
      }
    }
    __syncthreads();
    {
      f32x16 xu;
#pragma unroll
      for (int r = 0; r < 16; ++r) xu[r] = 0.f;
#pragma unroll
      for (int kk = 0; kk < 4; ++kk) {
        const s16x8 a = lds_row8(smem + CS_R1, 32 * mi + l31, kk * 16 + 8 * hh);
        const s16x8 bv = lds_tr8(smem + CS_VT, kk * 16, 32 * ni, lane);
        xu = MFMA(a, bv, xu);
      }
#pragma unroll
      for (int r = 0; r < 16; ++r) AZ[(32 * mi + crow(r, hh)) * 64 + 32 * ni + l31] = xu[r];
    }
    __syncthreads();
#pragma unroll
    for (int bk = 0; bk < 4; ++bk) {
      if (tid < 128) {
        float* rhs = (tid < 64) ? (WZ + tid) : (AZ + (tid - 64));
        float x[16], am[16][16];
#pragma unroll
        for (int r = 0; r < 16; ++r) x[r] = rhs[(16 * bk + r) * 64];
#pragma unroll
        for (int tp = 1; tp < 16; ++tp) {
#pragma unroll
          for (int s4 = 0; s4 < (tp + 3) / 4; ++s4) {
            const float4 v = *(const float4*)(AABD + bk * 256 + tp * 16 + s4 * 4);
            am[tp][s4 * 4] = v.x; am[tp][s4 * 4 + 1] = v.y; am[tp][s4 * 4 + 2] = v.z; am[tp][s4 * 4 + 3] = v.w;
          }
        }
#pragma unroll
        for (int sx = 0; sx < 15; ++sx) {
          const float xs = x[sx];
#pragma unroll
          for (int tp = sx + 1; tp < 16; ++tp) x[tp] = fmaf(am[tp][sx], xs, x[tp]);
        }
        char* dst = (tid < 64) ? (smem + CS_AT + tid * 2) : (smem + CS_UV + (tid - 64) * 2);
#pragma unroll
        for (int r = 0; r < 16; ++r) *(bf16_t*)(dst + (16 * bk + r) * 144) = f2bf(x[r]);
      }
      __syncthreads();
      if (bk < 3) {
        const char* xsrc = (w < 2) ? (smem + CS_AT) : (smem + CS_UV);
        float* rdst = (w < 2) ? WZ : AZ;
        const s16x8 bx = lds_tr8(xsrc, 16 * bk, 32 * (w & 1), lane);
#pragma unroll
        for (int rt = 0; rt < 2; ++rt) {
          if (32 * rt + 31 >= 16 * (bk + 1)) {
            f32x16 up;
#pragma unroll
            for (int r = 0; r < 16; ++r) up[r] = 0.f;
            const s16x8 aa = lds_row8(smem + CS_AAB, 32 * rt + l31, 16 * bk + 8 * hh);
            up = MFMA(aa, bx, up);
#pragma unroll
            for (int r = 0; r < 16; ++r) rdst[(32 * rt + crow(r, hh)) * 64 + 32 * (w & 1) + l31] += up[r];
          }
        }
        __syncthreads();
      }
    }
    f32x16 rh, yl, mm, cc;
#pragma unroll
    for (int r = 0; r < 16; ++r) { rh[r] = 0.f; yl[r] = 0.f; mm[r] = 0.f; cc[r] = 0.f; }
#pragma unroll
    for (int kk = 0; kk < 4; ++kk) {
      const s16x8 aRB = lds_row8(smem + CS_R2, 32 * mi + l31, kk * 16 + 8 * hh);
      const s16x8 aRK = lds_row8(smem + CS_R3, 32 * mi + l31, kk * 16 + 8 * hh);
      const s16x8 tAH = lds_tr8(smem + CS_AT, kk * 16, 32 * ni, lane);
      const s16x8 tUV = lds_tr8(smem + CS_UV, kk * 16, 32 * ni, lane);
      const s16x8 tVT = lds_tr8(smem + CS_VT, kk * 16, 32 * ni, lane);
      const s16x8 tBT = lds_tr8(smem + CS_BT, kk * 16, 32 * mi, lane);
      const s16x8 tKT = lds_tr8(smem + CS_KT, kk * 16, 32 * mi, lane);
      if (MODE == 1) {
        rh = MFMA(aRB, tAH, rh);
        yl = MFMA(aRB, tUV, yl);
        yl = MFMA(aRK, tVT, yl);
      }
      mm = MFMA(tBT, tAH, mm);
      cc = MFMA(tBT, tUV, cc);
      cc = MFMA(tKT, tVT, cc);
    }
#pragma unroll
    for (int r = 0; r < 16; ++r) if (MODE == 1) rh[r] += bf2f(*(const bf16_t*)(smem + CS_RT + (32 * mi + crow(r, hh)) * 144 + (32 * ni + l31) * 2));
    __syncthreads();
#pragma unroll
    for (int r = 0; r < 16; ++r) {
      const int rrow = 32 * mi + crow(r, hh), ccol = 32 * ni + l31;
      if (MODE == 1) *(bf16_t*)(smem + CS_R2 + rrow * 144 + ccol * 2) = f2bf(rh[r]);
      *(bf16_t*)(smem + CS_R3 + rrow * 144 + ccol * 2) = f2bf(mm[r]);
    }
    __syncthreads();
    f32x16 pp;
#pragma unroll
    for (int r = 0; r < 16; ++r) pp[r] = 0.f;
#pragma unroll
    for (int kk = 0; kk < 4; ++kk) {
      const s16x8 aMM = lds_row8(smem + CS_R3, 32 * mi + l31, kk * 16 + 8 * hh);
      const s16x8 tS = lds_tr8(smem + CS_S0T, kk * 16, 32 * ni, lane);
      if (MODE == 1) {
        const s16x8 aRH = lds_row8(smem + CS_R2, 32 * mi + l31, kk * 16 + 8 * hh);
        yl = MFMA(aRH, tS, yl);
      } else {
        const s16x8 tP = lds_tr8(smem + CS_RT, kk * 16, 32 * ni, lane);
        pp = MFMA(aMM, tP, pp);
      }
      cc = MFMA(aMM, tS, cc);
    }
#pragma unroll
    for (int r = 0; r < 16; ++r) {
      const float clv = CL[32 * mi + crow(r, hh)];
      Sacc[r] = clv * (Sacc[r] + cc[r]);
      if (MODE == 0) Pacc[r] = clv * (Pacc[r] + pp[r]);
    }
    __syncthreads();
#pragma unroll
    for (int r = 0; r < 16; ++r) {
      const int rrow = 32 * mi + crow(r, hh), ccol = 32 * ni + l31;
      *(bf16_t*)(smem + CS_S0T + rrow * 144 + ccol * 2) = f2bf(Sacc[r]);
      if (MODE == 0) *(bf16_t*)(smem + CS_RT + rrow * 144 + ccol * 2) = f2bf(Pacc[r]);
      if (MODE == 1) {
        const int yrow = seq_row(n, b, ck * 64 + rrow);
        Y[(size_t)yrow * D + hd * 64 + ccol] = f2bf(yl[r]);
      }
    }
  }
  if (MODE == 0) {
    float* PQ = SCR + (size_t)(cid * 3 + seg) * 8192;
#pragma unroll
    for (int r = 0; r < 16; ++r) {
      const int rrow = 32 * mi + crow(r, hh), ccol = 32 * ni + l31;
      PQ[rrow * 64 + ccol] = Pacc[r];
      PQ[4096 + rrow * 64 + ccol] = Sacc[r];
    }
  }
}

DI void run_phase(const Params& p, int ph, char* smem, const int TID) {
  bf16_t* T0 = (bf16_t*)(p.ws + 0 * SLOT);
  bf16_t* T1 = (bf16_t*)(p.ws + 1 * SLOT);
  bf16_t* T2 = (bf16_t*)(p.ws + 2 * SLOT);
  bf16_t* T3 = (bf16_t*)(p.ws + 3 * SLOT);
  bf16_t* T4 = (bf16_t*)(p.ws + 4 * SLOT);
  bf16_t* T5 = (bf16_t*)(p.ws + 5 * SLOT);
  bf16_t* VF = (bf16_t*)(p.ws + OFF_VF);
  bf16_t* W = (bf16_t*)(p.ws + OFF_W);
  const int tid = TID;
#ifdef ONLY_PHASE
    const int type = ONLY_PHASE, layer = p.player[ph];
#else
    const int type = p.ptype[ph], layer = p.player[ph];
#endif
    const int j = layer >> 1;
    switch (type) {
#ifdef DBG_PREPFILL
      case PH_PREP0: {
        for (size_t i = (size_t)blockIdx.x * 256 + tid; i < (size_t)(1 << 20); i += (size_t)gridDim.x * 256)
          *(uint4*)(T4 + (size_t)(2 << 20) * 8 + i * 8) = make_uint4(0x3f803f80u, 0x3f803f80u, 0x3f803f80u, 0x3f803f80u);
      } break;
#else
      case PH_PREP0: phase_prep0(p, smem, TID); break;
#endif
      case PH_PRE0: {
        for (int it = blockIdx.x; it < 128; it += gridDim.x) fourier_precompose(p, it, smem, TID);
        row_items(p, 0, false, true, NR, nullptr, T0, blockIdx.x, NR / 4, TID);
      } break;
      case PH_FGEMM1: {
        const int MT = NR / 128, NT = 12;
        for (int t = blockIdx.x; t < MT * NT; t += gridDim.x) {
          const int mt = t / NT, nt = t % NT;
          gemm_tile_n<false, 4>(T0, nullptr, nullptr, 1024, W, 1024, 1024, mt * 128, nt * 256, 3072, smem, TID, [=](int row, int col, float v) {
            bf16_t* dst = col < 1024 ? T1 : (col < 2048 ? T2 : T3);
            dst[(size_t)row * D + (col & 1023)] = f2bf(v);
          });
        }
      } break;
      case PH_FDFT1: {
        const bf16_t* F1 = (const bf16_t*)(p.ws + OFF_F1);
        const bf16_t* FC = (const bf16_t*)(p.ws + OFF_FC);
        const float2* TW = (const float2*)(p.ws + OFF_TW);
        bf16_t* YB = T4;
        const float* bmix = p.f_b_mix + (size_t)j * 1024;
        const int nctx = (layer == 3) ? 0 : 32;
        {
          constexpr int L_B = 0, L_F1 = 40960, L_TW = L_F1 + 128 * 272;
          const int lane = tid & 63, w = tid >> 6, l31 = lane & 31, hh = lane >> 5;
          const int rt0 = w & 1, ctb = 2 * (w >> 1);
          __syncthreads();
#pragma unroll
          for (int i = 0; i < 8; ++i) {
            const int c = tid + 256 * i, r = c >> 4, cc = c & 15;
            *(uint4*)(smem + L_F1 + r * 272 + cc * 16) = *(const uint4*)(F1 + r * 128 + cc * 8);
          }
#pragma unroll
          for (int i = 0; i < 16; ++i) *(uint4*)(smem + L_TW + (tid + 256 * i) * 16) = *(const uint4*)((const char*)TW + (size_t)(tid + 256 * i) * 16);
          uint4 bp0, bp1, bp2, bp3, bp4, bp5, bp6, bp7;
          const int br = tid >> 4, bcc = tid & 15;
          int it = blockIdx.x;
          if (it < 2048) {
              const int itn_ = it;
              const int b_ = itn_ >> 10, t2_ = (itn_ >> 3) & 127, cb_ = itn_ & 7;
              const size_t tok0_ = (size_t)b_ * 8192 + t2_;
              { const int kr = br + 0; bp0 = *(const uint4*)((kr < 64 ? T1 + (tok0_ + (size_t)kr * 128) * D : T2 + (tok0_ + (size_t)(kr - 64) * 128) * D) + cb_ * 128 + bcc * 8); }
              { const int kr = br + 16; bp1 = *(const uint4*)((kr < 64 ? T1 + (tok0_ + (size_t)kr * 128) * D : T2 + (tok0_ + (size_t)(kr - 64) * 128) * D) + cb_ * 128 + bcc * 8); }
              { const int kr = br + 32; bp2 = *(const uint4*)((kr < 64 ? T1 + (tok0_ + (size_t)kr * 128) * D : T2 + (tok0_ + (size_t)(kr - 64) * 128) * D) + cb_ * 128 + bcc * 8); }
              { const int kr = br + 48; bp3 = *(const uint4*)((kr < 64 ? T1 + (tok0_ + (size_t)kr * 128) * D : T2 + (tok0_ + (size_t)(kr - 64) * 128) * D) + cb_ * 128 + bcc * 8); }
              { const int kr = br + 64; bp4 = *(const uint4*)((kr < 64 ? T1 + (tok0_ + (size_t)kr * 128) * D : T2 + (tok0_ + (size_t)(kr - 64) * 128) * D) + cb_ * 128 + bcc * 8); }
              { const int kr = br + 80; bp5 = *(const uint4*)((kr < 64 ? T1 + (tok0_ + (size_t)kr * 128) * D : T2 + (tok0_ + (size_t)(kr - 64) * 128) * D) + cb_ * 128 + bcc * 8); }
              { const int kr = br + 96; bp6 = *(const uint4*)((kr < 64 ? T1 + (tok0_ + (size_t)kr * 128) * D : T2 + (tok0_ + (size_t)(kr - 64) * 128) * D) + cb_ * 128 + bcc * 8); }
              { const int kr = br + 112; bp7 = *(const uint4*)((kr < 64 ? T1 + (tok0_ + (size_t)kr * 128) * D : T2 + (tok0_ + (size_t)(kr - 64) * 128) * D) + cb_ * 128 + bcc * 8); }
            }
          for (; it < 2048; it += gridDim.x) {
            const int b = it >> 10, t2 = (it >> 3) & 127, cb = it & 7;
            __syncthreads();
            *(uint4*)(smem + L_B + (br + 0) * 320 + bcc * 16) = bp0;
            *(uint4*)(smem + L_B + (br + 16) * 320 + bcc * 16) = bp1;
            *(uint4*)(smem + L_B + (br + 32) * 320 + bcc * 16) = bp2;
            *(uint4*)(smem + L_B + (br + 48) * 320 + bcc * 16) = bp3;
            *(uint4*)(smem + L_B + (br + 64) * 320 + bcc * 16) = bp4;
            *(uint4*)(smem + L_B + (br + 80) * 320 + bcc * 16) = bp5;
            *(uint4*)(smem + L_B + (br + 96) * 320 + bcc * 16) = bp6;
            *(uint4*)(smem + L_B + (br + 112) * 320 + bcc * 16) = bp7;
            __syncthreads();
            if (it + (int)gridDim.x < 2048) {
              const int itn_ = it + (int)gridDim.x;
              const int b_ = itn_ >> 10, t2_ = (itn_ >> 3) & 127, cb_ = itn_ & 7;
              const size_t tok0_ = (size_t)b_ * 8192 + t2_;
              { const int kr = br + 0; bp0 = *(const uint4*)((kr < 64 ? T1 + (tok0_ + (size_t)kr * 128) * D : T2 + (tok0_ + (size_t)(kr - 64) * 128) * D) + cb_ * 128 + bcc * 8); }
              { const int kr = br + 16; bp1 = *(const uint4*)((kr < 64 ? T1 + (tok0_ + (size_t)kr * 128) * D : T2 + (tok0_ + (size_t)(kr - 64) * 128) * D) + cb_ * 128 + bcc * 8); }
              { const int kr = br + 32; bp2 = *(const uint4*)((kr < 64 ? T1 + (tok0_ + (size_t)kr * 128) * D : T2 + (tok0_ + (size_t)(kr - 64) * 128) * D) + cb_ * 128 + bcc * 8); }
              { const int kr = br + 48; bp3 = *(const uint4*)((kr < 64 ? T1 + (tok0_ + (size_t)kr * 128) * D : T2 + (tok0_ + (size_t)(kr - 64) * 128) * D) + cb_ * 128 + bcc * 8); }
              { const int kr = br + 64; bp4 = *(const uint4*)((kr < 64 ? T1 + (tok0_ + (size_t)kr * 128) * D : T2 + (tok0_ + (size_t)(kr - 64) * 128) * D) + cb_ * 128 + bcc * 8); }
              { const int kr = br + 80; bp5 = *(const uint4*)((kr < 64 ? T1 + (tok0_ + (size_t)kr * 128) * D : T2 + (tok0_ + (size_t)(kr - 64) * 128) * D) + cb_ * 128 + bcc * 8); }
              { const int kr = br + 96; bp6 = *(const uint4*)((kr < 64 ? T1 + (tok0_ + (size_t)kr * 128) * D : T2 + (tok0_ + (size_t)(kr - 64) * 128) * D) + cb_ * 128 + bcc * 8); }
              { const int kr = br + 112; bp7 = *(const uint4*)((kr < 64 ? T1 + (tok0_ + (size_t)kr * 128) * D : T2 + (tok0_ + (size_t)(kr - 64) * 128) * D) + cb_ * 128 + bcc * 8); }
            }
            f32x16 acc[2][2];
#pragma unroll
            for (int i = 0; i < 2; ++i)
#pragma unroll
              for (int jj = 0; jj < 2; ++jj)
#pragma unroll
                for (int r = 0; r < 16; ++r) acc[i][jj][r] = 0.f;
            const int g = lane >> 4, li = lane & 15, qq = li >> 2, pp = li & 3;
            const int tr_base = (8 * (g >> 1) + qq) * 320 + (16 * (g & 1) + 4 * pp) * 2;
#pragma unroll
            for (int ks = 0; ks < 8; ++ks) {
              s16x8 af[2];
#pragma unroll
              for (int h = 0; h < 2; ++h) af[h] = *(const s16x8*)(smem + L_F1 + (32 * (rt0 + 2 * h) + l31) * 272 + (ks * 16 + hh * 8) * 2);
#pragma unroll
              for (int c2 = 0; c2 < 2; ++c2) {
                const int off = L_B + tr_base + ks * 16 * 320 + (ctb + c2) * 64;
                const s16x4 lo = __builtin_amdgcn_ds_read_tr16_b64_v4i16((__attribute__((address_space(3))) s16x4*)(smem + off));
                const s16x4 hi = __builtin_amdgcn_ds_read_tr16_b64_v4i16((__attribute__((address_space(3))) s16x4*)(smem + off + 4 * 320));
                const s16x8 bq = __builtin_shufflevector(lo, hi, 0, 1, 2, 3, 4, 5, 6, 7);
#pragma unroll
                for (int h = 0; h < 2; ++h) acc[h][c2] = MFMA(af[h], bq, acc[h][c2]);
              }
            }
#pragma unroll
            for (int c2 = 0; c2 < 2; ++c2) {
              const int col = 32 * (ctb + c2) + l31;
#pragma unroll
              for (int r = 0; r < 16; ++r) {
                const int k1 = 32 * rt0 + crow(r, hh);
                const float2 tw = *(const float2*)(smem + L_TW + (k1 * 128 + t2) * 8);
                const float va = acc[0][c2][r], vb = acc[1][c2][r];
                const float yr = va * tw.x - vb * tw.y, yi = va * tw.y + vb * tw.x;
                bf16_t* d = YB + ((size_t)b * 8192 + k1 * 128 + t2) * 2048 + cb * 128 + col;
                d[0] = f2bf(yr); d[1024] = f2bf(yi);
              }
            }
          }
        }
        for (int it = 2048 + blockIdx.x; it < 2048 + nctx; it += gridDim.x) {
          {
            const int u = it - 2048, b = u >> 4, cb = (u >> 1) & 7, mh = u & 1;
            const size_t tok0 = (size_t)NLAT + b * 256;
            const float scale = 0.005524271728019903f;
            dft_tile(FC, 512, mh * 128, 256, T1 + tok0 * D + cb * 128, T2 + tok0 * D + cb * 128, D, 1, smem, TID,
                     [=](int rowA, int rowB, int col, float va, float vb) {
                       const int cc = cb * 128 + col;
                       bf16_t* z0 = T3 + (tok0 + mh * 128 + rowA) * D + cc;
                       bf16_t* z1 = T3 + (tok0 + mh * 128 + rowB) * D + cc;
                       const float bm = bmix[cc];
                       z0[0] = f2bf((va * scale + bm) * silu_f(bf2f(z0[0])));
                       z1[0] = f2bf((vb * scale + bm) * silu_f(bf2f(z1[0])));
                     });
          }
        }
      } break;
      case PH_FDFT3: {
        const bf16_t* F2 = (const bf16_t*)(p.ws + OFF_F2);
        const bf16_t* YB = T4;
        const float* bmix = p.f_b_mix + (size_t)j * 1024;
        const float scale = 0.0009765625f;
        constexpr int L_B = 0, L_F2 = 256 * 320;
        const int lane = tid & 63, w = tid >> 6, l31 = lane & 31, hh = lane >> 5;
        const int rt0 = w & 1, ctb = 2 * (w >> 1);
        const int br = tid >> 4, bcc = tid & 15;
        __syncthreads();
#pragma unroll
        for (int i = 0; i < 16; ++i) {
          const int c = tid + 256 * i, r = c >> 5, cc = c & 31;
          *(uint4*)(smem + L_F2 + r * 528 + cc * 16) = *(const uint4*)(F2 + r * 256 + cc * 8);
        }
        uint4 bp0, bp1, bp2, bp3, bp4, bp5, bp6, bp7, bp8, bp9, bp10, bp11, bp12, bp13, bp14, bp15;
        int it = blockIdx.x;
        if (it < 1024) {
          const int b_ = it >> 9, k1_ = (it >> 3) & 63, cb_ = it & 7;
          const size_t tok0_ = (size_t)b_ * 8192 + k1_ * 128;
              bp0 = *(const uint4*)(YB + (tok0_ + (size_t)(br + 0)) * 2048 + 0 + cb_ * 128 + bcc * 8);
              bp1 = *(const uint4*)(YB + (tok0_ + (size_t)(br + 16)) * 2048 + 0 + cb_ * 128 + bcc * 8);
              bp2 = *(const uint4*)(YB + (tok0_ + (size_t)(br + 32)) * 2048 + 0 + cb_ * 128 + bcc * 8);
              bp3 = *(const uint4*)(YB + (tok0_ + (size_t)(br + 48)) * 2048 + 0 + cb_ * 128 + bcc * 8);
              bp4 = *(const uint4*)(YB + (tok0_ + (size_t)(br + 64)) * 2048 + 0 + cb_ * 128 + bcc * 8);
              bp5 = *(const uint4*)(YB + (tok0_ + (size_t)(br + 80)) * 2048 + 0 + cb_ * 128 + bcc * 8);
              bp6 = *(const uint4*)(YB + (tok0_ + (size_t)(br + 96)) * 2048 + 0 + cb_ * 128 + bcc * 8);
              bp7 = *(const uint4*)(YB + (tok0_ + (size_t)(br + 112)) * 2048 + 0 + cb_ * 128 + bcc * 8);
              bp8 = *(const uint4*)(YB + (tok0_ + (size_t)(br + 0)) * 2048 + 1024 + cb_ * 128 + bcc * 8);
              bp9 = *(const uint4*)(YB + (tok0_ + (size_t)(br + 16)) * 2048 + 1024 + cb_ * 128 + bcc * 8);
              bp10 = *(const uint4*)(YB + (tok0_ + (size_t)(br + 32)) * 2048 + 1024 + cb_ * 128 + bcc * 8);
              bp11 = *(const uint4*)(YB + (tok0_ + (size_t)(br + 48)) * 2048 + 1024 + cb_ * 128 + bcc * 8);
              bp12 = *(const uint4*)(YB + (tok0_ + (size_t)(br + 64)) * 2048 + 1024 + cb_ * 128 + bcc * 8);
              bp13 = *(const uint4*)(YB + (tok0_ + (size_t)(br + 80)) * 2048 + 1024 + cb_ * 128 + bcc * 8);
              bp14 = *(const uint4*)(YB + (tok0_ + (size_t)(br + 96)) * 2048 + 1024 + cb_ * 128 + bcc * 8);
              bp15 = *(const uint4*)(YB + (tok0_ + (size_t)(br + 112)) * 2048 + 1024 + cb_ * 128 + bcc * 8);
        }
        for (; it < 1024; it += gridDim.x) {
          const int b = it >> 9, k1 = (it >> 3) & 63, cb = it & 7;
          __syncthreads();
            *(uint4*)(smem + L_B + (0 + br + 0) * 320 + bcc * 16) = bp0;
            *(uint4*)(smem + L_B + (0 + br + 16) * 320 + bcc * 16) = bp1;
            *(uint4*)(smem + L_B + (0 + br + 32) * 320 + bcc * 16) = bp2;
            *(uint4*)(smem + L_B + (0 + br + 48) * 320 + bcc * 16) = bp3;
            *(uint4*)(smem + L_B + (0 + br + 64) * 320 + bcc * 16) = bp4;
            *(uint4*)(smem + L_B + (0 + br + 80) * 320 + bcc * 16) = bp5;
            *(uint4*)(smem + L_B + (0 + br + 96) * 320 + bcc * 16) = bp6;
            *(uint4*)(smem + L_B + (0 + br + 112) * 320 + bcc * 16) = bp7;
            *(uint4*)(smem + L_B + (128 + br + 0) * 320 + bcc * 16) = bp8;
            *(uint4*)(smem + L_B + (128 + br + 16) * 320 + bcc * 16) = bp9;
            *(uint4*)(smem + L_B + (128 + br + 32) * 320 + bcc * 16) = bp10;
            *(uint4*)(smem + L_B + (128 + br + 48) * 320 + bcc * 16) = bp11;
            *(uint4*)(smem + L_B + (128 + br + 64) * 320 + bcc * 16) = bp12;
            *(uint4*)(smem + L_B + (128 + br + 80) * 320 + bcc * 16) = bp13;
            *(uint4*)(smem + L_B + (128 + br + 96) * 320 + bcc * 16) = bp14;
            *(uint4*)(smem + L_B + (128 + br + 112) * 320 + bcc * 16) = bp15;
          __syncthreads();
          if (it + (int)gridDim.x < 1024) {
            const int itn_ = it + (int)gridDim.x;
            const int b_ = itn_ >> 9, k1_ = (itn_ >> 3) & 63, cb_ = itn_ & 7;
            const size_t tok0_ = (size_t)b_ * 8192 + k1_ * 128;
              bp0 = *(const uint4*)(YB + (tok0_ + (size_t)(br + 0)) * 2048 + 0 + cb_ * 128 + bcc * 8);
              bp1 = *(const uint4*)(YB + (tok0_ + (size_t)(br + 16)) * 2048 + 0 + cb_ * 128 + bcc * 8);
              bp2 = *(const uint4*)(YB + (tok0_ + (size_t)(br + 32)) * 2048 + 0 + cb_ * 128 + bcc * 8);
              bp3 = *(const uint4*)(YB + (tok0_ + (size_t)(br + 48)) * 2048 + 0 + cb_ * 128 + bcc * 8);
              bp4 = *(const uint4*)(YB + (tok0_ + (size_t)(br + 64)) * 2048 + 0 + cb_ * 128 + bcc * 8);
              bp5 = *(const uint4*)(YB + (tok0_ + (size_t)(br + 80)) * 2048 + 0 + cb_ * 128 + bcc * 8);
              bp6 = *(const uint4*)(YB + (tok0_ + (size_t)(br + 96)) * 2048 + 0 + cb_ * 128 + bcc * 8);
              bp7 = *(const uint4*)(YB + (tok0_ + (size_t)(br + 112)) * 2048 + 0 + cb_ * 128 + bcc * 8);
              bp8 = *(const uint4*)(YB + (tok0_ + (size_t)(br + 0)) * 2048 + 1024 + cb_ * 128 + bcc * 8);
              bp9 = *(const uint4*)(YB + (tok0_ + (size_t)(br + 16)) * 2048 + 1024 + cb_ * 128 + bcc * 8);
              bp10 = *(const uint4*)(YB + (tok0_ + (size_t)(br + 32)) * 2048 + 1024 + cb_ * 128 + bcc * 8);
              bp11 = *(const uint4*)(YB + (tok0_ + (size_t)(br + 48)) * 2048 + 1024 + cb_ * 128 + bcc * 8);
              bp12 = *(const uint4*)(YB + (tok0_ + (size_t)(br + 64)) * 2048 + 1024 + cb_ * 128 + bcc * 8);
              bp13 = *(const uint4*)(YB + (tok0_ + (size_t)(br + 80)) * 2048 + 1024 + cb_ * 128 + bcc * 8);
              bp14 = *(const uint4*)(YB + (tok0_ + (size_t)(br + 96)) * 2048 + 1024 + cb_ * 128 + bcc * 8);
              bp15 = *(const uint4*)(YB + (tok0_ + (size_t)(br + 112)) * 2048 + 1024 + cb_ * 128 + bcc * 8);
          }
          f32x16 acc[2][2];
#pragma unroll
          for (int i = 0; i < 2; ++i)
#pragma unroll
            for (int jj = 0; jj < 2; ++jj)
#pragma unroll
              for (int r = 0; r < 16; ++r) acc[i][jj][r] = 0.f;
          const int g = lane >> 4, li = lane & 15, qq = li >> 2, pp = li & 3;
          const int tr_base = (8 * (g >> 1) + qq) * 320 + (16 * (g & 1) + 4 * pp) * 2;
#pragma unroll
          for (int ks = 0; ks < 16; ++ks) {
            s16x8 af[2];
#pragma unroll
            for (int h = 0; h < 2; ++h) af[h] = *(const s16x8*)(smem + L_F2 + (32 * (rt0 + 2 * h) + l31) * 528 + (ks * 16 + hh * 8) * 2);
#pragma unroll
            for (int c2 = 0; c2 < 2; ++c2) {
              const int off = L_B + tr_base + ks * 16 * 320 + (ctb + c2) * 64;
              const s16x4 lo = __builtin_amdgcn_ds_read_tr16_b64_v4i16((__attribute__((address_space(3))) s16x4*)(smem + off));
              const s16x4 hi = __builtin_amdgcn_ds_read_tr16_b64_v4i16((__attribute__((address_space(3))) s16x4*)(smem + off + 4 * 320));
              const s16x8 bq = __builtin_shufflevector(lo, hi, 0, 1, 2, 3, 4, 5, 6, 7);
#pragma unroll
              for (int h = 0; h < 2; ++h) acc[h][c2] = MFMA(af[h], bq, acc[h][c2]);
            }
          }
#pragma unroll
          for (int c2 = 0; c2 < 2; ++c2) {
            const int cc = cb * 128 + 32 * (ctb + c2) + l31;
            const float bm = bmix[cc];
#pragma unroll
            for (int r = 0; r < 16; ++r) {
              const int rowA = 32 * rt0 + crow(r, hh);
              if ((r & 3) == 0) asm volatile("" ::: "memory");
              bf16_t* z0 = T3 + ((size_t)b * 8192 + k1 + 64 * rowA) * D + cc;
              bf16_t* z1 = T3 + ((size_t)b * 8192 + k1 + 64 * (rowA + 64)) * D + cc;
              z0[0] = f2bf((acc[0][c2][r] * scale + bm) * silu_f(bf2f(z0[0])));
              z1[0] = f2bf((acc[1][c2][r] * scale + bm) * silu_f(bf2f(z1[0])));
            }
          }
        }
      } break;
      case PH_FOUT: {
        const int NBIG = 512, NSMALL = (NR / 128 * 4 - NBIG) * 2;
        for (int t = blockIdx.x; t < NBIG + NSMALL; t += gridDim.x) {
          if (t < NBIG) {
            const int mt = t / 4, nt = t % 4;
            gemm_tile_n<false, 4>(T3, nullptr, nullptr, 1024, W + (size_t)3072 * 1024, 1024, 1024, mt * 128, nt * 256, 1024, smem, TID,
                                  [=](int row, int col, float v) { T1[(size_t)row * D + col] = f2bf(v); });
          } else {
            const int u = t - NBIG, mt = 128 + u / 8, nt = u % 8;
            gemm_tile_n<false, 2>(T3, nullptr, nullptr, 1024, W + (size_t)3072 * 1024, 1024, 1024, mt * 128, nt * 128, 1024, smem, TID,
                                  [=](int row, int col, float v) { T1[(size_t)row * D + col] = f2bf(v); });
          }
        }
      } break;
      case PH_POSTPRE: {
        const int nl = layer + 1;
        if (nl & 1) { for (int it = blockIdx.x; it < N_RWPREP; it += gridDim.x) rwkv_wprep(p, nl >> 1, it, smem, TID); }
        else {
          for (int it = blockIdx.x; it < 128 + N_FWPREP; it += gridDim.x) {
            if (it < 128) fourier_precompose(p, it, smem, TID); else fourier_wprep(p, nl >> 1, it - 128, smem, TID);
          }
        }
        const bf16_t* O = (layer & 1) ? T2 : T1;
        row_items(p, layer, true, true, NR, O, T0, blockIdx.x, NR / 4, TID);
      } break;
      case PH_RSHIFT: {
        for (int idx = blockIdx.x * 256 + tid; idx < NR * 128; idx += gridDim.x * 256) {
          const int row = idx >> 7, cc = (idx & 127) * 8;
          bool ok0, ok1, ok2, ok3; float wgt;
          if (row < NLAT) {
            const int t = row & 8191, gy = t >> 6, gx = t & 63;
            wgt = 0.25f;
            ok0 = gy > 0; ok1 = gy < 127; ok2 = gx > 0; ok3 = gx < 63;
          } else {
            const int t = (row - NLAT) & 255;
            wgt = 0.5f;
            ok0 = false; ok1 = false; ok2 = t > 0; ok3 = t < 255;
          }
          float a[8] = {0, 0, 0, 0, 0, 0, 0, 0};
#pragma unroll
          for (int q = 0; q < 4; ++q) {
            const bool ok = q == 0 ? ok0 : (q == 1 ? ok1 : (q == 2 ? ok2 : ok3));
            const int nrow = q == 0 ? row - 64 : (q == 1 ? row + 64 : (q == 2 ? row - 1 : row + 1));
            if (ok) {
              const uint4 u = *(const uint4*)(T0 + (size_t)nrow * D + cc);
              a[0] += lo2f(u.x); a[1] += hi2f(u.x); a[2] += lo2f(u.y); a[3] += hi2f(u.y);
              a[4] += lo2f(u.z); a[5] += hi2f(u.z); a[6] += lo2f(u.w); a[7] += hi2f(u.w);
            }
          }
          *(uint4*)(T1 + (size_t)row * D + cc) = make_uint4(pack2(a[0] * wgt, a[1] * wgt), pack2(a[2] * wgt, a[3] * wgt),
                                                            pack2(a[4] * wgt, a[5] * wgt), pack2(a[6] * wgt, a[7] * wgt));
        }
        if (layer == 1) {
          for (int it = blockIdx.x; it < N_CWPREP; it += gridDim.x) fourier_cw_prep(p, 1, it, smem, TID);
        }
      } break;
      case PH_RINPROJ: {
        const int N = (j >= 1) ? 4384 : 4352;
        const int MT = NR / 128;
        const int NT_MAIN = 16, NT_TAIL = (N - 4096 + 127) / 128, NT = NT_MAIN + NT_TAIL;
        bf16_t* Vd = (j == 0) ? VF : T5;
        bf16_t* LW = (bf16_t*)(p.ws + OFF_LW);
        bf16_t* LA = (bf16_t*)(p.ws + OFF_LA);
        bf16_t* LV = (bf16_t*)(p.ws + OFF_LV);
        for (int t = blockIdx.x; t < MT * NT; t += gridDim.x) {
          const int mt = t / NT, nt = t % NT;
          if (nt < NT_MAIN) {
            const int n0 = nt * 256;
            const float* mu = p.r_mu + (size_t)(j * 6 + (n0 >> 10)) * 1024;
            gemm_tile_n<true, 4>(T0, T1, mu, 1024, W, 1024, 1024, mt * 128, n0, 4096, smem, TID, [=](int row, int col, float v) {
              bf16_t* dst = col < 1024 ? T2 : (col < 2048 ? T3 : (col < 3072 ? Vd : T4));
              dst[(size_t)row * D + (col & 1023)] = f2bf(v);
            });
          } else {
            const int n0 = 4096 + (nt - NT_MAIN) * 128;
            const int pi = n0 < 4224 ? 4 : (n0 < 4352 ? 5 : 2);
            const float* mu = p.r_mu + (size_t)(j * 6 + pi) * 1024;
            gemm_tile_n<true, 2>(T0, T1, mu, 1024, W, 1024, 1024, mt * 128, n0, N, smem, TID, [=](int row, int col, float v) {
              if (col < 4224) LW[(size_t)row * 128 + (col - 4096)] = f2bf(tanhf(v));
              else if (col < 4352) LA[(size_t)row * 128 + (col - 4224)] = f2bf(v);
              else LV[(size_t)row * 32 + (col - 4352)] = f2bf(v);
            });
          }
        }
      } break;
      case PH_RVUPD: {
        const bf16_t* LV = (const bf16_t*)(p.ws + OFF_LV);
        const float* v2 = p.r_v2 + (size_t)(j - 1) * 32 * 1024;
        const float* v0 = p.r_v0 + (size_t)(j - 1) * 1024;
        float* v2s = (float*)smem;
        __syncthreads();
        for (int e = tid; e < 32 * 256; e += 256) *(float4*)(v2s + e * 4) = *(const float4*)(v2 + e * 4);
        __syncthreads();
        const int wave = tid >> 6, lane = tid & 63;
        for (int row = blockIdx.x * 4 + wave; row < NR; row += gridDim.x * 4) {
          const float lvl = bf2f(LV[(size_t)row * 32 + (lane & 31)]);
          float acc[16];
#pragma unroll
          for (int qd = 0; qd < 4; ++qd) {
            const float4 t = *(const float4*)(v0 + qd * 256 + lane * 4);
            acc[qd * 4] = t.x; acc[qd * 4 + 1] = t.y; acc[qd * 4 + 2] = t.z; acc[qd * 4 + 3] = t.w;
          }
#pragma unroll 4
          for (int l = 0; l < 32; ++l) {
            const float a = __int_as_float(__builtin_amdgcn_readlane(__float_as_int(lvl), l));
#pragma unroll
            for (int qd = 0; qd < 4; ++qd) {
              const float4 wv = *(const float4*)(v2s + l * 1024 + qd * 256 + lane * 4);
              acc[qd * 4] += a * wv.x; acc[qd * 4 + 1] += a * wv.y; acc[qd * 4 + 2] += a * wv.z; acc[qd * 4 + 3] += a * wv.w;
            }
          }
#pragma unroll
          for (int qd = 0; qd < 4; ++qd) {
            const size_t idx = (size_t)row * D + qd * 256 + lane * 4;
            const uint2 uv = *(const uint2*)(T5 + idx);
            const uint2 uf = *(const uint2*)(VF + idx);
            float v[4] = {lo2f(uv.x), hi2f(uv.x), lo2f(uv.y), hi2f(uv.y)};
            const float f[4] = {lo2f(uf.x), hi2f(uf.x), lo2f(uf.y), hi2f(uf.y)};
#pragma unroll
            for (int e = 0; e < 4; ++e) v[e] = v[e] + (f[e] - v[e]) * fsig(acc[qd * 4 + e]);
            *(uint2*)(T5 + idx) = make_uint2(pack2(v[0], v[1]), pack2(v[2], v[3]));
          }
        }
      } break;
      case PH_RSCANA: {
        const bf16_t* V = (j == 0) ? VF : T5;
        float* SCR = (j == 0) ? (float*)(p.ws + 5 * SLOT + (8u << 20)) : (float*)(p.ws + OFF_VF);
        for (int it = blockIdx.x; it < 64 * (NSEG - 1); it += gridDim.x)
          scan_chain_chunked<0>(p, j, it / (NSEG - 1), it % (NSEG - 1), SCR, T2, T3, V, T0, T1, smem, TID);
      } break;
      case PH_RSCAN: {
        const bf16_t* V = (j == 0) ? VF : T5;
        float* SCR = (j == 0) ? (float*)(p.ws + 5 * SLOT + (8u << 20)) : (float*)(p.ws + OFF_VF);
        for (int it = blockIdx.x; it < 64 * NSEG; it += gridDim.x)
          scan_chain_chunked<1>(p, j, it / NSEG, it % NSEG, SCR, T2, T3, V, T0, T1, smem, TID);
      } break;
      case PH_ROUTPUT: {
        const bf16_t* V = (j == 0) ? VF : T5;
        const float* BON = (const float*)(p.ws + OFF_BON);
        const int wave = tid >> 6, lane = tid & 63;
        const int nrows = (layer == 3) ? NLAT : NR;
        for (int wi = blockIdx.x * 4 + wave; wi < nrows * 2; wi += gridDim.x * 4) {
          const int row = wi >> 1, c = (wi & 1) * 512 + lane * 8, h = c >> 6;
          const size_t idx = (size_t)row * D + c;
          const uint4 u0 = *(const uint4*)(T0 + idx), u1 = *(const uint4*)(T1 + idx), uv = *(const uint4*)(V + idx), ug = *(const uint4*)(T4 + idx);
          const float4 w0 = *(const float4*)(p.r_ln_w + (size_t)j * 1024 + c), w1 = *(const float4*)(p.r_ln_w + (size_t)j * 1024 + c + 4);
          const float4 b0 = *(const float4*)(p.r_ln_b + (size_t)j * 1024 + c), b1 = *(const float4*)(p.r_ln_b + (size_t)j * 1024 + c + 4);
          const float bon = BON[((size_t)0 * NR + row) * 16 + h] + BON[((size_t)1 * NR + row) * 16 + h];
          float y[8] = {lo2f(u0.x) + lo2f(u1.x), hi2f(u0.x) + hi2f(u1.x), lo2f(u0.y) + lo2f(u1.y), hi2f(u0.y) + hi2f(u1.y),
                        lo2f(u0.z) + lo2f(u1.z), hi2f(u0.z) + hi2f(u1.z), lo2f(u0.w) + lo2f(u1.w), hi2f(u0.w) + hi2f(u1.w)};
          const float vf[8] = {lo2f(uv.x), hi2f(uv.x), lo2f(uv.y), hi2f(uv.y), lo2f(uv.z), hi2f(uv.z), lo2f(uv.w), hi2f(uv.w)};
          const float gf[8] = {lo2f(ug.x), hi2f(ug.x), lo2f(ug.y), hi2f(ug.y), lo2f(ug.z), hi2f(ug.z), lo2f(ug.w), hi2f(ug.w)};
          const float lw8[8] = {w0.x, w0.y, w0.z, w0.w, w1.x, w1.y, w1.z, w1.w};
          const float lb8[8] = {b0.x, b0.y, b0.z, b0.w, b1.x, b1.y, b1.z, b1.w};
          float sm = 0.f;
#pragma unroll
          for (int e = 0; e < 8; ++e) sm += y[e];
          sm += __shfl_xor(sm, 1, 64); sm += __shfl_xor(sm, 2, 64); sm += __shfl_xor(sm, 4, 64);
          const float mean = sm * (1.f / 64.f);
          float vr = 0.f;
#pragma unroll
          for (int e = 0; e < 8; ++e) { y[e] -= mean; vr += y[e] * y[e]; }
          vr += __shfl_xor(vr, 1, 64); vr += __shfl_xor(vr, 2, 64); vr += __shfl_xor(vr, 4, 64);
          const float rstd = rsqrtf(vr * (1.f / 64.f) + GN_EPS);
          float o[8];
#pragma unroll
          for (int e = 0; e < 8; ++e) o[e] = (y[e] * rstd * lw8[e] + lb8[e] + bon * vf[e]) * silu_f(gf[e]);
          *(uint4*)(T4 + idx) = make_uint4(pack2(o[0], o[1]), pack2(o[2], o[3]), pack2(o[4], o[5]), pack2(o[6], o[7]));
        }
      } break;
      case PH_ROUTPROJ: {
        const int MT = ((layer == 3) ? NLAT : NR) / 128;
        const int NBIG = 512, NSMALL = (MT * 4 - NBIG) * 2;
        for (int t = blockIdx.x; t < NBIG + NSMALL; t += gridDim.x) {
          if (t < NBIG) {
            const int mt = t / 4, nt = t % 4;
            gemm_tile_n<false, 4>(T4, nullptr, nullptr, 1024, W + (size_t)4384 * 1024, 1024, 1024, mt * 128, nt * 256, 1024, smem, TID,
                                  [=](int row, int col, float v) { T2[(size_t)row * D + col] = f2bf(v); });
          } else {
            const int u = t - NBIG, mt = 128 + u / 8, nt = u % 8;
            gemm_tile_n<false, 2>(T4, nullptr, nullptr, 1024, W + (size_t)4384 * 1024, 1024, 1024, mt * 128, nt * 128, 1024, smem, TID,
                                  [=](int row, int col, float v) { T2[(size_t)row * D + col] = f2bf(v); });
          }
        }
      } break;
      case PH_POSTLAST: {
        row_items(p, layer, true, false, NLAT, T2, nullptr, blockIdx.x, NLAT / 4, TID);
      } break;
    }
}

#define XB_TMO      128
#define XB_XCNT(j)  (256  + 64 * (j))
#define XB_XSUB(j)  (1280 + 64 * (j))
#define XB_XGEN(j)  (2304 + 64 * (j))
#define XB_TOP      3328
#define XB_TOPGEN   3392
#define XCD_BAR_WORDS 3456
#define XB_SPIN_CAP (1u << 23)
#define LAS __attribute__((address_space(3)))

__device__ __forceinline__ unsigned xb_ld(unsigned* p)              { return __hip_atomic_load(p, __ATOMIC_RELAXED, __HIP_MEMORY_SCOPE_AGENT); }
__device__ __forceinline__ unsigned xb_add(unsigned* p, unsigned v) { return __hip_atomic_fetch_add(p, v, __ATOMIC_RELAXED, __HIP_MEMORY_SCOPE_AGENT); }
__device__ __forceinline__ unsigned xb_xcc_id() { return (unsigned)__builtin_amdgcn_s_getreg((3 << 11) | 20) & 0xFu; }
#define XB_SPIN(cond, bar) do { unsigned _sp = 0; while (cond) { __builtin_amdgcn_s_sleep(1); \
    if ((++_sp & 255u) == 0u) { if (xb_ld(&(bar)[XB_TMO])) break; if (_sp > XB_SPIN_CAP) { atomicAdd(&(bar)[XB_TMO], 1u); break; } } } } while (0)

struct XcdBarrier {
    unsigned* bar; unsigned x;
    volatile LAS unsigned* st;
};

__device__ __forceinline__ XcdBarrier xcd_barrier_post(unsigned* bar, volatile LAS unsigned* st) {
    XcdBarrier b; b.bar = bar; b.x = xb_xcc_id(); b.st = st;
    if (threadIdx.x == 0) (void)xb_add(&bar[XB_XCNT(b.x)], 1u);
    return b;
}
__device__ __forceinline__ void xcd_barrier_complete(unsigned* bar, unsigned x, unsigned& nloc, unsigned& nx) {
    const unsigned G = gridDim.x * gridDim.y * gridDim.z;
    unsigned sum, cnt, mine, sp = 0u;
    for (;;) {
        sum = 0u; cnt = 0u; mine = 0u;
#pragma unroll
        for (unsigned j = 0; j < 16; ++j) { const unsigned c = xb_ld(&bar[XB_XCNT(j)]); sum += c; cnt += (c > 0u) ? 1u : 0u; mine = (j == x) ? c : mine; }
        if (sum == G) break;
        __builtin_amdgcn_s_sleep(1);
        if ((++sp & 255u) == 0u) { if (xb_ld(&bar[XB_TMO])) break; if (sp > XB_SPIN_CAP) { atomicAdd(&bar[XB_TMO], 1u); break; } }
    }
    nloc = mine > 0u ? mine : 1u; nx = cnt > 0u ? cnt : 1u;
}

__device__ __forceinline__ void xcd_barrier(const XcdBarrier& b) {
    asm volatile("s_waitcnt vmcnt(0)" ::: "memory");
    __syncthreads();
    if (threadIdx.x == 0) {
        unsigned* bar = b.bar;
        __builtin_amdgcn_s_waitcnt(0);
        unsigned nloc = b.st[0], nx = b.st[1];
        if (nloc == 0u) { xcd_barrier_complete(bar, b.x, nloc, nx); b.st[0] = nloc; b.st[1] = nx; }
        const unsigned old = xb_add(&bar[XB_XSUB(b.x)], 1u);
        const unsigned gen = old / nloc;
        if (old + 1u == (gen + 1u) * nloc) {
            __builtin_amdgcn_fence(__ATOMIC_RELEASE, "agent");
            asm volatile("s_waitcnt vmcnt(0)" ::: "memory");
            const unsigned og = xb_add(&bar[XB_TOP], 1u);
            const unsigned tg = og / nx;
            if (og + 1u == (tg + 1u) * nx) xb_add(&bar[XB_TOPGEN], 1u);
            else XB_SPIN(xb_ld(&bar[XB_TOPGEN]) == tg, bar);
            __builtin_amdgcn_fence(__ATOMIC_ACQUIRE, "agent");
            xb_add(&bar[XB_XGEN(b.x)], 1u);
            asm volatile("s_waitcnt vmcnt(0)" ::: "memory");
        } else {
            XB_SPIN(xb_ld(&bar[XB_XGEN(b.x)]) == gen, bar);
            __builtin_amdgcn_fence(__ATOMIC_ACQUIRE, "agent");
            asm volatile("s_waitcnt vmcnt(0)" ::: "memory");
        }
    }
    __syncthreads();
}


__global__ void __launch_bounds__(256, 1) mega(Params p) {
  __shared__ __attribute__((aligned(16))) char smem[CS_END];
  cg::grid_group grid = cg::this_grid();
  __shared__ uint4 xb_words;
  if (threadIdx.x == 0) xb_words = make_uint4(0u, 0u, 0u, 0u);
  __syncthreads();
  XcdBarrier xb = xcd_barrier_post((unsigned*)(p.ws + OFF_BAR), (volatile LAS unsigned*)&xb_words);
  for (int ph = p.phase_lo; ph < p.phase_hi; ++ph) {
    int tid_l = threadIdx.x;
    asm volatile("" : "+v"(tid_l));
    run_phase(p, ph, smem, tid_l);
#ifdef REP_MASK
    if ((REP_MASK >> p.ptype[ph]) & 1) { asm volatile("s_waitcnt vmcnt(0) lgkmcnt(0)" ::: "memory"); grid.sync(); asm volatile("" : "+v"(tid_l)); run_phase(p, ph, smem, tid_l); }
#endif
    if (ph + 1 < p.phase_hi) {
      asm volatile("s_waitcnt vmcnt(0) lgkmcnt(0)" ::: "memory");
      if (ph == p.phase_lo) grid.sync();
      else xcd_barrier(xb);
    }
  }
}

extern "C" void kernel_launch(void* const* d_in, const int* in_sizes, int n_in, void* d_out, int out_size, void* d_ws, size_t ws_size,
                              hipStream_t stream) {
  static int grid_blocks = 0;
  if (!grid_blocks) {
    int dev = 0, cus = 0, per_cu = 0;
    hipGetDevice(&dev);
    hipDeviceGetAttribute(&cus, hipDeviceAttributeMultiprocessorCount, dev);
    hipOccupancyMaxActiveBlocksPerMultiprocessor(&per_cu, mega, 256, 0);
    if (per_cu > 2) per_cu = 2;
    if (per_cu < 1) per_cu = 1;
    grid_blocks = cus * per_cu;
  }
  Params p;
  memset(&p, 0, sizeof(p));
  const float** fp = (const float**)&p;
  for (int i = 0; i < 29; ++i) fp[i] = (const float*)d_in[i];
  p.out = (float*)d_out;
  p.ws = (char*)d_ws;
  int n = 0;
  auto add = [&](int t, int l) { p.ptype[n] = (unsigned char)t; p.player[n] = (unsigned char)l; ++n; };
  add(PH_PREP0, 0);
  add(PH_PRE0, 0);
  for (int l = 0; l < 4; ++l) {
    if ((l & 1) == 0) {
      add(PH_FGEMM1, l); add(PH_FDFT1, l); add(PH_FDFT3, l); add(PH_FOUT, l); add(PH_POSTPRE, l);
    } else {
      add(PH_RSHIFT, l); add(PH_RINPROJ, l);
      if (l == 3) add(PH_RVUPD, l);
      add(PH_RSCANA, l); add(PH_RSCAN, l); add(PH_ROUTPUT, l); add(PH_ROUTPROJ, l);
      add(l == 3 ? PH_POSTLAST : PH_POSTPRE, l);
    }
  }
#ifdef DBG_STOP
  n = DBG_STOP; add(PH_DUMP, 0);
#endif
#if SINGLE_LAUNCH
  hipMemsetAsync((char*)d_ws + OFF_BAR, 0, 3456 * 4, stream);
  p.phase_lo = 0; p.phase_hi = n;
  void* args[] = {&p};
  hipError_t e = hipLaunchCooperativeKernel((void*)mega, dim3(grid_blocks), dim3(256), args, 0, stream);
  if (e != hipSuccess) fprintf(stderr, "cooperative launch failed: %s (grid %d)\n", hipGetErrorString(e), grid_blocks);
#else
  for (int i = 0; i < n; ++i) {
    p.phase_lo = i; p.phase_hi = i + 1;
    hipLaunchKernelGGL(mega, dim3(grid_blocks), dim3(256), 0, stream, p);
  }
#endif
}
```

```cpp
#include <hip/hip_runtime.h>
#include <hip/hip_cooperative_groups.h>
#include <cstdio>
#include <cstring>
namespace cg = cooperative_groups;

#ifndef DBG_MASK
#define DBG_MASK 0
#endif
#ifndef SINGLE_LAUNCH
#define SINGLE_LAUNCH 1
#endif

typedef unsigned short bf16_t;
typedef short s16x8 __attribute__((ext_vector_type(8)));
typedef short s16x4 __attribute__((ext_vector_type(4)));
typedef float f32x16 __attribute__((ext_vector_type(16)));
#define DI __device__ __forceinline__
#define MFMA(a, b, c) __builtin_amdgcn_mfma_f32_32x32x16_bf16((a), (b), (c), 0, 0, 0)

constexpr int NR = 16896;
constexpr int NLAT = 16384;
constexpr int D = 1024;
constexpr size_t SLOT = (size_t)NR * D * 2;
constexpr float RMS_EPS = 1e-6f;
constexpr float GN_EPS = 64e-5f;

constexpr size_t OFF_T0 = 0;
constexpr size_t OFF_VF = 6 * SLOT;
constexpr size_t OFF_XCTX = OFF_VF + SLOT;
constexpr size_t OFF_W = OFF_XCTX + (size_t)512 * D * 4;
constexpr size_t W_BYTES = (size_t)(4384 + 1024) * 1024 * 2;
constexpr size_t OFF_LW = OFF_W + W_BYTES;
constexpr size_t OFF_LA = OFF_LW + (size_t)NR * 128 * 2;
constexpr size_t OFF_LV = OFF_LA + (size_t)NR * 128 * 2;
constexpr size_t OFF_MOD = OFF_LV + (size_t)NR * 32 * 2;
constexpr size_t OFF_F1 = OFF_MOD + (size_t)4 * 3 * 3072 * 4;
constexpr size_t OFF_F2 = OFF_F1 + 128 * 128 * 2;
constexpr size_t OFF_FC = OFF_F2 + 128 * 256 * 2;
constexpr size_t OFF_TW = OFF_FC + 256 * 512 * 2;
constexpr size_t OFF_BON = OFF_TW + 64 * 128 * 8;
constexpr size_t OFF_BAR = OFF_BON + (size_t)2 * NR * 16 * 4;
constexpr size_t WS_END = OFF_BAR + 3456 * 4;
static_assert(WS_END <= 268435456ull, "workspace overflow");

enum { PH_PREP0 = 0, PH_PRE0, PH_FGEMM1, PH_FDFT1, PH_FDFT3, PH_FOUT, PH_POSTPRE, PH_RSHIFT, PH_RINPROJ, PH_RVUPD, PH_RSCAN, PH_ROUTPUT, PH_ROUTPROJ, PH_POSTLAST, PH_DUMP, PH_RSCANA };

struct Params {
  const float *x, *c, *ctx, *c_ctx, *mod_w, *mod_b, *norm_pre, *norm_post, *f_w_in, *f_w_mix, *f_b_mix, *f_w_out,
      *r_mu, *r_w_in, *r_w0, *r_w1, *r_w2, *r_a0, *r_a1, *r_a2, *r_v0, *r_v1, *r_v2, *r_k_k, *r_k_a, *r_r_k, *r_ln_w, *r_ln_b, *r_w_out;
  float* out;
  char* ws;
  int phase_lo, phase_hi;
  unsigned char ptype[32];
  unsigned char player[32];
};

DI float bf2f(bf16_t u) { return __uint_as_float(((unsigned)u) << 16); }
DI bf16_t f2bf(float f) { unsigned r; asm("v_cvt_pk_bf16_f32 %0, %1, %1" : "=v"(r) : "v"(f)); return (bf16_t)r; }
DI unsigned pack2(float a, float b) { unsigned r; asm("v_cvt_pk_bf16_f32 %0, %1, %2" : "=v"(r) : "v"(a), "v"(b)); return r; }
DI float lo2f(unsigned u) { return __uint_as_float(u << 16); }
DI float hi2f(unsigned u) { return __uint_as_float(u & 0xffff0000u); }
DI float silu_f(float x) { return x * __builtin_amdgcn_rcpf(1.f + __expf(-x)); }
DI float sigmoid_f(float x) { return __builtin_amdgcn_rcpf(1.f + __expf(-x)); }
DI float fsig(float x) { return __builtin_amdgcn_rcpf(1.f + __expf(-x)); }
DI float softplus_f(float x) { return fmaxf(x, 0.f) + log1pf(__expf(-fabsf(x))); }
template <int CTRL>
DI float dpp_add(float v) { return v + __int_as_float(__builtin_amdgcn_update_dpp(0, __float_as_int(v), CTRL, 0xf, 0xf, true)); }
DI float wave_sum(float v) {
  v = dpp_add<0xB1>(v);
  v = dpp_add<0x4E>(v);
  v = dpp_add<0x141>(v);
  v = dpp_add<0x140>(v);
  const int iv = __float_as_int(v);
  return __int_as_float(__builtin_amdgcn_readlane(iv, 0)) + __int_as_float(__builtin_amdgcn_readlane(iv, 16)) +
         __int_as_float(__builtin_amdgcn_readlane(iv, 32)) + __int_as_float(__builtin_amdgcn_readlane(iv, 48));
}
DI int crow(int r, int h) { return (r & 3) + 8 * (r >> 2) + 4 * h; }

template <bool MIX>
DI uint4 mix_chunk(uint4 va, uint4 vs, const float4 m0v, const float4 m1v) {
  if (!MIX) return va;
  float h, sv;
  h = lo2f(va.x); sv = lo2f(vs.x); const float e0 = h + (sv - h) * m0v.x;
  h = hi2f(va.x); sv = hi2f(vs.x); const float e1 = h + (sv - h) * m0v.y;
  h = lo2f(va.y); sv = lo2f(vs.y); const float e2 = h + (sv - h) * m0v.z;
  h = hi2f(va.y); sv = hi2f(vs.y); const float e3 = h + (sv - h) * m0v.w;
  h = lo2f(va.z); sv = lo2f(vs.z); const float e4 = h + (sv - h) * m1v.x;
  h = hi2f(va.z); sv = hi2f(vs.z); const float e5 = h + (sv - h) * m1v.y;
  h = lo2f(va.w); sv = lo2f(vs.w); const float e6 = h + (sv - h) * m1v.z;
  h = hi2f(va.w); sv = hi2f(vs.w); const float e7 = h + (sv - h) * m1v.w;
  return make_uint4(pack2(e0, e1), pack2(e2, e3), pack2(e4, e5), pack2(e6, e7));
}
struct NoDst { DI bf16_t* operator()(int) const { return nullptr; } };
template <bool MIX, int NJ, bool PLAIN, class Epi, class DstFn>
DI void gemm_tile_impl(const bf16_t* __restrict__ A, const bf16_t* __restrict__ A2, const float* __restrict__ mu, int lda,
                    const bf16_t* __restrict__ BT, int ldb, int K, int m0, int n0, int N, char* smem, const int TID, Epi epi, DstFn dst_fn) {
  constexpr int BN = 64 * NJ, NB = BN / 32, NBQ = NB / 4;
  constexpr int STAGE = (128 + BN) * 144;
  const int tid = TID, lane = tid & 63, w = tid >> 6, wm = w & 1, wn = w >> 1;
  f32x16 acc[2][NJ];
#pragma unroll
  for (int i = 0; i < 2; ++i)
#pragma unroll
    for (int j = 0; j < NJ; ++j)
#pragma unroll
      for (int r = 0; r < 16; ++r) acc[i][j][r] = 0.f;
  uint4 ra[2][4], ra2[2][4], rb[2][NB];
  const int KT = K >> 6;
  const int lrow = tid >> 3, kc = tid & 7;
  const bf16_t* Ap = A + (size_t)(m0 + lrow) * lda + kc * 8;
  const bf16_t* A2p = MIX ? (A2 + (size_t)(m0 + lrow) * lda + kc * 8) : nullptr;
  const bf16_t* Bp = BT + (size_t)(n0 + lrow) * ldb + kc * 8;
  const bool nfull = (n0 + BN <= N);
#define GEMM_LOAD(ST_, KT_) { \
    _Pragma("unroll") for (int i = 0; i < 4; ++i) { \
      ra[ST_][i] = *(const uint4*)(Ap + (size_t)(32 * i) * lda + (KT_) * 64); \
      if (MIX) ra2[ST_][i] = *(const uint4*)(A2p + (size_t)(32 * i) * lda + (KT_) * 64); } \
    _Pragma("unroll") for (int i = 0; i < NB; ++i) \
      rb[ST_][i] = (nfull || (n0 + lrow + 32 * i) < N) ? *(const uint4*)(Bp + (size_t)(32 * i) * ldb + (KT_) * 64) : make_uint4(0, 0, 0, 0); }
#define GEMM_STAGE_SLICE(ST_, KT_, Q_, BUF_) { \
    bf16_t* As_ = (bf16_t*)(smem + (BUF_) * STAGE); bf16_t* Bs_ = As_ + 128 * 72; \
    float4 m0v_ = make_float4(0, 0, 0, 0), m1v_ = m0v_; \
    if (MIX) { m0v_ = *(const float4*)(mu + (KT_) * 64 + kc * 8); m1v_ = *(const float4*)(mu + (KT_) * 64 + kc * 8 + 4); } \
    *(uint4*)(As_ + (lrow + 32 * (Q_)) * 72 + kc * 8) = mix_chunk<MIX>(ra[ST_][Q_], ra2[ST_][Q_], m0v_, m1v_); \
    _Pragma("unroll") for (int u = 0; u < NBQ; ++u) *(uint4*)(Bs_ + (lrow + 32 * ((Q_) * NBQ + u)) * 72 + kc * 8) = rb[ST_][(Q_) * NBQ + u]; }
  GEMM_LOAD(0, 0)
  if (KT > 1) GEMM_LOAD(1, 1)
  __syncthreads();
#pragma unroll
  for (int qq = 0; qq < 4; ++qq) GEMM_STAGE_SLICE(0, 0, qq, 0)
  if (KT > 2) GEMM_LOAD(0, 2)
  __syncthreads();
  for (int kt0 = 0; kt0 < KT; kt0 += 2) {
#pragma unroll
    for (int st = 0; st < 2; ++st) {
      const int kt = kt0 + st;
      if (kt < KT) {
        const bf16_t* As = (const bf16_t*)(smem + st * STAGE);
        const bf16_t* Bs = As + 128 * 72;
        const bool more = (kt + 1 < KT);
        s16x8 fa[2][2], fb[2][NJ];
#pragma unroll
        for (int i = 0; i < 2; ++i) fa[0][i] = *(const s16x8*)(As + (64 * wm + 32 * i + (lane & 31)) * 72 + (lane >> 5) * 8);
#pragma unroll
        for (int j = 0; j < NJ; ++j) fb[0][j] = *(const s16x8*)(Bs + (32 * NJ * wn + 32 * j + (lane & 31)) * 72 + (lane >> 5) * 8);
#pragma unroll
        for (int kk = 0; kk < 4; ++kk) {
          if (kk < 3) {
#pragma unroll
            for (int i = 0; i < 2; ++i) fa[(kk + 1) & 1][i] = *(const s16x8*)(As + (64 * wm + 32 * i + (lane & 31)) * 72 + (kk + 1) * 16 + (lane >> 5) * 8);
#pragma unroll
            for (int j = 0; j < NJ; ++j) fb[(kk + 1) & 1][j] = *(const s16x8*)(Bs + (32 * NJ * wn + 32 * j + (lane & 31)) * 72 + (kk + 1) * 16 + (lane >> 5) * 8);
          }
#pragma unroll
          for (int i = 0; i < 2; ++i)
#pragma unroll
            for (int j = 0; j < NJ; ++j) acc[i][j] = MFMA(fa[kk & 1][i], fb[kk & 1][j], acc[i][j]);
          if (more) GEMM_STAGE_SLICE(st ^ 1, kt + 1, kk, st ^ 1)
        }
        if (kt + 3 < KT) GEMM_LOAD(st ^ 1, kt + 3)
        __syncthreads();
      }
    }
  }
#undef GEMM_LOAD
#undef GEMM_STAGE_SLICE
  if (PLAIN) {
    constexpr int PITCH = 32 * NJ * 2 + 16;
    char* reg = smem + w * (64 * PITCH);
    const int l31 = lane & 31, hh = lane >> 5;
#pragma unroll
    for (int i = 0; i < 2; ++i)
#pragma unroll
      for (int j = 0; j < NJ; ++j)
#pragma unroll
        for (int r = 0; r < 16; ++r)
          *(bf16_t*)(reg + (32 * i + crow(r, hh)) * PITCH + (32 * j + l31) * 2) = f2bf(acc[i][j][r]);
    __syncthreads();
    const int col0 = n0 + 32 * NJ * wn;
    bf16_t* dst = dst_fn(col0) + (size_t)(m0 + 64 * wm) * D + (col0 & 1023);
    constexpr int CPR = 4 * NJ;
    constexpr int RPI = 64 / CPR;
    const int rr = lane / CPR, ch = lane % CPR;
#pragma unroll
    for (int q = 0; q < CPR; ++q) {
      const int row = rr + RPI * q;
      *(uint4*)(dst + (size_t)row * D + ch * 8) = *(const uint4*)(reg + row * PITCH + ch * 16);
    }
    return;
  }
#pragma unroll
  for (int i = 0; i < 2; ++i)
#pragma unroll
    for (int j = 0; j < NJ; ++j) {
      const int col = n0 + 32 * NJ * wn + 32 * j + (lane & 31);
      if (col < N) {
#pragma unroll
        for (int r = 0; r < 16; ++r) {
          const int row = m0 + 64 * wm + 32 * i + crow(r, lane >> 5);
          epi(row, col, acc[i][j][r]);
        }
      }
    }
}
template <bool MIX, int NJ, class Epi>
DI void gemm_tile_n(const bf16_t* __restrict__ A, const bf16_t* __restrict__ A2, const float* __restrict__ mu, int lda,
                    const bf16_t* __restrict__ BT, int ldb, int K, int m0, int n0, int N, char* smem, const int TID, Epi epi) {
  gemm_tile_impl<MIX, NJ, false>(A, A2, mu, lda, BT, ldb, K, m0, n0, N, smem, TID, epi, NoDst());
}
template <bool MIX, int NJ, class DstFn>
DI void gemm_tile_plain(const bf16_t* __restrict__ A, const bf16_t* __restrict__ A2, const float* __restrict__ mu, int lda,
                        const bf16_t* __restrict__ BT, int ldb, int K, int m0, int n0, int N, char* smem, const int TID, DstFn dst_fn) {
  gemm_tile_impl<MIX, NJ, true>(A, A2, mu, lda, BT, ldb, K, m0, n0, N, smem, TID, [](int, int, float) {}, dst_fn);
}
template <bool MIX, class Epi>
DI void gemm_tile(const bf16_t* __restrict__ A, const bf16_t* __restrict__ A2, const float* __restrict__ mu, int lda,
                  const bf16_t* __restrict__ BT, int ldb, int K, int m0, int n0, int N, char* smem, const int TID, Epi epi) {
  gemm_tile_n<MIX, 2>(A, A2, mu, lda, BT, ldb, K, m0, n0, N, smem, TID, epi);
}

template <class Epi>
DI void dft_tile(const bf16_t* __restrict__ A, int lda, int arow0, int KH, const bf16_t* __restrict__ Bre,
                 const bf16_t* __restrict__ Bim, int ldb, int tstride, char* smem, const int TID, Epi epi) {
  const int tid = TID, lane = tid & 63, w = tid >> 6;
  const int rt0 = w & 1, ctb = 2 * (w >> 1);
  f32x16 acc[2][2];
#pragma unroll
  for (int i = 0; i < 2; ++i)
#pragma unroll
    for (int j = 0; j < 2; ++j)
#pragma unroll
      for (int r = 0; r < 16; ++r) acc[i][j][r] = 0.f;
  const int nch = (2 * KH) >> 7;
  const int g = lane >> 4, li = lane & 15, q = li >> 2, pp = li & 3;
  const int tr_base = (8 * (g >> 1) + q) * 320 + (16 * (g & 1) + 4 * pp) * 2;
  for (int ch = 0; ch < nch; ++ch) {
    __syncthreads();
#pragma unroll
    for (int i = 0; i < 8; ++i) {
      const int c = tid + 256 * i, r = c >> 4, cc = c & 15;
      const int kr = ch * 128 + r;
      const bf16_t* src = (kr < KH ? Bre + (size_t)kr * tstride * ldb : Bim + (size_t)(kr - KH) * tstride * ldb) + cc * 8;
      *(uint4*)(smem + r * 320 + cc * 16) = *(const uint4*)src;
    }
    __syncthreads();
#pragma unroll
    for (int kh = 0; kh < 2; ++kh) {
      asm volatile("" ::: "memory");
      s16x8 af[4][2];
#pragma unroll
      for (int k4 = 0; k4 < 4; ++k4)
#pragma unroll
        for (int h = 0; h < 2; ++h)
          af[k4][h] = *(const s16x8*)(A + (size_t)(arow0 + 32 * (rt0 + 2 * h) + (lane & 31)) * lda + ch * 128 + (kh * 4 + k4) * 16 + (lane >> 5) * 8);
#pragma unroll
      for (int k4 = 0; k4 < 4; ++k4) {
        const int ks = kh * 4 + k4;
#pragma unroll
        for (int c2 = 0; c2 < 2; ++c2) {
          const int off = tr_base + ks * 16 * 320 + (ctb + c2) * 64;
#ifdef NO_TR
          s16x8 b;
          {
            const int n = 32 * (ctb + c2) + (lane & 31), k0 = ks * 16 + 8 * (lane >> 5);
#pragma unroll
            for (int e = 0; e < 8; ++e) b[e] = *(const short*)(smem + (k0 + e) * 320 + n * 2);
          }
#else
          const s16x4 lo = __builtin_amdgcn_ds_read_tr16_b64_v4i16((__attribute__((address_space(3))) s16x4*)(smem + off));
          const s16x4 hi = __builtin_amdgcn_ds_read_tr16_b64_v4i16((__attribute__((address_space(3))) s16x4*)(smem + off + 4 * 320));
          const s16x8 b = __builtin_shufflevector(lo, hi, 0, 1, 2, 3, 4, 5, 6, 7);
#endif
#pragma unroll
          for (int h = 0; h < 2; ++h) acc[h][c2] = MFMA(af[k4][h], b, acc[h][c2]);
        }
      }
    }
  }
#pragma unroll
  for (int c2 = 0; c2 < 2; ++c2) {
    const int col = 32 * (ctb + c2) + (lane & 31);
#pragma unroll
    for (int r = 0; r < 16; ++r) {
      const int rowA = 32 * rt0 + crow(r, lane >> 5);
      if ((r & 3) == 0) asm volatile("" ::: "memory");
      epi(rowA, rowA + 64, col, acc[0][c2][r], acc[1][c2][r]);
    }
  }
}

DI void transpose_tile(const float* __restrict__ src, int lds_, bf16_t* __restrict__ dst, int ldd, int K, int N, int tk, int tn, char* smem, const int TID) {
  float* t = (float*)smem;
  const int tid = TID;
  __syncthreads();
#pragma unroll
  for (int i = 0; i < 16; ++i) {
    const int kk = (tid >> 6) + 4 * i, nn = tid & 63;
    const int k = tk * 64 + kk, n = tn * 64 + nn;
    t[kk * 65 + nn] = (k < K && n < N) ? src[(size_t)k * lds_ + n] : 0.f;
  }
  __syncthreads();
#pragma unroll
  for (int i = 0; i < 16; ++i) {
    const int nn = (tid >> 6) + 4 * i, kk = tid & 63;
    const int k = tk * 64 + kk, n = tn * 64 + nn;
    if (k < K && n < N) dst[(size_t)n * ldd + k] = f2bf(t[kk * 65 + nn]);
  }
}

DI void fourier_wprep(const Params& p, int j, int it, char* smem, const int TID) {
  bf16_t* W = (bf16_t*)(p.ws + OFF_W);
  const int job = it >> 8, t = it & 255;
  if (job == 0) transpose_tile(p.f_w_in + (size_t)j * 1024 * 2048 + 1024, 2048, W + (size_t)2048 * 1024, 1024, 1024, 1024, t >> 4, t & 15, smem, TID);
  else transpose_tile(p.f_w_out + (size_t)j * 1024 * 1024, 1024, W + (size_t)3072 * 1024, 1024, 1024, 1024, t >> 4, t & 15, smem, TID);
}
DI void rwkv_wprep(const Params& p, int j, int it, char* smem, const int TID) {
  bf16_t* W = (bf16_t*)(p.ws + OFF_W);
  if (it < 1024) {
    const int pi = it >> 8, t = it & 255;
    transpose_tile(p.r_w_in + (size_t)(j * 4 + pi) * 1024 * 1024, 1024, W + (size_t)pi * 1024 * 1024, 1024, 1024, 1024, t >> 4, t & 15, smem, TID);
  } else if (it < 1024 + 32) {
    const int u = it - 1024, n = u >> 4, t = u & 15;
    transpose_tile(p.r_w1 + (size_t)(j * 2 + n) * 1024 * 64, 64, W + (size_t)(4096 + 64 * n) * 1024, 1024, 1024, 64, t, 0, smem, TID);
  } else if (it < 1024 + 64) {
    const int u = it - 1056, n = u >> 4, t = u & 15;
    transpose_tile(p.r_a1 + (size_t)(j * 2 + n) * 1024 * 64, 64, W + (size_t)(4224 + 64 * n) * 1024, 1024, 1024, 64, t, 0, smem, TID);
  } else if (it < 1024 + 80) {
    const int t = it - 1088;
    if (j >= 1) transpose_tile(p.r_v1 + (size_t)(j - 1) * 1024 * 32, 32, W + (size_t)4352 * 1024, 1024, 1024, 32, t, 0, smem, TID);
  } else {
    const int t = it - 1104;
    transpose_tile(p.r_w_out + (size_t)j * 1024 * 1024, 1024, W + (size_t)4384 * 1024, 1024, 1024, 1024, t >> 4, t & 15, smem, TID);
  }
}
constexpr int N_FWPREP = 512, N_RWPREP = 1360;

DI void fourier_cw_prep(const Params& p, int j, int it, char* smem, const int TID) {
  bf16_t* FWU = (bf16_t*)(p.ws + 5 * SLOT);
  bf16_t* CWT = FWU + 1024 * 1024;
  const int tid = TID;
  if (it < 256) {
#pragma unroll
    for (int i = 0; i < 4; ++i) {
      const int row = it * 4 + i;
      const float4 v = *(const float4*)(p.f_w_in + (size_t)j * 1024 * 2048 + (size_t)row * 2048 + tid * 4);
      *(uint2*)(FWU + (size_t)row * 1024 + tid * 4) = make_uint2(pack2(v.x, v.y), pack2(v.z, v.w));
    }
  } else {
    float* tab = (float*)smem;
    __syncthreads();
    if (tid < 128) tab[tid] = cospif((float)tid / 64.f);
    __syncthreads();
    const int u = it - 256, pq = u >> 7, g = (u >> 4) & 7, cb = u & 15;
    const int e = tid & 127, cbase = cb * 8 + (tid >> 7) * 4;
    const float* wm = p.f_w_mix + ((size_t)j * 8 + g) * 128 * 128;
    const int off = pq ? 32 : 0;
    float a0 = 0.f, a1 = 0.f, a2 = 0.f, a3 = 0.f;
#pragma unroll 8
    for (int c2 = 0; c2 < 128; ++c2) {
      const float wv = wm[c2 * 128 + e];
      a0 += tab[((cbase + 0) * c2 - off) & 127] * wv;
      a1 += tab[((cbase + 1) * c2 - off) & 127] * wv;
      a2 += tab[((cbase + 2) * c2 - off) & 127] * wv;
      a3 += tab[((cbase + 3) * c2 - off) & 127] * wv;
    }
    *(uint2*)(CWT + (((size_t)pq * 8 + g) * 128 + e) * 128 + cbase) = make_uint2(pack2(a0, a1), pack2(a2, a3));
  }
}
constexpr int N_CWPREP = 256 + 256;

DI void fourier_precompose(const Params& p, int it, char* smem, const int TID) {
  const bf16_t* FWU = (const bf16_t*)(p.ws + 5 * SLOT);
  const bf16_t* CWT = FWU + 1024 * 1024;
  bf16_t* W = (bf16_t*)(p.ws + OFF_W);
  const int pg = it >> 3, nt = it & 7;
  const int g = pg & 7;
  bf16_t* dst = W + (size_t)pg * 128 * 1024;
  gemm_tile<false>(CWT + (size_t)pg * 128 * 128, nullptr, nullptr, 128, FWU + g * 128, 1024, 128, 0, nt * 128, 1024, smem, TID,
                   [=](int row, int col, float v) { dst[(size_t)row * 1024 + col] = f2bf(v); });
}

DI void phase_prep0(const Params& p, char* smem, const int TID) {
  const int tid = TID;

  float* MOD = (float*)(p.ws + OFF_MOD);
  const int N_MOD = 192, N_TAB = (128 * 128 + 128 * 256 + 256 * 512 + 64 * 128) / 256;
  const int total = N_MOD + N_TAB + N_CWPREP + N_FWPREP;
  for (int it = blockIdx.x; it < total; it += gridDim.x) {
    if (it < N_MOD) {
      const int layer = it / 48, chunk = it % 48;
      const int kp = tid >> 4, cgp = tid & 15;
      const float* wbase = p.mod_w + (size_t)layer * 1024 * 3072 + chunk * 64 + cgp * 4;
      float a0[4] = {0, 0, 0, 0}, a1[4] = {0, 0, 0, 0}, a2[4] = {0, 0, 0, 0};
      float* sc = (float*)(smem + 16384);
      __syncthreads();
      for (int e = tid; e < 1024; e += 256) { sc[e] = silu_f(p.c[e]); sc[1024 + e] = silu_f(p.c[1024 + e]); sc[2048 + e] = silu_f(p.c_ctx[e]); }
      __syncthreads();
#pragma unroll 8
      for (int k = kp * 64; k < kp * 64 + 64; ++k) {
        const float4 wv = *(const float4*)(wbase + (size_t)k * 3072);
        const float s0 = sc[k], s1 = sc[1024 + k], s2 = sc[2048 + k];
        a0[0] += s0 * wv.x; a0[1] += s0 * wv.y; a0[2] += s0 * wv.z; a0[3] += s0 * wv.w;
        a1[0] += s1 * wv.x; a1[1] += s1 * wv.y; a1[2] += s1 * wv.z; a1[3] += s1 * wv.w;
        a2[0] += s2 * wv.x; a2[1] += s2 * wv.y; a2[2] += s2 * wv.z; a2[3] += s2 * wv.w;
      }
      float* red = (float*)smem;
      __syncthreads();
#pragma unroll
      for (int e = 0; e < 4; ++e) {
        red[(kp * 3 + 0) * 64 + cgp * 4 + e] = a0[e];
        red[(kp * 3 + 1) * 64 + cgp * 4 + e] = a1[e];
        red[(kp * 3 + 2) * 64 + cgp * 4 + e] = a2[e];
      }
      __syncthreads();
      if (tid < 192) {
        const int v = tid >> 6, col = tid & 63;
        float s = 0.f;
#pragma unroll
        for (int k = 0; k < 16; ++k) s += red[(k * 3 + v) * 64 + col];
        const int cidx = chunk * 64 + col;
        MOD[((size_t)layer * 3 + v) * 3072 + cidx] = s + p.mod_b[(size_t)layer * 3072 + cidx];
      }
    } else if (it < N_MOD + N_TAB) {
      int e = (it - N_MOD) * 256 + tid;
      bf16_t* F1 = (bf16_t*)(p.ws + OFF_F1);
      bf16_t* F2 = (bf16_t*)(p.ws + OFF_F2);
      bf16_t* FC = (bf16_t*)(p.ws + OFF_FC);
      float2* TW = (float2*)(p.ws + OFF_TW);
      if (e < 128 * 128) {
        const int m = e >> 7, k = e & 127;
        const int mm = m & 63, kk = k & 63;
        const float ang = (float)((mm * kk) & 63) / 32.f;
        const float cv = cospif(ang), sv = sinpif(ang);
        float val;
        if (m < 64) val = (k < 64) ? cv : -sv; else val = (k < 64) ? sv : cv;
        F1[e] = f2bf(val);
      } else if ((e -= 128 * 128) < 128 * 256) {
        const int m = e >> 8, k = e & 255, kk = k & 127;
        const float ang = (float)((m * kk) & 127) / 64.f;
        F2[e] = f2bf(k < 128 ? cospif(ang) : -sinpif(ang));
      } else if ((e -= 128 * 256) < 256 * 512) {
        const int m = e >> 9, k = e & 511, kk = k & 255;
        const float ang = (float)((m * kk) & 255) / 128.f;
        FC[e] = f2bf(k < 256 ? cospif(ang) : -sinpif(ang));
      } else {
        e -= 256 * 512;
        const int k1 = e >> 7, t2 = e & 127;
        const float ang = (float)(k1 * t2) / 4096.f;
        TW[e] = make_float2(cospif(ang), sinpif(ang));
      }
    } else if (it < N_MOD + N_TAB + N_CWPREP) {
      fourier_cw_prep(p, 0, it - N_MOD - N_TAB, smem, TID);
    } else {
      fourier_wprep(p, 0, it - N_MOD - N_TAB - N_CWPREP, smem, TID);
    }
  }
}

DI void row_items(const Params& p, int layer, bool do_post, bool do_pre, int nrows, const bf16_t* O, bf16_t* H, int it0, int nit, const int TID) {
  const int wave = TID >> 6, lane = TID & 63;
  const float* MOD = (const float*)(p.ws + OFF_MOD);
  float* XCTX = (float*)(p.ws + OFF_XCTX);
  float4 nx0, nx1, nx2, nx3;
  uint2 no0 = make_uint2(0, 0), no1 = no0, no2 = no0, no3 = no0;
#define ROW_XIN(ROW_) ((layer == 0) ? ((ROW_) < NLAT ? p.x + (size_t)(ROW_) * D : p.ctx + (size_t)((ROW_) - NLAT) * D) \
                                    : ((ROW_) < NLAT ? p.out + (size_t)(ROW_) * D : XCTX + (size_t)((ROW_) - NLAT) * D))
#define ROW_PREFETCH(ROW_) { const float* xi_ = ROW_XIN(ROW_); \
    nx0 = *(const float4*)(xi_ + lane * 4); nx1 = *(const float4*)(xi_ + 256 + lane * 4); nx2 = *(const float4*)(xi_ + 512 + lane * 4); nx3 = *(const float4*)(xi_ + 768 + lane * 4); \
    if (do_post) { const bf16_t* oi_ = O + (size_t)(ROW_) * D + lane * 4; \
      no0 = *(const uint2*)(oi_); no1 = *(const uint2*)(oi_ + 256); no2 = *(const uint2*)(oi_ + 512); no3 = *(const uint2*)(oi_ + 768); } }
  if (it0 < nit) ROW_PREFETCH(it0 * 4 + wave)
  for (int it = it0; it < nit; it += gridDim.x) {
    const int row = it * 4 + wave;
    const int v = row < 8192 ? 0 : (row < 16384 ? 1 : 2);
    float* xout = row < NLAT ? p.out + (size_t)row * D : XCTX + (size_t)(row - NLAT) * D;
    float4 xv[4] = {nx0, nx1, nx2, nx3};
    const uint2 ou[4] = {no0, no1, no2, no3};
    if (it + (int)gridDim.x < nit) ROW_PREFETCH((it + (int)gridDim.x) * 4 + wave)
    if (do_post) {
      float ov[4][4];
      float ss = 0.f;
#pragma unroll
      for (int qd = 0; qd < 4; ++qd) {
        const uint2 u = ou[qd];
        ov[qd][0] = lo2f(u.x); ov[qd][1] = hi2f(u.x); ov[qd][2] = lo2f(u.y); ov[qd][3] = hi2f(u.y);
#pragma unroll
        for (int e = 0; e < 4; ++e) ss += ov[qd][e] * ov[qd][e];
      }
      ss = wave_sum(ss);
      const float rstd = rsqrtf(ss * (1.f / 1024.f) + RMS_EPS);
      const float* gate = MOD + ((size_t)layer * 3 + v) * 3072 + 2048;
      const float* np = p.norm_post + (size_t)layer * D;
#pragma unroll
      for (int qd = 0; qd < 4; ++qd) {
        const float4 gv = *(const float4*)(gate + qd * 256 + lane * 4);
        const float4 nv = *(const float4*)(np + qd * 256 + lane * 4);
        xv[qd].x += gv.x * (ov[qd][0] * rstd * nv.x);
        xv[qd].y += gv.y * (ov[qd][1] * rstd * nv.y);
        xv[qd].z += gv.z * (ov[qd][2] * rstd * nv.z);
        xv[qd].w += gv.w * (ov[qd][3] * rstd * nv.w);
        *(float4*)(xout + qd * 256 + lane * 4) = xv[qd];
      }
    }
    if (do_pre) {
      const int L = layer + (do_post ? 1 : 0);
      float ss = 0.f;
#pragma unroll
      for (int qd = 0; qd < 4; ++qd) ss += xv[qd].x * xv[qd].x + xv[qd].y * xv[qd].y + xv[qd].z * xv[qd].z + xv[qd].w * xv[qd].w;
      ss = wave_sum(ss);
      const float rstd = rsqrtf(ss * (1.f / 1024.f) + RMS_EPS);
      const float* sh = MOD + ((size_t)L * 3 + v) * 3072;
      const float* sc = sh + 1024;
      const float* np = p.norm_pre + (size_t)L * D;
#pragma unroll
      for (int qd = 0; qd < 4; ++qd) {
        const float4 a = *(const float4*)(sh + qd * 256 + lane * 4);
        const float4 b = *(const float4*)(sc + qd * 256 + lane * 4);
        const float4 n = *(const float4*)(np + qd * 256 + lane * 4);
        const float h0 = xv[qd].x * rstd * n.x * (1.f + b.x) + a.x;
        const float h1 = xv[qd].y * rstd * n.y * (1.f + b.y) + a.y;
        const float h2 = xv[qd].z * rstd * n.z * (1.f + b.z) + a.z;
        const float h3 = xv[qd].w * rstd * n.w * (1.f + b.w) + a.w;
        *(uint2*)(H + (size_t)row * D + qd * 256 + lane * 4) = make_uint2(pack2(h0, h1), pack2(h2, h3));
      }
    }
  }
}

#undef ROW_XIN
#undef ROW_PREFETCH
DI int seq_row(int n, int b, int s) {
  if (s < 256) { const int t = n ? 255 - s : s; return NLAT + b * 256 + t; }
  const int u = s - 256; const int t = n ? 8191 - u : u; return b * 8192 + t;
}
DI void scan_chain(const Params& p, int j, int cid, const bf16_t* R, const bf16_t* Kb, const bf16_t* V, bf16_t* Y0, bf16_t* Y1, char* smem, const int TID) {
  const int n = cid >> 5, b = (cid >> 4) & 1, h = cid & 15;
  const int tid = TID;
  float* rS = (float*)smem;
  float* wS = rS + 1024; float* kS = wS + 1024; float* vS = kS + 1024; float* aS = vS + 1024; float* bS = aS + 1024;
  float* lwS = bS + 1024; float* laS = lwS + 1024;
  float* w2S = laS + 1024;
  float* a2S = w2S + 4096;
  float* yS = lwS;
  const bf16_t* LW = (const bf16_t*)(p.ws + OFF_LW);
  const bf16_t* LA = (const bf16_t*)(p.ws + OFF_LA);
  float* BON = (float*)(p.ws + OFF_BON);
  bf16_t* Y = n ? Y1 : Y0;
  __syncthreads();
  {
    const float* w2 = p.r_w2 + (size_t)(j * 2 + n) * 64 * 1024 + h * 64;
    const float* a2 = p.r_a2 + (size_t)(j * 2 + n) * 64 * 1024 + h * 64;
    for (int e = tid; e < 4096; e += 256) { w2S[e] = w2[(size_t)(e >> 6) * 1024 + (e & 63)]; a2S[e] = a2[(size_t)(e >> 6) * 1024 + (e & 63)]; }
  }
  const int ltok = tid >> 4, cq = tid & 15, c4 = cq * 4;
  const int gc = h * 64 + c4;
  const float4 w0v = *(const float4*)(p.r_w0 + (size_t)(j * 2 + n) * 1024 + gc);
  const float4 a0v = *(const float4*)(p.r_a0 + (size_t)(j * 2 + n) * 1024 + gc);
  const float4 kkv = *(const float4*)(p.r_k_k + (size_t)j * 1024 + gc);
  const float4 kav = *(const float4*)(p.r_k_a + (size_t)j * 1024 + gc);
  const float4 rkv = *(const float4*)(p.r_r_k + (size_t)j * 1024 + gc);
  const int si = tid >> 2, jq = tid & 3;
  float S[16];
#pragma unroll
  for (int e = 0; e < 16; ++e) S[e] = 0.f;
  for (int ck = 0; ck < 528; ++ck) {
    const int s = ck * 16 + ltok;
    const int row = seq_row(n, b, s);
    const uint2 ur = *(const uint2*)(R + (size_t)row * D + gc);
    const uint2 uk = *(const uint2*)(Kb + (size_t)row * D + gc);
    const uint2 uv = *(const uint2*)(V + (size_t)row * D + gc);
    const uint2 ulw = *(const uint2*)(LW + (size_t)row * 128 + n * 64 + c4);
    const uint2 ula = *(const uint2*)(LA + (size_t)row * 128 + n * 64 + c4);
    __syncthreads();
    *(float4*)(lwS + ltok * 64 + c4) = make_float4(lo2f(ulw.x), hi2f(ulw.x), lo2f(ulw.y), hi2f(ulw.y));
    *(float4*)(laS + ltok * 64 + c4) = make_float4(lo2f(ula.x), hi2f(ula.x), lo2f(ula.y), hi2f(ula.y));
    __syncthreads();
    float wz[4] = {w0v.x, w0v.y, w0v.z, w0v.w}, az[4] = {a0v.x, a0v.y, a0v.z, a0v.w};
    for (int l = 0; l < 64; ++l) {
      const float lw = lwS[ltok * 64 + l], la = laS[ltok * 64 + l];
      const float4 w2v = *(const float4*)(w2S + l * 64 + c4);
      const float4 a2v = *(const float4*)(a2S + l * 64 + c4);
      wz[0] += lw * w2v.x; wz[1] += lw * w2v.y; wz[2] += lw * w2v.z; wz[3] += lw * w2v.w;
      az[0] += la * a2v.x; az[1] += la * a2v.y; az[2] += la * a2v.z; az[3] += la * a2v.w;
    }
    const float rr[4] = {lo2f(ur.x), hi2f(ur.x), lo2f(ur.y), hi2f(ur.y)};
    const float kr[4] = {lo2f(uk.x), hi2f(uk.x), lo2f(uk.y), hi2f(uk.y)};
    const float vr[4] = {lo2f(uv.x), hi2f(uv.x), lo2f(uv.y), hi2f(uv.y)};
    const float kkw[4] = {kkv.x, kkv.y, kkv.z, kkv.w}, kaw[4] = {kav.x, kav.y, kav.z, kav.w}, rkw[4] = {rkv.x, rkv.y, rkv.z, rkv.w};
    float kk[4], ss = 0.f;
#pragma unroll
    for (int e = 0; e < 4; ++e) { kk[e] = kr[e] * kkw[e]; ss += kk[e] * kk[e]; }
#pragma unroll
    for (int o = 8; o > 0; o >>= 1) ss += __shfl_xor(ss, o, 64);
    const float inv = 1.f / fmaxf(sqrtf(ss), 1e-12f);
    float dec[4], as[4], kd[4], bb[4], bon = 0.f;
#pragma unroll
    for (int e = 0; e < 4; ++e) {
      kk[e] *= inv;
      dec[e] = __expf(-__expf(-softplus_f(-wz[e]) - 0.5f));
      as[e] = sigmoid_f(az[e]);
      kd[e] = kr[e] * (1.f + (as[e] - 1.f) * kaw[e]);
      bb[e] = kk[e] * as[e];
      bon += rr[e] * kd[e] * rkw[e];
    }
#pragma unroll
    for (int o = 8; o > 0; o >>= 1) bon += __shfl_xor(bon, o, 64);
    if (cq == 0) BON[((size_t)n * NR + row) * 16 + h] = bon;
    *(float4*)(rS + ltok * 64 + c4) = make_float4(rr[0], rr[1], rr[2], rr[3]);
    *(float4*)(wS + ltok * 64 + c4) = make_float4(dec[0], dec[1], dec[2], dec[3]);
    *(float4*)(kS + ltok * 64 + c4) = make_float4(kd[0], kd[1], kd[2], kd[3]);
    *(float4*)(vS + ltok * 64 + c4) = make_float4(vr[0], vr[1], vr[2], vr[3]);
    *(float4*)(aS + ltok * 64 + c4) = make_float4(-kk[0], -kk[1], -kk[2], -kk[3]);
    *(float4*)(bS + ltok * 64 + c4) = make_float4(bb[0], bb[1], bb[2], bb[3]);
    __syncthreads();
    for (int t = 0; t < 16; ++t) {
      float av[16], sa = 0.f;
#pragma unroll
      for (int m = 0; m < 4; ++m) {
        const float4 a4 = *(const float4*)(aS + t * 64 + jq * 16 + m * 4);
        av[m * 4] = a4.x; av[m * 4 + 1] = a4.y; av[m * 4 + 2] = a4.z; av[m * 4 + 3] = a4.w;
      }
#pragma unroll
      for (int e = 0; e < 16; ++e) sa += S[e] * av[e];
      sa += __shfl_xor(sa, 1, 64);
      sa += __shfl_xor(sa, 2, 64);
      const float vi = vS[t * 64 + si];
      float y = 0.f;
#pragma unroll
      for (int m = 0; m < 4; ++m) {
        const float4 w4 = *(const float4*)(wS + t * 64 + jq * 16 + m * 4);
        const float4 b4 = *(const float4*)(bS + t * 64 + jq * 16 + m * 4);
        const float4 k4 = *(const float4*)(kS + t * 64 + jq * 16 + m * 4);
        const float4 r4 = *(const float4*)(rS + t * 64 + jq * 16 + m * 4);
        S[m * 4 + 0] = S[m * 4 + 0] * w4.x + sa * b4.x + vi * k4.x; y += S[m * 4 + 0] * r4.x;
        S[m * 4 + 1] = S[m * 4 + 1] * w4.y + sa * b4.y + vi * k4.y; y += S[m * 4 + 1] * r4.y;
        S[m * 4 + 2] = S[m * 4 + 2] * w4.z + sa * b4.z + vi * k4.z; y += S[m * 4 + 2] * r4.z;
        S[m * 4 + 3] = S[m * 4 + 3] * w4.w + sa * b4.w + vi * k4.w; y += S[m * 4 + 3] * r4.w;
      }
      y += __shfl_xor(y, 1, 64);
      y += __shfl_xor(y, 2, 64);
      if (jq == 0) yS[t * 64 + si] = y;
    }
    __syncthreads();
    {
      const float4 yv = *(const float4*)(yS + ltok * 64 + c4);
      *(uint2*)(Y + (size_t)row * D + gc) = make_uint2(pack2(yv.x, yv.y), pack2(yv.z, yv.w));
    }
  }
}


constexpr int CS_W2T = 0, CS_A2T = 9216, CS_R1 = 18432, CS_R2 = 27648, CS_R3 = 36864, CS_WZ = 46080, CS_AZ = 62464,
              CS_AT = 78848, CS_RT = 88064, CS_BT = 97280, CS_KT = 106496, CS_VT = 115712, CS_AAB = 124928, CS_UV = 142336,
              CS_S0T = 151552, CS_TOT = 160768, CS_CL = 161792, CS_CST = 162048, CS_END = 163328;
DI s16x8 lds_row8(const char* base, int row, int col) { return *(const s16x8*)(base + row * 144 + col * 2); }
DI s16x8 lds_tr8(const char* base, int krow0, int ncol0, int lane) {
  const int g = lane >> 4, li = lane & 15, qq = li >> 2, pp = li & 3;
  const int off = (krow0 + 8 * (g >> 1) + qq) * 144 + (ncol0 + 16 * (g & 1) + 4 * pp) * 2;
  const s16x4 lo = __builtin_amdgcn_ds_read_tr16_b64_v4i16((__attribute__((address_space(3))) s16x4*)(base + off));
  const s16x4 hi = __builtin_amdgcn_ds_read_tr16_b64_v4i16((__attribute__((address_space(3))) s16x4*)(base + off + 4 * 144));
  return __builtin_shufflevector(lo, hi, 0, 1, 2, 3, 4, 5, 6, 7);
}
DI void unpack16(const uint4 a, const uint4 b, float* f) {
  f[0] = lo2f(a.x); f[1] = hi2f(a.x); f[2] = lo2f(a.y); f[3] = hi2f(a.y); f[4] = lo2f(a.z); f[5] = hi2f(a.z); f[6] = lo2f(a.w); f[7] = hi2f(a.w);
  f[8] = lo2f(b.x); f[9] = hi2f(b.x); f[10] = lo2f(b.y); f[11] = hi2f(b.y); f[12] = lo2f(b.z); f[13] = hi2f(b.z); f[14] = lo2f(b.w); f[15] = hi2f(b.w);
}
DI void store16bf(char* dst, const float* f) {
  *(uint4*)dst = make_uint4(pack2(f[0], f[1]), pack2(f[2], f[3]), pack2(f[4], f[5]), pack2(f[6], f[7]));
  *(uint4*)(dst + 16) = make_uint4(pack2(f[8], f[9]), pack2(f[10], f[11]), pack2(f[12], f[13]), pack2(f[14], f[15]));
}
constexpr int NSEG = 4, SEGCH = 33;
template <int MODE>
DI void scan_chain_chunked(const Params& p, int j, int cid, int seg, float* SCR, const bf16_t* R, const bf16_t* Kb, const bf16_t* V, bf16_t* Y0, bf16_t* Y1, char* smem, const int TID) {
  const int n = cid >> 5, b = (cid >> 4) & 1, hd = cid & 15;
  const int tid = TID, lane = tid & 63, w = tid >> 6, l31 = lane & 31, hh = lane >> 5;
  const int mi = w >> 1, ni = w & 1;
  const int tok = tid >> 2, q = tid & 3, c0 = 16 * q;
  const bf16_t* LW = (const bf16_t*)(p.ws + OFF_LW);
  const bf16_t* LA = (const bf16_t*)(p.ws + OFF_LA);
  float* BON = (float*)(p.ws + OFF_BON);
  bf16_t* Y = n ? Y1 : Y0;
  float* WZ = (float*)(smem + CS_WZ);
  float* AZ = (float*)(smem + CS_AZ);
  float* AABD = (float*)(smem + CS_AAB + 9216);
  float* TOT = (float*)(smem + CS_TOT);
  float* CL = (float*)(smem + CS_CL);
  float* CST = (float*)(smem + CS_CST);
  __syncthreads();
  {
    const float* w2 = p.r_w2 + (size_t)(j * 2 + n) * 64 * 1024 + hd * 64;
    const float* a2 = p.r_a2 + (size_t)(j * 2 + n) * 64 * 1024 + hd * 64;
    for (int e = tid; e < 4096; e += 256) {
      const int l = e >> 6, col = e & 63;
      *(bf16_t*)(smem + CS_W2T + col * 144 + l * 2) = f2bf(w2[(size_t)l * 1024 + col]);
      *(bf16_t*)(smem + CS_A2T + col * 144 + l * 2) = f2bf(a2[(size_t)l * 1024 + col]);
    }
    for (int e = tid; e < 64 * 72; e += 256) *(bf16_t*)(smem + CS_S0T + e * 2) = 0;
    if (tid < 64) {
      CST[tid] = p.r_w0[(size_t)(j * 2 + n) * 1024 + hd * 64 + tid];
      CST[64 + tid] = p.r_a0[(size_t)(j * 2 + n) * 1024 + hd * 64 + tid];
      CST[128 + tid] = p.r_k_k[(size_t)j * 1024 + hd * 64 + tid];
      CST[192 + tid] = p.r_k_a[(size_t)j * 1024 + hd * 64 + tid];
      CST[256 + tid] = p.r_r_k[(size_t)j * 1024 + hd * 64 + tid];
    }
  }
  f32x16 Sacc, Pacc;
#pragma unroll
  for (int r = 0; r < 16; ++r) { Sacc[r] = 0.f; Pacc[r] = 0.f; }
  if (MODE == 0) {
    for (int e = tid; e < 64 * 72; e += 256) *(bf16_t*)(smem + CS_RT + e * 2) = ((e / 72) == (e % 72)) ? (bf16_t)0x3f80 : (bf16_t)0;
#pragma unroll
    for (int r = 0; r < 16; ++r) Pacc[r] = ((32 * mi + crow(r, hh)) == (32 * ni + l31)) ? 1.f : 0.f;
  } else if (seg > 0) {
    const int jr = tid >> 2, ib = (tid & 3) * 16;
    const float* PQ = SCR + (size_t)(cid * 3) * 8192;
    float nv[16];
#pragma unroll
    for (int e = 0; e < 16; ++e) nv[e] = PQ[4096 + jr * 64 + ib + e];
    for (int sg = 1; sg < seg; ++sg) {
      __syncthreads();
#pragma unroll
      for (int e = 0; e < 16; ++e) WZ[jr * 64 + ib + e] = nv[e];
      __syncthreads();
      const float* Pm = PQ + (size_t)sg * 8192;
#pragma unroll
      for (int e = 0; e < 16; ++e) nv[e] = Pm[4096 + jr * 64 + ib + e];
      for (int jp = 0; jp < 64; jp += 4) {
        const float4 pv = *(const float4*)(Pm + jr * 64 + jp);
#pragma unroll
        for (int e = 0; e < 16; ++e)
          nv[e] += pv.x * WZ[(jp + 0) * 64 + ib + e] + pv.y * WZ[(jp + 1) * 64 + ib + e] + pv.z * WZ[(jp + 2) * 64 + ib + e] + pv.w * WZ[(jp + 3) * 64 + ib + e];
      }
    }
    __syncthreads();
#pragma unroll
    for (int e = 0; e < 16; ++e) WZ[jr * 64 + ib + e] = nv[e];
    __syncthreads();
#pragma unroll
    for (int r = 0; r < 16; ++r) {
      const int rrow = 32 * mi + crow(r, hh), ccol = 32 * ni + l31;
      Sacc[r] = WZ[rrow * 64 + ccol];
      *(bf16_t*)(smem + CS_S0T + rrow * 144 + ccol * 2) = f2bf(Sacc[r]);
    }
    __syncthreads();
  }
  const int ck0 = seg * SEGCH, ck1 = ck0 + SEGCH;
  uint4 ur0, ur1, uk0, uk1, uv0, uv1, l0, l1, m0, m1;
#define SCAN_LOAD(CK) { const int row_ = seq_row(n, b, (CK) * 64 + tok); const size_t g_ = (size_t)row_ * D + hd * 64 + c0; \
    ur0 = *(const uint4*)(R + g_); ur1 = *(const uint4*)(R + g_ + 8); uk0 = *(const uint4*)(Kb + g_); uk1 = *(const uint4*)(Kb + g_ + 8); \
    uv0 = *(const uint4*)(V + g_); uv1 = *(const uint4*)(V + g_ + 8); \
    l0 = *(const uint4*)(LW + (size_t)row_ * 128 + n * 64 + c0); l1 = *(const uint4*)(LW + (size_t)row_ * 128 + n * 64 + c0 + 8); \
    m0 = *(const uint4*)(LA + (size_t)row_ * 128 + n * 64 + c0); m1 = *(const uint4*)(LA + (size_t)row_ * 128 + n * 64 + c0 + 8); }
  SCAN_LOAD(ck0)
  for (int ck = ck0; ck < ck1; ++ck) {
    const int row = seq_row(n, b, ck * 64 + tok);
    *(uint4*)(smem + CS_R1 + tok * 144 + c0 * 2) = l0; *(uint4*)(smem + CS_R1 + tok * 144 + c0 * 2 + 16) = l1;
    *(uint4*)(smem + CS_R2 + tok * 144 + c0 * 2) = m0; *(uint4*)(smem + CS_R2 + tok * 144 + c0 * 2 + 16) = m1;
    __syncthreads();
    {
      f32x16 awz, aaz;
#pragma unroll
      for (int r = 0; r < 16; ++r) { awz[r] = 0.f; aaz[r] = 0.f; }
#pragma unroll
      for (int kk = 0; kk < 4; ++kk) {
        const s16x8 alw = lds_row8(smem + CS_R1, 32 * mi + l31, kk * 16 + 8 * hh);
        const s16x8 ala = lds_row8(smem + CS_R2, 32 * mi + l31, kk * 16 + 8 * hh);
        const s16x8 bw = lds_row8(smem + CS_W2T, 32 * ni + l31, kk * 16 + 8 * hh);
        const s16x8 ba = lds_row8(smem + CS_A2T, 32 * ni + l31, kk * 16 + 8 * hh);
        awz = MFMA(alw, bw, awz);
        aaz = MFMA(ala, ba, aaz);
      }
#pragma unroll
      for (int r = 0; r < 16; ++r) {
        const int t = 32 * mi + crow(r, hh), col = 32 * ni + l31;
        WZ[t * 64 + col] = awz[r];
        AZ[t * 64 + col] = aaz[r];
      }
    }
    __syncthreads();
    float lw[16], rr[16], kd[16], av[16], bb[16];
    {
      float kr[16], cw0[16], ca0[16], ckk[16], cka[16], crk[16], wzv[16], azv[16];
      unpack16(ur0, ur1, rr);
      unpack16(uk0, uk1, kr);
#pragma unroll
      for (int e4 = 0; e4 < 4; ++e4) {
        const float4 v0 = *(const float4*)(CST + c0 + e4 * 4), v1 = *(const float4*)(CST + 64 + c0 + e4 * 4), v2 = *(const float4*)(CST + 128 + c0 + e4 * 4);
        const float4 v3 = *(const float4*)(CST + 192 + c0 + e4 * 4), v4 = *(const float4*)(CST + 256 + c0 + e4 * 4);
        const float4 v5 = *(const float4*)(WZ + tok * 64 + c0 + e4 * 4), v6 = *(const float4*)(AZ + tok * 64 + c0 + e4 * 4);
        cw0[e4 * 4] = v0.x; cw0[e4 * 4 + 1] = v0.y; cw0[e4 * 4 + 2] = v0.z; cw0[e4 * 4 + 3] = v0.w;
        ca0[e4 * 4] = v1.x; ca0[e4 * 4 + 1] = v1.y; ca0[e4 * 4 + 2] = v1.z; ca0[e4 * 4 + 3] = v1.w;
        ckk[e4 * 4] = v2.x; ckk[e4 * 4 + 1] = v2.y; ckk[e4 * 4 + 2] = v2.z; ckk[e4 * 4 + 3] = v2.w;
        cka[e4 * 4] = v3.x; cka[e4 * 4 + 1] = v3.y; cka[e4 * 4 + 2] = v3.z; cka[e4 * 4 + 3] = v3.w;
        crk[e4 * 4] = v4.x; crk[e4 * 4 + 1] = v4.y; crk[e4 * 4 + 2] = v4.z; crk[e4 * 4 + 3] = v4.w;
        wzv[e4 * 4] = v5.x; wzv[e4 * 4 + 1] = v5.y; wzv[e4 * 4 + 2] = v5.z; wzv[e4 * 4 + 3] = v5.w;
        azv[e4 * 4] = v6.x; azv[e4 * 4 + 1] = v6.y; azv[e4 * 4 + 2] = v6.z; azv[e4 * 4 + 3] = v6.w;
      }
      float ss = 0.f;
#pragma unroll
      for (int e = 0; e < 16; ++e) { av[e] = kr[e] * ckk[e]; ss += av[e] * av[e]; }
      ss = dpp_add<0xB1>(ss);
      ss = dpp_add<0x4E>(ss);
      const float inv = __frsqrt_rn(fmaxf(ss, 1e-24f));
      float bon = 0.f;
#pragma unroll
      for (int e = 0; e < 16; ++e) {
        const float wz = wzv[e] + cw0[e];
        const float az = azv[e] + ca0[e];
        lw[e] = -0.60653066f * fsig(wz);
        const float as = fsig(az);
        const float kkn = av[e] * inv;
        kd[e] = kr[e] * (1.f + (as - 1.f) * cka[e]);
        bb[e] = kkn * as;
        av[e] = -kkn;
        bon += rr[e] * kd[e] * crk[e];
      }
#pragma unroll
      for (int e4 = 0; e4 < 4; ++e4) *(float4*)(WZ + tok * 64 + c0 + e4 * 4) = make_float4(lw[e4 * 4], lw[e4 * 4 + 1], lw[e4 * 4 + 2], lw[e4 * 4 + 3]);
      bon = dpp_add<0xB1>(bon);
      bon = dpp_add<0x4E>(bon);
      if (MODE == 1 && q == 0) BON[((size_t)n * NR + row) * 16 + hd] = bon;
    }
    __syncthreads();
    {
      const int col = tid & 63, qt = tid >> 6;
      float pv[16];
#pragma unroll
      for (int t = 0; t < 16; ++t) pv[t] = WZ[(16 * qt + t) * 64 + col];
      float sacc = 0.f;
#pragma unroll
      for (int t = 0; t < 16; ++t) { sacc += pv[t]; WZ[(16 * qt + t) * 64 + col] = sacc; }
      TOT[qt * 64 + col] = sacc;
    }
    __syncthreads();
    {
      float fa[16], fr[16], fb[16], fk[16], fv[16];
      unpack16(uv0, uv1, fv);
      const int qt = tok >> 4;
      float tb[16], tt[16], cum[16];
#pragma unroll
      for (int e4 = 0; e4 < 4; ++e4) {
        const float4 t0 = *(const float4*)(TOT + c0 + e4 * 4), t1 = *(const float4*)(TOT + 64 + c0 + e4 * 4);
        const float4 t2 = *(const float4*)(TOT + 128 + c0 + e4 * 4), t3 = *(const float4*)(TOT + 192 + c0 + e4 * 4);
        const float4 cv = *(const float4*)(WZ + tok * 64 + c0 + e4 * 4);
        const float m0_ = qt > 0 ? 1.f : 0.f, m1_ = qt > 1 ? 1.f : 0.f, m2_ = qt > 2 ? 1.f : 0.f;
        tb[e4 * 4] = m0_ * t0.x + m1_ * t1.x + m2_ * t2.x; tb[e4 * 4 + 1] = m0_ * t0.y + m1_ * t1.y + m2_ * t2.y;
        tb[e4 * 4 + 2] = m0_ * t0.z + m1_ * t1.z + m2_ * t2.z; tb[e4 * 4 + 3] = m0_ * t0.w + m1_ * t1.w + m2_ * t2.w;
        tt[e4 * 4] = t0.x + t1.x + t2.x + t3.x; tt[e4 * 4 + 1] = t0.y + t1.y + t2.y + t3.y;
        tt[e4 * 4 + 2] = t0.z + t1.z + t2.z + t3.z; tt[e4 * 4 + 3] = t0.w + t1.w + t2.w + t3.w;
        cum[e4 * 4] = cv.x; cum[e4 * 4 + 1] = cv.y; cum[e4 * 4 + 2] = cv.z; cum[e4 * 4 + 3] = cv.w;
      }
#pragma unroll
      for (int e = 0; e < 16; ++e) {
        const float incl = cum[e] + tb[e];
        const float excl = incl - lw[e];
        const float ei = __expf(incl), ee = __expf(excl), nin = __builtin_amdgcn_rcpf(ei);
        fa[e] = av[e] * ee; fr[e] = rr[e] * ei; fb[e] = bb[e] * nin; fk[e] = kd[e] * nin;
      }
#pragma unroll
      for (int e4 = 0; e4 < 4; ++e4) {
        *(float4*)(WZ + tok * 64 + c0 + e4 * 4) = make_float4(fa[e4 * 4], fa[e4 * 4 + 1], fa[e4 * 4 + 2], fa[e4 * 4 + 3]);
        if (tok == 0) *(float4*)(CL + c0 + e4 * 4) = make_float4(__expf(tt[e4 * 4]), __expf(tt[e4 * 4 + 1]), __expf(tt[e4 * 4 + 2]), __expf(tt[e4 * 4 + 3]));
      }
      store16bf(smem + CS_AT + tok * 144 + c0 * 2, fa);
      if (MODE == 1) store16bf(smem + CS_RT + tok * 144 + c0 * 2, fr);
      store16bf(smem + CS_BT + tok * 144 + c0 * 2, fb);
      store16bf(smem + CS_KT + tok * 144 + c0 * 2, fk);
      *(uint4*)(smem + CS_VT + tok * 144 + c0 * 2) = uv0;
      *(uint4*)(smem + CS_VT + tok * 144 + c0 * 2 + 16) = uv1;
    }
    if (ck + 1 < ck1) SCAN_LOAD(ck + 1)
    __syncthreads();
    {
      f32x16 ab, ak, rb, rk;
#pragma unroll
      for (int r = 0; r < 16; ++r) { ab[r] = 0.f; ak[r] = 0.f; rb[r] = 0.f; rk[r] = 0.f; }
      if (mi >= ni) {
#pragma unroll
        for (int kk = 0; kk < 4; ++kk) {
          const s16x8 aA = lds_row8(smem + CS_AT, 32 * mi + l31, kk * 16 + 8 * hh);
          const s16x8 aR = lds_row8(smem + CS_RT, 32 * mi + l31, kk * 16 + 8 * hh);
          const s16x8 bB = lds_row8(smem + CS_BT, 32 * ni + l31, kk * 16 + 8 * hh);
          const s16x8 bK = lds_row8(smem + CS_KT, 32 * ni + l31, kk * 16 + 8 * hh);
          ab = MFMA(aA, bB, ab); ak = MFMA(aA, bK, ak);
          if (MODE == 1) { rb = MFMA(aR, bB, rb); rk = MFMA(aR, bK, rk); }
        }
      }
#pragma unroll
      for (int r = 0; r < 16; ++r) {
        const int t = 32 * mi + crow(r, hh), sx = 32 * ni + l31;
        const bool lo_s = sx < t, lo_i = sx <= t;
        *(bf16_t*)(smem + CS_AAB + t * 144 + sx * 2) = f2bf(lo_s ? ab[r] : 0.f);
        if ((t >> 4) == (sx >> 4)) AABD[(t >> 4) * 256 + (t & 15) * 16 + (sx & 15)] = lo_s ? ab[r] : 0.f;
        *(bf16_t*)(smem + CS_R1 + t * 144 + sx * 2) = f2bf(lo_s ? ak[r] : 0.f);
        if (MODE == 1) {
          *(bf16_t*)(smem + CS_R2 + t * 144 + sx * 2) = f2bf(lo_i ? rb[r] : 0.f);
          *(bf16_t*)(smem + CS_R3 + t * 144 + sx * 2) = f2bf(lo_i ? rk[r] : 0.f);
        }
      }
    }
    __syncthreads();
    {
      f32x16 xu;
#pragma unroll
      for (int r = 0; r < 16; ++r) xu[r] = 0.f;
#pragma unroll
      for (int kk = 0; kk < 4; ++kk) {
        const s16x8 a = lds_row8(smem + CS_R1, 32 * mi + l31, kk * 16 + 8 * hh);
        const s16x8 bv = lds_tr8(smem + CS_VT, kk * 16, 32 * ni, lane);
        xu = MFMA(a, bv, xu);
      }
#pragma unroll
      for (int r = 0; r < 16; ++r) AZ[(32 * mi + crow(r, hh)) * 64 + 32 * ni + l31] = xu[r];
    }
    __syncthreads();
#pragma unroll
    for (int bk = 0; bk < 4; ++bk) {
      if (tid < 128) {
        float* rhs = (tid < 64) ? (WZ + tid) : (AZ + (tid - 64));
        float x[16], am[16][16];
#pragma unroll
        for (int r = 0; r < 16; ++r) x[r] = rhs[(16 * bk + r) * 64];
#pragma unroll
        for (int tp = 1; tp < 16; ++tp) {
#pragma unroll
          for (int s4 = 0; s4 < (tp + 3) / 4; ++s4) {
            const float4 v = *(const float4*)(AABD + bk * 256 + tp * 16 + s4 * 4);
            am[tp][s4 * 4] = v.x; am[tp][s4 * 4 + 1] = v.y; am[tp][s4 * 4 + 2] = v.z; am[tp][s4 * 4 + 3] = v.w;
          }
        }
#pragma unroll
        for (int sx = 0; sx < 15; ++sx) {
          const float xs = x[sx];
#pragma unroll
          for (int tp = sx + 1; tp < 16; ++tp) x[tp] = fmaf(am[tp][sx], xs, x[tp]);
        }
        char* dst = (tid < 64) ? (smem + CS_AT + tid * 2) : (smem + CS_UV + (tid - 64) * 2);
#pragma unroll
        for (int r = 0; r < 16; ++r) *(bf16_t*)(dst + (16 * bk + r) * 144) = f2bf(x[r]);
      }
      __syncthreads();
      if (bk < 3) {
        const char* xsrc = (w < 2) ? (smem + CS_AT) : (smem + CS_UV);
        float* rdst = (w < 2) ? WZ : AZ;
        const s16x8 bx = lds_tr8(xsrc, 16 * bk, 32 * (w & 1), lane);
#pragma unroll
        for (int rt = 0; rt < 2; ++rt) {
          if (32 * rt + 31 >= 16 * (bk + 1)) {
            f32x16 up;
#pragma unroll
            for (int r = 0; r < 16; ++r) up[r] = 0.f;
            const s16x8 aa = lds_row8(smem + CS_AAB, 32 * rt + l31, 16 * bk + 8 * hh);
            up = MFMA(aa, bx, up);
#pragma unroll
            for (int r = 0; r < 16; ++r) rdst[(32 * rt + crow(r, hh)) * 64 + 32 * (w & 1) + l31] += up[r];
          }
        }
        __syncthreads();
      }
    }
    f32x16 rh, yl, mm, cc;
#pragma unroll
    for (int r = 0; r < 16; ++r) { rh[r] = 0.f; yl[r] = 0.f; mm[r] = 0.f; cc[r] = 0.f; }
#pragma unroll
    for (int kk = 0; kk < 4; ++kk) {
      const s16x8 aRB = lds_row8(smem + CS_R2, 32 * mi + l31, kk * 16 + 8 * hh);
      const s16x8 aRK = lds_row8(smem + CS_R3, 32 * mi + l31, kk * 16 + 8 * hh);
      const s16x8 tAH = lds_tr8(smem + CS_AT, kk * 16, 32 * ni, lane);
      const s16x8 tUV = lds_tr8(smem + CS_UV, kk * 16, 32 * ni, lane);
      const s16x8 tVT = lds_tr8(smem + CS_VT, kk * 16, 32 * ni, lane);
      const s16x8 tBT = lds_tr8(smem + CS_BT, kk * 16, 32 * mi, lane);
      const s16x8 tKT = lds_tr8(smem + CS_KT, kk * 16, 32 * mi, lane);
      if (MODE == 1) {
        rh = MFMA(aRB, tAH, rh);
        yl = MFMA(aRB, tUV, yl);
        yl = MFMA(aRK, tVT, yl);
      }
      mm = MFMA(tBT, tAH, mm);
      cc = MFMA(tBT, tUV, cc);
      cc = MFMA(tKT, tVT, cc);
    }
#pragma unroll
    for (int r = 0; r < 16; ++r) if (MODE == 1) rh[r] += bf2f(*(const bf16_t*)(smem + CS_RT + (32 * mi + crow(r, hh)) * 144 + (32 * ni + l31) * 2));
    __syncthreads();
#pragma unroll
    for (int r = 0; r < 16; ++r) {
      const int rrow = 32 * mi + crow(r, hh), ccol = 32 * ni + l31;
      if (MODE == 1) *(bf16_t*)(smem + CS_R2 + rrow * 144 + ccol * 2) = f2bf(rh[r]);
      *(bf16_t*)(smem + CS_R3 + rrow * 144 + ccol * 2) = f2bf(mm[r]);
    }
    __syncthreads();
    f32x16 pp;
#pragma unroll
    for (int r = 0; r < 16; ++r) pp[r] = 0.f;
#pragma unroll
    for (int kk = 0; kk < 4; ++kk) {
      const s16x8 aMM = lds_row8(smem + CS_R3, 32 * mi + l31, kk * 16 + 8 * hh);
      const s16x8 tS = lds_tr8(smem + CS_S0T, kk * 16, 32 * ni, lane);
      if (MODE == 1) {
        const s16x8 aRH = lds_row8(smem + CS_R2, 32 * mi + l31, kk * 16 + 8 * hh);
        yl = MFMA(aRH, tS, yl);
      } else {
        const s16x8 tP = lds_tr8(smem + CS_RT, kk * 16, 32 * ni, lane);
        pp = MFMA(aMM, tP, pp);
      }
      cc = MFMA(aMM, tS, cc);
    }
#pragma unroll
    for (int r = 0; r < 16; ++r) {
      const float clv = CL[32 * mi + crow(r, hh)];
      Sacc[r] = clv * (Sacc[r] + cc[r]);
      if (MODE == 0) Pacc[r] = clv * (Pacc[r] + pp[r]);
    }
    __syncthreads();
#pragma unroll
    for (int r = 0; r < 16; ++r) {
      const int rrow = 32 * mi + crow(r, hh), ccol = 32 * ni + l31;
      *(bf16_t*)(smem + CS_S0T + rrow * 144 + ccol * 2) = f2bf(Sacc[r]);
      if (MODE == 0) *(bf16_t*)(smem + CS_RT + rrow * 144 + ccol * 2) = f2bf(Pacc[r]);
      if (MODE == 1) {
        const int yrow = seq_row(n, b, ck * 64 + rrow);
        Y[(size_t)yrow * D + hd * 64 + ccol] = f2bf(yl[r]);
      }
    }
  }
  if (MODE == 0) {
    float* PQ = SCR + (size_t)(cid * 3 + seg) * 8192;
#pragma unroll
    for (int r = 0; r < 16; ++r) {
      const int rrow = 32 * mi + crow(r, hh), ccol = 32 * ni + l31;
      PQ[rrow * 64 + ccol] = Pacc[r];
      PQ[4096 + rrow * 64 + ccol] = Sacc[r];
    }
  }
}

DI void run_phase(const Params& p, int ph, char* smem, const int TID) {
  bf16_t* T0 = (bf16_t*)(p.ws + 0 * SLOT);
  bf16_t* T1 = (bf16_t*)(p.ws + 1 * SLOT);
  bf16_t* T2 = (bf16_t*)(p.ws + 2 * SLOT);
  bf16_t* T3 = (bf16_t*)(p.ws + 3 * SLOT);
  bf16_t* T4 = (bf16_t*)(p.ws + 4 * SLOT);
  bf16_t* T5 = (bf16_t*)(p.ws + 5 * SLOT);
  bf16_t* VF = (bf16_t*)(p.ws + OFF_VF);
  bf16_t* W = (bf16_t*)(p.ws + OFF_W);
  const int tid = TID;
#ifdef ONLY_PHASE
    const int type = ONLY_PHASE, layer = p.player[ph];
#else
    const int type = p.ptype[ph], layer = p.player[ph];
#endif
    const int j = layer >> 1;
    switch (type) {
#ifdef DBG_PREPFILL
      case PH_PREP0: {
        for (size_t i = (size_t)blockIdx.x * 256 + tid; i < (size_t)(1 << 20); i += (size_t)gridDim.x * 256)
          *(uint4*)(T4 + (size_t)(2 << 20) * 8 + i * 8) = make_uint4(0x3f803f80u, 0x3f803f80u, 0x3f803f80u, 0x3f803f80u);
      } break;
#else
      case PH_PREP0: phase_prep0(p, smem, TID); break;
#endif
      case PH_PRE0: {
        for (int it = blockIdx.x; it < 128; it += gridDim.x) fourier_precompose(p, it, smem, TID);
        row_items(p, 0, false, true, NR, nullptr, T0, blockIdx.x, NR / 4, TID);
      } break;
      case PH_FGEMM1: {
        const int MT = NR / 128, NT = 12;
        for (int t = blockIdx.x; t < MT * NT; t += gridDim.x) {
          const int mt = t / NT, nt = t % NT;
          gemm_tile_plain<false, 4>(T0, nullptr, nullptr, 1024, W, 1024, 1024, mt * 128, nt * 256, 3072, smem, TID,
                                    [=](int col0) { return col0 < 1024 ? T1 : (col0 < 2048 ? T2 : T3); });
        }
      } break;
      case PH_FDFT1: {
        const bf16_t* F1 = (const bf16_t*)(p.ws + OFF_F1);
        const bf16_t* FC = (const bf16_t*)(p.ws + OFF_FC);
        const float2* TW = (const float2*)(p.ws + OFF_TW);
        bf16_t* YB = T4;
        const float* bmix = p.f_b_mix + (size_t)j * 1024;
        const int nctx = (layer == 3) ? 0 : 32;
        {
          constexpr int L_B = 0, L_F1 = 40960, L_TW = L_F1 + 128 * 272;
          const int lane = tid & 63, w = tid >> 6, l31 = lane & 31, hh = lane >> 5;
          const int rt0 = w & 1, ctb = 2 * (w >> 1);
          __syncthreads();
#pragma unroll
          for (int i = 0; i < 8; ++i) {
            const int c = tid + 256 * i, r = c >> 4, cc = c & 15;
            *(uint4*)(smem + L_F1 + r * 272 + cc * 16) = *(const uint4*)(F1 + r * 128 + cc * 8);
          }
#pragma unroll
          for (int i = 0; i < 16; ++i) *(uint4*)(smem + L_TW + (tid + 256 * i) * 16) = *(const uint4*)((const char*)TW + (size_t)(tid + 256 * i) * 16);
          uint4 bp0, bp1, bp2, bp3, bp4, bp5, bp6, bp7;
          const int br = tid >> 4, bcc = tid & 15;
          int it = blockIdx.x;
          if (it < 2048) {
              const int itn_ = it;
              const int b_ = itn_ >> 10, t2_ = (itn_ >> 3) & 127, cb_ = itn_ & 7;
              const size_t tok0_ = (size_t)b_ * 8192 + t2_;
              { const int kr = br + 0; bp0 = *(const uint4*)((kr < 64 ? T1 + (tok0_ + (size_t)kr * 128) * D : T2 + (tok0_ + (size_t)(kr - 64) * 128) * D) + cb_ * 128 + bcc * 8); }
              { const int kr = br + 16; bp1 = *(const uint4*)((kr < 64 ? T1 + (tok0_ + (size_t)kr * 128) * D : T2 + (tok0_ + (size_t)(kr - 64) * 128) * D) + cb_ * 128 + bcc * 8); }
              { const int kr = br + 32; bp2 = *(const uint4*)((kr < 64 ? T1 + (tok0_ + (size_t)kr * 128) * D : T2 + (tok0_ + (size_t)(kr - 64) * 128) * D) + cb_ * 128 + bcc * 8); }
              { const int kr = br + 48; bp3 = *(const uint4*)((kr < 64 ? T1 + (tok0_ + (size_t)kr * 128) * D : T2 + (tok0_ + (size_t)(kr - 64) * 128) * D) + cb_ * 128 + bcc * 8); }
              { const int kr = br + 64; bp4 = *(const uint4*)((kr < 64 ? T1 + (tok0_ + (size_t)kr * 128) * D : T2 + (tok0_ + (size_t)(kr - 64) * 128) * D) + cb_ * 128 + bcc * 8); }
              { const int kr = br + 80; bp5 = *(const uint4*)((kr < 64 ? T1 + (tok0_ + (size_t)kr * 128) * D : T2 + (tok0_ + (size_t)(kr - 64) * 128) * D) + cb_ * 128 + bcc * 8); }
              { const int kr = br + 96; bp6 = *(const uint4*)((kr < 64 ? T1 + (tok0_ + (size_t)kr * 128) * D : T2 + (tok0_ + (size_t)(kr - 64) * 128) * D) + cb_ * 128 + bcc * 8); }
              { const int kr = br + 112; bp7 = *(const uint4*)((kr < 64 ? T1 + (tok0_ + (size_t)kr * 128) * D : T2 + (tok0_ + (size_t)(kr - 64) * 128) * D) + cb_ * 128 + bcc * 8); }
            }
          for (; it < 2048; it += gridDim.x) {
            const int b = it >> 10, t2 = (it >> 3) & 127, cb = it & 7;
            __syncthreads();
            *(uint4*)(smem + L_B + (br + 0) * 320 + bcc * 16) = bp0;
            *(uint4*)(smem + L_B + (br + 16) * 320 + bcc * 16) = bp1;
            *(uint4*)(smem + L_B + (br + 32) * 320 + bcc * 16) = bp2;
            *(uint4*)(smem + L_B + (br + 48) * 320 + bcc * 16) = bp3;
            *(uint4*)(smem + L_B + (br + 64) * 320 + bcc * 16) = bp4;
            *(uint4*)(smem + L_B + (br + 80) * 320 + bcc * 16) = bp5;
            *(uint4*)(smem + L_B + (br + 96) * 320 + bcc * 16) = bp6;
            *(uint4*)(smem + L_B + (br + 112) * 320 + bcc * 16) = bp7;
            __syncthreads();
            if (it + (int)gridDim.x < 2048) {
              const int itn_ = it + (int)gridDim.x;
              const int b_ = itn_ >> 10, t2_ = (itn_ >> 3) & 127, cb_ = itn_ & 7;
              const size_t tok0_ = (size_t)b_ * 8192 + t2_;
              { const int kr = br + 0; bp0 = *(const uint4*)((kr < 64 ? T1 + (tok0_ + (size_t)kr * 128) * D : T2 + (tok0_ + (size_t)(kr - 64) * 128) * D) + cb_ * 128 + bcc * 8); }
              { const int kr = br + 16; bp1 = *(const uint4*)((kr < 64 ? T1 + (tok0_ + (size_t)kr * 128) * D : T2 + (tok0_ + (size_t)(kr - 64) * 128) * D) + cb_ * 128 + bcc * 8); }
              { const int kr = br + 32; bp2 = *(const uint4*)((kr < 64 ? T1 + (tok0_ + (size_t)kr * 128) * D : T2 + (tok0_ + (size_t)(kr - 64) * 128) * D) + cb_ * 128 + bcc * 8); }
              { const int kr = br + 48; bp3 = *(const uint4*)((kr < 64 ? T1 + (tok0_ + (size_t)kr * 128) * D : T2 + (tok0_ + (size_t)(kr - 64) * 128) * D) + cb_ * 128 + bcc * 8); }
              { const int kr = br + 64; bp4 = *(const uint4*)((kr < 64 ? T1 + (tok0_ + (size_t)kr * 128) * D : T2 + (tok0_ + (size_t)(kr - 64) * 128) * D) + cb_ * 128 + bcc * 8); }
              { const int kr = br + 80; bp5 = *(const uint4*)((kr < 64 ? T1 + (tok0_ + (size_t)kr * 128) * D : T2 + (tok0_ + (size_t)(kr - 64) * 128) * D) + cb_ * 128 + bcc * 8); }
              { const int kr = br + 96; bp6 = *(const uint4*)((kr < 64 ? T1 + (tok0_ + (size_t)kr * 128) * D : T2 + (tok0_ + (size_t)(kr - 64) * 128) * D) + cb_ * 128 + bcc * 8); }
              { const int kr = br + 112; bp7 = *(const uint4*)((kr < 64 ? T1 + (tok0_ + (size_t)kr * 128) * D : T2 + (tok0_ + (size_t)(kr - 64) * 128) * D) + cb_ * 128 + bcc * 8); }
            }
            f32x16 acc[2][2];
#pragma unroll
            for (int i = 0; i < 2; ++i)
#pragma unroll
              for (int jj = 0; jj < 2; ++jj)
#pragma unroll
                for (int r = 0; r < 16; ++r) acc[i][jj][r] = 0.f;
            const int g = lane >> 4, li = lane & 15, qq = li >> 2, pp = li & 3;
            const int tr_base = (8 * (g >> 1) + qq) * 320 + (16 * (g & 1) + 4 * pp) * 2;
#pragma unroll
            for (int ks = 0; ks < 8; ++ks) {
              s16x8 af[2];
#pragma unroll
              for (int h = 0; h < 2; ++h) af[h] = *(const s16x8*)(smem + L_F1 + (32 * (rt0 + 2 * h) + l31) * 272 + (ks * 16 + hh * 8) * 2);
#pragma unroll
              for (int c2 = 0; c2 < 2; ++c2) {
                const int off = L_B + tr_base + ks * 16 * 320 + (ctb + c2) * 64;
                const s16x4 lo = __builtin_amdgcn_ds_read_tr16_b64_v4i16((__attribute__((address_space(3))) s16x4*)(smem + off));
                const s16x4 hi = __builtin_amdgcn_ds_read_tr16_b64_v4i16((__attribute__((address_space(3))) s16x4*)(smem + off + 4 * 320));
                const s16x8 bq = __builtin_shufflevector(lo, hi, 0, 1, 2, 3, 4, 5, 6, 7);
#pragma unroll
                for (int h = 0; h < 2; ++h) acc[h][c2] = MFMA(af[h], bq, acc[h][c2]);
              }
            }
#pragma unroll
            for (int c2 = 0; c2 < 2; ++c2) {
              const int col = 32 * (ctb + c2) + l31;
#pragma unroll
              for (int r = 0; r < 16; ++r) {
                const int k1 = 32 * rt0 + crow(r, hh);
                const float2 tw = *(const float2*)(smem + L_TW + (k1 * 128 + t2) * 8);
                const float va = acc[0][c2][r], vb = acc[1][c2][r];
                const float yr = va * tw.x - vb * tw.y, yi = va * tw.y + vb * tw.x;
                bf16_t* d = YB + ((size_t)b * 8192 + k1 * 128 + t2) * 2048 + cb * 128 + col;
                d[0] = f2bf(yr); d[1024] = f2bf(yi);
              }
            }
          }
        }
        for (int it = 2048 + blockIdx.x; it < 2048 + nctx; it += gridDim.x) {
          {
            const int u = it - 2048, b = u >> 4, cb = (u >> 1) & 7, mh = u & 1;
            const size_t tok0 = (size_t)NLAT + b * 256;
            const float scale = 0.005524271728019903f;
            dft_tile(FC, 512, mh * 128, 256, T1 + tok0 * D + cb * 128, T2 + tok0 * D + cb * 128, D, 1, smem, TID,
                     [=](int rowA, int rowB, int col, float va, float vb) {
                       const int cc = cb * 128 + col;
                       bf16_t* z0 = T3 + (tok0 + mh * 128 + rowA) * D + cc;
                       bf16_t* z1 = T3 + (tok0 + mh * 128 + rowB) * D + cc;
                       const float bm = bmix[cc];
                       z0[0] = f2bf((va * scale + bm) * silu_f(bf2f(z0[0])));
                       z1[0] = f2bf((vb * scale + bm) * silu_f(bf2f(z1[0])));
                     });
          }
        }
      } break;
      case PH_FDFT3: {
        const bf16_t* F2 = (const bf16_t*)(p.ws + OFF_F2);
        const bf16_t* YB = T4;
        const float* bmix = p.f_b_mix + (size_t)j * 1024;
        const float scale = 0.0009765625f;
        constexpr int L_B = 0, L_F2 = 256 * 320;
        const int lane = tid & 63, w = tid >> 6, l31 = lane & 31, hh = lane >> 5;
        const int rt0 = w & 1, ctb = 2 * (w >> 1);
        const int br = tid >> 4, bcc = tid & 15;
        __syncthreads();
#pragma unroll
        for (int i = 0; i < 16; ++i) {
          const int c = tid + 256 * i, r = c >> 5, cc = c & 31;
          *(uint4*)(smem + L_F2 + r * 528 + cc * 16) = *(const uint4*)(F2 + r * 256 + cc * 8);
        }
        uint4 bp0, bp1, bp2, bp3, bp4, bp5, bp6, bp7, bp8, bp9, bp10, bp11, bp12, bp13, bp14, bp15;
        int it = blockIdx.x;
        if (it < 1024) {
          const int b_ = it >> 9, k1_ = (it >> 3) & 63, cb_ = it & 7;
          const size_t tok0_ = (size_t)b_ * 8192 + k1_ * 128;
              bp0 = *(const uint4*)(YB + (tok0_ + (size_t)(br + 0)) * 2048 + 0 + cb_ * 128 + bcc * 8);
              bp1 = *(const uint4*)(YB + (tok0_ + (size_t)(br + 16)) * 2048 + 0 + cb_ * 128 + bcc * 8);
              bp2 = *(const uint4*)(YB + (tok0_ + (size_t)(br + 32)) * 2048 + 0 + cb_ * 128 + bcc * 8);
              bp3 = *(const uint4*)(YB + (tok0_ + (size_t)(br + 48)) * 2048 + 0 + cb_ * 128 + bcc * 8);
              bp4 = *(const uint4*)(YB + (tok0_ + (size_t)(br + 64)) * 2048 + 0 + cb_ * 128 + bcc * 8);
              bp5 = *(const uint4*)(YB + (tok0_ + (size_t)(br + 80)) * 2048 + 0 + cb_ * 128 + bcc * 8);
              bp6 = *(const uint4*)(YB + (tok0_ + (size_t)(br + 96)) * 2048 + 0 + cb_ * 128 + bcc * 8);
              bp7 = *(const uint4*)(YB + (tok0_ + (size_t)(br + 112)) * 2048 + 0 + cb_ * 128 + bcc * 8);
              bp8 = *(const uint4*)(YB + (tok0_ + (size_t)(br + 0)) * 2048 + 1024 + cb_ * 128 + bcc * 8);
              bp9 = *(const uint4*)(YB + (tok0_ + (size_t)(br + 16)) * 2048 + 1024 + cb_ * 128 + bcc * 8);
              bp10 = *(const uint4*)(YB + (tok0_ + (size_t)(br + 32)) * 2048 + 1024 + cb_ * 128 + bcc * 8);
              bp11 = *(const uint4*)(YB + (tok0_ + (size_t)(br + 48)) * 2048 + 1024 + cb_ * 128 + bcc * 8);
              bp12 = *(const uint4*)(YB + (tok0_ + (size_t)(br + 64)) * 2048 + 1024 + cb_ * 128 + bcc * 8);
              bp13 = *(const uint4*)(YB + (tok0_ + (size_t)(br + 80)) * 2048 + 1024 + cb_ * 128 + bcc * 8);
              bp14 = *(const uint4*)(YB + (tok0_ + (size_t)(br + 96)) * 2048 + 1024 + cb_ * 128 + bcc * 8);
              bp15 = *(const uint4*)(YB + (tok0_ + (size_t)(br + 112)) * 2048 + 1024 + cb_ * 128 + bcc * 8);
        }
        for (; it < 1024; it += gridDim.x) {
          const int b = it >> 9, k1 = (it >> 3) & 63, cb = it & 7;
          __syncthreads();
            *(uint4*)(smem + L_B + (0 + br + 0) * 320 + bcc * 16) = bp0;
            *(uint4*)(smem + L_B + (0 + br + 16) * 320 + bcc * 16) = bp1;
            *(uint4*)(smem + L_B + (0 + br + 32) * 320 + bcc * 16) = bp2;
            *(uint4*)(smem + L_B + (0 + br + 48) * 320 + bcc * 16) = bp3;
            *(uint4*)(smem + L_B + (0 + br + 64) * 320 + bcc * 16) = bp4;
            *(uint4*)(smem + L_B + (0 + br + 80) * 320 + bcc * 16) = bp5;
            *(uint4*)(smem + L_B + (0 + br + 96) * 320 + bcc * 16) = bp6;
            *(uint4*)(smem + L_B + (0 + br + 112) * 320 + bcc * 16) = bp7;
            *(uint4*)(smem + L_B + (128 + br + 0) * 320 + bcc * 16) = bp8;
            *(uint4*)(smem + L_B + (128 + br + 16) * 320 + bcc * 16) = bp9;
            *(uint4*)(smem + L_B + (128 + br + 32) * 320 + bcc * 16) = bp10;
            *(uint4*)(smem + L_B + (128 + br + 48) * 320 + bcc * 16) = bp11;
            *(uint4*)(smem + L_B + (128 + br + 64) * 320 + bcc * 16) = bp12;
            *(uint4*)(smem + L_B + (128 + br + 80) * 320 + bcc * 16) = bp13;
            *(uint4*)(smem + L_B + (128 + br + 96) * 320 + bcc * 16) = bp14;
            *(uint4*)(smem + L_B + (128 + br + 112) * 320 + bcc * 16) = bp15;
          __syncthreads();
          if (it + (int)gridDim.x < 1024) {
            const int itn_ = it + (int)gridDim.x;
            const int b_ = itn_ >> 9, k1_ = (itn_ >> 3) & 63, cb_ = itn_ & 7;
            const size_t tok0_ = (size_t)b_ * 8192 + k1_ * 128;
              bp0 = *(const uint4*)(YB + (tok0_ + (size_t)(br + 0)) * 2048 + 0 + cb_ * 128 + bcc * 8);
              bp1 = *(const uint4*)(YB + (tok0_ + (size_t)(br + 16)) * 2048 + 0 + cb_ * 128 + bcc * 8);
              bp2 = *(const uint4*)(YB + (tok0_ + (size_t)(br + 32)) * 2048 + 0 + cb_ * 128 + bcc * 8);
              bp3 = *(const uint4*)(YB + (tok0_ + (size_t)(br + 48)) * 2048 + 0 + cb_ * 128 + bcc * 8);
              bp4 = *(const uint4*)(YB + (tok0_ + (size_t)(br + 64)) * 2048 + 0 + cb_ * 128 + bcc * 8);
              bp5 = *(const uint4*)(YB + (tok0_ + (size_t)(br + 80)) * 2048 + 0 + cb_ * 128 + bcc * 8);
              bp6 = *(const uint4*)(YB + (tok0_ + (size_t)(br + 96)) * 2048 + 0 + cb_ * 128 + bcc * 8);
              bp7 = *(const uint4*)(YB + (tok0_ + (size_t)(br + 112)) * 2048 + 0 + cb_ * 128 + bcc * 8);
              bp8 = *(const uint4*)(YB + (tok0_ + (size_t)(br + 0)) * 2048 + 1024 + cb_ * 128 + bcc * 8);
              bp9 = *(const uint4*)(YB + (tok0_ + (size_t)(br + 16)) * 2048 + 1024 + cb_ * 128 + bcc * 8);
              bp10 = *(const uint4*)(YB + (tok0_ + (size_t)(br + 32)) * 2048 + 1024 + cb_ * 128 + bcc * 8);
              bp11 = *(const uint4*)(YB + (tok0_ + (size_t)(br + 48)) * 2048 + 1024 + cb_ * 128 + bcc * 8);
              bp12 = *(const uint4*)(YB + (tok0_ + (size_t)(br + 64)) * 2048 + 1024 + cb_ * 128 + bcc * 8);
              bp13 = *(const uint4*)(YB + (tok0_ + (size_t)(br + 80)) * 2048 + 1024 + cb_ * 128 + bcc * 8);
              bp14 = *(const uint4*)(YB + (tok0_ + (size_t)(br + 96)) * 2048 + 1024 + cb_ * 128 + bcc * 8);
              bp15 = *(const uint4*)(YB + (tok0_ + (size_t)(br + 112)) * 2048 + 1024 + cb_ * 128 + bcc * 8);
          }
          f32x16 acc[2][2];
#pragma unroll
          for (int i = 0; i < 2; ++i)
#pragma unroll
            for (int jj = 0; jj < 2; ++jj)
#pragma unroll
              for (int r = 0; r < 16; ++r) acc[i][jj][r] = 0.f;
          const int g = lane >> 4, li = lane & 15, qq = li >> 2, pp = li & 3;
          const int tr_base = (8 * (g >> 1) + qq) * 320 + (16 * (g & 1) + 4 * pp) * 2;
#pragma unroll
          for (int ks = 0; ks < 16; ++ks) {
            s16x8 af[2];
#pragma unroll
            for (int h = 0; h < 2; ++h) af[h] = *(const s16x8*)(smem + L_F2 + (32 * (rt0 + 2 * h) + l31) * 528 + (ks * 16 + hh * 8) * 2);
#pragma unroll
            for (int c2 = 0; c2 < 2; ++c2) {
              const int off = L_B + tr_base + ks * 16 * 320 + (ctb + c2) * 64;
              const s16x4 lo = __builtin_amdgcn_ds_read_tr16_b64_v4i16((__attribute__((address_space(3))) s16x4*)(smem + off));
              const s16x4 hi = __builtin_amdgcn_ds_read_tr16_b64_v4i16((__attribute__((address_space(3))) s16x4*)(smem + off + 4 * 320));
              const s16x8 bq = __builtin_shufflevector(lo, hi, 0, 1, 2, 3, 4, 5, 6, 7);
#pragma unroll
              for (int h = 0; h < 2; ++h) acc[h][c2] = MFMA(af[h], bq, acc[h][c2]);
            }
          }
#pragma unroll
          for (int c2 = 0; c2 < 2; ++c2) {
            const int cc = cb * 128 + 32 * (ctb + c2) + l31;
            const float bm = bmix[cc];
#pragma unroll
            for (int r = 0; r < 16; ++r) {
              const int rowA = 32 * rt0 + crow(r, hh);
              if ((r & 3) == 0) asm volatile("" ::: "memory");
              bf16_t* z0 = T3 + ((size_t)b * 8192 + k1 + 64 * rowA) * D + cc;
              bf16_t* z1 = T3 + ((size_t)b * 8192 + k1 + 64 * (rowA + 64)) * D + cc;
              z0[0] = f2bf((acc[0][c2][r] * scale + bm) * silu_f(bf2f(z0[0])));
              z1[0] = f2bf((acc[1][c2][r] * scale + bm) * silu_f(bf2f(z1[0])));
            }
          }
        }
      } break;
      case PH_FOUT: {
        const int NBIG = 512, NSMALL = (NR / 128 * 4 - NBIG) * 2;
        for (int t = blockIdx.x; t < NBIG + NSMALL; t += gridDim.x) {
          if (t < NBIG) {
            const int mt = t / 4, nt = t % 4;
            gemm_tile_plain<false, 4>(T3, nullptr, nullptr, 1024, W + (size_t)3072 * 1024, 1024, 1024, mt * 128, nt * 256, 1024, smem, TID,
                                       [=](int) { return T1; });
          } else {
            const int u = t - NBIG, mt = 128 + u / 8, nt = u % 8;
            gemm_tile_plain<false, 2>(T3, nullptr, nullptr, 1024, W + (size_t)3072 * 1024, 1024, 1024, mt * 128, nt * 128, 1024, smem, TID,
                                       [=](int) { return T1; });
          }
        }
      } break;
      case PH_POSTPRE: {
        const int nl = layer + 1;
        if (nl & 1) { for (int it = blockIdx.x; it < N_RWPREP; it += gridDim.x) rwkv_wprep(p, nl >> 1, it, smem, TID); }
        else {
          for (int it = blockIdx.x; it < 128 + N_FWPREP; it += gridDim.x) {
            if (it < 128) fourier_precompose(p, it, smem, TID); else fourier_wprep(p, nl >> 1, it - 128, smem, TID);
          }
        }
        const bf16_t* O = (layer & 1) ? T2 : T1;
        row_items(p, layer, true, true, NR, O, T0, blockIdx.x, NR / 4, TID);
      } break;
      case PH_RSHIFT: {
        for (int idx = blockIdx.x * 256 + tid; idx < NR * 128; idx += gridDim.x * 256) {
          const int row = idx >> 7, cc = (idx & 127) * 8;
          bool ok0, ok1, ok2, ok3; float wgt;
          if (row < NLAT) {
            const int t = row & 8191, gy = t >> 6, gx = t & 63;
            wgt = 0.25f;
            ok0 = gy > 0; ok1 = gy < 127; ok2 = gx > 0; ok3 = gx < 63;
          } else {
            const int t = (row - NLAT) & 255;
            wgt = 0.5f;
            ok0 = false; ok1 = false; ok2 = t > 0; ok3 = t < 255;
          }
          float a[8] = {0, 0, 0, 0, 0, 0, 0, 0};
#pragma unroll
          for (int q = 0; q < 4; ++q) {
            const bool ok = q == 0 ? ok0 : (q == 1 ? ok1 : (q == 2 ? ok2 : ok3));
            const int nrow = q == 0 ? row - 64 : (q == 1 ? row + 64 : (q == 2 ? row - 1 : row + 1));
            if (ok) {
              const uint4 u = *(const uint4*)(T0 + (size_t)nrow * D + cc);
              a[0] += lo2f(u.x); a[1] += hi2f(u.x); a[2] += lo2f(u.y); a[3] += hi2f(u.y);
              a[4] += lo2f(u.z); a[5] += hi2f(u.z); a[6] += lo2f(u.w); a[7] += hi2f(u.w);
            }
          }
          *(uint4*)(T1 + (size_t)row * D + cc) = make_uint4(pack2(a[0] * wgt, a[1] * wgt), pack2(a[2] * wgt, a[3] * wgt),
                                                            pack2(a[4] * wgt, a[5] * wgt), pack2(a[6] * wgt, a[7] * wgt));
        }
        if (layer == 1) {
          for (int it = blockIdx.x; it < N_CWPREP; it += gridDim.x) fourier_cw_prep(p, 1, it, smem, TID);
        }
      } break;
      case PH_RINPROJ: {
        const int N = (j >= 1) ? 4384 : 4352;
        const int MT = NR / 128;
        const int NT_MAIN = 16, NT_TAIL = (N - 4096 + 127) / 128, NT = NT_MAIN + NT_TAIL;
        bf16_t* Vd = (j == 0) ? VF : T5;
        bf16_t* LW = (bf16_t*)(p.ws + OFF_LW);
        bf16_t* LA = (bf16_t*)(p.ws + OFF_LA);
        bf16_t* LV = (bf16_t*)(p.ws + OFF_LV);
        for (int t = blockIdx.x; t < MT * NT; t += gridDim.x) {
          const int mt = t / NT, nt = t % NT;
          if (nt < NT_MAIN) {
            const int n0 = nt * 256;
            const float* mu = p.r_mu + (size_t)(j * 6 + (n0 >> 10)) * 1024;
            gemm_tile_plain<true, 4>(T0, T1, mu, 1024, W, 1024, 1024, mt * 128, n0, 4096, smem, TID,
                                     [=](int col0) { return col0 < 1024 ? T2 : (col0 < 2048 ? T3 : (col0 < 3072 ? Vd : T4)); });
          } else {
            const int n0 = 4096 + (nt - NT_MAIN) * 128;
            const int pi = n0 < 4224 ? 4 : (n0 < 4352 ? 5 : 2);
            const float* mu = p.r_mu + (size_t)(j * 6 + pi) * 1024;
            gemm_tile_n<true, 2>(T0, T1, mu, 1024, W, 1024, 1024, mt * 128, n0, N, smem, TID, [=](int row, int col, float v) {
              if (col < 4224) LW[(size_t)row * 128 + (col - 4096)] = f2bf(tanhf(v));
              else if (col < 4352) LA[(size_t)row * 128 + (col - 4224)] = f2bf(v);
              else LV[(size_t)row * 32 + (col - 4352)] = f2bf(v);
            });
          }
        }
      } break;
      case PH_RVUPD: {
        const bf16_t* LV = (const bf16_t*)(p.ws + OFF_LV);
        const float* v2 = p.r_v2 + (size_t)(j - 1) * 32 * 1024;
        const float* v0 = p.r_v0 + (size_t)(j - 1) * 1024;
        float* v2s = (float*)smem;
        __syncthreads();
        for (int e = tid; e < 32 * 256; e += 256) *(float4*)(v2s + e * 4) = *(const float4*)(v2 + e * 4);
        __syncthreads();
        const int wave = tid >> 6, lane = tid & 63;
        for (int row = blockIdx.x * 4 + wave; row < NR; row += gridDim.x * 4) {
          const float lvl = bf2f(LV[(size_t)row * 32 + (lane & 31)]);
          float acc[16];
#pragma unroll
          for (int qd = 0; qd < 4; ++qd) {
            const float4 t = *(const float4*)(v0 + qd * 256 + lane * 4);
            acc[qd * 4] = t.x; acc[qd * 4 + 1] = t.y; acc[qd * 4 + 2] = t.z; acc[qd * 4 + 3] = t.w;
          }
#pragma unroll 4
          for (int l = 0; l < 32; ++l) {
            const float a = __int_as_float(__builtin_amdgcn_readlane(__float_as_int(lvl), l));
#pragma unroll
            for (int qd = 0; qd < 4; ++qd) {
              const float4 wv = *(const float4*)(v2s + l * 1024 + qd * 256 + lane * 4);
              acc[qd * 4] += a * wv.x; acc[qd * 4 + 1] += a * wv.y; acc[qd * 4 + 2] += a * wv.z; acc[qd * 4 + 3] += a * wv.w;
            }
          }
#pragma unroll
          for (int qd = 0; qd < 4; ++qd) {
            const size_t idx = (size_t)row * D + qd * 256 + lane * 4;
            const uint2 uv = *(const uint2*)(T5 + idx);
            const uint2 uf = *(const uint2*)(VF + idx);
            float v[4] = {lo2f(uv.x), hi2f(uv.x), lo2f(uv.y), hi2f(uv.y)};
            const float f[4] = {lo2f(uf.x), hi2f(uf.x), lo2f(uf.y), hi2f(uf.y)};
#pragma unroll
            for (int e = 0; e < 4; ++e) v[e] = v[e] + (f[e] - v[e]) * fsig(acc[qd * 4 + e]);
            *(uint2*)(T5 + idx) = make_uint2(pack2(v[0], v[1]), pack2(v[2], v[3]));
          }
        }
      } break;
      case PH_RSCANA: {
        const bf16_t* V = (j == 0) ? VF : T5;
        float* SCR = (j == 0) ? (float*)(p.ws + 5 * SLOT + (8u << 20)) : (float*)(p.ws + OFF_VF);
        for (int it = blockIdx.x; it < 64 * (NSEG - 1); it += gridDim.x)
          scan_chain_chunked<0>(p, j, it / (NSEG - 1), it % (NSEG - 1), SCR, T2, T3, V, T0, T1, smem, TID);
      } break;
      case PH_RSCAN: {
        const bf16_t* V = (j == 0) ? VF : T5;
        float* SCR = (j == 0) ? (float*)(p.ws + 5 * SLOT + (8u << 20)) : (float*)(p.ws + OFF_VF);
        for (int it = blockIdx.x; it < 64 * NSEG; it += gridDim.x)
          scan_chain_chunked<1>(p, j, it / NSEG, it % NSEG, SCR, T2, T3, V, T0, T1, smem, TID);
      } break;
      case PH_ROUTPUT: {
        const bf16_t* V = (j == 0) ? VF : T5;
        const float* BON = (const float*)(p.ws + OFF_BON);
        const int wave = tid >> 6, lane = tid & 63;
        const int nrows = (layer == 3) ? NLAT : NR;
        for (int wi = blockIdx.x * 4 + wave; wi < nrows * 2; wi += gridDim.x * 4) {
          const int row = wi >> 1, c = (wi & 1) * 512 + lane * 8, h = c >> 6;
          const size_t idx = (size_t)row * D + c;
          const uint4 u0 = *(const uint4*)(T0 + idx), u1 = *(const uint4*)(T1 + idx), uv = *(const uint4*)(V + idx), ug = *(const uint4*)(T4 + idx);
          const float4 w0 = *(const float4*)(p.r_ln_w + (size_t)j * 1024 + c), w1 = *(const float4*)(p.r_ln_w + (size_t)j * 1024 + c + 4);
          const float4 b0 = *(const float4*)(p.r_ln_b + (size_t)j * 1024 + c), b1 = *(const float4*)(p.r_ln_b + (size_t)j * 1024 + c + 4);
          const float bon = BON[((size_t)0 * NR + row) * 16 + h] + BON[((size_t)1 * NR + row) * 16 + h];
          float y[8] = {lo2f(u0.x) + lo2f(u1.x), hi2f(u0.x) + hi2f(u1.x), lo2f(u0.y) + lo2f(u1.y), hi2f(u0.y) + hi2f(u1.y),
                        lo2f(u0.z) + lo2f(u1.z), hi2f(u0.z) + hi2f(u1.z), lo2f(u0.w) + lo2f(u1.w), hi2f(u0.w) + hi2f(u1.w)};
          const float vf[8] = {lo2f(uv.x), hi2f(uv.x), lo2f(uv.y), hi2f(uv.y), lo2f(uv.z), hi2f(uv.z), lo2f(uv.w), hi2f(uv.w)};
          const float gf[8] = {lo2f(ug.x), hi2f(ug.x), lo2f(ug.y), hi2f(ug.y), lo2f(ug.z), hi2f(ug.z), lo2f(ug.w), hi2f(ug.w)};
          const float lw8[8] = {w0.x, w0.y, w0.z, w0.w, w1.x, w1.y, w1.z, w1.w};
          const float lb8[8] = {b0.x, b0.y, b0.z, b0.w, b1.x, b1.y, b1.z, b1.w};
          float sm = 0.f;
#pragma unroll
          for (int e = 0; e < 8; ++e) sm += y[e];
          sm += __shfl_xor(sm, 1, 64); sm += __shfl_xor(sm, 2, 64); sm += __shfl_xor(sm, 4, 64);
          const float mean = sm * (1.f / 64.f);
          float vr = 0.f;
#pragma unroll
          for (int e = 0; e < 8; ++e) { y[e] -= mean; vr += y[e] * y[e]; }
          vr += __shfl_xor(vr, 1, 64); vr += __shfl_xor(vr, 2, 64); vr += __shfl_xor(vr, 4, 64);
          const float rstd = rsqrtf(vr * (1.f / 64.f) + GN_EPS);
          float o[8];
#pragma unroll
          for (int e = 0; e < 8; ++e) o[e] = (y[e] * rstd * lw8[e] + lb8[e] + bon * vf[e]) * silu_f(gf[e]);
          *(uint4*)(T4 + idx) = make_uint4(pack2(o[0], o[1]), pack2(o[2], o[3]), pack2(o[4], o[5]), pack2(o[6], o[7]));
        }
      } break;
      case PH_ROUTPROJ: {
        const int MT = ((layer == 3) ? NLAT : NR) / 128;
        const int NBIG = 512, NSMALL = (MT * 4 - NBIG) * 2;
        for (int t = blockIdx.x; t < NBIG + NSMALL; t += gridDim.x) {
          if (t < NBIG) {
            const int mt = t / 4, nt = t % 4;
            gemm_tile_plain<false, 4>(T4, nullptr, nullptr, 1024, W + (size_t)4384 * 1024, 1024, 1024, mt * 128, nt * 256, 1024, smem, TID,
                                       [=](int) { return T2; });
          } else {
            const int u = t - NBIG, mt = 128 + u / 8, nt = u % 8;
            gemm_tile_plain<false, 2>(T4, nullptr, nullptr, 1024, W + (size_t)4384 * 1024, 1024, 1024, mt * 128, nt * 128, 1024, smem, TID,
                                       [=](int) { return T2; });
          }
        }
      } break;
      case PH_POSTLAST: {
        row_items(p, layer, true, false, NLAT, T2, nullptr, blockIdx.x, NLAT / 4, TID);
      } break;
    }
}

#define XB_TMO      128
#define XB_XCNT(j)  (256  + 64 * (j))
#define XB_XSUB(j)  (1280 + 64 * (j))
#define XB_XGEN(j)  (2304 + 64 * (j))
#define XB_TOP      3328
#define XB_TOPGEN   3392
#define XCD_BAR_WORDS 3456
#define XB_SPIN_CAP (1u << 23)
#define LAS __attribute__((address_space(3)))

__device__ __forceinline__ unsigned xb_ld(unsigned* p)              { return __hip_atomic_load(p, __ATOMIC_RELAXED, __HIP_MEMORY_SCOPE_AGENT); }
__device__ __forceinline__ unsigned xb_add(unsigned* p, unsigned v) { return __hip_atomic_fetch_add(p, v, __ATOMIC_RELAXED, __HIP_MEMORY_SCOPE_AGENT); }
__device__ __forceinline__ unsigned xb_xcc_id() { return (unsigned)__builtin_amdgcn_s_getreg((3 << 11) | 20) & 0xFu; }
#define XB_SPIN(cond, bar) do { unsigned _sp = 0; while (cond) { __builtin_amdgcn_s_sleep(1); \
    if ((++_sp & 255u) == 0u) { if (xb_ld(&(bar)[XB_TMO])) break; if (_sp > XB_SPIN_CAP) { atomicAdd(&(bar)[XB_TMO], 1u); break; } } } } while (0)

struct XcdBarrier {
    unsigned* bar; unsigned x;
    volatile LAS unsigned* st;
};

__device__ __forceinline__ XcdBarrier xcd_barrier_post(unsigned* bar, volatile LAS unsigned* st) {
    XcdBarrier b; b.bar = bar; b.x = xb_xcc_id(); b.st = st;
    if (threadIdx.x == 0) (void)xb_add(&bar[XB_XCNT(b.x)], 1u);
    return b;
}
__device__ __forceinline__ void xcd_barrier_complete(unsigned* bar, unsigned x, unsigned& nloc, unsigned& nx) {
    const unsigned G = gridDim.x * gridDim.y * gridDim.z;
    unsigned sum, cnt, mine, sp = 0u;
    for (;;) {
        sum = 0u; cnt = 0u; mine = 0u;
#pragma unroll
        for (unsigned j = 0; j < 16; ++j) { const unsigned c = xb_ld(&bar[XB_XCNT(j)]); sum += c; cnt += (c > 0u) ? 1u : 0u; mine = (j == x) ? c : mine; }
        if (sum == G) break;
        __builtin_amdgcn_s_sleep(1);
        if ((++sp & 255u) == 0u) { if (xb_ld(&bar[XB_TMO])) break; if (sp > XB_SPIN_CAP) { atomicAdd(&bar[XB_TMO], 1u); break; } }
    }
    nloc = mine > 0u ? mine : 1u; nx = cnt > 0u ? cnt : 1u;
}

__device__ __forceinline__ void xcd_barrier(const XcdBarrier& b) {
    asm volatile("s_waitcnt vmcnt(0)" ::: "memory");
    __syncthreads();
    if (threadIdx.x == 0) {
        unsigned* bar = b.bar;
        __builtin_amdgcn_s_waitcnt(0);
        unsigned nloc = b.st[0], nx = b.st[1];
        if (nloc == 0u) { xcd_barrier_complete(bar, b.x, nloc, nx); b.st[0] = nloc; b.st[1] = nx; }
        const unsigned old = xb_add(&bar[XB_XSUB(b.x)], 1u);
        const unsigned gen = old / nloc;
        if (old + 1u == (gen + 1u) * nloc) {
            __builtin_amdgcn_fence(__ATOMIC_RELEASE, "agent");
            asm volatile("s_waitcnt vmcnt(0)" ::: "memory");
            const unsigned og = xb_add(&bar[XB_TOP], 1u);
            const unsigned tg = og / nx;
            if (og + 1u == (tg + 1u) * nx) xb_add(&bar[XB_TOPGEN], 1u);
            else XB_SPIN(xb_ld(&bar[XB_TOPGEN]) == tg, bar);
            __builtin_amdgcn_fence(__ATOMIC_ACQUIRE, "agent");
            xb_add(&bar[XB_XGEN(b.x)], 1u);
            asm volatile("s_waitcnt vmcnt(0)" ::: "memory");
        } else {
            XB_SPIN(xb_ld(&bar[XB_XGEN(b.x)]) == gen, bar);
            __builtin_amdgcn_fence(__ATOMIC_ACQUIRE, "agent");
            asm volatile("s_waitcnt vmcnt(0)" ::: "memory");
        }
    }
    __syncthreads();
}


__global__ void __launch_bounds__(256, 1) mega(Params p) {
  __shared__ __attribute__((aligned(16))) char smem[CS_END];
  cg::grid_group grid = cg::this_grid();
  __shared__ uint4 xb_words;
  if (threadIdx.x == 0) xb_words = make_uint4(0u, 0u, 0u, 0u);
  __syncthreads();
  XcdBarrier xb = xcd_barrier_post((unsigned*)(p.ws + OFF_BAR), (volatile LAS unsigned*)&xb_words);
  for (int ph = p.phase_lo; ph < p.phase_hi; ++ph) {
    int tid_l = threadIdx.x;
    asm volatile("" : "+v"(tid_l));
    run_phase(p, ph, smem, tid_l);
#ifdef REP_MASK
    if ((REP_MASK >> p.ptype[ph]) & 1) { asm volatile("s_waitcnt vmcnt(0) lgkmcnt(0)" ::: "memory"); grid.sync(); asm volatile("" : "+v"(tid_l)); run_phase(p, ph, smem, tid_l); }
#endif
    if (ph + 1 < p.phase_hi) {
      asm volatile("s_waitcnt vmcnt(0) lgkmcnt(0)" ::: "memory");
      if (ph == p.phase_lo) grid.sync();
      else xcd_barrier(xb);
    }
  }
}

extern "C" void kernel_launch(void* const* d_in, const int* in_sizes, int n_in, void* d_out, int out_size, void* d_ws, size_t ws_size,
                              hipStream_t stream) {
  static int grid_blocks = 0;
  if (!grid_blocks) {
    int dev = 0, cus = 0, per_cu = 0;
    hipGetDevice(&dev);
    hipDeviceGetAttribute(&cus, hipDeviceAttributeMultiprocessorCount, dev);
    hipOccupancyMaxActiveBlocksPerMultiprocessor(&per_cu, mega, 256, 0);
    if (per_cu > 2) per_cu = 2;
    if (per_cu < 1) per_cu = 1;
    grid_blocks = cus * per_cu;
  }
  Params p;
  memset(&p, 0, sizeof(p));
  const float** fp = (const float**)&p;
  for (int i = 0; i < 29; ++i) fp[i] = (const float*)d_in[i];
  p.out = (float*)d_out;
  p.ws = (char*)d_ws;
  int n = 0;
  auto add = [&](int t, int l) { p.ptype[n] = (unsigned char)t; p.player[n] = (unsigned char)l; ++n; };
  add(PH_PREP0, 0);
  add(PH_PRE0, 0);
  for (int l = 0; l < 4; ++l) {
    if ((l & 1) == 0) {
      add(PH_FGEMM1, l); add(PH_FDFT1, l); add(PH_FDFT3, l); add(PH_FOUT, l); add(PH_POSTPRE, l);
    } else {
      add(PH_RSHIFT, l); add(PH_RINPROJ, l);
      if (l == 3) add(PH_RVUPD, l);
      add(PH_RSCANA, l); add(PH_RSCAN, l); add(PH_ROUTPUT, l); add(PH_ROUTPROJ, l);
      add(l == 3 ? PH_POSTLAST : PH_POSTPRE, l);
    }
  }
#ifdef DBG_STOP
  n = DBG_STOP; add(PH_DUMP, 0);
#endif
#if SINGLE_LAUNCH
  hipMemsetAsync((char*)d_ws + OFF_BAR, 0, 3456 * 4, stream);
  p.phase_lo = 0; p.phase_hi = n;
  void* args[] = {&p};
  hipError_t e = hipLaunchCooperativeKernel((void*)mega, dim3(grid_blocks), dim3(256), args, 0, stream);
  if (e != hipSuccess) fprintf(stderr, "cooperative launch failed: %s (grid %d)\n", hipGetErrorString(e), grid_blocks);
#else
  for (int i = 0; i < n; ++i) {
    p.phase_lo = i; p.phase_hi = i + 1;
    hipLaunchKernelGGL(mega, dim3(grid_blocks), dim3(256), 0, stream, p);
  }
#endif
}
```

```cpp
#include <hip/hip_runtime.h>
#include <hip/hip_cooperative_groups.h>
#include <cstdio>
#include <cstring>
namespace cg = cooperative_groups;

#ifndef DBG_MASK
#define DBG_MASK 0
#endif
#ifndef SINGLE_LAUNCH
#define SINGLE_LAUNCH 1
#endif

typedef unsigned short bf16_t;
typedef short s16x8 __attribute__((ext_vector_type(8)));
typedef short s16x4 __attribute__((ext_vector_type(4)));
typedef float f32x16 __attribute__((ext_vector_type(16)));
#define DI __device__ __forceinline__
#define MFMA(a, b, c) __builtin_amdgcn_mfma_f32_32x32x16_bf16((a), (b), (c), 0, 0, 0)

constexpr int NR = 16896;
constexpr int NLAT = 16384;
constexpr int D = 1024;
constexpr size_t SLOT = (size_t)NR * D * 2;
constexpr float RMS_EPS = 1e-6f;
constexpr float GN_EPS = 64e-5f;

constexpr size_t OFF_T0 = 0;
constexpr size_t OFF_VF = 6 * SLOT;
constexpr size_t OFF_XCTX = OFF_VF + SLOT;
constexpr size_t OFF_W = OFF_XCTX + (size_t)512 * D * 4;
constexpr size_t W_BYTES = (size_t)(4384 + 1024) * 1024 * 2;
constexpr size_t OFF_LW = OFF_W + W_BYTES;
constexpr size_t OFF_LA = OFF_LW + (size_t)NR * 128 * 2;
constexpr size_t OFF_LV = OFF_LA + (size_t)NR * 128 * 2;
constexpr size_t OFF_MOD = OFF_LV + (size_t)NR * 32 * 2;
constexpr size_t OFF_F1 = OFF_MOD + (size_t)4 * 3 * 3072 * 4;
constexpr size_t OFF_F2 = OFF_F1 + 128 * 128 * 2;
constexpr size_t OFF_FC = OFF_F2 + 128 * 256 * 2;
constexpr size_t OFF_TW = OFF_FC + 256 * 512 * 2;
constexpr size_t OFF_BON = OFF_TW + 64 * 128 * 8;
constexpr size_t OFF_BAR = OFF_BON + (size_t)2 * NR * 16 * 4;
constexpr size_t WS_END = OFF_BAR + 3456 * 4;
static_assert(WS_END <= 268435456ull, "workspace overflow");

enum { PH_PREP0 = 0, PH_PRE0, PH_FGEMM1, PH_FDFT1, PH_FDFT3, PH_FOUT, PH_POSTPRE, PH_RSHIFT, PH_RINPROJ, PH_RVUPD, PH_RSCAN, PH_ROUTPUT, PH_ROUTPROJ, PH_POSTLAST, PH_DUMP, PH_RSCANA };

struct Params {
  const float *x, *c, *ctx, *c_ctx, *mod_w, *mod_b, *norm_pre, *norm_post, *f_w_in, *f_w_mix, *f_b_mix, *f_w_out,
      *r_mu, *r_w_in, *r_w0, *r_w1, *r_w2, *r_a0, *r_a1, *r_a2, *r_v0, *r_v1, *r_v2, *r_k_k, *r_k_a, *r_r_k, *r_ln_w, *r_ln_b, *r_w_out;
  float* out;
  char* ws;
  int phase_lo, phase_hi;
  unsigned char ptype[32];
  unsigned char player[32];
};

DI float bf2f(bf16_t u) { return __uint_as_float(((unsigned)u) << 16); }
DI bf16_t f2bf(float f) { unsigned r; asm("v_cvt_pk_bf16_f32 %0, %1, %1" : "=v"(r) : "v"(f)); return (bf16_t)r; }
DI unsigned pack2(float a, float b) { unsigned r; asm("v_cvt_pk_bf16_f32 %0, %1, %2" : "=v"(r) : "v"(a), "v"(b)); return r; }
DI float lo2f(unsigned u) { return __uint_as_float(u << 16); }
DI float hi2f(unsigned u) { return __uint_as_float(u & 0xffff0000u); }
DI float silu_f(float x) { return x * __builtin_amdgcn_rcpf(1.f + __expf(-x)); }
DI float sigmoid_f(float x) { return __builtin_amdgcn_rcpf(1.f + __expf(-x)); }
DI float fsig(float x) { return __builtin_amdgcn_rcpf(1.f + __expf(-x)); }
DI float softplus_f(float x) { return fmaxf(x, 0.f) + log1pf(__expf(-fabsf(x))); }
template <int CTRL>
DI float dpp_add(float v) { return v + __int_as_float(__builtin_amdgcn_update_dpp(0, __float_as_int(v), CTRL, 0xf, 0xf, true)); }
DI float wave_sum(float v) {
  v = dpp_add<0xB1>(v);
  v = dpp_add<0x4E>(v);
  v = dpp_add<0x141>(v);
  v = dpp_add<0x140>(v);
  const int iv = __float_as_int(v);
  return __int_as_float(__builtin_amdgcn_readlane(iv, 0)) + __int_as_float(__builtin_amdgcn_readlane(iv, 16)) +
         __int_as_float(__builtin_amdgcn_readlane(iv, 32)) + __int_as_float(__builtin_amdgcn_readlane(iv, 48));
}
DI int crow(int r, int h) { return (r & 3) + 8 * (r >> 2) + 4 * h; }

template <bool MIX>
DI uint4 mix_chunk(uint4 va, uint4 vs, const float4 m0v, const float4 m1v) {
  if (!MIX) return va;
  float h, sv;
  h = lo2f(va.x); sv = lo2f(vs.x); const float e0 = h + (sv - h) * m0v.x;
  h = hi2f(va.x); sv = hi2f(vs.x); const float e1 = h + (sv - h) * m0v.y;
  h = lo2f(va.y); sv = lo2f(vs.y); const float e2 = h + (sv - h) * m0v.z;
  h = hi2f(va.y); sv = hi2f(vs.y); const float e3 = h + (sv - h) * m0v.w;
  h = lo2f(va.z); sv = lo2f(vs.z); const float e4 = h + (sv - h) * m1v.x;
  h = hi2f(va.z); sv = hi2f(vs.z); const float e5 = h + (sv - h) * m1v.y;
  h = lo2f(va.w); sv = lo2f(vs.w); const float e6 = h + (sv - h) * m1v.z;
  h = hi2f(va.w); sv = hi2f(vs.w); const float e7 = h + (sv - h) * m1v.w;
  return make_uint4(pack2(e0, e1), pack2(e2, e3), pack2(e4, e5), pack2(e6, e7));
}
struct NoDst { DI bf16_t* operator()(int) const { return nullptr; } };
template <bool MIX, int NJ, bool PLAIN, class Epi, class DstFn>
DI void gemm_tile_impl(const bf16_t* __restrict__ A, const bf16_t* __restrict__ A2, const float* __restrict__ mu, int lda,
                    const bf16_t* __restrict__ BT, int ldb, int K, int m0, int n0, int N, char* smem, const int TID, Epi epi, DstFn dst_fn) {
  constexpr int BN = 64 * NJ, NB = BN / 32, NBQ = NB / 4;
  constexpr int STAGE = (128 + BN) * 144;
  const int tid = TID, lane = tid & 63, w = tid >> 6, wm = w & 1, wn = w >> 1;
  f32x16 acc[2][NJ];
#pragma unroll
  for (int i = 0; i < 2; ++i)
#pragma unroll
    for (int j = 0; j < NJ; ++j)
#pragma unroll
      for (int r = 0; r < 16; ++r) acc[i][j][r] = 0.f;
  uint4 ra[2][4], ra2[2][4], rb[2][NB];
  const int KT = K >> 6;
  const int lrow = tid >> 3, kc = tid & 7;
  const bf16_t* Ap = A + (size_t)(m0 + lrow) * lda + kc * 8;
  const bf16_t* A2p = MIX ? (A2 + (size_t)(m0 + lrow) * lda + kc * 8) : nullptr;
  const bf16_t* Bp = BT + (size_t)(n0 + lrow) * ldb + kc * 8;
  const bool nfull = (n0 + BN <= N);
#define GEMM_LOAD(ST_, KT_) { \
    _Pragma("unroll") for (int i = 0; i < 4; ++i) { \
      ra[ST_][i] = *(const uint4*)(Ap + (size_t)(32 * i) * lda + (KT_) * 64); \
      if (MIX) ra2[ST_][i] = *(const uint4*)(A2p + (size_t)(32 * i) * lda + (KT_) * 64); } \
    _Pragma("unroll") for (int i = 0; i < NB; ++i) \
      rb[ST_][i] = (nfull || (n0 + lrow + 32 * i) < N) ? *(const uint4*)(Bp + (size_t)(32 * i) * ldb + (KT_) * 64) : make_uint4(0, 0, 0, 0); }
#define GEMM_STAGE_SLICE(ST_, KT_, Q_, BUF_) { \
    bf16_t* As_ = (bf16_t*)(smem + (BUF_) * STAGE); bf16_t* Bs_ = As_ + 128 * 72; \
    float4 m0v_ = make_float4(0, 0, 0, 0), m1v_ = m0v_; \
    if (MIX) { m0v_ = *(const float4*)(mu + (KT_) * 64 + kc * 8); m1v_ = *(const float4*)(mu + (KT_) * 64 + kc * 8 + 4); } \
    *(uint4*)(As_ + (lrow + 32 * (Q_)) * 72 + kc * 8) = mix_chunk<MIX>(ra[ST_][Q_], ra2[ST_][Q_], m0v_, m1v_); \
    _Pragma("unroll") for (int u = 0; u < NBQ; ++u) *(uint4*)(Bs_ + (lrow + 32 * ((Q_) * NBQ + u)) * 72 + kc * 8) = rb[ST_][(Q_) * NBQ + u]; }
  GEMM_LOAD(0, 0)
  if (KT > 1) GEMM_LOAD(1, 1)
  __syncthreads();
#pragma unroll
  for (int qq = 0; qq < 4; ++qq) GEMM_STAGE_SLICE(0, 0, qq, 0)
  if (KT > 2) GEMM_LOAD(0, 2)
  __syncthreads();
  for (int kt0 = 0; kt0 < KT; kt0 += 2) {
#pragma unroll
    for (int st = 0; st < 2; ++st) {
      const int kt = kt0 + st;
      if (kt < KT) {
        const bf16_t* As = (const bf16_t*)(smem + st * STAGE);
        const bf16_t* Bs = As + 128 * 72;
        const bool more = (kt + 1 < KT);
        s16x8 fa[2][2], fb[2][NJ];
#pragma unroll
        for (int i = 0; i < 2; ++i) fa[0][i] = *(const s16x8*)(As + (64 * wm + 32 * i + (lane & 31)) * 72 + (lane >> 5) * 8);
#pragma unroll
        for (int j = 0; j < NJ; ++j) fb[0][j] = *(const s16x8*)(Bs + (32 * NJ * wn + 32 * j + (lane & 31)) * 72 + (lane >> 5) * 8);
#pragma unroll
        for (int kk = 0; kk < 4; ++kk) {
          if (kk < 3) {
#pragma unroll
            for (int i = 0; i < 2; ++i) fa[(kk + 1) & 1][i] = *(const s16x8*)(As + (64 * wm + 32 * i + (lane & 31)) * 72 + (kk + 1) * 16 + (lane >> 5) * 8);
#pragma unroll
            for (int j = 0; j < NJ; ++j) fb[(kk + 1) & 1][j] = *(const s16x8*)(Bs + (32 * NJ * wn + 32 * j + (lane & 31)) * 72 + (kk + 1) * 16 + (lane >> 5) * 8);
          }
#pragma unroll
          for (int i = 0; i < 2; ++i)
#pragma unroll
            for (int j = 0; j < NJ; ++j) acc[i][j] = MFMA(fa[kk & 1][i], fb[kk & 1][j], acc[i][j]);
          if (more) GEMM_STAGE_SLICE(st ^ 1, kt + 1, kk, st ^ 1)
        }
        if (kt + 3 < KT) GEMM_LOAD(st ^ 1, kt + 3)
        __syncthreads();
      }
    }
  }
#undef GEMM_LOAD
#undef GEMM_STAGE_SLICE
  if (PLAIN) {
    constexpr int PITCH = 32 * NJ * 2 + 16;
    char* reg = smem + w * (64 * PITCH);
    const int l31 = lane & 31, hh = lane >> 5;
#pragma unroll
    for (int i = 0; i < 2; ++i)
#pragma unroll
      for (int j = 0; j < NJ; ++j)
#pragma unroll
        for (int r = 0; r < 16; ++r)
          *(bf16_t*)(reg + (32 * i + crow(r, hh)) * PITCH + (32 * j + l31) * 2) = f2bf(acc[i][j][r]);
    __syncthreads();
    const int col0 = n0 + 32 * NJ * wn;
    bf16_t* dst = dst_fn(col0) + (size_t)(m0 + 64 * wm) * D + (col0 & 1023);
    constexpr int CPR = 4 * NJ;
    constexpr int RPI = 64 / CPR;
    const int rr = lane / CPR, ch = lane % CPR;
#pragma unroll
    for (int q = 0; q < CPR; ++q) {
      const int row = rr + RPI * q;
      *(uint4*)(dst + (size_t)row * D + ch * 8) = *(const uint4*)(reg + row * PITCH + ch * 16);
    }
    return;
  }
#pragma unroll
  for (int i = 0; i < 2; ++i)
#pragma unroll
    for (int j = 0; j < NJ; ++j) {
      const int col = n0 + 32 * NJ * wn + 32 * j + (lane & 31);
      if (col < N) {
#pragma unroll
        for (int r = 0; r < 16; ++r) {
          const int row = m0 + 64 * wm + 32 * i + crow(r, lane >> 5);
          epi(row, col, acc[i][j][r]);
        }
      }
    }
}
template <bool MIX, int NJ, class Epi>
DI void gemm_tile_n(const bf16_t* __restrict__ A, const bf16_t* __restrict__ A2, const float* __restrict__ mu, int lda,
                    const bf16_t* __restrict__ BT, int ldb, int K, int m0, int n0, int N, char* smem, const int TID, Epi epi) {
  gemm_tile_impl<MIX, NJ, false>(A, A2, mu, lda, BT, ldb, K, m0, n0, N, smem, TID, epi, NoDst());
}
template <bool MIX, int NJ, class DstFn>
DI void gemm_tile_plain(const bf16_t* __restrict__ A, const bf16_t* __restrict__ A2, const float* __restrict__ mu, int lda,
                        const bf16_t* __restrict__ BT, int ldb, int K, int m0, int n0, int N, char* smem, const int TID, DstFn dst_fn) {
  gemm_tile_impl<MIX, NJ, true>(A, A2, mu, lda, BT, ldb, K, m0, n0, N, smem, TID, [](int, int, float) {}, dst_fn);
}
template <bool MIX, class Epi>
DI void gemm_tile(const bf16_t* __restrict__ A, const bf16_t* __restrict__ A2, const float* __restrict__ mu, int lda,
                  const bf16_t* __restrict__ BT, int ldb, int K, int m0, int n0, int N, char* smem, const int TID, Epi epi) {
  gemm_tile_n<MIX, 2>(A, A2, mu, lda, BT, ldb, K, m0, n0, N, smem, TID, epi);
}

template <class Epi>
DI void dft_tile(const bf16_t* __restrict__ A, int lda, int arow0, int KH, const bf16_t* __restrict__ Bre,
                 const bf16_t* __restrict__ Bim, int ldb, int tstride, char* smem, const int TID, Epi epi) {
  const int tid = TID, lane = tid & 63, w = tid >> 6;
  const int rt0 = w & 1, ctb = 2 * (w >> 1);
  f32x16 acc[2][2];
#pragma unroll
  for (int i = 0; i < 2; ++i)
#pragma unroll
    for (int j = 0; j < 2; ++j)
#pragma unroll
      for (int r = 0; r < 16; ++r) acc[i][j][r] = 0.f;
  const int nch = (2 * KH) >> 7;
  const int g = lane >> 4, li = lane & 15, q = li >> 2, pp = li & 3;
  const int tr_base = (8 * (g >> 1) + q) * 320 + (16 * (g & 1) + 4 * pp) * 2;
  for (int ch = 0; ch < nch; ++ch) {
    __syncthreads();
#pragma unroll
    for (int i = 0; i < 8; ++i) {
      const int c = tid + 256 * i, r = c >> 4, cc = c & 15;
      const int kr = ch * 128 + r;
      const bf16_t* src = (kr < KH ? Bre + (size_t)kr * tstride * ldb : Bim + (size_t)(kr - KH) * tstride * ldb) + cc * 8;
      *(uint4*)(smem + r * 320 + cc * 16) = *(const uint4*)src;
    }
    __syncthreads();
#pragma unroll
    for (int kh = 0; kh < 2; ++kh) {
      asm volatile("" ::: "memory");
      s16x8 af[4][2];
#pragma unroll
      for (int k4 = 0; k4 < 4; ++k4)
#pragma unroll
        for (int h = 0; h < 2; ++h)
          af[k4][h] = *(const s16x8*)(A + (size_t)(arow0 + 32 * (rt0 + 2 * h) + (lane & 31)) * lda + ch * 128 + (kh * 4 + k4) * 16 + (lane >> 5) * 8);
#pragma unroll
      for (int k4 = 0; k4 < 4; ++k4) {
        const int ks = kh * 4 + k4;
#pragma unroll
        for (int c2 = 0; c2 < 2; ++c2) {
          const int off = tr_base + ks * 16 * 320 + (ctb + c2) * 64;
#ifdef NO_TR
          s16x8 b;
          {
            const int n = 32 * (ctb + c2) + (lane & 31), k0 = ks * 16 + 8 * (lane >> 5);
#pragma unroll
            for (int e = 0; e < 8; ++e) b[e] = *(const short*)(smem + (k0 + e) * 320 + n * 2);
          }
#else
          const s16x4 lo = __builtin_amdgcn_ds_read_tr16_b64_v4i16((__attribute__((address_space(3))) s16x4*)(smem + off));
          const s16x4 hi = __builtin_amdgcn_ds_read_tr16_b64_v4i16((__attribute__((address_space(3))) s16x4*)(smem + off + 4 * 320));
          const s16x8 b = __builtin_shufflevector(lo, hi, 0, 1, 2, 3, 4, 5, 6, 7);
#endif
#pragma unroll
          for (int h = 0; h < 2; ++h) acc[h][c2] = MFMA(af[k4][h], b, acc[h][c2]);
        }
      }
    }
  }
#pragma unroll
  for (int c2 = 0; c2 < 2; ++c2) {
    const int col = 32 * (ctb + c2) + (lane & 31);
#pragma unroll
    for (int r = 0; r < 16; ++r) {
      const int rowA = 32 * rt0 + crow(r, lane >> 5);
      if ((r & 3) == 0) asm volatile("" ::: "memory");
      epi(rowA, rowA + 64, col, acc[0][c2][r], acc[1][c2][r]);
    }
  }
}

DI void transpose_tile(const float* __restrict__ src, int lds_, bf16_t* __restrict__ dst, int ldd, int K, int N, int tk, int tn, char* smem, const int TID) {
  float* t = (float*)smem;
  const int tid = TID;
  __syncthreads();
#pragma unroll
  for (int i = 0; i < 16; ++i) {
    const int kk = (tid >> 6) + 4 * i, nn = tid & 63;
    const int k = tk * 64 + kk, n = tn * 64 + nn;
    t[kk * 65 + nn] = (k < K && n < N) ? src[(size_t)k * lds_ + n] : 0.f;
  }
  __syncthreads();
#pragma unroll
  for (int i = 0; i < 16; ++i) {
    const int nn = (tid >> 6) + 4 * i, kk = tid & 63;
    const int k = tk * 64 + kk, n = tn * 64 + nn;
    if (k < K && n < N) dst[(size_t)n * ldd + k] = f2bf(t[kk * 65 + nn]);
  }
}

DI void fourier_wprep(const Params& p, int j, int it, char* smem, const int TID) {
  bf16_t* W = (bf16_t*)(p.ws + OFF_W);
  const int job = it >> 8, t = it & 255;
  if (job == 0) transpose_tile(p.f_w_in + (size_t)j * 1024 * 2048 + 1024, 2048, W + (size_t)2048 * 1024, 1024, 1024, 1024, t >> 4, t & 15, smem, TID);
  else transpose_tile(p.f_w_out + (size_t)j * 1024 * 1024, 1024, W + (size_t)3072 * 1024, 1024, 1024, 1024, t >> 4, t & 15, smem, TID);
}
DI void rwkv_wprep(const Params& p, int j, int it, char* smem, const int TID) {
  bf16_t* W = (bf16_t*)(p.ws + OFF_W);
  if (it < 1024) {
    const int pi = it >> 8, t = it & 255;
    transpose_tile(p.r_w_in + (size_t)(j * 4 + pi) * 1024 * 1024, 1024, W + (size_t)pi * 1024 * 1024, 1024, 1024, 1024, t >> 4, t & 15, smem, TID);
  } else if (it < 1024 + 32) {
    const int u = it - 1024, n = u >> 4, t = u & 15;
    transpose_tile(p.r_w1 + (size_t)(j * 2 + n) * 1024 * 64, 64, W + (size_t)(4096 + 64 * n) * 1024, 1024, 1024, 64, t, 0, smem, TID);
  } else if (it < 1024 + 64) {
    const int u = it - 1056, n = u >> 4, t = u & 15;
    transpose_tile(p.r_a1 + (size_t)(j * 2 + n) * 1024 * 64, 64, W + (size_t)(4224 + 64 * n) * 1024, 1024, 1024, 64, t, 0, smem, TID);
  } else if (it < 1024 + 80) {
    const int t = it - 1088;
    if (j >= 1) transpose_tile(p.r_v1 + (size_t)(j - 1) * 1024 * 32, 32, W + (size_t)4352 * 1024, 1024, 1024, 32, t, 0, smem, TID);
  } else {
    const int t = it - 1104;
    transpose_tile(p.r_w_out + (size_t)j * 1024 * 1024, 1024, W + (size_t)4384 * 1024, 1024, 1024, 1024, t >> 4, t & 15, smem, TID);
  }
}
constexpr int N_FWPREP = 512, N_RWPREP = 1360;

DI void fourier_cw_prep(const Params& p, int j, int it, char* smem, const int TID) {
  bf16_t* FWU = (bf16_t*)(p.ws + 5 * SLOT);
  bf16_t* CWT = FWU + 1024 * 1024;
  const int tid = TID;
  if (it < 256) {
#pragma unroll
    for (int i = 0; i < 4; ++i) {
      const int row = it * 4 + i;
      const float4 v = *(const float4*)(p.f_w_in + (size_t)j * 1024 * 2048 + (size_t)row * 2048 + tid * 4);
      *(uint2*)(FWU + (size_t)row * 1024 + tid * 4) = make_uint2(pack2(v.x, v.y), pack2(v.z, v.w));
    }
  } else {
    float* tab = (float*)smem;
    __syncthreads();
    if (tid < 128) tab[tid] = cospif((float)tid / 64.f);
    __syncthreads();
    const int u = it - 256, pq = u >> 7, g = (u >> 4) & 7, cb = u & 15;
    const int e = tid & 127, cbase = cb * 8 + (tid >> 7) * 4;
    const float* wm = p.f_w_mix + ((size_t)j * 8 + g) * 128 * 128;
    const int off = pq ? 32 : 0;
    float a0 = 0.f, a1 = 0.f, a2 = 0.f, a3 = 0.f;
#pragma unroll 8
    for (int c2 = 0; c2 < 128; ++c2) {
      const float wv = wm[c2 * 128 + e];
      a0 += tab[((cbase + 0) * c2 - off) & 127] * wv;
      a1 += tab[((cbase + 1) * c2 - off) & 127] * wv;
      a2 += tab[((cbase + 2) * c2 - off) & 127] * wv;
      a3 += tab[((cbase + 3) * c2 - off) & 127] * wv;
    }
    *(uint2*)(CWT + (((size_t)pq * 8 + g) * 128 + e) * 128 + cbase) = make_uint2(pack2(a0, a1), pack2(a2, a3));
  }
}
constexpr int N_CWPREP = 256 + 256;

DI void fourier_precompose(const Params& p, int it, char* smem, const int TID) {
  const bf16_t* FWU = (const bf16_t*)(p.ws + 5 * SLOT);
  const bf16_t* CWT = FWU + 1024 * 1024;
  bf16_t* W = (bf16_t*)(p.ws + OFF_W);
  const int pg = it >> 3, nt = it & 7;
  const int g = pg & 7;
  bf16_t* dst = W + (size_t)pg * 128 * 1024;
  gemm_tile<false>(CWT + (size_t)pg * 128 * 128, nullptr, nullptr, 128, FWU + g * 128, 1024, 128, 0, nt * 128, 1024, smem, TID,
                   [=](int row, int col, float v) { dst[(size_t)row * 1024 + col] = f2bf(v); });
}

DI void phase_prep0(const Params& p, char* smem, const int TID) {
  const int tid = TID;

  float* MOD = (float*)(p.ws + OFF_MOD);
  const int N_MOD = 192, N_TAB = (128 * 128 + 128 * 256 + 256 * 512 + 64 * 128) / 256;
  const int total = N_MOD + N_TAB + N_CWPREP + N_FWPREP;
  for (int it = blockIdx.x; it < total; it += gridDim.x) {
    if (it < N_MOD) {
      const int layer = it / 48, chunk = it % 48;
      const int kp = tid >> 4, cgp = tid & 15;
      const float* wbase = p.mod_w + (size_t)layer * 1024 * 3072 + chunk * 64 + cgp * 4;
      float a0[4] = {0, 0, 0, 0}, a1[4] = {0, 0, 0, 0}, a2[4] = {0, 0, 0, 0};
      float* sc = (float*)(smem + 16384);
      __syncthreads();
      for (int e = tid; e < 1024; e += 256) { sc[e] = silu_f(p.c[e]); sc[1024 + e] = silu_f(p.c[1024 + e]); sc[2048 + e] = silu_f(p.c_ctx[e]); }
      __syncthreads();
#pragma unroll 8
      for (int k = kp * 64; k < kp * 64 + 64; ++k) {
        const float4 wv = *(const float4*)(wbase + (size_t)k * 3072);
        const float s0 = sc[k], s1 = sc[1024 + k], s2 = sc[2048 + k];
        a0[0] += s0 * wv.x; a0[1] += s0 * wv.y; a0[2] += s0 * wv.z; a0[3] += s0 * wv.w;
        a1[0] += s1 * wv.x; a1[1] += s1 * wv.y; a1[2] += s1 * wv.z; a1[3] += s1 * wv.w;
        a2[0] += s2 * wv.x; a2[1] += s2 * wv.y; a2[2] += s2 * wv.z; a2[3] += s2 * wv.w;
      }
      float* red = (float*)smem;
      __syncthreads();
#pragma unroll
      for (int e = 0; e < 4; ++e) {
        red[(kp * 3 + 0) * 64 + cgp * 4 + e] = a0[e];
        red[(kp * 3 + 1) * 64 + cgp * 4 + e] = a1[e];
        red[(kp * 3 + 2) * 64 + cgp * 4 + e] = a2[e];
      }
      __syncthreads();
      if (tid < 192) {
        const int v = tid >> 6, col = tid & 63;
        float s = 0.f;
#pragma unroll
        for (int k = 0; k < 16; ++k) s += red[(k * 3 + v) * 64 + col];
        const int cidx = chunk * 64 + col;
        MOD[((size_t)layer * 3 + v) * 3072 + cidx] = s + p.mod_b[(size_t)layer * 3072 + cidx];
      }
    } else if (it < N_MOD + N_TAB) {
      int e = (it - N_MOD) * 256 + tid;
      bf16_t* F1 = (bf16_t*)(p.ws + OFF_F1);
      bf16_t* F2 = (bf16_t*)(p.ws + OFF_F2);
      bf16_t* FC = (bf16_t*)(p.ws + OFF_FC);
      float2* TW = (float2*)(p.ws + OFF_TW);
      if (e < 128 * 128) {
        const int m = e >> 7, k = e & 127;
        const int mm = m & 63, kk = k & 63;
        const float ang = (float)((mm * kk) & 63) / 32.f;
        const float cv = cospif(ang), sv = sinpif(ang);
        float val;
        if (m < 64) val = (k < 64) ? cv : -sv; else val = (k < 64) ? sv : cv;
        F1[e] = f2bf(val);
      } else if ((e -= 128 * 128) < 128 * 256) {
        const int m = e >> 8, k = e & 255, kk = k & 127;
        const float ang = (float)((m * kk) & 127) / 64.f;
        F2[e] = f2bf(k < 128 ? cospif(ang) : -sinpif(ang));
      } else if ((e -= 128 * 256) < 256 * 512) {
        const int m = e >> 9, k = e & 511, kk = k & 255;
        const float ang = (float)((m * kk) & 255) / 128.f;
        FC[e] = f2bf(k < 256 ? cospif(ang) : -sinpif(ang));
      } else {
        e -= 256 * 512;
        const int k1 = e >> 7, t2 = e & 127;
        const float ang = (float)(k1 * t2) / 4096.f;
        TW[e] = make_float2(cospif(ang), sinpif(ang));
      }
    } else if (it < N_MOD + N_TAB + N_CWPREP) {
      fourier_cw_prep(p, 0, it - N_MOD - N_TAB, smem, TID);
    } else {
      fourier_wprep(p, 0, it - N_MOD - N_TAB - N_CWPREP, smem, TID);
    }
  }
}

DI void row_items(const Params& p, int layer, bool do_post, bool do_pre, int nrows, const bf16_t* O, bf16_t* H, int it0, int nit, const int TID) {
  const int wave = TID >> 6, lane = TID & 63;
  const float* MOD = (const float*)(p.ws + OFF_MOD);
  float* XCTX = (float*)(p.ws + OFF_XCTX);
  float4 nx0, nx1, nx2, nx3;
  uint2 no0 = make_uint2(0, 0), no1 = no0, no2 = no0, no3 = no0;
#define ROW_XIN(ROW_) ((layer == 0) ? ((ROW_) < NLAT ? p.x + (size_t)(ROW_) * D : p.ctx + (size_t)((ROW_) - NLAT) * D) \
                                    : ((ROW_) < NLAT ? p.out + (size_t)(ROW_) * D : XCTX + (size_t)((ROW_) - NLAT) * D))
#define ROW_PREFETCH(ROW_) { const float* xi_ = ROW_XIN(ROW_); \
    nx0 = *(const float4*)(xi_ + lane * 4); nx1 = *(const float4*)(xi_ + 256 + lane * 4); nx2 = *(const float4*)(xi_ + 512 + lane * 4); nx3 = *(const float4*)(xi_ + 768 + lane * 4); \
    if (do_post) { const bf16_t* oi_ = O + (size_t)(ROW_) * D + lane * 4; \
      no0 = *(const uint2*)(oi_); no1 = *(const uint2*)(oi_ + 256); no2 = *(const uint2*)(oi_ + 512); no3 = *(const uint2*)(oi_ + 768); } }
  if (it0 < nit) ROW_PREFETCH(it0 * 4 + wave)
  for (int it = it0; it < nit; it += gridDim.x) {
    const int row = it * 4 + wave;
    const int v = row < 8192 ? 0 : (row < 16384 ? 1 : 2);
    float* xout = row < NLAT ? p.out + (size_t)row * D : XCTX + (size_t)(row - NLAT) * D;
    float4 xv[4] = {nx0, nx1, nx2, nx3};
    const uint2 ou[4] = {no0, no1, no2, no3};
    if (it + (int)gridDim.x < nit) ROW_PREFETCH((it + (int)gridDim.x) * 4 + wave)
    if (do_post) {
      float ov[4][4];
      float ss = 0.f;
#pragma unroll
      for (int qd = 0; qd < 4; ++qd) {
        const uint2 u = ou[qd];
        ov[qd][0] = lo2f(u.x); ov[qd][1] = hi2f(u.x); ov[qd][2] = lo2f(u.y); ov[qd][3] = hi2f(u.y);
#pragma unroll
        for (int e = 0; e < 4; ++e) ss += ov[qd][e] * ov[qd][e];
      }
      ss = wave_sum(ss);
      const float rstd = rsqrtf(ss * (1.f / 1024.f) + RMS_EPS);
      const float* gate = MOD + ((size_t)layer * 3 + v) * 3072 + 2048;
      const float* np = p.norm_post + (size_t)layer * D;
#pragma unroll
      for (int qd = 0; qd < 4; ++qd) {
        const float4 gv = *(const float4*)(gate + qd * 256 + lane * 4);
        const float4 nv = *(const float4*)(np + qd * 256 + lane * 4);
        xv[qd].x += gv.x * (ov[qd][0] * rstd * nv.x);
        xv[qd].y += gv.y * (ov[qd][1] * rstd * nv.y);
        xv[qd].z += gv.z * (ov[qd][2] * rstd * nv.z);
        xv[qd].w += gv.w * (ov[qd][3] * rstd * nv.w);
        *(float4*)(xout + qd * 256 + lane * 4) = xv[qd];
      }
    }
    if (do_pre) {
      const int L = layer + (do_post ? 1 : 0);
      float ss = 0.f;
#pragma unroll
      for (int qd = 0; qd < 4; ++qd) ss += xv[qd].x * xv[qd].x + xv[qd].y * xv[qd].y + xv[qd].z * xv[qd].z + xv[qd].w * xv[qd].w;
      ss = wave_sum(ss);
      const float rstd = rsqrtf(ss * (1.f / 1024.f) + RMS_EPS);
      const float* sh = MOD + ((size_t)L * 3 + v) * 3072;
      const float* sc = sh + 1024;
      const float* np = p.norm_pre + (size_t)L * D;
#pragma unroll
      for (int qd = 0; qd < 4; ++qd) {
        const float4 a = *(const float4*)(sh + qd * 256 + lane * 4);
        const float4 b = *(const float4*)(sc + qd * 256 + lane * 4);
        const float4 n = *(const float4*)(np + qd * 256 + lane * 4);
        const float h0 = xv[qd].x * rstd * n.x * (1.f + b.x) + a.x;
        const float h1 = xv[qd].y * rstd * n.y * (1.f + b.y) + a.y;
        const float h2 = xv[qd].z * rstd * n.z * (1.f + b.z) + a.z;
        const float h3 = xv[qd].w * rstd * n.w * (1.f + b.w) + a.w;
        *(uint2*)(H + (size_t)row * D + qd * 256 + lane * 4) = make_uint2(pack2(h0, h1), pack2(h2, h3));
      }
    }
  }
}

#undef ROW_XIN
#undef ROW_PREFETCH
DI int seq_row(int n, int b, int s) {
  if (s < 256) { const int t = n ? 255 - s : s; return NLAT + b * 256 + t; }
  const int u = s - 256; const int t = n ? 8191 - u : u; return b * 8192 + t;
}
DI void scan_chain(const Params& p, int j, int cid, const bf16_t* R, const bf16_t* Kb, const bf16_t* V, bf16_t* Y0, bf16_t* Y1, char* smem, const int TID) {
  const int n = cid >> 5, b = (cid >> 4) & 1, h = cid & 15;
  const int tid = TID;
  float* rS = (float*)smem;
  float* wS = rS + 1024; float* kS = wS + 1024; float* vS = kS + 1024; float* aS = vS + 1024; float* bS = aS + 1024;
  float* lwS = bS + 1024; float* laS = lwS + 1024;
  float* w2S = laS + 1024;
  float* a2S = w2S + 4096;
  float* yS = lwS;
  const bf16_t* LW = (const bf16_t*)(p.ws + OFF_LW);
  const bf16_t* LA = (const bf16_t*)(p.ws + OFF_LA);
  float* BON = (float*)(p.ws + OFF_BON);
  bf16_t* Y = n ? Y1 : Y0;
  __syncthreads();
  {
    const float* w2 = p.r_w2 + (size_t)(j * 2 + n) * 64 * 1024 + h * 64;
    const float* a2 = p.r_a2 + (size_t)(j * 2 + n) * 64 * 1024 + h * 64;
    for (int e = tid; e < 4096; e += 256) { w2S[e] = w2[(size_t)(e >> 6) * 1024 + (e & 63)]; a2S[e] = a2[(size_t)(e >> 6) * 1024 + (e & 63)]; }
  }
  const int ltok = tid >> 4, cq = tid & 15, c4 = cq * 4;
  const int gc = h * 64 + c4;
  const float4 w0v = *(const float4*)(p.r_w0 + (size_t)(j * 2 + n) * 1024 + gc);
  const float4 a0v = *(const float4*)(p.r_a0 + (size_t)(j * 2 + n) * 1024 + gc);
  const float4 kkv = *(const float4*)(p.r_k_k + (size_t)j * 1024 + gc);
  const float4 kav = *(const float4*)(p.r_k_a + (size_t)j * 1024 + gc);
  const float4 rkv = *(const float4*)(p.r_r_k + (size_t)j * 1024 + gc);
  const int si = tid >> 2, jq = tid & 3;
  float S[16];
#pragma unroll
  for (int e = 0; e < 16; ++e) S[e] = 0.f;
  for (int ck = 0; ck < 528; ++ck) {
    const int s = ck * 16 + ltok;
    const int row = seq_row(n, b, s);
    const uint2 ur = *(const uint2*)(R + (size_t)row * D + gc);
    const uint2 uk = *(const uint2*)(Kb + (size_t)row * D + gc);
    const uint2 uv = *(const uint2*)(V + (size_t)row * D + gc);
    const uint2 ulw = *(const uint2*)(LW + (size_t)row * 128 + n * 64 + c4);
    const uint2 ula = *(const uint2*)(LA + (size_t)row * 128 + n * 64 + c4);
    __syncthreads();
    *(float4*)(lwS + ltok * 64 + c4) = make_float4(lo2f(ulw.x), hi2f(ulw.x), lo2f(ulw.y), hi2f(ulw.y));
    *(float4*)(laS + ltok * 64 + c4) = make_float4(lo2f(ula.x), hi2f(ula.x), lo2f(ula.y), hi2f(ula.y));
    __syncthreads();
    float wz[4] = {w0v.x, w0v.y, w0v.z, w0v.w}, az[4] = {a0v.x, a0v.y, a0v.z, a0v.w};
    for (int l = 0; l < 64; ++l) {
      const float lw = lwS[ltok * 64 + l], la = laS[ltok * 64 + l];
      const float4 w2v = *(const float4*)(w2S + l * 64 + c4);
      const float4 a2v = *(const float4*)(a2S + l * 64 + c4);
      wz[0] += lw * w2v.x; wz[1] += lw * w2v.y; wz[2] += lw * w2v.z; wz[3] += lw * w2v.w;
      az[0] += la * a2v.x; az[1] += la * a2v.y; az[2] += la * a2v.z; az[3] += la * a2v.w;
    }
    const float rr[4] = {lo2f(ur.x), hi2f(ur.x), lo2f(ur.y), hi2f(ur.y)};
    const float kr[4] = {lo2f(uk.x), hi2f(uk.x), lo2f(uk.y), hi2f(uk.y)};
    const float vr[4] = {lo2f(uv.x), hi2f(uv.x), lo2f(uv.y), hi2f(uv.y)};
    const float kkw[4] = {kkv.x, kkv.y, kkv.z, kkv.w}, kaw[4] = {kav.x, kav.y, kav.z, kav.w}, rkw[4] = {rkv.x, rkv.y, rkv.z, rkv.w};
    float kk[4], ss = 0.f;
#pragma unroll
    for (int e = 0; e < 4; ++e) { kk[e] = kr[e] * kkw[e]; ss += kk[e] * kk[e]; }
#pragma unroll
    for (int o = 8; o > 0; o >>= 1) ss += __shfl_xor(ss, o, 64);
    const float inv = 1.f / fmaxf(sqrtf(ss), 1e-12f);
    float dec[4], as[4], kd[4], bb[4], bon = 0.f;
#pragma unroll
    for (int e = 0; e < 4; ++e) {
      kk[e] *= inv;
      dec[e] = __expf(-__expf(-softplus_f(-wz[e]) - 0.5f));
      as[e] = sigmoid_f(az[e]);
      kd[e] = kr[e] * (1.f + (as[e] - 1.f) * kaw[e]);
      bb[e] = kk[e] * as[e];
      bon += rr[e] * kd[e] * rkw[e];
    }
#pragma unroll
    for (int o = 8; o > 0; o >>= 1) bon += __shfl_xor(bon, o, 64);
    if (cq == 0) BON[((size_t)n * NR + row) * 16 + h] = bon;
    *(float4*)(rS + ltok * 64 + c4) = make_float4(rr[0], rr[1], rr[2], rr[3]);
    *(float4*)(wS + ltok * 64 + c4) = make_float4(dec[0], dec[1], dec[2], dec[3]);
    *(float4*)(kS + ltok * 64 + c4) = make_float4(kd[0], kd[1], kd[2], kd[3]);
    *(float4*)(vS + ltok * 64 + c4) = make_float4(vr[0], vr[1], vr[2], vr[3]);
    *(float4*)(aS + ltok * 64 + c4) = make_float4(-kk[0], -kk[1], -kk[2], -kk[3]);
    *(float4*)(bS + ltok * 64 + c4) = make_float4(bb[0], bb[1], bb[2], bb[3]);
    __syncthreads();
    for (int t = 0; t < 16; ++t) {
      float av[16], sa = 0.f;
#pragma unroll
      for (int m = 0; m < 4; ++m) {
        const float4 a4 = *(const float4*)(aS + t * 64 + jq * 16 + m * 4);
        av[m * 4] = a4.x; av[m * 4 + 1] = a4.y; av[m * 4 + 2] = a4.z; av[m * 4 + 3] = a4.w;
      }
#pragma unroll
      for (int e = 0; e < 16; ++e) sa += S[e] * av[e];
      sa += __shfl_xor(sa, 1, 64);
      sa += __shfl_xor(sa, 2, 64);
      const float vi = vS[t * 64 + si];
      float y = 0.f;
#pragma unroll
      for (int m = 0; m < 4; ++m) {
        const float4 w4 = *(const float4*)(wS + t * 64 + jq * 16 + m * 4);
        const float4 b4 = *(const float4*)(bS + t * 64 + jq * 16 + m * 4);
        const float4 k4 = *(const float4*)(kS + t * 64 + jq * 16 + m * 4);
        const float4 r4 = *(const float4*)(rS + t * 64 + jq * 16 + m * 4);
        S[m * 4 + 0] = S[m * 4 + 0] * w4.x + sa * b4.x + vi * k4.x; y += S[m * 4 + 0] * r4.x;
        S[m * 4 + 1] = S[m * 4 + 1] * w4.y + sa * b4.y + vi * k4.y; y += S[m * 4 + 1] * r4.y;
        S[m * 4 + 2] = S[m * 4 + 2] * w4.z + sa * b4.z + vi * k4.z; y += S[m * 4 + 2] * r4.z;
        S[m * 4 + 3] = S[m * 4 + 3] * w4.w + sa * b4.w + vi * k4.w; y += S[m * 4 + 3] * r4.w;
      }
      y += __shfl_xor(y, 1, 64);
      y += __shfl_xor(y, 2, 64);
      if (jq == 0) yS[t * 64 + si] = y;
    }
    __syncthreads();
    {
      const float4 yv = *(const float4*)(yS + ltok * 64 + c4);
      *(uint2*)(Y + (size_t)row * D + gc) = make_uint2(pack2(yv.x, yv.y), pack2(yv.z, yv.w));
    }
  }
}


constexpr int CS_W2T = 0, CS_A2T = 9216, CS_R1 = 18432, CS_R2 = 27648, CS_R3 = 36864, CS_WZ = 46080, CS_AZ = 62464,
              CS_AT = 78848, CS_RT = 88064, CS_BT = 97280, CS_KT = 106496, CS_VT = 115712, CS_AAB = 124928, CS_UV = 142336,
              CS_S0T = 151552, CS_TOT = 160768, CS_CL = 161792, CS_CST = 162048, CS_END = 163328;
DI s16x8 lds_row8(const char* base, int row, int col) { return *(const s16x8*)(base + row * 144 + col * 2); }
DI s16x8 lds_tr8(const char* base, int krow0, int ncol0, int lane) {
  const int g = lane >> 4, li = lane & 15, qq = li >> 2, pp = li & 3;
  const int off = (krow0 + 8 * (g >> 1) + qq) * 144 + (ncol0 + 16 * (g & 1) + 4 * pp) * 2;
  const s16x4 lo = __builtin_amdgcn_ds_read_tr16_b64_v4i16((__attribute__((address_space(3))) s16x4*)(base + off));
  const s16x4 hi = __builtin_amdgcn_ds_read_tr16_b64_v4i16((__attribute__((address_space(3))) s16x4*)(base + off + 4 * 144));
  return __builtin_shufflevector(lo, hi, 0, 1, 2, 3, 4, 5, 6, 7);
}
DI void unpack16(const uint4 a, const uint4 b, float* f) {
  f[0] = lo2f(a.x); f[1] = hi2f(a.x); f[2] = lo2f(a.y); f[3] = hi2f(a.y); f[4] = lo2f(a.z); f[5] = hi2f(a.z); f[6] = lo2f(a.w); f[7] = hi2f(a.w);
  f[8] = lo2f(b.x); f[9] = hi2f(b.x); f[10] = lo2f(b.y); f[11] = hi2f(b.y); f[12] = lo2f(b.z); f[13] = hi2f(b.z); f[14] = lo2f(b.w); f[15] = hi2f(b.w);
}
DI void store16bf(char* dst, const float* f) {
  *(uint4*)dst = make_uint4(pack2(f[0], f[1]), pack2(f[2], f[3]), pack2(f[4], f[5]), pack2(f[6], f[7]));
  *(uint4*)(dst + 16) = make_uint4(pack2(f[8], f[9]), pack2(f[10], f[11]), pack2(f[12], f[13]), pack2(f[14], f[15]));
}
constexpr int NSEG = 5;
DI int seg_start(int sg) { return sg == 0 ? 0 : (sg == 1 ? 27 : (sg == 2 ? 54 : (sg == 3 ? 80 : (sg == 4 ? 106 : 132)))); }
template <int MODE>
DI void scan_chain_chunked(const Params& p, int j, int cid, int seg, float* SCR, const bf16_t* R, const bf16_t* Kb, const bf16_t* V, bf16_t* Y0, bf16_t* Y1, char* smem, const int TID) {
  const int n = cid >> 5, b = (cid >> 4) & 1, hd = cid & 15;
  const int tid = TID, lane = tid & 63, w = tid >> 6, l31 = lane & 31, hh = lane >> 5;
  const int mi = w >> 1, ni = w & 1;
  const int tok = tid >> 2, q = tid & 3, c0 = 16 * q;
  const bf16_t* LW = (const bf16_t*)(p.ws + OFF_LW);
  const bf16_t* LA = (const bf16_t*)(p.ws + OFF_LA);
  float* BON = (float*)(p.ws + OFF_BON);
  bf16_t* Y = n ? Y1 : Y0;
  float* WZ = (float*)(smem + CS_WZ);
  float* AZ = (float*)(smem + CS_AZ);
  float* AABD = (float*)(smem + CS_AAB + 9216);
  float* TOT = (float*)(smem + CS_TOT);
  float* CL = (float*)(smem + CS_CL);
  float* CST = (float*)(smem + CS_CST);
  __syncthreads();
  {
    const float* w2 = p.r_w2 + (size_t)(j * 2 + n) * 64 * 1024 + hd * 64;
    const float* a2 = p.r_a2 + (size_t)(j * 2 + n) * 64 * 1024 + hd * 64;
    for (int e = tid; e < 4096; e += 256) {
      const int l = e >> 6, col = e & 63;
      *(bf16_t*)(smem + CS_W2T + col * 144 + l * 2) = f2bf(w2[(size_t)l * 1024 + col]);
      *(bf16_t*)(smem + CS_A2T + col * 144 + l * 2) = f2bf(a2[(size_t)l * 1024 + col]);
    }
    for (int e = tid; e < 64 * 72; e += 256) *(bf16_t*)(smem + CS_S0T + e * 2) = 0;
    if (tid < 64) {
      CST[tid] = p.r_w0[(size_t)(j * 2 + n) * 1024 + hd * 64 + tid];
      CST[64 + tid] = p.r_a0[(size_t)(j * 2 + n) * 1024 + hd * 64 + tid];
      CST[128 + tid] = p.r_k_k[(size_t)j * 1024 + hd * 64 + tid];
      CST[192 + tid] = p.r_k_a[(size_t)j * 1024 + hd * 64 + tid];
      CST[256 + tid] = p.r_r_k[(size_t)j * 1024 + hd * 64 + tid];
    }
  }
  f32x16 Sacc, Pacc;
#pragma unroll
  for (int r = 0; r < 16; ++r) { Sacc[r] = 0.f; Pacc[r] = 0.f; }
  if (MODE == 0) {
    for (int e = tid; e < 64 * 72; e += 256) *(bf16_t*)(smem + CS_RT + e * 2) = ((e / 72) == (e % 72)) ? (bf16_t)0x3f80 : (bf16_t)0;
#pragma unroll
    for (int r = 0; r < 16; ++r) Pacc[r] = ((32 * mi + crow(r, hh)) == (32 * ni + l31)) ? 1.f : 0.f;
  } else if (seg > 0) {
    const int jr = tid >> 2, ib = (tid & 3) * 16;
    const float* PQ = SCR + (size_t)(cid * 4) * 8192;
    float nv[16];
#pragma unroll
    for (int e = 0; e < 16; ++e) nv[e] = PQ[4096 + jr * 64 + ib + e];
    for (int sg = 1; sg < seg; ++sg) {
      __syncthreads();
#pragma unroll
      for (int e = 0; e < 16; ++e) WZ[jr * 64 + ib + e] = nv[e];
      __syncthreads();
      const float* Pm = PQ + (size_t)sg * 8192;
#pragma unroll
      for (int e = 0; e < 16; ++e) nv[e] = Pm[4096 + jr * 64 + ib + e];
      for (int jp = 0; jp < 64; jp += 4) {
        const float4 pv = *(const float4*)(Pm + jr * 64 + jp);
#pragma unroll
        for (int e = 0; e < 16; ++e)
          nv[e] += pv.x * WZ[(jp + 0) * 64 + ib + e] + pv.y * WZ[(jp + 1) * 64 + ib + e] + pv.z * WZ[(jp + 2) * 64 + ib + e] + pv.w * WZ[(jp + 3) * 64 + ib + e];
      }
    }
    __syncthreads();
#pragma unroll
    for (int e = 0; e < 16; ++e) WZ[jr * 64 + ib + e] = nv[e];
    __syncthreads();
#pragma unroll
    for (int r = 0; r < 16; ++r) {
      const int rrow = 32 * mi + crow(r, hh), ccol = 32 * ni + l31;
      Sacc[r] = WZ[rrow * 64 + ccol];
      *(bf16_t*)(smem + CS_S0T + rrow * 144 + ccol * 2) = f2bf(Sacc[r]);
    }
    __syncthreads();
  }
  const int ck0 = seg_start(seg), ck1 = seg_start(seg + 1);
  uint4 ur0, ur1, uk0, uk1, uv0, uv1, l0, l1, m0, m1;
#define SCAN_LOAD(CK) { const int row_ = seq_row(n, b, (CK) * 64 + tok); const size_t g_ = (size_t)row_ * D + hd * 64 + c0; \
    ur0 = *(const uint4*)(R + g_); ur1 = *(const uint4*)(R + g_ + 8); uk0 = *(const uint4*)(Kb + g_); uk1 = *(const uint4*)(Kb + g_ + 8); \
    uv0 = *(const uint4*)(V + g_); uv1 = *(const uint4*)(V + g_ + 8); \
    l0 = *(const uint4*)(LW + (size_t)row_ * 128 + n * 64 + c0); l1 = *(const uint4*)(LW + (size_t)row_ * 128 + n * 64 + c0 + 8); \
    m0 = *(const uint4*)(LA + (size_t)row_ * 128 + n * 64 + c0); m1 = *(const uint4*)(LA + (size_t)row_ * 128 + n * 64 + c0 + 8); }
  SCAN_LOAD(ck0)
  for (int ck = ck0; ck < ck1; ++ck) {
    const int row = seq_row(n, b, ck * 64 + tok);
    *(uint4*)(smem + CS_R1 + tok * 144 + c0 * 2) = l0; *(uint4*)(smem + CS_R1 + tok * 144 + c0 * 2 + 16) = l1;
    *(uint4*)(smem + CS_R2 + tok * 144 + c0 * 2) = m0; *(uint4*)(smem + CS_R2 + tok * 144 + c0 * 2 + 16) = m1;
    __syncthreads();
    {
      f32x16 awz, aaz;
#pragma unroll
      for (int r = 0; r < 16; ++r) { awz[r] = 0.f; aaz[r] = 0.f; }
#pragma unroll
      for (int kk = 0; kk < 4; ++kk) {
        const s16x8 alw = lds_row8(smem + CS_R1, 32 * mi + l31, kk * 16 + 8 * hh);
        const s16x8 ala = lds_row8(smem + CS_R2, 32 * mi + l31, kk * 16 + 8 * hh);
        const s16x8 bw = lds_row8(smem + CS_W2T, 32 * ni + l31, kk * 16 + 8 * hh);
        const s16x8 ba = lds_row8(smem + CS_A2T, 32 * ni + l31, kk * 16 + 8 * hh);
        awz = MFMA(alw, bw, awz);
        aaz = MFMA(ala, ba, aaz);
      }
#pragma unroll
      for (int r = 0; r < 16; ++r) {
        const int t = 32 * mi + crow(r, hh), col = 32 * ni + l31;
        WZ[t * 64 + col] = awz[r];
        AZ[t * 64 + col] = aaz[r];
      }
    }
    __syncthreads();
    float lw[16], rr[16], kd[16], av[16], bb[16];
    {
      float kr[16], cw0[16], ca0[16], ckk[16], cka[16], crk[16], wzv[16], azv[16];
      unpack16(ur0, ur1, rr);
      unpack16(uk0, uk1, kr);
#pragma unroll
      for (int e4 = 0; e4 < 4; ++e4) {
        const float4 v0 = *(const float4*)(CST + c0 + e4 * 4), v1 = *(const float4*)(CST + 64 + c0 + e4 * 4), v2 = *(const float4*)(CST + 128 + c0 + e4 * 4);
        const float4 v3 = *(const float4*)(CST + 192 + c0 + e4 * 4), v4 = *(const float4*)(CST + 256 + c0 + e4 * 4);
        const float4 v5 = *(const float4*)(WZ + tok * 64 + c0 + e4 * 4), v6 = *(const float4*)(AZ + tok * 64 + c0 + e4 * 4);
        cw0[e4 * 4] = v0.x; cw0[e4 * 4 + 1] = v0.y; cw0[e4 * 4 + 2] = v0.z; cw0[e4 * 4 + 3] = v0.w;
        ca0[e4 * 4] = v1.x; ca0[e4 * 4 + 1] = v1.y; ca0[e4 * 4 + 2] = v1.z; ca0[e4 * 4 + 3] = v1.w;
        ckk[e4 * 4] = v2.x; ckk[e4 * 4 + 1] = v2.y; ckk[e4 * 4 + 2] = v2.z; ckk[e4 * 4 + 3] = v2.w;
        cka[e4 * 4] = v3.x; cka[e4 * 4 + 1] = v3.y; cka[e4 * 4 + 2] = v3.z; cka[e4 * 4 + 3] = v3.w;
        crk[e4 * 4] = v4.x; crk[e4 * 4 + 1] = v4.y; crk[e4 * 4 + 2] = v4.z; crk[e4 * 4 + 3] = v4.w;
        wzv[e4 * 4] = v5.x; wzv[e4 * 4 + 1] = v5.y; wzv[e4 * 4 + 2] = v5.z; wzv[e4 * 4 + 3] = v5.w;
        azv[e4 * 4] = v6.x; azv[e4 * 4 + 1] = v6.y; azv[e4 * 4 + 2] = v6.z; azv[e4 * 4 + 3] = v6.w;
      }
      float ss = 0.f;
#pragma unroll
      for (int e = 0; e < 16; ++e) { av[e] = kr[e] * ckk[e]; ss += av[e] * av[e]; }
      ss = dpp_add<0xB1>(ss);
      ss = dpp_add<0x4E>(ss);
      const float inv = __frsqrt_rn(fmaxf(ss, 1e-24f));
      float bon = 0.f;
#pragma unroll
      for (int e = 0; e < 16; ++e) {
        const float wz = wzv[e] + cw0[e];
        const float az = azv[e] + ca0[e];
        lw[e] = -0.60653066f * fsig(wz);
        const float as = fsig(az);
        const float kkn = av[e] * inv;
        kd[e] = kr[e] * (1.f + (as - 1.f) * cka[e]);
        bb[e] = kkn * as;
        av[e] = -kkn;
        bon += rr[e] * kd[e] * crk[e];
      }
#pragma unroll
      for (int e4 = 0; e4 < 4; ++e4) *(float4*)(WZ + tok * 64 + c0 + e4 * 4) = make_float4(lw[e4 * 4], lw[e4 * 4 + 1], lw[e4 * 4 + 2], lw[e4 * 4 + 3]);
      bon = dpp_add<0xB1>(bon);
      bon = dpp_add<0x4E>(bon);
      if (MODE == 1 && q == 0) BON[((size_t)n * NR + row) * 16 + hd] = bon;
    }
    __syncthreads();
    {
      const int col = tid & 63, qt = tid >> 6;
      float pv[16];
#pragma unroll
      for (int t = 0; t < 16; ++t) pv[t] = WZ[(16 * qt + t) * 64 + col];
      float sacc = 0.f;
#pragma unroll
      for (int t = 0; t < 16; ++t) { sacc += pv[t]; WZ[(16 * qt + t) * 64 + col] = sacc; }
      TOT[qt * 64 + col] = sacc;
    }
    __syncthreads();
    {
      float fa[16], fr[16], fb[16], fk[16], fv[16];
      unpack16(uv0, uv1, fv);
      const int qt = tok >> 4;
      float tb[16], tt[16], cum[16];
#pragma unroll
      for (int e4 = 0; e4 < 4; ++e4) {
        const float4 t0 = *(const float4*)(TOT + c0 + e4 * 4), t1 = *(const float4*)(TOT + 64 + c0 + e4 * 4);
        const float4 t2 = *(const float4*)(TOT + 128 + c0 + e4 * 4), t3 = *(const float4*)(TOT + 192 + c0 + e4 * 4);
        const float4 cv = *(const float4*)(WZ + tok * 64 + c0 + e4 * 4);
        const float m0_ = qt > 0 ? 1.f : 0.f, m1_ = qt > 1 ? 1.f : 0.f, m2_ = qt > 2 ? 1.f : 0.f;
        tb[e4 * 4] = m0_ * t0.x + m1_ * t1.x + m2_ * t2.x; tb[e4 * 4 + 1] = m0_ * t0.y + m1_ * t1.y + m2_ * t2.y;
        tb[e4 * 4 + 2] = m0_ * t0.z + m1_ * t1.z + m2_ * t2.z; tb[e4 * 4 + 3] = m0_ * t0.w + m1_ * t1.w + m2_ * t2.w;
        tt[e4 * 4] = t0.x + t1.x + t2.x + t3.x; tt[e4 * 4 + 1] = t0.y + t1.y + t2.y + t3.y;
        tt[e4 * 4 + 2] = t0.z + t1.z + t2.z + t3.z; tt[e4 * 4 + 3] = t0.w + t1.w + t2.w + t3.w;
        cum[e4 * 4] = cv.x; cum[e4 * 4 + 1] = cv.y; cum[e4 * 4 + 2] = cv.z; cum[e4 * 4 + 3] = cv.w;
      }
#pragma unroll
      for (int e = 0; e < 16; ++e) {
        const float incl = cum[e] + tb[e];
        const float excl = incl - lw[e];
        const float ei = __expf(incl), ee = __expf(excl), nin = __builtin_amdgcn_rcpf(ei);
        fa[e] = av[e] * ee; fr[e] = rr[e] * ei; fb[e] = bb[e] * nin; fk[e] = kd[e] * nin;
      }
#pragma unroll
      for (int e4 = 0; e4 < 4; ++e4) {
        *(float4*)(WZ + tok * 64 + c0 + e4 * 4) = make_float4(fa[e4 * 4], fa[e4 * 4 + 1], fa[e4 * 4 + 2], fa[e4 * 4 + 3]);
        if (tok == 0) *(float4*)(CL + c0 + e4 * 4) = make_float4(__expf(tt[e4 * 4]), __expf(tt[e4 * 4 + 1]), __expf(tt[e4 * 4 + 2]), __expf(tt[e4 * 4 + 3]));
      }
      store16bf(smem + CS_AT + tok * 144 + c0 * 2, fa);
      if (MODE == 1) store16bf(smem + CS_RT + tok * 144 + c0 * 2, fr);
      store16bf(smem + CS_BT + tok * 144 + c0 * 2, fb);
      store16bf(smem + CS_KT + tok * 144 + c0 * 2, fk);
      *(uint4*)(smem + CS_VT + tok * 144 + c0 * 2) = uv0;
      *(uint4*)(smem + CS_VT + tok * 144 + c0 * 2 + 16) = uv1;
    }
    if (ck + 1 < ck1) SCAN_LOAD(ck + 1)
    __syncthreads();
    {
      f32x16 ab, ak, rb, rk;
#pragma unroll
      for (int r = 0; r < 16; ++r) { ab[r] = 0.f; ak[r] = 0.f; rb[r] = 0.f; rk[r] = 0.f; }
      if (mi >= ni) {
#pragma unroll
        for (int kk = 0; kk < 4; ++kk) {
          const s16x8 aA = lds_row8(smem + CS_AT, 32 * mi + l31, kk * 16 + 8 * hh);
          const s16x8 aR = lds_row8(smem + CS_RT, 32 * mi + l31, kk * 16 + 8 * hh);
          const s16x8 bB = lds_row8(smem + CS_BT, 32 * ni + l31, kk * 16 + 8 * hh);
          const s16x8 bK = lds_row8(smem + CS_KT, 32 * ni + l31, kk * 16 + 8 * hh);
          ab = MFMA(aA, bB, ab); ak = MFMA(aA, bK, ak);
          if (MODE == 1) { rb = MFMA(aR, bB, rb); rk = MFMA(aR, bK, rk); }
        }
      }
#pragma unroll
      for (int r = 0; r < 16; ++r) {
        const int t = 32 * mi + crow(r, hh), sx = 32 * ni + l31;
        const bool lo_s = sx < t, lo_i = sx <= t;
        *(bf16_t*)(smem + CS_AAB + t * 144 + sx * 2) = f2bf(lo_s ? ab[r] : 0.f);
        if ((t >> 4) == (sx >> 4)) AABD[(t >> 4) * 256 + (t & 15) * 16 + (sx & 15)] = lo_s ? ab[r] : 0.f;
        *(bf16_t*)(smem + CS_R1 + t * 144 + sx * 2) = f2bf(lo_s ? ak[r] : 0.f);
        if (MODE == 1) {
          *(bf16_t*)(smem + CS_R2 + t * 144 + sx * 2) = f2bf(lo_i ? rb[r] : 0.f);
          *(bf16_t*)(smem + CS_R3 + t * 144 + sx * 2) = f2bf(lo_i ? rk[r] : 0.f);
        }
      }
    }
    __syncthreads();
    {
      f32x16 xu;
#pragma unroll
      for (int r = 0; r < 16; ++r) xu[r] = 0.f;
#pragma unroll
      for (int kk = 0; kk < 4; ++kk) {
        const s16x8 a = lds_row8(smem + CS_R1, 32 * mi + l31, kk * 16 + 8 * hh);
        const s16x8 bv = lds_tr8(smem + CS_VT, kk * 16, 32 * ni, lane);
        xu = MFMA(a, bv, xu);
      }
#pragma unroll
      for (int r = 0; r < 16; ++r) AZ[(32 * mi + crow(r, hh)) * 64 + 32 * ni + l31] = xu[r];
    }
    __syncthreads();
#pragma unroll
    for (int bk = 0; bk < 4; ++bk) {
      if (tid < 128) {
        float* rhs = (tid < 64) ? (WZ + tid) : (AZ + (tid - 64));
        float x[16], am[16][16];
#pragma unroll
        for (int r = 0; r < 16; ++r) x[r] = rhs[(16 * bk + r) * 64];
#pragma unroll
        for (int tp = 1; tp < 16; ++tp) {
#pragma unroll
          for (int s4 = 0; s4 < (tp + 3) / 4; ++s4) {
            const float4 v = *(const float4*)(AABD + bk * 256 + tp * 16 + s4 * 4);
            am[tp][s4 * 4] = v.x; am[tp][s4 * 4 + 1] = v.y; am[tp][s4 * 4 + 2] = v.z; am[tp][s4 * 4 + 3] = v.w;
          }
        }
#pragma unroll
        for (int sx = 0; sx < 15; ++sx) {
          const float xs = x[sx];
#pragma unroll
          for (int tp = sx + 1; tp < 16; ++tp) x[tp] = fmaf(am[tp][sx], xs, x[tp]);
        }
        char* dst = (tid < 64) ? (smem + CS_AT + tid * 2) : (smem + CS_UV + (tid - 64) * 2);
#pragma unroll
        for (int r = 0; r < 16; ++r) *(bf16_t*)(dst + (16 * bk + r) * 144) = f2bf(x[r]);
      }
      __syncthreads();
      if (bk < 3) {
        const char* xsrc = (w < 2) ? (smem + CS_AT) : (smem + CS_UV);
        float* rdst = (w < 2) ? WZ : AZ;
        const s16x8 bx = lds_tr8(xsrc, 16 * bk, 32 * (w & 1), lane);
#pragma unroll
        for (int rt = 0; rt < 2; ++rt) {
          if (32 * rt + 31 >= 16 * (bk + 1)) {
            f32x16 up;
#pragma unroll
            for (int r = 0; r < 16; ++r) up[r] = 0.f;
            const s16x8 aa = lds_row8(smem + CS_AAB, 32 * rt + l31, 16 * bk + 8 * hh);
            up = MFMA(aa, bx, up);
#pragma unroll
            for (int r = 0; r < 16; ++r) rdst[(32 * rt + crow(r, hh)) * 64 + 32 * (w & 1) + l31] += up[r];
          }
        }
        __syncthreads();
      }
    }
    f32x16 rh, yl, mm, cc;
#pragma unroll
    for (int r = 0; r < 16; ++r) { rh[r] = 0.f; yl[r] = 0.f; mm[r] = 0.f; cc[r] = 0.f; }
#pragma unroll
    for (int kk = 0; kk < 4; ++kk) {
      const s16x8 aRB = lds_row8(smem + CS_R2, 32 * mi + l31, kk * 16 + 8 * hh);
      const s16x8 aRK = lds_row8(smem + CS_R3, 32 * mi + l31, kk * 16 + 8 * hh);
      const s16x8 tAH = lds_tr8(smem + CS_AT, kk * 16, 32 * ni, lane);
      const s16x8 tUV = lds_tr8(smem + CS_UV, kk * 16, 32 * ni, lane);
      const s16x8 tVT = lds_tr8(smem + CS_VT, kk * 16, 32 * ni, lane);
      const s16x8 tBT = lds_tr8(smem + CS_BT, kk * 16, 32 * mi, lane);
      const s16x8 tKT = lds_tr8(smem + CS_KT, kk * 16, 32 * mi, lane);
      if (MODE == 1) {
        rh = MFMA(aRB, tAH, rh);
        yl = MFMA(aRB, tUV, yl);
        yl = MFMA(aRK, tVT, yl);
      }
      mm = MFMA(tBT, tAH, mm);
      cc = MFMA(tBT, tUV, cc);
      cc = MFMA(tKT, tVT, cc);
    }
#pragma unroll
    for (int r = 0; r < 16; ++r) if (MODE == 1) rh[r] += bf2f(*(const bf16_t*)(smem + CS_RT + (32 * mi + crow(r, hh)) * 144 + (32 * ni + l31) * 2));
    __syncthreads();
#pragma unroll
    for (int r = 0; r < 16; ++r) {
      const int rrow = 32 * mi + crow(r, hh), ccol = 32 * ni + l31;
      if (MODE == 1) *(bf16_t*)(smem + CS_R2 + rrow * 144 + ccol * 2) = f2bf(rh[r]);
      *(bf16_t*)(smem + CS_R3 + rrow * 144 + ccol * 2) = f2bf(mm[r]);
    }
    __syncthreads();
    f32x16 pp;
#pragma unroll
    for (int r = 0; r < 16; ++r) pp[r] = 0.f;
#pragma unroll
    for (int kk = 0; kk < 4; ++kk) {
      const s16x8 aMM = lds_row8(smem + CS_R3, 32 * mi + l31, kk * 16 + 8 * hh);
      const s16x8 tS = lds_tr8(smem + CS_S0T, kk * 16, 32 * ni, lane);
      if (MODE == 1) {
        const s16x8 aRH = lds_row8(smem + CS_R2, 32 * mi + l31, kk * 16 + 8 * hh);
        yl = MFMA(aRH, tS, yl);
      } else {
        const s16x8 tP = lds_tr8(smem + CS_RT, kk * 16, 32 * ni, lane);
        pp = MFMA(aMM, tP, pp);
      }
      cc = MFMA(aMM, tS, cc);
    }
#pragma unroll
    for (int r = 0; r < 16; ++r) {
      const float clv = CL[32 * mi + crow(r, hh)];
      Sacc[r] = clv * (Sacc[r] + cc[r]);
      if (MODE == 0) Pacc[r] = clv * (Pacc[r] + pp[r]);
    }
    __syncthreads();
#pragma unroll
    for (int r = 0; r < 16; ++r) {
      const int rrow = 32 * mi + crow(r, hh), ccol = 32 * ni + l31;
      *(bf16_t*)(smem + CS_S0T + rrow * 144 + ccol * 2) = f2bf(Sacc[r]);
      if (MODE == 0) *(bf16_t*)(smem + CS_RT + rrow * 144 + ccol * 2) = f2bf(Pacc[r]);
      if (MODE == 1) {
        const int yrow = seq_row(n, b, ck * 64 + rrow);
        Y[(size_t)yrow * D + hd * 64 + ccol] = f2bf(yl[r]);
      }
    }
  }
  if (MODE == 0 || seg == 0) {
    float* PQ = SCR + (size_t)(cid * 4 + seg) * 8192;
#pragma unroll
    for (int r = 0; r < 16; ++r) {
      const int rrow = 32 * mi + crow(r, hh), ccol = 32 * ni + l31;
      if (MODE == 0) PQ[rrow * 64 + ccol] = Pacc[r];
      PQ[4096 + rrow * 64 + ccol] = Sacc[r];
    }
  }
}

DI void run_phase(const Params& p, int ph, char* smem, const int TID) {
  bf16_t* T0 = (bf16_t*)(p.ws + 0 * SLOT);
  bf16_t* T1 = (bf16_t*)(p.ws + 1 * SLOT);
  bf16_t* T2 = (bf16_t*)(p.ws + 2 * SLOT);
  bf16_t* T3 = (bf16_t*)(p.ws + 3 * SLOT);
  bf16_t* T4 = (bf16_t*)(p.ws + 4 * SLOT);
  bf16_t* T5 = (bf16_t*)(p.ws + 5 * SLOT);
  bf16_t* VF = (bf16_t*)(p.ws + OFF_VF);
  bf16_t* W = (bf16_t*)(p.ws + OFF_W);
  const int tid = TID;
#ifdef ONLY_PHASE
    const int type = ONLY_PHASE, layer = p.player[ph];
#else
    const int type = p.ptype[ph], layer = p.player[ph];
#endif
    const int j = layer >> 1;
    switch (type) {
#ifdef DBG_PREPFILL
      case PH_PREP0: {
        for (size_t i = (size_t)blockIdx.x * 256 + tid; i < (size_t)(1 << 20); i += (size_t)gridDim.x * 256)
          *(uint4*)(T4 + (size_t)(2 << 20) * 8 + i * 8) = make_uint4(0x3f803f80u, 0x3f803f80u, 0x3f803f80u, 0x3f803f80u);
      } break;
#else
      case PH_PREP0: phase_prep0(p, smem, TID); break;
#endif
      case PH_PRE0: {
        for (int it = blockIdx.x; it < 128; it += gridDim.x) fourier_precompose(p, it, smem, TID);
        row_items(p, 0, false, true, NR, nullptr, T0, blockIdx.x, NR / 4, TID);
      } break;
      case PH_FGEMM1: {
        const int MT = NR / 128, NT = 12;
        for (int t = blockIdx.x; t < MT * NT; t += gridDim.x) {
          const int mt = t / NT, nt = t % NT;
          gemm_tile_plain<false, 4>(T0, nullptr, nullptr, 1024, W, 1024, 1024, mt * 128, nt * 256, 3072, smem, TID,
                                    [=](int col0) { return col0 < 1024 ? T1 : (col0 < 2048 ? T2 : T3); });
        }
      } break;
      case PH_FDFT1: {
        const bf16_t* F1 = (const bf16_t*)(p.ws + OFF_F1);
        const bf16_t* FC = (const bf16_t*)(p.ws + OFF_FC);
        const float2* TW = (const float2*)(p.ws + OFF_TW);
        bf16_t* YB = T4;
        const float* bmix = p.f_b_mix + (size_t)j * 1024;
        const int nctx = (layer == 3) ? 0 : 32;
        {
          constexpr int L_B = 0, L_F1 = 40960, L_TW = L_F1 + 128 * 272;
          const int lane = tid & 63, w = tid >> 6, l31 = lane & 31, hh = lane >> 5;
          const int rt0 = w & 1, ctb = 2 * (w >> 1);
          __syncthreads();
#pragma unroll
          for (int i = 0; i < 8; ++i) {
            const int c = tid + 256 * i, r = c >> 4, cc = c & 15;
            *(uint4*)(smem + L_F1 + r * 272 + cc * 16) = *(const uint4*)(F1 + r * 128 + cc * 8);
          }
#pragma unroll
          for (int i = 0; i < 16; ++i) *(uint4*)(smem + L_TW + (tid + 256 * i) * 16) = *(const uint4*)((const char*)TW + (size_t)(tid + 256 * i) * 16);
          uint4 bp0, bp1, bp2, bp3, bp4, bp5, bp6, bp7;
          const int br = tid >> 4, bcc = tid & 15;
          int it = blockIdx.x;
          if (it < 2048) {
              const int itn_ = it;
              const int b_ = itn_ >> 10, t2_ = (itn_ >> 3) & 127, cb_ = itn_ & 7;
              const size_t tok0_ = (size_t)b_ * 8192 + t2_;
              { const int kr = br + 0; bp0 = *(const uint4*)((kr < 64 ? T1 + (tok0_ + (size_t)kr * 128) * D : T2 + (tok0_ + (size_t)(kr - 64) * 128) * D) + cb_ * 128 + bcc * 8); }
              { const int kr = br + 16; bp1 = *(const uint4*)((kr < 64 ? T1 + (tok0_ + (size_t)kr * 128) * D : T2 + (tok0_ + (size_t)(kr - 64) * 128) * D) + cb_ * 128 + bcc * 8); }
              { const int kr = br + 32; bp2 = *(const uint4*)((kr < 64 ? T1 + (tok0_ + (size_t)kr * 128) * D : T2 + (tok0_ + (size_t)(kr - 64) * 128) * D) + cb_ * 128 + bcc * 8); }
              { const int kr = br + 48; bp3 = *(const uint4*)((kr < 64 ? T1 + (tok0_ + (size_t)kr * 128) * D : T2 + (tok0_ + (size_t)(kr - 64) * 128) * D) + cb_ * 128 + bcc * 8); }
              { const int kr = br + 64; bp4 = *(const uint4*)((kr < 64 ? T1 + (tok0_ + (size_t)kr * 128) * D : T2 + (tok0_ + (size_t)(kr - 64) * 128) * D) + cb_ * 128 + bcc * 8); }
              { const int kr = br + 80; bp5 = *(const uint4*)((kr < 64 ? T1 + (tok0_ + (size_t)kr * 128) * D : T2 + (tok0_ + (size_t)(kr - 64) * 128) * D) + cb_ * 128 + bcc * 8); }
              { const int kr = br + 96; bp6 = *(const uint4*)((kr < 64 ? T1 + (tok0_ + (size_t)kr * 128) * D : T2 + (tok0_ + (size_t)(kr - 64) * 128) * D) + cb_ * 128 + bcc * 8); }
              { const int kr = br + 112; bp7 = *(const uint4*)((kr < 64 ? T1 + (tok0_ + (size_t)kr * 128) * D : T2 + (tok0_ + (size_t)(kr - 64) * 128) * D) + cb_ * 128 + bcc * 8); }
            }
          for (; it < 2048; it += gridDim.x) {
            const int b = it >> 10, t2 = (it >> 3) & 127, cb = it & 7;
            __syncthreads();
            *(uint4*)(smem + L_B + (br + 0) * 320 + bcc * 16) = bp0;
            *(uint4*)(smem + L_B + (br + 16) * 320 + bcc * 16) = bp1;
            *(uint4*)(smem + L_B + (br + 32) * 320 + bcc * 16) = bp2;
            *(uint4*)(smem + L_B + (br + 48) * 320 + bcc * 16) = bp3;
            *(uint4*)(smem + L_B + (br + 64) * 320 + bcc * 16) = bp4;
            *(uint4*)(smem + L_B + (br + 80) * 320 + bcc * 16) = bp5;
            *(uint4*)(smem + L_B + (br + 96) * 320 + bcc * 16) = bp6;
            *(uint4*)(smem + L_B + (br + 112) * 320 + bcc * 16) = bp7;
            __syncthreads();
            if (it + (int)gridDim.x < 2048) {
              const int itn_ = it + (int)gridDim.x;
              const int b_ = itn_ >> 10, t2_ = (itn_ >> 3) & 127, cb_ = itn_ & 7;
              const size_t tok0_ = (size_t)b_ * 8192 + t2_;
              { const int kr = br + 0; bp0 = *(const uint4*)((kr < 64 ? T1 + (tok0_ + (size_t)kr * 128) * D : T2 + (tok0_ + (size_t)(kr - 64) * 128) * D) + cb_ * 128 + bcc * 8); }
              { const int kr = br + 16; bp1 = *(const uint4*)((kr < 64 ? T1 + (tok0_ + (size_t)kr * 128) * D : T2 + (tok0_ + (size_t)(kr - 64) * 128) * D) + cb_ * 128 + bcc * 8); }
              { const int kr = br + 32; bp2 = *(const uint4*)((kr < 64 ? T1 + (tok0_ + (size_t)kr * 128) * D : T2 + (tok0_ + (size_t)(kr - 64) * 128) * D) + cb_ * 128 + bcc * 8); }
              { const int kr = br + 48; bp3 = *(const uint4*)((kr < 64 ? T1 + (tok0_ + (size_t)kr * 128) * D : T2 + (tok0_ + (size_t)(kr - 64) * 128) * D) + cb_ * 128 + bcc * 8); }
              { const int kr = br + 64; bp4 = *(const uint4*)((kr < 64 ? T1 + (tok0_ + (size_t)kr * 128) * D : T2 + (tok0_ + (size_t)(kr - 64) * 128) * D) + cb_ * 128 + bcc * 8); }
              { const int kr = br + 80; bp5 = *(const uint4*)((kr < 64 ? T1 + (tok0_ + (size_t)kr * 128) * D : T2 + (tok0_ + (size_t)(kr - 64) * 128) * D) + cb_ * 128 + bcc * 8); }
              { const int kr = br + 96; bp6 = *(const uint4*)((kr < 64 ? T1 + (tok0_ + (size_t)kr * 128) * D : T2 + (tok0_ + (size_t)(kr - 64) * 128) * D) + cb_ * 128 + bcc * 8); }
              { const int kr = br + 112; bp7 = *(const uint4*)((kr < 64 ? T1 + (tok0_ + (size_t)kr * 128) * D : T2 + (tok0_ + (size_t)(kr - 64) * 128) * D) + cb_ * 128 + bcc * 8); }
            }
            f32x16 acc[2][2];
#pragma unroll
            for (int i = 0; i < 2; ++i)
#pragma unroll
              for (int jj = 0; jj < 2; ++jj)
#pragma unroll
                for (int r = 0; r < 16; ++r) acc[i][jj][r] = 0.f;
            const int g = lane >> 4, li = lane & 15, qq = li >> 2, pp = li & 3;
            const int tr_base = (8 * (g >> 1) + qq) * 320 + (16 * (g & 1) + 4 * pp) * 2;
#pragma unroll
            for (int ks = 0; ks < 8; ++ks) {
              s16x8 af[2];
#pragma unroll
              for (int h = 0; h < 2; ++h) af[h] = *(const s16x8*)(smem + L_F1 + (32 * (rt0 + 2 * h) + l31) * 272 + (ks * 16 + hh * 8) * 2);
#pragma unroll
              for (int c2 = 0; c2 < 2; ++c2) {
                const int off = L_B + tr_base + ks * 16 * 320 + (ctb + c2) * 64;
                const s16x4 lo = __builtin_amdgcn_ds_read_tr16_b64_v4i16((__attribute__((address_space(3))) s16x4*)(smem + off));
                const s16x4 hi = __builtin_amdgcn_ds_read_tr16_b64_v4i16((__attribute__((address_space(3))) s16x4*)(smem + off + 4 * 320));
                const s16x8 bq = __builtin_shufflevector(lo, hi, 0, 1, 2, 3, 4, 5, 6, 7);
#pragma unroll
                for (int h = 0; h < 2; ++h) acc[h][c2] = MFMA(af[h], bq, acc[h][c2]);
              }
            }
#pragma unroll
            for (int c2 = 0; c2 < 2; ++c2) {
              const int col = 32 * (ctb + c2) + l31;
#pragma unroll
              for (int r = 0; r < 16; ++r) {
                const int k1 = 32 * rt0 + crow(r, hh);
                const float2 tw = *(const float2*)(smem + L_TW + (k1 * 128 + t2) * 8);
                const float va = acc[0][c2][r], vb = acc[1][c2][r];
                const float yr = va * tw.x - vb * tw.y, yi = va * tw.y + vb * tw.x;
                bf16_t* d = YB + ((size_t)b * 8192 + k1 * 128 + t2) * 2048 + cb * 128 + col;
                d[0] = f2bf(yr); d[1024] = f2bf(yi);
              }
            }
          }
        }
        for (int it = 2048 + blockIdx.x; it < 2048 + nctx; it += gridDim.x) {
          {
            const int u = it - 2048, b = u >> 4, cb = (u >> 1) & 7, mh = u & 1;
            const size_t tok0 = (size_t)NLAT + b * 256;
            const float scale = 0.005524271728019903f;
            dft_tile(FC, 512, mh * 128, 256, T1 + tok0 * D + cb * 128, T2 + tok0 * D + cb * 128, D, 1, smem, TID,
                     [=](int rowA, int rowB, int col, float va, float vb) {
                       const int cc = cb * 128 + col;
                       bf16_t* z0 = T3 + (tok0 + mh * 128 + rowA) * D + cc;
                       bf16_t* z1 = T3 + (tok0 + mh * 128 + rowB) * D + cc;
                       const float bm = bmix[cc];
                       z0[0] = f2bf((va * scale + bm) * silu_f(bf2f(z0[0])));
                       z1[0] = f2bf((vb * scale + bm) * silu_f(bf2f(z1[0])));
                     });
          }
        }
      } break;
      case PH_FDFT3: {
        const bf16_t* F2 = (const bf16_t*)(p.ws + OFF_F2);
        const bf16_t* YB = T4;
        const float* bmix = p.f_b_mix + (size_t)j * 1024;
        const float scale = 0.0009765625f;
        constexpr int L_B = 0, L_F2 = 256 * 320;
        const int lane = tid & 63, w = tid >> 6, l31 = lane & 31, hh = lane >> 5;
        const int rt0 = w & 1, ctb = 2 * (w >> 1);
        const int br = tid >> 4, bcc = tid & 15;
        __syncthreads();
#pragma unroll
        for (int i = 0; i < 16; ++i) {
          const int c = tid + 256 * i, r = c >> 5, cc = c & 31;
          *(uint4*)(smem + L_F2 + r * 528 + cc * 16) = *(const uint4*)(F2 + r * 256 + cc * 8);
        }
        uint4 bp0, bp1, bp2, bp3, bp4, bp5, bp6, bp7, bp8, bp9, bp10, bp11, bp12, bp13, bp14, bp15;
        int it = blockIdx.x;
        if (it < 1024) {
          const int b_ = it >> 9, k1_ = (it >> 3) & 63, cb_ = it & 7;
          const size_t tok0_ = (size_t)b_ * 8192 + k1_ * 128;
              bp0 = *(const uint4*)(YB + (tok0_ + (size_t)(br + 0)) * 2048 + 0 + cb_ * 128 + bcc * 8);
              bp1 = *(const uint4*)(YB + (tok0_ + (size_t)(br + 16)) * 2048 + 0 + cb_ * 128 + bcc * 8);
              bp2 = *(const uint4*)(YB + (tok0_ + (size_t)(br + 32)) * 2048 + 0 + cb_ * 128 + bcc * 8);
              bp3 = *(const uint4*)(YB + (tok0_ + (size_t)(br + 48)) * 2048 + 0 + cb_ * 128 + bcc * 8);
              bp4 = *(const uint4*)(YB + (tok0_ + (size_t)(br + 64)) * 2048 + 0 + cb_ * 128 + bcc * 8);
              bp5 = *(const uint4*)(YB + (tok0_ + (size_t)(br + 80)) * 2048 + 0 + cb_ * 128 + bcc * 8);
              bp6 = *(const uint4*)(YB + (tok0_ + (size_t)(br + 96)) * 2048 + 0 + cb_ * 128 + bcc * 8);
              bp7 = *(const uint4*)(YB + (tok0_ + (size_t)(br + 112)) * 2048 + 0 + cb_ * 128 + bcc * 8);
              bp8 = *(const uint4*)(YB + (tok0_ + (size_t)(br + 0)) * 2048 + 1024 + cb_ * 128 + bcc * 8);
              bp9 = *(const uint4*)(YB + (tok0_ + (size_t)(br + 16)) * 2048 + 1024 + cb_ * 128 + bcc * 8);
              bp10 = *(const uint4*)(YB + (tok0_ + (size_t)(br + 32)) * 2048 + 1024 + cb_ * 128 + bcc * 8);
              bp11 = *(const uint4*)(YB + (tok0_ + (size_t)(br + 48)) * 2048 + 1024 + cb_ * 128 + bcc * 8);
              bp12 = *(const uint4*)(YB + (tok0_ + (size_t)(br + 64)) * 2048 + 1024 + cb_ * 128 + bcc * 8);
              bp13 = *(const uint4*)(YB + (tok0_ + (size_t)(br + 80)) * 2048 + 1024 + cb_ * 128 + bcc * 8);
              bp14 = *(const uint4*)(YB + (tok0_ + (size_t)(br + 96)) * 2048 + 1024 + cb_ * 128 + bcc * 8);
              bp15 = *(const uint4*)(YB + (tok0_ + (size_t)(br + 112)) * 2048 + 1024 + cb_ * 128 + bcc * 8);
        }
        for (; it < 1024; it += gridDim.x) {
          const int b = it >> 9, k1 = (it >> 3) & 63, cb = it & 7;
          __syncthreads();
            *(uint4*)(smem + L_B + (0 + br + 0) * 320 + bcc * 16) = bp0;
            *(uint4*)(smem + L_B + (0 + br + 16) * 320 + bcc * 16) = bp1;
            *(uint4*)(smem + L_B + (0 + br + 32) * 320 + bcc * 16) = bp2;
            *(uint4*)(smem + L_B + (0 + br + 48) * 320 + bcc * 16) = bp3;
            *(uint4*)(smem + L_B + (0 + br + 64) * 320 + bcc * 16) = bp4;
            *(uint4*)(smem + L_B + (0 + br + 80) * 320 + bcc * 16) = bp5;
            *(uint4*)(smem + L_B + (0 + br + 96) * 320 + bcc * 16) = bp6;
            *(uint4*)(smem + L_B + (0 + br + 112) * 320 + bcc * 16) = bp7;
            *(uint4*)(smem + L_B + (128 + br + 0) * 320 + bcc * 16) = bp8;
            *(uint4*)(smem + L_B + (128 + br + 16) * 320 + bcc * 16) = bp9;
            *(uint4*)(smem + L_B + (128 + br + 32) * 320 + bcc * 16) = bp10;
            *(uint4*)(smem + L_B + (128 + br + 48) * 320 + bcc * 16) = bp11;
            *(uint4*)(smem + L_B + (128 + br + 64) * 320 + bcc * 16) = bp12;
            *(uint4*)(smem + L_B + (128 + br + 80) * 320 + bcc * 16) = bp13;
            *(uint4*)(smem + L_B + (128 + br + 96) * 320 + bcc * 16) = bp14;
            *(uint4*)(smem + L_B + (128 + br + 112) * 320 + bcc * 16) = bp15;
          __syncthreads();
          if (it + (int)gridDim.x < 1024) {
            const int itn_ = it + (int)gridDim.x;
            const int b_ = itn_ >> 9, k1_ = (itn_ >> 3) & 63, cb_ = itn_ & 7;
            const size_t tok0_ = (size_t)b_ * 8192 + k1_ * 128;
              bp0 = *(const uint4*)(YB + (tok0_ + (size_t)(br + 0)) * 2048 + 0 + cb_ * 128 + bcc * 8);
              bp1 = *(const uint4*)(YB + (tok0_ + (size_t)(br + 16)) * 2048 + 0 + cb_ * 128 + bcc * 8);
              bp2 = *(const uint4*)(YB + (tok0_ + (size_t)(br + 32)) * 2048 + 0 + cb_ * 128 + bcc * 8);
              bp3 = *(const uint4*)(YB + (tok0_ + (size_t)(br + 48)) * 2048 + 0 + cb_ * 128 + bcc * 8);
              bp4 = *(const uint4*)(YB + (tok0_ + (size_t)(br + 64)) * 2048 + 0 + cb_ * 128 + bcc * 8);
              bp5 = *(const uint4*)(YB + (tok0_ + (size_t)(br + 80)) * 2048 + 0 + cb_ * 128 + bcc * 8);
              bp6 = *(const uint4*)(YB + (tok0_ + (size_t)(br + 96)) * 2048 + 0 + cb_ * 128 + bcc * 8);
              bp7 = *(const uint4*)(YB + (tok0_ + (size_t)(br + 112)) * 2048 + 0 + cb_ * 128 + bcc * 8);
              bp8 = *(const uint4*)(YB + (tok0_ + (size_t)(br + 0)) * 2048 + 1024 + cb_ * 128 + bcc * 8);
              bp9 = *(const uint4*)(YB + (tok0_ + (size_t)(br + 16)) * 2048 + 1024 + cb_ * 128 + bcc * 8);
              bp10 = *(const uint4*)(YB + (tok0_ + (size_t)(br + 32)) * 2048 + 1024 + cb_ * 128 + bcc * 8);
              bp11 = *(const uint4*)(YB + (tok0_ + (size_t)(br + 48)) * 2048 + 1024 + cb_ * 128 + bcc * 8);
              bp12 = *(const uint4*)(YB + (tok0_ + (size_t)(br + 64)) * 2048 + 1024 + cb_ * 128 + bcc * 8);
              bp13 = *(const uint4*)(YB + (tok0_ + (size_t)(br + 80)) * 2048 + 1024 + cb_ * 128 + bcc * 8);
              bp14 = *(const uint4*)(YB + (tok0_ + (size_t)(br + 96)) * 2048 + 1024 + cb_ * 128 + bcc * 8);
              bp15 = *(const uint4*)(YB + (tok0_ + (size_t)(br + 112)) * 2048 + 1024 + cb_ * 128 + bcc * 8);
          }
          f32x16 acc[2][2];
#pragma unroll
          for (int i = 0; i < 2; ++i)
#pragma unroll
            for (int jj = 0; jj < 2; ++jj)
#pragma unroll
              for (int r = 0; r < 16; ++r) acc[i][jj][r] = 0.f;
          const int g = lane >> 4, li = lane & 15, qq = li >> 2, pp = li & 3;
          const int tr_base = (8 * (g >> 1) + qq) * 320 + (16 * (g & 1) + 4 * pp) * 2;
#pragma unroll
          for (int ks = 0; ks < 16; ++ks) {
            s16x8 af[2];
#pragma unroll
            for (int h = 0; h < 2; ++h) af[h] = *(const s16x8*)(smem + L_F2 + (32 * (rt0 + 2 * h) + l31) * 528 + (ks * 16 + hh * 8) * 2);
#pragma unroll
            for (int c2 = 0; c2 < 2; ++c2) {
              const int off = L_B + tr_base + ks * 16 * 320 + (ctb + c2) * 64;
              const s16x4 lo = __builtin_amdgcn_ds_read_tr16_b64_v4i16((__attribute__((address_space(3))) s16x4*)(smem + off));
              const s16x4 hi = __builtin_amdgcn_ds_read_tr16_b64_v4i16((__attribute__((address_space(3))) s16x4*)(smem + off + 4 * 320));
              const s16x8 bq = __builtin_shufflevector(lo, hi, 0, 1, 2, 3, 4, 5, 6, 7);
#pragma unroll
              for (int h = 0; h < 2; ++h) acc[h][c2] = MFMA(af[h], bq, acc[h][c2]);
            }
          }
#pragma unroll
          for (int c2 = 0; c2 < 2; ++c2) {
            const int cc = cb * 128 + 32 * (ctb + c2) + l31;
            const float bm = bmix[cc];
#pragma unroll
            for (int r = 0; r < 16; ++r) {
              const int rowA = 32 * rt0 + crow(r, hh);
              if ((r & 3) == 0) asm volatile("" ::: "memory");
              bf16_t* z0 = T3 + ((size_t)b * 8192 + k1 + 64 * rowA) * D + cc;
              bf16_t* z1 = T3 + ((size_t)b * 8192 + k1 + 64 * (rowA + 64)) * D + cc;
              z0[0] = f2bf((acc[0][c2][r] * scale + bm) * silu_f(bf2f(z0[0])));
              z1[0] = f2bf((acc[1][c2][r] * scale + bm) * silu_f(bf2f(z1[0])));
            }
          }
        }
      } break;
      case PH_FOUT: {
        const int NBIG = 512, NSMALL = (NR / 128 * 4 - NBIG) * 2;
        for (int t = blockIdx.x; t < NBIG + NSMALL; t += gridDim.x) {
          if (t < NBIG) {
            const int mt = t / 4, nt = t % 4;
            gemm_tile_plain<false, 4>(T3, nullptr, nullptr, 1024, W + (size_t)3072 * 1024, 1024, 1024, mt * 128, nt * 256, 1024, smem, TID,
                                       [=](int) { return T1; });
          } else {
            const int u = t - NBIG, mt = 128 + u / 8, nt = u % 8;
            gemm_tile_plain<false, 2>(T3, nullptr, nullptr, 1024, W + (size_t)3072 * 1024, 1024, 1024, mt * 128, nt * 128, 1024, smem, TID,
                                       [=](int) { return T1; });
          }
        }
      } break;
      case PH_POSTPRE: {
        const int nl = layer + 1;
        if (nl & 1) { for (int it = blockIdx.x; it < N_RWPREP; it += gridDim.x) rwkv_wprep(p, nl >> 1, it, smem, TID); }
        else {
          for (int it = blockIdx.x; it < 128 + N_FWPREP; it += gridDim.x) {
            if (it < 128) fourier_precompose(p, it, smem, TID); else fourier_wprep(p, nl >> 1, it - 128, smem, TID);
          }
        }
        const bf16_t* O = (layer & 1) ? T2 : T1;
        row_items(p, layer, true, true, NR, O, T0, blockIdx.x, NR / 4, TID);
      } break;
      case PH_RSHIFT: {
        for (int idx = blockIdx.x * 256 + tid; idx < NR * 128; idx += gridDim.x * 256) {
          const int row = idx >> 7, cc = (idx & 127) * 8;
          bool ok0, ok1, ok2, ok3; float wgt;
          if (row < NLAT) {
            const int t = row & 8191, gy = t >> 6, gx = t & 63;
            wgt = 0.25f;
            ok0 = gy > 0; ok1 = gy < 127; ok2 = gx > 0; ok3 = gx < 63;
          } else {
            const int t = (row - NLAT) & 255;
            wgt = 0.5f;
            ok0 = false; ok1 = false; ok2 = t > 0; ok3 = t < 255;
          }
          float a[8] = {0, 0, 0, 0, 0, 0, 0, 0};
#pragma unroll
          for (int q = 0; q < 4; ++q) {
            const bool ok = q == 0 ? ok0 : (q == 1 ? ok1 : (q == 2 ? ok2 : ok3));
            const int nrow = q == 0 ? row - 64 : (q == 1 ? row + 64 : (q == 2 ? row - 1 : row + 1));
            if (ok) {
              const uint4 u = *(const uint4*)(T0 + (size_t)nrow * D + cc);
              a[0] += lo2f(u.x); a[1] += hi2f(u.x); a[2] += lo2f(u.y); a[3] += hi2f(u.y);
              a[4] += lo2f(u.z); a[5] += hi2f(u.z); a[6] += lo2f(u.w); a[7] += hi2f(u.w);
            }
          }
          *(uint4*)(T1 + (size_t)row * D + cc) = make_uint4(pack2(a[0] * wgt, a[1] * wgt), pack2(a[2] * wgt, a[3] * wgt),
                                                            pack2(a[4] * wgt, a[5] * wgt), pack2(a[6] * wgt, a[7] * wgt));
        }
        if (layer == 1) {
          for (int it = blockIdx.x; it < N_CWPREP; it += gridDim.x) fourier_cw_prep(p, 1, it, smem, TID);
        }
      } break;
      case PH_RINPROJ: {
        const int N = (j >= 1) ? 4384 : 4352;
        const int MT = NR / 128;
        const int NT_MAIN = 16, NT_TAIL = (N - 4096 + 127) / 128, NT = NT_MAIN + NT_TAIL;
        bf16_t* Vd = (j == 0) ? VF : T5;
        bf16_t* LW = (bf16_t*)(p.ws + OFF_LW);
        bf16_t* LA = (bf16_t*)(p.ws + OFF_LA);
        bf16_t* LV = (bf16_t*)(p.ws + OFF_LV);
        for (int t = blockIdx.x; t < MT * NT; t += gridDim.x) {
          const int mt = t / NT, nt = t % NT;
          if (nt < NT_MAIN) {
            const int n0 = nt * 256;
            const float* mu = p.r_mu + (size_t)(j * 6 + (n0 >> 10)) * 1024;
            gemm_tile_plain<true, 4>(T0, T1, mu, 1024, W, 1024, 1024, mt * 128, n0, 4096, smem, TID,
                                     [=](int col0) { return col0 < 1024 ? T2 : (col0 < 2048 ? T3 : (col0 < 3072 ? Vd : T4)); });
          } else {
            const int n0 = 4096 + (nt - NT_MAIN) * 128;
            const int pi = n0 < 4224 ? 4 : (n0 < 4352 ? 5 : 2);
            const float* mu = p.r_mu + (size_t)(j * 6 + pi) * 1024;
            gemm_tile_n<true, 2>(T0, T1, mu, 1024, W, 1024, 1024, mt * 128, n0, N, smem, TID, [=](int row, int col, float v) {
              if (col < 4224) LW[(size_t)row * 128 + (col - 4096)] = f2bf(tanhf(v));
              else if (col < 4352) LA[(size_t)row * 128 + (col - 4224)] = f2bf(v);
              else LV[(size_t)row * 32 + (col - 4352)] = f2bf(v);
            });
          }
        }
      } break;
      case PH_RVUPD: {
        const bf16_t* LV = (const bf16_t*)(p.ws + OFF_LV);
        const float* v2 = p.r_v2 + (size_t)(j - 1) * 32 * 1024;
        const float* v0 = p.r_v0 + (size_t)(j - 1) * 1024;
        float* v2s = (float*)smem;
        __syncthreads();
        for (int e = tid; e < 32 * 256; e += 256) *(float4*)(v2s + e * 4) = *(const float4*)(v2 + e * 4);
        __syncthreads();
        const int wave = tid >> 6, lane = tid & 63;
        for (int row = blockIdx.x * 4 + wave; row < NR; row += gridDim.x * 4) {
          const float lvl = bf2f(LV[(size_t)row * 32 + (lane & 31)]);
          float acc[16];
#pragma unroll
          for (int qd = 0; qd < 4; ++qd) {
            const float4 t = *(const float4*)(v0 + qd * 256 + lane * 4);
            acc[qd * 4] = t.x; acc[qd * 4 + 1] = t.y; acc[qd * 4 + 2] = t.z; acc[qd * 4 + 3] = t.w;
          }
#pragma unroll 4
          for (int l = 0; l < 32; ++l) {
            const float a = __int_as_float(__builtin_amdgcn_readlane(__float_as_int(lvl), l));
#pragma unroll
            for (int qd = 0; qd < 4; ++qd) {
              const float4 wv = *(const float4*)(v2s + l * 1024 + qd * 256 + lane * 4);
              acc[qd * 4] += a * wv.x; acc[qd * 4 + 1] += a * wv.y; acc[qd * 4 + 2] += a * wv.z; acc[qd * 4 + 3] += a * wv.w;
            }
          }
#pragma unroll
          for (int qd = 0; qd < 4; ++qd) {
            const size_t idx = (size_t)row * D + qd * 256 + lane * 4;
            const uint2 uv = *(const uint2*)(T5 + idx);
            const uint2 uf = *(const uint2*)(VF + idx);
            float v[4] = {lo2f(uv.x), hi2f(uv.x), lo2f(uv.y), hi2f(uv.y)};
            const float f[4] = {lo2f(uf.x), hi2f(uf.x), lo2f(uf.y), hi2f(uf.y)};
#pragma unroll
            for (int e = 0; e < 4; ++e) v[e] = v[e] + (f[e] - v[e]) * fsig(acc[qd * 4 + e]);
            *(uint2*)(T5 + idx) = make_uint2(pack2(v[0], v[1]), pack2(v[2], v[3]));
          }
        }
      } break;
      case PH_RSCANA: {
        const bf16_t* V = (j == 0) ? VF : T5;
        float* SCR = (j == 0) ? (float*)(p.ws + 5 * SLOT + (8u << 20)) : (float*)(p.ws + OFF_VF);
        for (int it = blockIdx.x; it < 64 * 4; it += gridDim.x) {
          const int cid = it >> 2, k = it & 3;
          int tl = TID;
          asm volatile("" : "+v"(tl));
          if (k == 0) scan_chain_chunked<1>(p, j, cid, 0, SCR, T2, T3, V, T0, T1, smem, tl);
          else scan_chain_chunked<0>(p, j, cid, k, SCR, T2, T3, V, T0, T1, smem, tl);
        }
      } break;
      case PH_RSCAN: {
        const bf16_t* V = (j == 0) ? VF : T5;
        float* SCR = (j == 0) ? (float*)(p.ws + 5 * SLOT + (8u << 20)) : (float*)(p.ws + OFF_VF);
        for (int it = blockIdx.x; it < 64 * 4; it += gridDim.x)
          scan_chain_chunked<1>(p, j, it >> 2, 1 + (it & 3), SCR, T2, T3, V, T0, T1, smem, TID);
      } break;
      case PH_ROUTPUT: {
        const bf16_t* V = (j == 0) ? VF : T5;
        const float* BON = (const float*)(p.ws + OFF_BON);
        const int wave = tid >> 6, lane = tid & 63;
        const int nrows = (layer == 3) ? NLAT : NR;
        for (int wi = blockIdx.x * 4 + wave; wi < nrows * 2; wi += gridDim.x * 4) {
          const int row = wi >> 1, c = (wi & 1) * 512 + lane * 8, h = c >> 6;
          const size_t idx = (size_t)row * D + c;
          const uint4 u0 = *(const uint4*)(T0 + idx), u1 = *(const uint4*)(T1 + idx), uv = *(const uint4*)(V + idx), ug = *(const uint4*)(T4 + idx);
          const float4 w0 = *(const float4*)(p.r_ln_w + (size_t)j * 1024 + c), w1 = *(const float4*)(p.r_ln_w + (size_t)j * 1024 + c + 4);
          const float4 b0 = *(const float4*)(p.r_ln_b + (size_t)j * 1024 + c), b1 = *(const float4*)(p.r_ln_b + (size_t)j * 1024 + c + 4);
          const float bon = BON[((size_t)0 * NR + row) * 16 + h] + BON[((size_t)1 * NR + row) * 16 + h];
          float y[8] = {lo2f(u0.x) + lo2f(u1.x), hi2f(u0.x) + hi2f(u1.x), lo2f(u0.y) + lo2f(u1.y), hi2f(u0.y) + hi2f(u1.y),
                        lo2f(u0.z) + lo2f(u1.z), hi2f(u0.z) + hi2f(u1.z), lo2f(u0.w) + lo2f(u1.w), hi2f(u0.w) + hi2f(u1.w)};
          const float vf[8] = {lo2f(uv.x), hi2f(uv.x), lo2f(uv.y), hi2f(uv.y), lo2f(uv.z), hi2f(uv.z), lo2f(uv.w), hi2f(uv.w)};
          const float gf[8] = {lo2f(ug.x), hi2f(ug.x), lo2f(ug.y), hi2f(ug.y), lo2f(ug.z), hi2f(ug.z), lo2f(ug.w), hi2f(ug.w)};
          const float lw8[8] = {w0.x, w0.y, w0.z, w0.w, w1.x, w1.y, w1.z, w1.w};
          const float lb8[8] = {b0.x, b0.y, b0.z, b0.w, b1.x, b1.y, b1.z, b1.w};
          float sm = 0.f;
#pragma unroll
          for (int e = 0; e < 8; ++e) sm += y[e];
          sm += __shfl_xor(sm, 1, 64); sm += __shfl_xor(sm, 2, 64); sm += __shfl_xor(sm, 4, 64);
          const float mean = sm * (1.f / 64.f);
          float vr = 0.f;
#pragma unroll
          for (int e = 0; e < 8; ++e) { y[e] -= mean; vr += y[e] * y[e]; }
          vr += __shfl_xor(vr, 1, 64); vr += __shfl_xor(vr, 2, 64); vr += __shfl_xor(vr, 4, 64);
          const float rstd = rsqrtf(vr * (1.f / 64.f) + GN_EPS);
          float o[8];
#pragma unroll
          for (int e = 0; e < 8; ++e) o[e] = (y[e] * rstd * lw8[e] + lb8[e] + bon * vf[e]) * silu_f(gf[e]);
          *(uint4*)(T4 + idx) = make_uint4(pack2(o[0], o[1]), pack2(o[2], o[3]), pack2(o[4], o[5]), pack2(o[6], o[7]));
        }
      } break;
      case PH_ROUTPROJ: {
        const int MT = ((layer == 3) ? NLAT : NR) / 128;
        const int NBIG = 512, NSMALL = (MT * 4 - NBIG) * 2;
        for (int t = blockIdx.x; t < NBIG + NSMALL; t += gridDim.x) {
          if (t < NBIG) {
            const int mt = t / 4, nt = t % 4;
            gemm_tile_plain<false, 4>(T4, nullptr, nullptr, 1024, W + (size_t)4384 * 1024, 1024, 1024, mt * 128, nt * 256, 1024, smem, TID,
                                       [=](int) { return T2; });
          } else {
            const int u = t - NBIG, mt = 128 + u / 8, nt = u % 8;
            gemm_tile_plain<false, 2>(T4, nullptr, nullptr, 1024, W + (size_t)4384 * 1024, 1024, 1024, mt * 128, nt * 128, 1024, smem, TID,
                                       [=](int) { return T2; });
          }
        }
      } break;
      case PH_POSTLAST: {
        row_items(p, layer, true, false, NLAT, T2, nullptr, blockIdx.x, NLAT / 4, TID);
      } break;
    }
}

#define XB_TMO      128
#define XB_XCNT(j)  (256  + 64 * (j))
#define XB_XSUB(j)  (1280 + 64 * (j))
#define XB_XGEN(j)  (2304 + 64 * (j))
#define XB_TOP      3328
#define XB_TOPGEN   3392
#define XCD_BAR_WORDS 3456
#define XB_SPIN_CAP (1u << 23)
#define LAS __attribute__((address_space(3)))

__device__ __forceinline__ unsigned xb_ld(unsigned* p)              { return __hip_atomic_load(p, __ATOMIC_RELAXED, __HIP_MEMORY_SCOPE_AGENT); }
__device__ __forceinline__ unsigned xb_add(unsigned* p, unsigned v) { return __hip_atomic_fetch_add(p, v, __ATOMIC_RELAXED, __HIP_MEMORY_SCOPE_AGENT); }
__device__ __forceinline__ unsigned xb_xcc_id() { return (unsigned)__builtin_amdgcn_s_getreg((3 << 11) | 20) & 0xFu; }
#define XB_SPIN(cond, bar) do { unsigned _sp = 0; while (cond) { __builtin_amdgcn_s_sleep(1); \
    if ((++_sp & 255u) == 0u) { if (xb_ld(&(bar)[XB_TMO])) break; if (_sp > XB_SPIN_CAP) { atomicAdd(&(bar)[XB_TMO], 1u); break; } } } } while (0)

struct XcdBarrier {
    unsigned* bar; unsigned x;
    volatile LAS unsigned* st;
};

__device__ __forceinline__ XcdBarrier xcd_barrier_post(unsigned* bar, volatile LAS unsigned* st) {
    XcdBarrier b; b.bar = bar; b.x = xb_xcc_id(); b.st = st;
    if (threadIdx.x == 0) (void)xb_add(&bar[XB_XCNT(b.x)], 1u);
    return b;
}
__device__ __forceinline__ void xcd_barrier_complete(unsigned* bar, unsigned x, unsigned& nloc, unsigned& nx) {
    const unsigned G = gridDim.x * gridDim.y * gridDim.z;
    unsigned sum, cnt, mine, sp = 0u;
    for (;;) {
        sum = 0u; cnt = 0u; mine = 0u;
#pragma unroll
        for (unsigned j = 0; j < 16; ++j) { const unsigned c = xb_ld(&bar[XB_XCNT(j)]); sum += c; cnt += (c > 0u) ? 1u : 0u; mine = (j == x) ? c : mine; }
        if (sum == G) break;
        __builtin_amdgcn_s_sleep(1);
        if ((++sp & 255u) == 0u) { if (xb_ld(&bar[XB_TMO])) break; if (sp > XB_SPIN_CAP) { atomicAdd(&bar[XB_TMO], 1u); break; } }
    }
    nloc = mine > 0u ? mine : 1u; nx = cnt > 0u ? cnt : 1u;
}

__device__ __forceinline__ void xcd_barrier(const XcdBarrier& b) {
    asm volatile("s_waitcnt vmcnt(0)" ::: "memory");
    __syncthreads();
    if (threadIdx.x == 0) {
        unsigned* bar = b.bar;
        __builtin_amdgcn_s_waitcnt(0);
        unsigned nloc = b.st[0], nx = b.st[1];
        if (nloc == 0u) { xcd_barrier_complete(bar, b.x, nloc, nx); b.st[0] = nloc; b.st[1] = nx; }
        const unsigned old = xb_add(&bar[XB_XSUB(b.x)], 1u);
        const unsigned gen = old / nloc;
        if (old + 1u == (gen + 1u) * nloc) {
            __builtin_amdgcn_fence(__ATOMIC_RELEASE, "agent");
            asm volatile("s_waitcnt vmcnt(0)" ::: "memory");
            const unsigned og = xb_add(&bar[XB_TOP], 1u);
            const unsigned tg = og / nx;
            if (og + 1u == (tg + 1u) * nx) xb_add(&bar[XB_TOPGEN], 1u);
            else XB_SPIN(xb_ld(&bar[XB_TOPGEN]) == tg, bar);
            __builtin_amdgcn_fence(__ATOMIC_ACQUIRE, "agent");
            xb_add(&bar[XB_XGEN(b.x)], 1u);
            asm volatile("s_waitcnt vmcnt(0)" ::: "memory");
        } else {
            XB_SPIN(xb_ld(&bar[XB_XGEN(b.x)]) == gen, bar);
            __builtin_amdgcn_fence(__ATOMIC_ACQUIRE, "agent");
            asm volatile("s_waitcnt vmcnt(0)" ::: "memory");
        }
    }
    __syncthreads();
}


__global__ void __launch_bounds__(256, 1) mega(Params p) {
  __shared__ __attribute__((aligned(16))) char smem[CS_END];
  cg::grid_group grid = cg::this_grid();
  __shared__ uint4 xb_words;
  if (threadIdx.x == 0) xb_words = make_uint4(0u, 0u, 0u, 0u);
  __syncthreads();
  XcdBarrier xb = xcd_barrier_post((unsigned*)(p.ws + OFF_BAR), (volatile LAS unsigned*)&xb_words);
  for (int ph = p.phase_lo; ph < p.phase_hi; ++ph) {
    int tid_l = threadIdx.x;
    asm volatile("" : "+v"(tid_l));
    run_phase(p, ph, smem, tid_l);
#ifdef REP_MASK
    if ((REP_MASK >> p.ptype[ph]) & 1) { asm volatile("s_waitcnt vmcnt(0) lgkmcnt(0)" ::: "memory"); grid.sync(); asm volatile("" : "+v"(tid_l)); run_phase(p, ph, smem, tid_l); }
#endif
    if (ph + 1 < p.phase_hi) {
      asm volatile("s_waitcnt vmcnt(0) lgkmcnt(0)" ::: "memory");
      if (ph == p.phase_lo) grid.sync();
      else xcd_barrier(xb);
    }
  }
}

extern "C" void kernel_launch(void* const* d_in, const int* in_sizes, int n_in, void* d_out, int out_size, void* d_ws, size_t ws_size,
                              hipStream_t stream) {
  static int grid_blocks = 0;
  if (!grid_blocks) {
    int dev = 0, cus = 0, per_cu = 0;
    hipGetDevice(&dev);
    hipDeviceGetAttribute(&cus, hipDeviceAttributeMultiprocessorCount, dev);
    hipOccupancyMaxActiveBlocksPerMultiprocessor(&per_cu, mega, 256, 0);
    if (per_cu > 2) per_cu = 2;
    if (per_cu < 1) per_cu = 1;
    grid_blocks = cus * per_cu;
  }
  Params p;
  memset(&p, 0, sizeof(p));
  const float** fp = (const float**)&p;
  for (int i = 0; i < 29; ++i) fp[i] = (const float*)d_in[i];
  p.out = (float*)d_out;
  p.ws = (char*)d_ws;
  int n = 0;
  auto add = [&](int t, int l) { p.ptype[n] = (unsigned char)t; p.player[n] = (unsigned char)l; ++n; };
  add(PH_PREP0, 0);
  add(PH_PRE0, 0);
  for (int l = 0; l < 4; ++l) {
    if ((l & 1) == 0) {
      add(PH_FGEMM1, l); add(PH_FDFT1, l); add(PH_FDFT3, l); add(PH_FOUT, l); add(PH_POSTPRE, l);
    } else {
      add(PH_RSHIFT, l); add(PH_RINPROJ, l);
      if (l == 3) add(PH_RVUPD, l);
      add(PH_RSCANA, l); add(PH_RSCAN, l); add(PH_ROUTPUT, l); add(PH_ROUTPROJ, l);
      add(l == 3 ? PH_POSTLAST : PH_POSTPRE, l);
    }
  }
#ifdef DBG_STOP
  n = DBG_STOP; add(PH_DUMP, 0);
#endif
#if SINGLE_LAUNCH
  hipMemsetAsync((char*)d_ws + OFF_BAR, 0, 3456 * 4, stream);
  p.phase_lo = 0; p.phase_hi = n;
  void* args[] = {&p};
  hipError_t e = hipLaunchCooperativeKernel((void*)mega, dim3(grid_blocks), dim3(256), args, 0, stream);
  if (e != hipSuccess) fprintf(stderr, "cooperative launch failed: %s (grid %d)\n", hipGetErrorString(e), grid_blocks);
#else
  for (int i = 0; i < n; ++i) {
    p.phase_lo = i; p.phase_hi = i + 1;
    hipLaunchKernelGGL(mega, dim3(grid_blocks), dim3(256), 0, stream, p);
  }
#endif
}
```

```cpp
#include <hip/hip_runtime.h>
#include <hip/hip_cooperative_groups.h>
#include <cstdio>
#include <cstring>
namespace cg = cooperative_groups;

#ifndef DBG_MASK
#define DBG_MASK 0
#endif
#ifndef SINGLE_LAUNCH
#define SINGLE_LAUNCH 1
#endif

typedef unsigned short bf16_t;
typedef short s16x8 __attribute__((ext_vector_type(8)));
typedef short s16x4 __attribute__((ext_vector_type(4)));
typedef float f32x16 __attribute__((ext_vector_type(16)));
#define DI __device__ __forceinline__
#define MFMA(a, b, c) __builtin_amdgcn_mfma_f32_32x32x16_bf16((a), (b), (c), 0, 0, 0)

constexpr int NR = 16896;
constexpr int NLAT = 16384;
constexpr int D = 1024;
constexpr size_t SLOT = (size_t)NR * D * 2;
constexpr float RMS_EPS = 1e-6f;
constexpr float GN_EPS = 64e-5f;

constexpr size_t OFF_T0 = 0;
constexpr size_t OFF_VF = 6 * SLOT;
constexpr size_t OFF_XCTX = OFF_VF + SLOT;
constexpr size_t OFF_W = OFF_XCTX + (size_t)512 * D * 4;
constexpr size_t W_BYTES = (size_t)(4384 + 1024) * 1024 * 2;
constexpr size_t OFF_LW = OFF_W + W_BYTES;
constexpr size_t OFF_LA = OFF_LW + (size_t)NR * 128 * 2;
constexpr size_t OFF_LV = OFF_LA + (size_t)NR * 128 * 2;
constexpr size_t OFF_MOD = OFF_LV + (size_t)NR * 32 * 2;
constexpr size_t OFF_F1 = OFF_MOD + (size_t)4 * 3 * 3072 * 4;
constexpr size_t OFF_F2 = OFF_F1 + 128 * 128 * 2;
constexpr size_t OFF_FC = OFF_F2 + 128 * 256 * 2;
constexpr size_t OFF_TW = OFF_FC + 256 * 512 * 2;
constexpr size_t OFF_BON = OFF_TW + 64 * 128 * 8;
constexpr size_t OFF_BAR = OFF_BON + (size_t)2 * NR * 16 * 4;
constexpr size_t WS_END = OFF_BAR + 3456 * 4;
static_assert(WS_END <= 268435456ull, "workspace overflow");

enum { PH_PREP0 = 0, PH_PRE0, PH_FGEMM1, PH_FDFT1, PH_FDFT3, PH_FOUT, PH_POSTPRE, PH_RSHIFT, PH_RINPROJ, PH_RVUPD, PH_RSCAN, PH_ROUTPUT, PH_ROUTPROJ, PH_POSTLAST, PH_DUMP, PH_RSCANA };

struct Params {
  const float *x, *c, *ctx, *c_ctx, *mod_w, *mod_b, *norm_pre, *norm_post, *f_w_in, *f_w_mix, *f_b_mix, *f_w_out,
      *r_mu, *r_w_in, *r_w0, *r_w1, *r_w2, *r_a0, *r_a1, *r_a2, *r_v0, *r_v1, *r_v2, *r_k_k, *r_k_a, *r_r_k, *r_ln_w, *r_ln_b, *r_w_out;
  float* out;
  char* ws;
  int phase_lo, phase_hi;
  unsigned char ptype[32];
  unsigned char player[32];
};

DI float bf2f(bf16_t u) { return __uint_as_float(((unsigned)u) << 16); }
DI bf16_t f2bf(float f) { unsigned r; asm("v_cvt_pk_bf16_f32 %0, %1, %1" : "=v"(r) : "v"(f)); return (bf16_t)r; }
DI unsigned pack2(float a, float b) { unsigned r; asm("v_cvt_pk_bf16_f32 %0, %1, %2" : "=v"(r) : "v"(a), "v"(b)); return r; }
DI float lo2f(unsigned u) { return __uint_as_float(u << 16); }
DI float hi2f(unsigned u) { return __uint_as_float(u & 0xffff0000u); }
DI float silu_f(float x) { return x * __builtin_amdgcn_rcpf(1.f + __expf(-x)); }
DI float sigmoid_f(float x) { return __builtin_amdgcn_rcpf(1.f + __expf(-x)); }
DI float fsig(float x) { return __builtin_amdgcn_rcpf(1.f + __expf(-x)); }
DI float softplus_f(float x) { return fmaxf(x, 0.f) + log1pf(__expf(-fabsf(x))); }
template <int CTRL>
DI float dpp_add(float v) { return v + __int_as_float(__builtin_amdgcn_update_dpp(0, __float_as_int(v), CTRL, 0xf, 0xf, true)); }
DI float wave_sum(float v) {
  v = dpp_add<0xB1>(v);
  v = dpp_add<0x4E>(v);
  v = dpp_add<0x141>(v);
  v = dpp_add<0x140>(v);
  const int iv = __float_as_int(v);
  return __int_as_float(__builtin_amdgcn_readlane(iv, 0)) + __int_as_float(__builtin_amdgcn_readlane(iv, 16)) +
         __int_as_float(__builtin_amdgcn_readlane(iv, 32)) + __int_as_float(__builtin_amdgcn_readlane(iv, 48));
}
DI int crow(int r, int h) { return (r & 3) + 8 * (r >> 2) + 4 * h; }

template <bool MIX>
DI uint4 mix_chunk(uint4 va, uint4 vs, const float4 m0v, const float4 m1v) {
  if (!MIX) return va;
  float h, sv;
  h = lo2f(va.x); sv = lo2f(vs.x); const float e0 = h + (sv - h) * m0v.x;
  h = hi2f(va.x); sv = hi2f(vs.x); const float e1 = h + (sv - h) * m0v.y;
  h = lo2f(va.y); sv = lo2f(vs.y); const float e2 = h + (sv - h) * m0v.z;
  h = hi2f(va.y); sv = hi2f(vs.y); const float e3 = h + (sv - h) * m0v.w;
  h = lo2f(va.z); sv = lo2f(vs.z); const float e4 = h + (sv - h) * m1v.x;
  h = hi2f(va.z); sv = hi2f(vs.z); const float e5 = h + (sv - h) * m1v.y;
  h = lo2f(va.w); sv = lo2f(vs.w); const float e6 = h + (sv - h) * m1v.z;
  h = hi2f(va.w); sv = hi2f(vs.w); const float e7 = h + (sv - h) * m1v.w;
  return make_uint4(pack2(e0, e1), pack2(e2, e3), pack2(e4, e5), pack2(e6, e7));
}
struct NoDst { DI bf16_t* operator()(int) const { return nullptr; } };
template <bool MIX, int NJ, bool PLAIN, class Epi, class DstFn>
DI void gemm_tile_impl(const bf16_t* __restrict__ A, const bf16_t* __restrict__ A2, const float* __restrict__ mu, int lda,
                    const bf16_t* __restrict__ BT, int ldb, int K, int m0, int n0, int N, char* smem, const int TID, Epi epi, DstFn dst_fn) {
  constexpr int BN = 64 * NJ, NB = BN / 32, NBQ = NB / 4;
  constexpr int STAGE = (128 + BN) * 144;
  const int tid = TID, lane = tid & 63, w = tid >> 6, wm = w & 1, wn = w >> 1;
  f32x16 acc[2][NJ];
#pragma unroll
  for (int i = 0; i < 2; ++i)
#pragma unroll
    for (int j = 0; j < NJ; ++j)
#pragma unroll
      for (int r = 0; r < 16; ++r) acc[i][j][r] = 0.f;
  uint4 ra[2][4], ra2[2][4], rb[2][NB];
  const int KT = K >> 6;
  const int lrow = tid >> 3, kc = tid & 7;
  const bf16_t* Ap = A + (size_t)(m0 + lrow) * lda + kc * 8;
  const bf16_t* A2p = MIX ? (A2 + (size_t)(m0 + lrow) * lda + kc * 8) : nullptr;
  const bf16_t* Bp = BT + (size_t)(n0 + lrow) * ldb + kc * 8;
  const bool nfull = (n0 + BN <= N);
#define GEMM_LOAD(ST_, KT_) { \
    _Pragma("unroll") for (int i = 0; i < 4; ++i) { \
      ra[ST_][i] = *(const uint4*)(Ap + (size_t)(32 * i) * lda + (KT_) * 64); \
      if (MIX) ra2[ST_][i] = *(const uint4*)(A2p + (size_t)(32 * i) * lda + (KT_) * 64); } \
    _Pragma("unroll") for (int i = 0; i < NB; ++i) \
      rb[ST_][i] = (nfull || (n0 + lrow + 32 * i) < N) ? *(const uint4*)(Bp + (size_t)(32 * i) * ldb + (KT_) * 64) : make_uint4(0, 0, 0, 0); }
#define GEMM_STAGE_SLICE(ST_, KT_, Q_, BUF_) { \
    bf16_t* As_ = (bf16_t*)(smem + (BUF_) * STAGE); bf16_t* Bs_ = As_ + 128 * 72; \
    float4 m0v_ = make_float4(0, 0, 0, 0), m1v_ = m0v_; \
    if (MIX) { m0v_ = *(const float4*)(mu + (KT_) * 64 + kc * 8); m1v_ = *(const float4*)(mu + (KT_) * 64 + kc * 8 + 4); } \
    *(uint4*)(As_ + (lrow + 32 * (Q_)) * 72 + kc * 8) = mix_chunk<MIX>(ra[ST_][Q_], ra2[ST_][Q_], m0v_, m1v_); \
    _Pragma("unroll") for (int u = 0; u < NBQ; ++u) *(uint4*)(Bs_ + (lrow + 32 * ((Q_) * NBQ + u)) * 72 + kc * 8) = rb[ST_][(Q_) * NBQ + u]; }
  GEMM_LOAD(0, 0)
  if (KT > 1) GEMM_LOAD(1, 1)
  __syncthreads();
#pragma unroll
  for (int qq = 0; qq < 4; ++qq) GEMM_STAGE_SLICE(0, 0, qq, 0)
  if (KT > 2) GEMM_LOAD(0, 2)
  __syncthreads();
  for (int kt0 = 0; kt0 < KT; kt0 += 2) {
#pragma unroll
    for (int st = 0; st < 2; ++st) {
      const int kt = kt0 + st;
      if (kt < KT) {
        const bf16_t* As = (const bf16_t*)(smem + st * STAGE);
        const bf16_t* Bs = As + 128 * 72;
        const bool more = (kt + 1 < KT);
        s16x8 fa[2][2], fb[2][NJ];
#pragma unroll
        for (int i = 0; i < 2; ++i) fa[0][i] = *(const s16x8*)(As + (64 * wm + 32 * i + (lane & 31)) * 72 + (lane >> 5) * 8);
#pragma unroll
        for (int j = 0; j < NJ; ++j) fb[0][j] = *(const s16x8*)(Bs + (32 * NJ * wn + 32 * j + (lane & 31)) * 72 + (lane >> 5) * 8);
#pragma unroll
        for (int kk = 0; kk < 4; ++kk) {
          if (kk < 3) {
#pragma unroll
            for (int i = 0; i < 2; ++i) fa[(kk + 1) & 1][i] = *(const s16x8*)(As + (64 * wm + 32 * i + (lane & 31)) * 72 + (kk + 1) * 16 + (lane >> 5) * 8);
#pragma unroll
            for (int j = 0; j < NJ; ++j) fb[(kk + 1) & 1][j] = *(const s16x8*)(Bs + (32 * NJ * wn + 32 * j + (lane & 31)) * 72 + (kk + 1) * 16 + (lane >> 5) * 8);
          }
#pragma unroll
          for (int i = 0; i < 2; ++i)
#pragma unroll
            for (int j = 0; j < NJ; ++j) acc[i][j] = MFMA(fa[kk & 1][i], fb[kk & 1][j], acc[i][j]);
          if (more) GEMM_STAGE_SLICE(st ^ 1, kt + 1, kk, st ^ 1)
        }
        if (kt + 3 < KT) GEMM_LOAD(st ^ 1, kt + 3)
        __syncthreads();
      }
    }
  }
#undef GEMM_LOAD
#undef GEMM_STAGE_SLICE
  if (PLAIN) {
    constexpr int PITCH = 32 * NJ * 2 + 16;
    char* reg = smem + w * (64 * PITCH);
    const int l31 = lane & 31, hh = lane >> 5;
#pragma unroll
    for (int i = 0; i < 2; ++i)
#pragma unroll
      for (int j = 0; j < NJ; ++j)
#pragma unroll
        for (int r = 0; r < 16; ++r)
          *(bf16_t*)(reg + (32 * i + crow(r, hh)) * PITCH + (32 * j + l31) * 2) = f2bf(acc[i][j][r]);
    __syncthreads();
    const int col0 = n0 + 32 * NJ * wn;
    bf16_t* dst = dst_fn(col0) + (size_t)(m0 + 64 * wm) * D + (col0 & 1023);
    constexpr int CPR = 4 * NJ;
    constexpr int RPI = 64 / CPR;
    const int rr = lane / CPR, ch = lane % CPR;
#pragma unroll
    for (int q = 0; q < CPR; ++q) {
      const int row = rr + RPI * q;
      *(uint4*)(dst + (size_t)row * D + ch * 8) = *(const uint4*)(reg + row * PITCH + ch * 16);
    }
    return;
  }
#pragma unroll
  for (int i = 0; i < 2; ++i)
#pragma unroll
    for (int j = 0; j < NJ; ++j) {
      const int col = n0 + 32 * NJ * wn + 32 * j + (lane & 31);
      if (col < N) {
#pragma unroll
        for (int r = 0; r < 16; ++r) {
          const int row = m0 + 64 * wm + 32 * i + crow(r, lane >> 5);
          epi(row, col, acc[i][j][r]);
        }
      }
    }
}
template <bool MIX, int NJ, class Epi>
DI void gemm_tile_n(const bf16_t* __restrict__ A, const bf16_t* __restrict__ A2, const float* __restrict__ mu, int lda,
                    const bf16_t* __restrict__ BT, int ldb, int K, int m0, int n0, int N, char* smem, const int TID, Epi epi) {
  gemm_tile_impl<MIX, NJ, false>(A, A2, mu, lda, BT, ldb, K, m0, n0, N, smem, TID, epi, NoDst());
}
template <bool MIX, int NJ, class DstFn>
DI void gemm_tile_plain(const bf16_t* __restrict__ A, const bf16_t* __restrict__ A2, const float* __restrict__ mu, int lda,
                        const bf16_t* __restrict__ BT, int ldb, int K, int m0, int n0, int N, char* smem, const int TID, DstFn dst_fn) {
  gemm_tile_impl<MIX, NJ, true>(A, A2, mu, lda, BT, ldb, K, m0, n0, N, smem, TID, [](int, int, float) {}, dst_fn);
}
template <bool MIX, class Epi>
DI void gemm_tile(const bf16_t* __restrict__ A, const bf16_t* __restrict__ A2, const float* __restrict__ mu, int lda,
                  const bf16_t* __restrict__ BT, int ldb, int K, int m0, int n0, int N, char* smem, const int TID, Epi epi) {
  gemm_tile_n<MIX, 2>(A, A2, mu, lda, BT, ldb, K, m0, n0, N, smem, TID, epi);
}

template <class Epi>
DI void dft_tile(const bf16_t* __restrict__ A, int lda, int arow0, int KH, const bf16_t* __restrict__ Bre,
                 const bf16_t* __restrict__ Bim, int ldb, int tstride, char* smem, const int TID, Epi epi) {
  const int tid = TID, lane = tid & 63, w = tid >> 6;
  const int rt0 = w & 1, ctb = 2 * (w >> 1);
  f32x16 acc[2][2];
#pragma unroll
  for (int i = 0; i < 2; ++i)
#pragma unroll
    for (int j = 0; j < 2; ++j)
#pragma unroll
      for (int r = 0; r < 16; ++r) acc[i][j][r] = 0.f;
  const int nch = (2 * KH) >> 7;
  const int g = lane >> 4, li = lane & 15, q = li >> 2, pp = li & 3;
  const int tr_base = (8 * (g >> 1) + q) * 320 + (16 * (g & 1) + 4 * pp) * 2;
  for (int ch = 0; ch < nch; ++ch) {
    __syncthreads();
#pragma unroll
    for (int i = 0; i < 8; ++i) {
      const int c = tid + 256 * i, r = c >> 4, cc = c & 15;
      const int kr = ch * 128 + r;
      const bf16_t* src = (kr < KH ? Bre + (size_t)kr * tstride * ldb : Bim + (size_t)(kr - KH) * tstride * ldb) + cc * 8;
      *(uint4*)(smem + r * 320 + cc * 16) = *(const uint4*)src;
    }
    __syncthreads();
#pragma unroll
    for (int kh = 0; kh < 2; ++kh) {
      asm volatile("" ::: "memory");
      s16x8 af[4][2];
#pragma unroll
      for (int k4 = 0; k4 < 4; ++k4)
#pragma unroll
        for (int h = 0; h < 2; ++h)
          af[k4][h] = *(const s16x8*)(A + (size_t)(arow0 + 32 * (rt0 + 2 * h) + (lane & 31)) * lda + ch * 128 + (kh * 4 + k4) * 16 + (lane >> 5) * 8);
#pragma unroll
      for (int k4 = 0; k4 < 4; ++k4) {
        const int ks = kh * 4 + k4;
#pragma unroll
        for (int c2 = 0; c2 < 2; ++c2) {
          const int off = tr_base + ks * 16 * 320 + (ctb + c2) * 64;
#ifdef NO_TR
          s16x8 b;
          {
            const int n = 32 * (ctb + c2) + (lane & 31), k0 = ks * 16 + 8 * (lane >> 5);
#pragma unroll
            for (int e = 0; e < 8; ++e) b[e] = *(const short*)(smem + (k0 + e) * 320 + n * 2);
          }
#else
          const s16x4 lo = __builtin_amdgcn_ds_read_tr16_b64_v4i16((__attribute__((address_space(3))) s16x4*)(smem + off));
          const s16x4 hi = __builtin_amdgcn_ds_read_tr16_b64_v4i16((__attribute__((address_space(3))) s16x4*)(smem + off + 4 * 320));
          const s16x8 b = __builtin_shufflevector(lo, hi, 0, 1, 2, 3, 4, 5, 6, 7);
#endif
#pragma unroll
          for (int h = 0; h < 2; ++h) acc[h][c2] = MFMA(af[k4][h], b, acc[h][c2]);
        }
      }
    }
  }
#pragma unroll
  for (int c2 = 0; c2 < 2; ++c2) {
    const int col = 32 * (ctb + c2) + (lane & 31);
#pragma unroll
    for (int r = 0; r < 16; ++r) {
      const int rowA = 32 * rt0 + crow(r, lane >> 5);
      if ((r & 3) == 0) asm volatile("" ::: "memory");
      epi(rowA, rowA + 64, col, acc[0][c2][r], acc[1][c2][r]);
    }
  }
}

DI void transpose_tile(const float* __restrict__ src, int lds_, bf16_t* __restrict__ dst, int ldd, int K, int N, int tk, int tn, char* smem, const int TID) {
  float* t = (float*)smem;
  const int tid = TID;
  __syncthreads();
#pragma unroll
  for (int i = 0; i < 16; ++i) {
    const int kk = (tid >> 6) + 4 * i, nn = tid & 63;
    const int k = tk * 64 + kk, n = tn * 64 + nn;
    t[kk * 65 + nn] = (k < K && n < N) ? src[(size_t)k * lds_ + n] : 0.f;
  }
  __syncthreads();
#pragma unroll
  for (int i = 0; i < 16; ++i) {
    const int nn = (tid >> 6) + 4 * i, kk = tid & 63;
    const int k = tk * 64 + kk, n = tn * 64 + nn;
    if (k < K && n < N) dst[(size_t)n * ldd + k] = f2bf(t[kk * 65 + nn]);
  }
}

DI void fourier_wprep(const Params& p, int j, int it, char* smem, const int TID) {
  bf16_t* W = (bf16_t*)(p.ws + OFF_W);
  const int job = it >> 8, t = it & 255;
  if (job == 0) transpose_tile(p.f_w_in + (size_t)j * 1024 * 2048 + 1024, 2048, W + (size_t)2048 * 1024, 1024, 1024, 1024, t >> 4, t & 15, smem, TID);
  else transpose_tile(p.f_w_out + (size_t)j * 1024 * 1024, 1024, W + (size_t)3072 * 1024, 1024, 1024, 1024, t >> 4, t & 15, smem, TID);
}
DI void rwkv_wprep(const Params& p, int j, int it, char* smem, const int TID) {
  bf16_t* W = (bf16_t*)(p.ws + OFF_W);
  if (it < 1024) {
    const int pi = it >> 8, t = it & 255;
    transpose_tile(p.r_w_in + (size_t)(j * 4 + pi) * 1024 * 1024, 1024, W + (size_t)pi * 1024 * 1024, 1024, 1024, 1024, t >> 4, t & 15, smem, TID);
  } else if (it < 1024 + 32) {
    const int u = it - 1024, n = u >> 4, t = u & 15;
    transpose_tile(p.r_w1 + (size_t)(j * 2 + n) * 1024 * 64, 64, W + (size_t)(4096 + 64 * n) * 1024, 1024, 1024, 64, t, 0, smem, TID);
  } else if (it < 1024 + 64) {
    const int u = it - 1056, n = u >> 4, t = u & 15;
    transpose_tile(p.r_a1 + (size_t)(j * 2 + n) * 1024 * 64, 64, W + (size_t)(4224 + 64 * n) * 1024, 1024, 1024, 64, t, 0, smem, TID);
  } else if (it < 1024 + 80) {
    const int t = it - 1088;
    if (j >= 1) transpose_tile(p.r_v1 + (size_t)(j - 1) * 1024 * 32, 32, W + (size_t)4352 * 1024, 1024, 1024, 32, t, 0, smem, TID);
  } else {
    const int t = it - 1104;
    transpose_tile(p.r_w_out + (size_t)j * 1024 * 1024, 1024, W + (size_t)4384 * 1024, 1024, 1024, 1024, t >> 4, t & 15, smem, TID);
  }
}
constexpr int N_FWPREP = 512, N_RWPREP = 1360;

DI void fourier_cw_prep(const Params& p, int j, int it, char* smem, const int TID) {
  bf16_t* FWU = (bf16_t*)(p.ws + 5 * SLOT);
  bf16_t* CWT = FWU + 1024 * 1024;
  const int tid = TID;
  if (it < 256) {
#pragma unroll
    for (int i = 0; i < 4; ++i) {
      const int row = it * 4 + i;
      const float4 v = *(const float4*)(p.f_w_in + (size_t)j * 1024 * 2048 + (size_t)row * 2048 + tid * 4);
      *(uint2*)(FWU + (size_t)row * 1024 + tid * 4) = make_uint2(pack2(v.x, v.y), pack2(v.z, v.w));
    }
  } else {
    float* tab = (float*)smem;
    __syncthreads();
    if (tid < 128) tab[tid] = cospif((float)tid / 64.f);
    __syncthreads();
    const int u = it - 256, pq = u >> 7, g = (u >> 4) & 7, cb = u & 15;
    const int e = tid & 127, cbase = cb * 8 + (tid >> 7) * 4;
    const float* wm = p.f_w_mix + ((size_t)j * 8 + g) * 128 * 128;
    const int off = pq ? 32 : 0;
    float a0 = 0.f, a1 = 0.f, a2 = 0.f, a3 = 0.f;
#pragma unroll 8
    for (int c2 = 0; c2 < 128; ++c2) {
      const float wv = wm[c2 * 128 + e];
      a0 += tab[((cbase + 0) * c2 - off) & 127] * wv;
      a1 += tab[((cbase + 1) * c2 - off) & 127] * wv;
      a2 += tab[((cbase + 2) * c2 - off) & 127] * wv;
      a3 += tab[((cbase + 3) * c2 - off) & 127] * wv;
    }
    *(uint2*)(CWT + (((size_t)pq * 8 + g) * 128 + e) * 128 + cbase) = make_uint2(pack2(a0, a1), pack2(a2, a3));
  }
}
constexpr int N_CWPREP = 256 + 256;

DI void fourier_precompose(const Params& p, int it, char* smem, const int TID) {
  const bf16_t* FWU = (const bf16_t*)(p.ws + 5 * SLOT);
  const bf16_t* CWT = FWU + 1024 * 1024;
  bf16_t* W = (bf16_t*)(p.ws + OFF_W);
  const int pg = it >> 3, nt = it & 7;
  const int g = pg & 7;
  bf16_t* dst = W + (size_t)pg * 128 * 1024;
  gemm_tile<false>(CWT + (size_t)pg * 128 * 128, nullptr, nullptr, 128, FWU + g * 128, 1024, 128, 0, nt * 128, 1024, smem, TID,
                   [=](int row, int col, float v) { dst[(size_t)row * 1024 + col] = f2bf(v); });
}

DI void phase_prep0(const Params& p, char* smem, const int TID) {
  const int tid = TID;

  float* MOD = (float*)(p.ws + OFF_MOD);
  const int N_MOD = 192, N_TAB = (128 * 128 + 128 * 256 + 256 * 512 + 64 * 128) / 256;
  const int total = N_MOD + N_TAB + N_CWPREP + N_FWPREP;
  for (int it = blockIdx.x; it < total; it += gridDim.x) {
    if (it < N_MOD) {
      const int layer = it / 48, chunk = it % 48;
      const int kp = tid >> 4, cgp = tid & 15;
      const float* wbase = p.mod_w + (size_t)layer * 1024 * 3072 + chunk * 64 + cgp * 4;
      float a0[4] = {0, 0, 0, 0}, a1[4] = {0, 0, 0, 0}, a2[4] = {0, 0, 0, 0};
      float* sc = (float*)(smem + 16384);
      __syncthreads();
      for (int e = tid; e < 1024; e += 256) { sc[e] = silu_f(p.c[e]); sc[1024 + e] = silu_f(p.c[1024 + e]); sc[2048 + e] = silu_f(p.c_ctx[e]); }
      __syncthreads();
#pragma unroll 8
      for (int k = kp * 64; k < kp * 64 + 64; ++k) {
        const float4 wv = *(const float4*)(wbase + (size_t)k * 3072);
        const float s0 = sc[k], s1 = sc[1024 + k], s2 = sc[2048 + k];
        a0[0] += s0 * wv.x; a0[1] += s0 * wv.y; a0[2] += s0 * wv.z; a0[3] += s0 * wv.w;
        a1[0] += s1 * wv.x; a1[1] += s1 * wv.y; a1[2] += s1 * wv.z; a1[3] += s1 * wv.w;
        a2[0] += s2 * wv.x; a2[1] += s2 * wv.y; a2[2] += s2 * wv.z; a2[3] += s2 * wv.w;
      }
      float* red = (float*)smem;
      __syncthreads();
#pragma unroll
      for (int e = 0; e < 4; ++e) {
        red[(kp * 3 + 0) * 64 + cgp * 4 + e] = a0[e];
        red[(kp * 3 + 1) * 64 + cgp * 4 + e] = a1[e];
        red[(kp * 3 + 2) * 64 + cgp * 4 + e] = a2[e];
      }
      __syncthreads();
      if (tid < 192) {
        const int v = tid >> 6, col = tid & 63;
        float s = 0.f;
#pragma unroll
        for (int k = 0; k < 16; ++k) s += red[(k * 3 + v) * 64 + col];
        const int cidx = chunk * 64 + col;
        MOD[((size_t)layer * 3 + v) * 3072 + cidx] = s + p.mod_b[(size_t)layer * 3072 + cidx];
      }
    } else if (it < N_MOD + N_TAB) {
      int e = (it - N_MOD) * 256 + tid;
      bf16_t* F1 = (bf16_t*)(p.ws + OFF_F1);
      bf16_t* F2 = (bf16_t*)(p.ws + OFF_F2);
      bf16_t* FC = (bf16_t*)(p.ws + OFF_FC);
      float2* TW = (float2*)(p.ws + OFF_TW);
      if (e < 128 * 128) {
        const int m = e >> 7, k = e & 127;
        const int mm = m & 63, kk = k & 63;
        const float ang = (float)((mm * kk) & 63) / 32.f;
        const float cv = cospif(ang), sv = sinpif(ang);
        float val;
        if (m < 64) val = (k < 64) ? cv : -sv; else val = (k < 64) ? sv : cv;
        F1[e] = f2bf(val);
      } else if ((e -= 128 * 128) < 128 * 256) {
        const int m = e >> 8, k = e & 255, kk = k & 127;
        const float ang = (float)((m * kk) & 127) / 64.f;
        F2[e] = f2bf(k < 128 ? cospif(ang) : -sinpif(ang));
      } else if ((e -= 128 * 256) < 256 * 512) {
        const int m = e >> 9, k = e & 511, kk = k & 255;
        const float ang = (float)((m * kk) & 255) / 128.f;
        FC[e] = f2bf(k < 256 ? cospif(ang) : -sinpif(ang));
      } else {
        e -= 256 * 512;
        const int k1 = e >> 7, t2 = e & 127;
        const float ang = (float)(k1 * t2) / 4096.f;
        TW[e] = make_float2(cospif(ang), sinpif(ang));
      }
    } else if (it < N_MOD + N_TAB + N_CWPREP) {
      fourier_cw_prep(p, 0, it - N_MOD - N_TAB, smem, TID);
    } else {
      fourier_wprep(p, 0, it - N_MOD - N_TAB - N_CWPREP, smem, TID);
    }
  }
}

DI void row_items(const Params& p, int layer, bool do_post, bool do_pre, int nrows, const bf16_t* O, bf16_t* H, int it0, int nit, const int TID) {
  const int wave = TID >> 6, lane = TID & 63;
  const float* MOD = (const float*)(p.ws + OFF_MOD);
  float* XCTX = (float*)(p.ws + OFF_XCTX);
  float4 nx0, nx1, nx2, nx3;
  uint2 no0 = make_uint2(0, 0), no1 = no0, no2 = no0, no3 = no0;
#define ROW_XIN(ROW_) ((layer == 0) ? ((ROW_) < NLAT ? p.x + (size_t)(ROW_) * D : p.ctx + (size_t)((ROW_) - NLAT) * D) \
                                    : ((ROW_) < NLAT ? p.out + (size_t)(ROW_) * D : XCTX + (size_t)((ROW_) - NLAT) * D))
#define ROW_PREFETCH(ROW_) { const float* xi_ = ROW_XIN(ROW_); \
    nx0 = *(const float4*)(xi_ + lane * 4); nx1 = *(const float4*)(xi_ + 256 + lane * 4); nx2 = *(const float4*)(xi_ + 512 + lane * 4); nx3 = *(const float4*)(xi_ + 768 + lane * 4); \
    if (do_post) { const bf16_t* oi_ = O + (size_t)(ROW_) * D + lane * 4; \
      no0 = *(const uint2*)(oi_); no1 = *(const uint2*)(oi_ + 256); no2 = *(const uint2*)(oi_ + 512); no3 = *(const uint2*)(oi_ + 768); } }
  if (it0 < nit) ROW_PREFETCH(it0 * 4 + wave)
  for (int it = it0; it < nit; it += gridDim.x) {
    const int row = it * 4 + wave;
    const int v = row < 8192 ? 0 : (row < 16384 ? 1 : 2);
    float* xout = row < NLAT ? p.out + (size_t)row * D : XCTX + (size_t)(row - NLAT) * D;
    float4 xv[4] = {nx0, nx1, nx2, nx3};
    const uint2 ou[4] = {no0, no1, no2, no3};
    if (it + (int)gridDim.x < nit) ROW_PREFETCH((it + (int)gridDim.x) * 4 + wave)
    if (do_post) {
      float ov[4][4];
      float ss = 0.f;
#pragma unroll
      for (int qd = 0; qd < 4; ++qd) {
        const uint2 u = ou[qd];
        ov[qd][0] = lo2f(u.x); ov[qd][1] = hi2f(u.x); ov[qd][2] = lo2f(u.y); ov[qd][3] = hi2f(u.y);
#pragma unroll
        for (int e = 0; e < 4; ++e) ss += ov[qd][e] * ov[qd][e];
      }
      ss = wave_sum(ss);
      const float rstd = rsqrtf(ss * (1.f / 1024.f) + RMS_EPS);
      const float* gate = MOD + ((size_t)layer * 3 + v) * 3072 + 2048;
      const float* np = p.norm_post + (size_t)layer * D;
#pragma unroll
      for (int qd = 0; qd < 4; ++qd) {
        const float4 gv = *(const float4*)(gate + qd * 256 + lane * 4);
        const float4 nv = *(const float4*)(np + qd * 256 + lane * 4);
        xv[qd].x += gv.x * (ov[qd][0] * rstd * nv.x);
        xv[qd].y += gv.y * (ov[qd][1] * rstd * nv.y);
        xv[qd].z += gv.z * (ov[qd][2] * rstd * nv.z);
        xv[qd].w += gv.w * (ov[qd][3] * rstd * nv.w);
        *(float4*)(xout + qd * 256 + lane * 4) = xv[qd];
      }
    }
    if (do_pre) {
      const int L = layer + (do_post ? 1 : 0);
      float ss = 0.f;
#pragma unroll
      for (int qd = 0; qd < 4; ++qd) ss += xv[qd].x * xv[qd].x + xv[qd].y * xv[qd].y + xv[qd].z * xv[qd].z + xv[qd].w * xv[qd].w;
      ss = wave_sum(ss);
      const float rstd = rsqrtf(ss * (1.f / 1024.f) + RMS_EPS);
      const float* sh = MOD + ((size_t)L * 3 + v) * 3072;
      const float* sc = sh + 1024;
      const float* np = p.norm_pre + (size_t)L * D;
#pragma unroll
      for (int qd = 0; qd < 4; ++qd) {
        const float4 a = *(const float4*)(sh + qd * 256 + lane * 4);
        const float4 b = *(const float4*)(sc + qd * 256 + lane * 4);
        const float4 n = *(const float4*)(np + qd * 256 + lane * 4);
        const float h0 = xv[qd].x * rstd * n.x * (1.f + b.x) + a.x;
        const float h1 = xv[qd].y * rstd * n.y * (1.f + b.y) + a.y;
        const float h2 = xv[qd].z * rstd * n.z * (1.f + b.z) + a.z;
        const float h3 = xv[qd].w * rstd * n.w * (1.f + b.w) + a.w;
        *(uint2*)(H + (size_t)row * D + qd * 256 + lane * 4) = make_uint2(pack2(h0, h1), pack2(h2, h3));
      }
    }
  }
}

#undef ROW_XIN
#undef ROW_PREFETCH
DI int seq_row(int n, int b, int s) {
  if (s < 256) { const int t = n ? 255 - s : s; return NLAT + b * 256 + t; }
  const int u = s - 256; const int t = n ? 8191 - u : u; return b * 8192 + t;
}
DI void scan_chain(const Params& p, int j, int cid, const bf16_t* R, const bf16_t* Kb, const bf16_t* V, bf16_t* Y0, bf16_t* Y1, char* smem, const int TID) {
  const int n = cid >> 5, b = (cid >> 4) & 1, h = cid & 15;
  const int tid = TID;
  float* rS = (float*)smem;
  float* wS = rS + 1024; float* kS = wS + 1024; float* vS = kS + 1024; float* aS = vS + 1024; float* bS = aS + 1024;
  float* lwS = bS + 1024; float* laS = lwS + 1024;
  float* w2S = laS + 1024;
  float* a2S = w2S + 4096;
  float* yS = lwS;
  const bf16_t* LW = (const bf16_t*)(p.ws + OFF_LW);
  const bf16_t* LA = (const bf16_t*)(p.ws + OFF_LA);
  float* BON = (float*)(p.ws + OFF_BON);
  bf16_t* Y = n ? Y1 : Y0;
  __syncthreads();
  {
    const float* w2 = p.r_w2 + (size_t)(j * 2 + n) * 64 * 1024 + h * 64;
    const float* a2 = p.r_a2 + (size_t)(j * 2 + n) * 64 * 1024 + h * 64;
    for (int e = tid; e < 4096; e += 256) { w2S[e] = w2[(size_t)(e >> 6) * 1024 + (e & 63)]; a2S[e] = a2[(size_t)(e >> 6) * 1024 + (e & 63)]; }
  }
  const int ltok = tid >> 4, cq = tid & 15, c4 = cq * 4;
  const int gc = h * 64 + c4;
  const float4 w0v = *(const float4*)(p.r_w0 + (size_t)(j * 2 + n) * 1024 + gc);
  const float4 a0v = *(const float4*)(p.r_a0 + (size_t)(j * 2 + n) * 1024 + gc);
  const float4 kkv = *(const float4*)(p.r_k_k + (size_t)j * 1024 + gc);
  const float4 kav = *(const float4*)(p.r_k_a + (size_t)j * 1024 + gc);
  const float4 rkv = *(const float4*)(p.r_r_k + (size_t)j * 1024 + gc);
  const int si = tid >> 2, jq = tid & 3;
  float S[16];
#pragma unroll
  for (int e = 0; e < 16; ++e) S[e] = 0.f;
  for (int ck = 0; ck < 528; ++ck) {
    const int s = ck * 16 + ltok;
    const int row = seq_row(n, b, s);
    const uint2 ur = *(const uint2*)(R + (size_t)row * D + gc);
    const uint2 uk = *(const uint2*)(Kb + (size_t)row * D + gc);
    const uint2 uv = *(const uint2*)(V + (size_t)row * D + gc);
    const uint2 ulw = *(const uint2*)(LW + (size_t)row * 128 + n * 64 + c4);
    const uint2 ula = *(const uint2*)(LA + (size_t)row * 128 + n * 64 + c4);
    __syncthreads();
    *(float4*)(lwS + ltok * 64 + c4) = make_float4(lo2f(ulw.x), hi2f(ulw.x), lo2f(ulw.y), hi2f(ulw.y));
    *(float4*)(laS + ltok * 64 + c4) = make_float4(lo2f(ula.x), hi2f(ula.x), lo2f(ula.y), hi2f(ula.y));
    __syncthreads();
    float wz[4] = {w0v.x, w0v.y, w0v.z, w0v.w}, az[4] = {a0v.x, a0v.y, a0v.z, a0v.w};
    for (int l = 0; l < 64; ++l) {
      const float lw = lwS[ltok * 64 + l], la = laS[ltok * 64 + l];
      const float4 w2v = *(const float4*)(w2S + l * 64 + c4);
      const float4 a2v = *(const float4*)(a2S + l * 64 + c4);
      wz[0] += lw * w2v.x; wz[1] += lw * w2v.y; wz[2] += lw * w2v.z; wz[3] += lw * w2v.w;
      az[0] += la * a2v.x; az[1] += la * a2v.y; az[2] += la * a2v.z; az[3] += la * a2v.w;
    }
    const float rr[4] = {lo2f(ur.x), hi2f(ur.x), lo2f(ur.y), hi2f(ur.y)};
    const float kr[4] = {lo2f(uk.x), hi2f(uk.x), lo2f(uk.y), hi2f(uk.y)};
    const float vr[4] = {lo2f(uv.x), hi2f(uv.x), lo2f(uv.y), hi2f(uv.y)};
    const float kkw[4] = {kkv.x, kkv.y, kkv.z, kkv.w}, kaw[4] = {kav.x, kav.y, kav.z, kav.w}, rkw[4] = {rkv.x, rkv.y, rkv.z, rkv.w};
    float kk[4], ss = 0.f;
#pragma unroll
    for (int e = 0; e < 4; ++e) { kk[e] = kr[e] * kkw[e]; ss += kk[e] * kk[e]; }
#pragma unroll
    for (int o = 8; o > 0; o >>= 1) ss += __shfl_xor(ss, o, 64);
    const float inv = 1.f / fmaxf(sqrtf(ss), 1e-12f);
    float dec[4], as[4], kd[4], bb[4], bon = 0.f;
#pragma unroll
    for (int e = 0; e < 4; ++e) {
      kk[e] *= inv;
      dec[e] = __expf(-__expf(-softplus_f(-wz[e]) - 0.5f));
      as[e] = sigmoid_f(az[e]);
      kd[e] = kr[e] * (1.f + (as[e] - 1.f) * kaw[e]);
      bb[e] = kk[e] * as[e];
      bon += rr[e] * kd[e] * rkw[e];
    }
#pragma unroll
    for (int o = 8; o > 0; o >>= 1) bon += __shfl_xor(bon, o, 64);
    if (cq == 0) BON[((size_t)n * NR + row) * 16 + h] = bon;
    *(float4*)(rS + ltok * 64 + c4) = make_float4(rr[0], rr[1], rr[2], rr[3]);
    *(float4*)(wS + ltok * 64 + c4) = make_float4(dec[0], dec[1], dec[2], dec[3]);
    *(float4*)(kS + ltok * 64 + c4) = make_float4(kd[0], kd[1], kd[2], kd[3]);
    *(float4*)(vS + ltok * 64 + c4) = make_float4(vr[0], vr[1], vr[2], vr[3]);
    *(float4*)(aS + ltok * 64 + c4) = make_float4(-kk[0], -kk[1], -kk[2], -kk[3]);
    *(float4*)(bS + ltok * 64 + c4) = make_float4(bb[0], bb[1], bb[2], bb[3]);
    __syncthreads();
    for (int t = 0; t < 16; ++t) {
      float av[16], sa = 0.f;
#pragma unroll
      for (int m = 0; m < 4; ++m) {
        const float4 a4 = *(const float4*)(aS + t * 64 + jq * 16 + m * 4);
        av[m * 4] = a4.x; av[m * 4 + 1] = a4.y; av[m * 4 + 2] = a4.z; av[m * 4 + 3] = a4.w;
      }
#pragma unroll
      for (int e = 0; e < 16; ++e) sa += S[e] * av[e];
      sa += __shfl_xor(sa, 1, 64);
      sa += __shfl_xor(sa, 2, 64);
      const float vi = vS[t * 64 + si];
      float y = 0.f;
#pragma unroll
      for (int m = 0; m < 4; ++m) {
        const float4 w4 = *(const float4*)(wS + t * 64 + jq * 16 + m * 4);
        const float4 b4 = *(const float4*)(bS + t * 64 + jq * 16 + m * 4);
        const float4 k4 = *(const float4*)(kS + t * 64 + jq * 16 + m * 4);
        const float4 r4 = *(const float4*)(rS + t * 64 + jq * 16 + m * 4);
        S[m * 4 + 0] = S[m * 4 + 0] * w4.x + sa * b4.x + vi * k4.x; y += S[m * 4 + 0] * r4.x;
        S[m * 4 + 1] = S[m * 4 + 1] * w4.y + sa * b4.y + vi * k4.y; y += S[m * 4 + 1] * r4.y;
        S[m * 4 + 2] = S[m * 4 + 2] * w4.z + sa * b4.z + vi * k4.z; y += S[m * 4 + 2] * r4.z;
        S[m * 4 + 3] = S[m * 4 + 3] * w4.w + sa * b4.w + vi * k4.w; y += S[m * 4 + 3] * r4.w;
      }
      y += __shfl_xor(y, 1, 64);
      y += __shfl_xor(y, 2, 64);
      if (jq == 0) yS[t * 64 + si] = y;
    }
    __syncthreads();
    {
      const float4 yv = *(const float4*)(yS + ltok * 64 + c4);
      *(uint2*)(Y + (size_t)row * D + gc) = make_uint2(pack2(yv.x, yv.y), pack2(yv.z, yv.w));
    }
  }
}


constexpr int CS_W2T = 0, CS_A2T = 9216, CS_R1 = 18432, CS_R2 = 27648, CS_R3 = 36864, CS_WZ = 46080, CS_AZ = 62464,
              CS_AT = 78848, CS_RT = 88064, CS_BT = 97280, CS_KT = 106496, CS_VT = 115712, CS_AAB = 124928, CS_UV = 142336,
              CS_S0T = 151552, CS_TOT = 160768, CS_CL = 161792, CS_CST = 162048, CS_END = 163328;
DI s16x8 lds_row8(const char* base, int row, int col) { return *(const s16x8*)(base + row * 144 + col * 2); }
DI s16x8 lds_tr8(const char* base, int krow0, int ncol0, int lane) {
  const int g = lane >> 4, li = lane & 15, qq = li >> 2, pp = li & 3;
  const int off = (krow0 + 8 * (g >> 1) + qq) * 144 + (ncol0 + 16 * (g & 1) + 4 * pp) * 2;
  const s16x4 lo = __builtin_amdgcn_ds_read_tr16_b64_v4i16((__attribute__((address_space(3))) s16x4*)(base + off));
  const s16x4 hi = __builtin_amdgcn_ds_read_tr16_b64_v4i16((__attribute__((address_space(3))) s16x4*)(base + off + 4 * 144));
  return __builtin_shufflevector(lo, hi, 0, 1, 2, 3, 4, 5, 6, 7);
}
DI void unpack16(const uint4 a, const uint4 b, float* f) {
  f[0] = lo2f(a.x); f[1] = hi2f(a.x); f[2] = lo2f(a.y); f[3] = hi2f(a.y); f[4] = lo2f(a.z); f[5] = hi2f(a.z); f[6] = lo2f(a.w); f[7] = hi2f(a.w);
  f[8] = lo2f(b.x); f[9] = hi2f(b.x); f[10] = lo2f(b.y); f[11] = hi2f(b.y); f[12] = lo2f(b.z); f[13] = hi2f(b.z); f[14] = lo2f(b.w); f[15] = hi2f(b.w);
}
DI void store16bf(char* dst, const float* f) {
  *(uint4*)dst = make_uint4(pack2(f[0], f[1]), pack2(f[2], f[3]), pack2(f[4], f[5]), pack2(f[6], f[7]));
  *(uint4*)(dst + 16) = make_uint4(pack2(f[8], f[9]), pack2(f[10], f[11]), pack2(f[12], f[13]), pack2(f[14], f[15]));
}
constexpr int NSEG = 5;
DI int seg_start(int sg) { return sg == 0 ? 0 : (sg == 1 ? 26 : (sg == 2 ? 53 : (sg == 3 ? 80 : (sg == 4 ? 106 : 132)))); }
template <int MODE>
DI void scan_chain_chunked(const Params& p, int j, int cid, int seg, float* SCR, const bf16_t* R, const bf16_t* Kb, const bf16_t* V, bf16_t* Y0, bf16_t* Y1, char* smem, const int TID) {
  const int n = cid >> 5, b = (cid >> 4) & 1, hd = cid & 15;
  const int tid = TID, lane = tid & 63, w = tid >> 6, l31 = lane & 31, hh = lane >> 5;
  const int mi = w >> 1, ni = w & 1;
  const int tok = tid >> 2, q = tid & 3, c0 = 16 * q;
  const bf16_t* LW = (const bf16_t*)(p.ws + OFF_LW);
  const bf16_t* LA = (const bf16_t*)(p.ws + OFF_LA);
  float* BON = (float*)(p.ws + OFF_BON);
  bf16_t* Y = n ? Y1 : Y0;
  float* WZ = (float*)(smem + CS_WZ);
  float* AZ = (float*)(smem + CS_AZ);
  float* AABD = (float*)(smem + CS_AAB + 9216);
  float* TOT = (float*)(smem + CS_TOT);
  float* CL = (float*)(smem + CS_CL);
  float* CST = (float*)(smem + CS_CST);
  __syncthreads();
  {
    const float* w2 = p.r_w2 + (size_t)(j * 2 + n) * 64 * 1024 + hd * 64;
    const float* a2 = p.r_a2 + (size_t)(j * 2 + n) * 64 * 1024 + hd * 64;
    for (int e = tid; e < 4096; e += 256) {
      const int l = e >> 6, col = e & 63;
      *(bf16_t*)(smem + CS_W2T + col * 144 + l * 2) = f2bf(w2[(size_t)l * 1024 + col]);
      *(bf16_t*)(smem + CS_A2T + col * 144 + l * 2) = f2bf(a2[(size_t)l * 1024 + col]);
    }
    for (int e = tid; e < 64 * 72; e += 256) *(bf16_t*)(smem + CS_S0T + e * 2) = 0;
    if (tid < 64) {
      CST[tid] = p.r_w0[(size_t)(j * 2 + n) * 1024 + hd * 64 + tid];
      CST[64 + tid] = p.r_a0[(size_t)(j * 2 + n) * 1024 + hd * 64 + tid];
      CST[128 + tid] = p.r_k_k[(size_t)j * 1024 + hd * 64 + tid];
      CST[192 + tid] = p.r_k_a[(size_t)j * 1024 + hd * 64 + tid];
      CST[256 + tid] = p.r_r_k[(size_t)j * 1024 + hd * 64 + tid];
    }
  }
  f32x16 Sacc, Pacc;
#pragma unroll
  for (int r = 0; r < 16; ++r) { Sacc[r] = 0.f; Pacc[r] = 0.f; }
  if (MODE == 0) {
    for (int e = tid; e < 64 * 72; e += 256) *(bf16_t*)(smem + CS_RT + e * 2) = ((e / 72) == (e % 72)) ? (bf16_t)0x3f80 : (bf16_t)0;
#pragma unroll
    for (int r = 0; r < 16; ++r) Pacc[r] = ((32 * mi + crow(r, hh)) == (32 * ni + l31)) ? 1.f : 0.f;
  } else if (seg > 0) {
    const int jr = tid >> 2, ib = (tid & 3) * 16;
    const float* PQ = SCR + (size_t)(cid * 4) * 8192;
    float nv[16];
#pragma unroll
    for (int e = 0; e < 16; ++e) nv[e] = PQ[4096 + jr * 64 + ib + e];
    for (int sg = 1; sg < seg; ++sg) {
      __syncthreads();
#pragma unroll
      for (int e = 0; e < 16; ++e) WZ[jr * 64 + ib + e] = nv[e];
      __syncthreads();
      const float* Pm = PQ + (size_t)sg * 8192;
#pragma unroll
      for (int e = 0; e < 16; ++e) nv[e] = Pm[4096 + jr * 64 + ib + e];
      for (int jp = 0; jp < 64; jp += 4) {
        const float4 pv = *(const float4*)(Pm + jr * 64 + jp);
#pragma unroll
        for (int e = 0; e < 16; ++e)
          nv[e] += pv.x * WZ[(jp + 0) * 64 + ib + e] + pv.y * WZ[(jp + 1) * 64 + ib + e] + pv.z * WZ[(jp + 2) * 64 + ib + e] + pv.w * WZ[(jp + 3) * 64 + ib + e];
      }
    }
    __syncthreads();
#pragma unroll
    for (int e = 0; e < 16; ++e) WZ[jr * 64 + ib + e] = nv[e];
    __syncthreads();
#pragma unroll
    for (int r = 0; r < 16; ++r) {
      const int rrow = 32 * mi + crow(r, hh), ccol = 32 * ni + l31;
      Sacc[r] = WZ[rrow * 64 + ccol];
      *(bf16_t*)(smem + CS_S0T + rrow * 144 + ccol * 2) = f2bf(Sacc[r]);
    }
    __syncthreads();
  }
  const int ck0 = seg_start(seg), ck1 = seg_start(seg + 1);
  uint4 ur0, ur1, uk0, uk1, uv0, uv1, l0, l1, m0, m1;
#define SCAN_LOAD(CK) { const int row_ = seq_row(n, b, (CK) * 64 + tok); const size_t g_ = (size_t)row_ * D + hd * 64 + c0; \
    ur0 = *(const uint4*)(R + g_); ur1 = *(const uint4*)(R + g_ + 8); uk0 = *(const uint4*)(Kb + g_); uk1 = *(const uint4*)(Kb + g_ + 8); \
    uv0 = *(const uint4*)(V + g_); uv1 = *(const uint4*)(V + g_ + 8); \
    l0 = *(const uint4*)(LW + (size_t)row_ * 128 + n * 64 + c0); l1 = *(const uint4*)(LW + (size_t)row_ * 128 + n * 64 + c0 + 8); \
    m0 = *(const uint4*)(LA + (size_t)row_ * 128 + n * 64 + c0); m1 = *(const uint4*)(LA + (size_t)row_ * 128 + n * 64 + c0 + 8); }
  SCAN_LOAD(ck0)
  for (int ck = ck0; ck < ck1; ++ck) {
    const int row = seq_row(n, b, ck * 64 + tok);
    *(uint4*)(smem + CS_R1 + tok * 144 + c0 * 2) = l0; *(uint4*)(smem + CS_R1 + tok * 144 + c0 * 2 + 16) = l1;
    *(uint4*)(smem + CS_R2 + tok * 144 + c0 * 2) = m0; *(uint4*)(smem + CS_R2 + tok * 144 + c0 * 2 + 16) = m1;
    __syncthreads();
    {
      f32x16 awz, aaz;
#pragma unroll
      for (int r = 0; r < 16; ++r) { awz[r] = 0.f; aaz[r] = 0.f; }
#pragma unroll
      for (int kk = 0; kk < 4; ++kk) {
        const s16x8 alw = lds_row8(smem + CS_R1, 32 * mi + l31, kk * 16 + 8 * hh);
        const s16x8 ala = lds_row8(smem + CS_R2, 32 * mi + l31, kk * 16 + 8 * hh);
        const s16x8 bw = lds_row8(smem + CS_W2T, 32 * ni + l31, kk * 16 + 8 * hh);
        const s16x8 ba = lds_row8(smem + CS_A2T, 32 * ni + l31, kk * 16 + 8 * hh);
        awz = MFMA(alw, bw, awz);
        aaz = MFMA(ala, ba, aaz);
      }
#pragma unroll
      for (int r = 0; r < 16; ++r) {
        const int t = 32 * mi + crow(r, hh), col = 32 * ni + l31;
        WZ[t * 64 + col] = awz[r];
        AZ[t * 64 + col] = aaz[r];
      }
    }
    __syncthreads();
    float lw[16], rr[16], kd[16], av[16], bb[16];
    {
      float kr[16], cw0[16], ca0[16], ckk[16], cka[16], crk[16], wzv[16], azv[16];
      unpack16(ur0, ur1, rr);
      unpack16(uk0, uk1, kr);
#pragma unroll
      for (int e4 = 0; e4 < 4; ++e4) {
        const float4 v0 = *(const float4*)(CST + c0 + e4 * 4), v1 = *(const float4*)(CST + 64 + c0 + e4 * 4), v2 = *(const float4*)(CST + 128 + c0 + e4 * 4);
        const float4 v3 = *(const float4*)(CST + 192 + c0 + e4 * 4), v4 = *(const float4*)(CST + 256 + c0 + e4 * 4);
        const float4 v5 = *(const float4*)(WZ + tok * 64 + c0 + e4 * 4), v6 = *(const float4*)(AZ + tok * 64 + c0 + e4 * 4);
        cw0[e4 * 4] = v0.x; cw0[e4 * 4 + 1] = v0.y; cw0[e4 * 4 + 2] = v0.z; cw0[e4 * 4 + 3] = v0.w;
        ca0[e4 * 4] = v1.x; ca0[e4 * 4 + 1] = v1.y; ca0[e4 * 4 + 2] = v1.z; ca0[e4 * 4 + 3] = v1.w;
        ckk[e4 * 4] = v2.x; ckk[e4 * 4 + 1] = v2.y; ckk[e4 * 4 + 2] = v2.z; ckk[e4 * 4 + 3] = v2.w;
        cka[e4 * 4] = v3.x; cka[e4 * 4 + 1] = v3.y; cka[e4 * 4 + 2] = v3.z; cka[e4 * 4 + 3] = v3.w;
        crk[e4 * 4] = v4.x; crk[e4 * 4 + 1] = v4.y; crk[e4 * 4 + 2] = v4.z; crk[e4 * 4 + 3] = v4.w;
        wzv[e4 * 4] = v5.x; wzv[e4 * 4 + 1] = v5.y; wzv[e4 * 4 + 2] = v5.z; wzv[e4 * 4 + 3] = v5.w;
        azv[e4 * 4] = v6.x; azv[e4 * 4 + 1] = v6.y; azv[e4 * 4 + 2] = v6.z; azv[e4 * 4 + 3] = v6.w;
      }
      float ss = 0.f;
#pragma unroll
      for (int e = 0; e < 16; ++e) { av[e] = kr[e] * ckk[e]; ss += av[e] * av[e]; }
      ss = dpp_add<0xB1>(ss);
      ss = dpp_add<0x4E>(ss);
      const float inv = __frsqrt_rn(fmaxf(ss, 1e-24f));
      float bon = 0.f;
#pragma unroll
      for (int e = 0; e < 16; ++e) {
        const float wz = wzv[e] + cw0[e];
        const float az = azv[e] + ca0[e];
        lw[e] = -0.60653066f * fsig(wz);
        const float as = fsig(az);
        const float kkn = av[e] * inv;
        kd[e] = kr[e] * (1.f + (as - 1.f) * cka[e]);
        bb[e] = kkn * as;
        av[e] = -kkn;
        bon += rr[e] * kd[e] * crk[e];
      }
#pragma unroll
      for (int e4 = 0; e4 < 4; ++e4) *(float4*)(WZ + tok * 64 + c0 + e4 * 4) = make_float4(lw[e4 * 4], lw[e4 * 4 + 1], lw[e4 * 4 + 2], lw[e4 * 4 + 3]);
      bon = dpp_add<0xB1>(bon);
      bon = dpp_add<0x4E>(bon);
      if (MODE == 1 && q == 0) BON[((size_t)n * NR + row) * 16 + hd] = bon;
    }
    __syncthreads();
    {
      const int col = tid & 63, qt = tid >> 6;
      float pv[16];
#pragma unroll
      for (int t = 0; t < 16; ++t) pv[t] = WZ[(16 * qt + t) * 64 + col];
      float sacc = 0.f;
#pragma unroll
      for (int t = 0; t < 16; ++t) { sacc += pv[t]; WZ[(16 * qt + t) * 64 + col] = sacc; }
      TOT[qt * 64 + col] = sacc;
    }
    __syncthreads();
    {
      float fa[16], fr[16], fb[16], fk[16], fv[16];
      unpack16(uv0, uv1, fv);
      const int qt = tok >> 4;
      float tb[16], tt[16], cum[16];
#pragma unroll
      for (int e4 = 0; e4 < 4; ++e4) {
        const float4 t0 = *(const float4*)(TOT + c0 + e4 * 4), t1 = *(const float4*)(TOT + 64 + c0 + e4 * 4);
        const float4 t2 = *(const float4*)(TOT + 128 + c0 + e4 * 4), t3 = *(const float4*)(TOT + 192 + c0 + e4 * 4);
        const float4 cv = *(const float4*)(WZ + tok * 64 + c0 + e4 * 4);
        const float m0_ = qt > 0 ? 1.f : 0.f, m1_ = qt > 1 ? 1.f : 0.f, m2_ = qt > 2 ? 1.f : 0.f;
        tb[e4 * 4] = m0_ * t0.x + m1_ * t1.x + m2_ * t2.x; tb[e4 * 4 + 1] = m0_ * t0.y + m1_ * t1.y + m2_ * t2.y;
        tb[e4 * 4 + 2] = m0_ * t0.z + m1_ * t1.z + m2_ * t2.z; tb[e4 * 4 + 3] = m0_ * t0.w + m1_ * t1.w + m2_ * t2.w;
        tt[e4 * 4] = t0.x + t1.x + t2.x + t3.x; tt[e4 * 4 + 1] = t0.y + t1.y + t2.y + t3.y;
        tt[e4 * 4 + 2] = t0.z + t1.z + t2.z + t3.z; tt[e4 * 4 + 3] = t0.w + t1.w + t2.w + t3.w;
        cum[e4 * 4] = cv.x; cum[e4 * 4 + 1] = cv.y; cum[e4 * 4 + 2] = cv.z; cum[e4 * 4 + 3] = cv.w;
      }
#pragma unroll
      for (int e = 0; e < 16; ++e) {
        const float incl = cum[e] + tb[e];
        const float excl = incl - lw[e];
        const float ei = __expf(incl), ee = __expf(excl), nin = __builtin_amdgcn_rcpf(ei);
        fa[e] = av[e] * ee; fr[e] = rr[e] * ei; fb[e] = bb[e] * nin; fk[e] = kd[e] * nin;
      }
#pragma unroll
      for (int e4 = 0; e4 < 4; ++e4) {
        *(float4*)(WZ + tok * 64 + c0 + e4 * 4) = make_float4(fa[e4 * 4], fa[e4 * 4 + 1], fa[e4 * 4 + 2], fa[e4 * 4 + 3]);
        if (tok == 0) *(float4*)(CL + c0 + e4 * 4) = make_float4(__expf(tt[e4 * 4]), __expf(tt[e4 * 4 + 1]), __expf(tt[e4 * 4 + 2]), __expf(tt[e4 * 4 + 3]));
      }
      store16bf(smem + CS_AT + tok * 144 + c0 * 2, fa);
      if (MODE == 1) store16bf(smem + CS_RT + tok * 144 + c0 * 2, fr);
      store16bf(smem + CS_BT + tok * 144 + c0 * 2, fb);
      store16bf(smem + CS_KT + tok * 144 + c0 * 2, fk);
      *(uint4*)(smem + CS_VT + tok * 144 + c0 * 2) = uv0;
      *(uint4*)(smem + CS_VT + tok * 144 + c0 * 2 + 16) = uv1;
    }
    if (ck + 1 < ck1) SCAN_LOAD(ck + 1)
    __syncthreads();
    {
      f32x16 ab, ak, rb, rk;
#pragma unroll
      for (int r = 0; r < 16; ++r) { ab[r] = 0.f; ak[r] = 0.f; rb[r] = 0.f; rk[r] = 0.f; }
      if (mi >= ni) {
#pragma unroll
        for (int kk = 0; kk < 4; ++kk) {
          const s16x8 aA = lds_row8(smem + CS_AT, 32 * mi + l31, kk * 16 + 8 * hh);
          const s16x8 aR = lds_row8(smem + CS_RT, 32 * mi + l31, kk * 16 + 8 * hh);
          const s16x8 bB = lds_row8(smem + CS_BT, 32 * ni + l31, kk * 16 + 8 * hh);
          const s16x8 bK = lds_row8(smem + CS_KT, 32 * ni + l31, kk * 16 + 8 * hh);
          ab = MFMA(aA, bB, ab); ak = MFMA(aA, bK, ak);
          if (MODE == 1) { rb = MFMA(aR, bB, rb); rk = MFMA(aR, bK, rk); }
        }
      }
#pragma unroll
      for (int r = 0; r < 16; ++r) {
        const int t = 32 * mi + crow(r, hh), sx = 32 * ni + l31;
        const bool lo_s = sx < t, lo_i = sx <= t;
        *(bf16_t*)(smem + CS_AAB + t * 144 + sx * 2) = f2bf(lo_s ? ab[r] : 0.f);
        if ((t >> 4) == (sx >> 4)) AABD[(t >> 4) * 256 + (t & 15) * 16 + (sx & 15)] = lo_s ? ab[r] : 0.f;
        *(bf16_t*)(smem + CS_R1 + t * 144 + sx * 2) = f2bf(lo_s ? ak[r] : 0.f);
        if (MODE == 1) {
          *(bf16_t*)(smem + CS_R2 + t * 144 + sx * 2) = f2bf(lo_i ? rb[r] : 0.f);
          *(bf16_t*)(smem + CS_R3 + t * 144 + sx * 2) = f2bf(lo_i ? rk[r] : 0.f);
        }
      }
    }
    __syncthreads();
    {
      f32x16 xu;
#pragma unroll
      for (int r = 0; r < 16; ++r) xu[r] = 0.f;
#pragma unroll
      for (int kk = 0; kk < 4; ++kk) {
        const s16x8 a = lds_row8(smem + CS_R1, 32 * mi + l31, kk * 16 + 8 * hh);
        const s16x8 bv = lds_tr8(smem + CS_VT, kk * 16, 32 * ni, lane);
        xu = MFMA(a, bv, xu);
      }
#pragma unroll
      for (int r = 0; r < 16; ++r) AZ[(32 * mi + crow(r, hh)) * 64 + 32 * ni + l31] = xu[r];
    }
    __syncthreads();
#pragma unroll
    for (int bk = 0; bk < 4; ++bk) {
      if (tid < 128) {
        float* rhs = (tid < 64) ? (WZ + tid) : (AZ + (tid - 64));
        float x[16], am[16][16];
#pragma unroll
        for (int r = 0; r < 16; ++r) x[r] = rhs[(16 * bk + r) * 64];
#pragma unroll
        for (int tp = 1; tp < 16; ++tp) {
#pragma unroll
          for (int s4 = 0; s4 < (tp + 3) / 4; ++s4) {
            const float4 v = *(const float4*)(AABD + bk * 256 + tp * 16 + s4 * 4);
            am[tp][s4 * 4] = v.x; am[tp][s4 * 4 + 1] = v.y; am[tp][s4 * 4 + 2] = v.z; am[tp][s4 * 4 + 3] = v.w;
          }
        }
#pragma unroll
        for (int sx = 0; sx < 15; ++sx) {
          const float xs = x[sx];
#pragma unroll
          for (int tp = sx + 1; tp < 16; ++tp) x[tp] = fmaf(am[tp][sx], xs, x[tp]);
        }
        char* dst = (tid < 64) ? (smem + CS_AT + tid * 2) : (smem + CS_UV + (tid - 64) * 2);
#pragma unroll
        for (int r = 0; r < 16; ++r) *(bf16_t*)(dst + (16 * bk + r) * 144) = f2bf(x[r]);
      }
      __syncthreads();
      if (bk < 3) {
        const char* xsrc = (w < 2) ? (smem + CS_AT) : (smem + CS_UV);
        float* rdst = (w < 2) ? WZ : AZ;
        const s16x8 bx = lds_tr8(xsrc, 16 * bk, 32 * (w & 1), lane);
#pragma unroll
        for (int rt = 0; rt < 2; ++rt) {
          if (32 * rt + 31 >= 16 * (bk + 1)) {
            f32x16 up;
#pragma unroll
            for (int r = 0; r < 16; ++r) up[r] = 0.f;
            const s16x8 aa = lds_row8(smem + CS_AAB, 32 * rt + l31, 16 * bk + 8 * hh);
            up = MFMA(aa, bx, up);
#pragma unroll
            for (int r = 0; r < 16; ++r) rdst[(32 * rt + crow(r, hh)) * 64 + 32 * (w & 1) + l31] += up[r];
          }
        }
        __syncthreads();
      }
    }
    f32x16 rh, yl, mm, cc;
#pragma unroll
    for (int r = 0; r < 16; ++r) { rh[r] = 0.f; yl[r] = 0.f; mm[r] = 0.f; cc[r] = 0.f; }
#pragma unroll
    for (int kk = 0; kk < 4; ++kk) {
      const s16x8 aRB = lds_row8(smem + CS_R2, 32 * mi + l31, kk * 16 + 8 * hh);
      const s16x8 aRK = lds_row8(smem + CS_R3, 32 * mi + l31, kk * 16 + 8 * hh);
      const s16x8 tAH = lds_tr8(smem + CS_AT, kk * 16, 32 * ni, lane);
      const s16x8 tUV = lds_tr8(smem + CS_UV, kk * 16, 32 * ni, lane);
      const s16x8 tVT = lds_tr8(smem + CS_VT, kk * 16, 32 * ni, lane);
      const s16x8 tBT = lds_tr8(smem + CS_BT, kk * 16, 32 * mi, lane);
      const s16x8 tKT = lds_tr8(smem + CS_KT, kk * 16, 32 * mi, lane);
      if (MODE == 1) {
        rh = MFMA(aRB, tAH, rh);
        yl = MFMA(aRB, tUV, yl);
        yl = MFMA(aRK, tVT, yl);
      }
      mm = MFMA(tBT, tAH, mm);
      cc = MFMA(tBT, tUV, cc);
      cc = MFMA(tKT, tVT, cc);
    }
#pragma unroll
    for (int r = 0; r < 16; ++r) if (MODE == 1) rh[r] += bf2f(*(const bf16_t*)(smem + CS_RT + (32 * mi + crow(r, hh)) * 144 + (32 * ni + l31) * 2));
    __syncthreads();
#pragma unroll
    for (int r = 0; r < 16; ++r) {
      const int rrow = 32 * mi + crow(r, hh), ccol = 32 * ni + l31;
      if (MODE == 1) *(bf16_t*)(smem + CS_R2 + rrow * 144 + ccol * 2) = f2bf(rh[r]);
      *(bf16_t*)(smem + CS_R3 + rrow * 144 + ccol * 2) = f2bf(mm[r]);
    }
    __syncthreads();
    f32x16 pp;
#pragma unroll
    for (int r = 0; r < 16; ++r) pp[r] = 0.f;
#pragma unroll
    for (int kk = 0; kk < 4; ++kk) {
      const s16x8 aMM = lds_row8(smem + CS_R3, 32 * mi + l31, kk * 16 + 8 * hh);
      const s16x8 tS = lds_tr8(smem + CS_S0T, kk * 16, 32 * ni, lane);
      if (MODE == 1) {
        const s16x8 aRH = lds_row8(smem + CS_R2, 32 * mi + l31, kk * 16 + 8 * hh);
        yl = MFMA(aRH, tS, yl);
      } else {
        const s16x8 tP = lds_tr8(smem + CS_RT, kk * 16, 32 * ni, lane);
        pp = MFMA(aMM, tP, pp);
      }
      cc = MFMA(aMM, tS, cc);
    }
#pragma unroll
    for (int r = 0; r < 16; ++r) {
      const float clv = CL[32 * mi + crow(r, hh)];
      Sacc[r] = clv * (Sacc[r] + cc[r]);
      if (MODE == 0) Pacc[r] = clv * (Pacc[r] + pp[r]);
    }
    __syncthreads();
#pragma unroll
    for (int r = 0; r < 16; ++r) {
      const int rrow = 32 * mi + crow(r, hh), ccol = 32 * ni + l31;
      *(bf16_t*)(smem + CS_S0T + rrow * 144 + ccol * 2) = f2bf(Sacc[r]);
      if (MODE == 0) *(bf16_t*)(smem + CS_RT + rrow * 144 + ccol * 2) = f2bf(Pacc[r]);
      if (MODE == 1) {
        const int yrow = seq_row(n, b, ck * 64 + rrow);
        Y[(size_t)yrow * D + hd * 64 + ccol] = f2bf(yl[r]);
      }
    }
  }
  if (MODE == 0 || seg == 0) {
    float* PQ = SCR + (size_t)(cid * 4 + seg) * 8192;
#pragma unroll
    for (int r = 0; r < 16; ++r) {
      const int rrow = 32 * mi + crow(r, hh), ccol = 32 * ni + l31;
      if (MODE == 0) PQ[rrow * 64 + ccol] = Pacc[r];
      PQ[4096 + rrow * 64 + ccol] = Sacc[r];
    }
  }
}

DI void run_phase(const Params& p, int ph, char* smem, const int TID) {
  bf16_t* T0 = (bf16_t*)(p.ws + 0 * SLOT);
  bf16_t* T1 = (bf16_t*)(p.ws + 1 * SLOT);
  bf16_t* T2 = (bf16_t*)(p.ws + 2 * SLOT);
  bf16_t* T3 = (bf16_t*)(p.ws + 3 * SLOT);
  bf16_t* T4 = (bf16_t*)(p.ws + 4 * SLOT);
  bf16_t* T5 = (bf16_t*)(p.ws + 5 * SLOT);
  bf16_t* VF = (bf16_t*)(p.ws + OFF_VF);
  bf16_t* W = (bf16_t*)(p.ws + OFF_W);
  const int tid = TID;
#ifdef ONLY_PHASE
    const int type = ONLY_PHASE, layer = p.player[ph];
#else
    const int type = p.ptype[ph], layer = p.player[ph];
#endif
    const int j = layer >> 1;
    switch (type) {
#ifdef DBG_PREPFILL
      case PH_PREP0: {
        for (size_t i = (size_t)blockIdx.x * 256 + tid; i < (size_t)(1 << 20); i += (size_t)gridDim.x * 256)
          *(uint4*)(T4 + (size_t)(2 << 20) * 8 + i * 8) = make_uint4(0x3f803f80u, 0x3f803f80u, 0x3f803f80u, 0x3f803f80u);
      } break;
#else
      case PH_PREP0: phase_prep0(p, smem, TID); break;
#endif
      case PH_PRE0: {
        for (int it = blockIdx.x; it < 128; it += gridDim.x) fourier_precompose(p, it, smem, TID);
        row_items(p, 0, false, true, NR, nullptr, T0, blockIdx.x, NR / 4, TID);
      } break;
      case PH_FGEMM1: {
        const int MT = NR / 128, NT = 12;
        for (int t = blockIdx.x; t < MT * NT; t += gridDim.x) {
          const int mt = t / NT, nt = t % NT;
          gemm_tile_plain<false, 4>(T0, nullptr, nullptr, 1024, W, 1024, 1024, mt * 128, nt * 256, 3072, smem, TID,
                                    [=](int col0) { return col0 < 1024 ? T1 : (col0 < 2048 ? T2 : T3); });
        }
      } break;
      case PH_FDFT1: {
        const bf16_t* F1 = (const bf16_t*)(p.ws + OFF_F1);
        const bf16_t* FC = (const bf16_t*)(p.ws + OFF_FC);
        const float2* TW = (const float2*)(p.ws + OFF_TW);
        bf16_t* YB = T4;
        const float* bmix = p.f_b_mix + (size_t)j * 1024;
        const int nctx = (layer == 3) ? 0 : 32;
        {
          constexpr int L_B = 0, L_F1 = 40960, L_TW = L_F1 + 128 * 272;
          const int lane = tid & 63, w = tid >> 6, l31 = lane & 31, hh = lane >> 5;
          const int rt0 = w & 1, ctb = 2 * (w >> 1);
          __syncthreads();
#pragma unroll
          for (int i = 0; i < 8; ++i) {
            const int c = tid + 256 * i, r = c >> 4, cc = c & 15;
            *(uint4*)(smem + L_F1 + r * 272 + cc * 16) = *(const uint4*)(F1 + r * 128 + cc * 8);
          }
#pragma unroll
          for (int i = 0; i < 16; ++i) *(uint4*)(smem + L_TW + (tid + 256 * i) * 16) = *(const uint4*)((const char*)TW + (size_t)(tid + 256 * i) * 16);
          uint4 bp0, bp1, bp2, bp3, bp4, bp5, bp6, bp7;
          const int br = tid >> 4, bcc = tid & 15;
          int it = blockIdx.x;
          if (it < 2048) {
              const int itn_ = it;
              const int b_ = itn_ >> 10, t2_ = (itn_ >> 3) & 127, cb_ = itn_ & 7;
              const size_t tok0_ = (size_t)b_ * 8192 + t2_;
              { const int kr = br + 0; bp0 = *(const uint4*)((kr < 64 ? T1 + (tok0_ + (size_t)kr * 128) * D : T2 + (tok0_ + (size_t)(kr - 64) * 128) * D) + cb_ * 128 + bcc * 8); }
              { const int kr = br + 16; bp1 = *(const uint4*)((kr < 64 ? T1 + (tok0_ + (size_t)kr * 128) * D : T2 + (tok0_ + (size_t)(kr - 64) * 128) * D) + cb_ * 128 + bcc * 8); }
              { const int kr = br + 32; bp2 = *(const uint4*)((kr < 64 ? T1 + (tok0_ + (size_t)kr * 128) * D : T2 + (tok0_ + (size_t)(kr - 64) * 128) * D) + cb_ * 128 + bcc * 8); }
              { const int kr = br + 48; bp3 = *(const uint4*)((kr < 64 ? T1 + (tok0_ + (size_t)kr * 128) * D : T2 + (tok0_ + (size_t)(kr - 64) * 128) * D) + cb_ * 128 + bcc * 8); }
              { const int kr = br + 64; bp4 = *(const uint4*)((kr < 64 ? T1 + (tok0_ + (size_t)kr * 128) * D : T2 + (tok0_ + (size_t)(kr - 64) * 128) * D) + cb_ * 128 + bcc * 8); }
              { const int kr = br + 80; bp5 = *(const uint4*)((kr < 64 ? T1 + (tok0_ + (size_t)kr * 128) * D : T2 + (tok0_ + (size_t)(kr - 64) * 128) * D) + cb_ * 128 + bcc * 8); }
              { const int kr = br + 96; bp6 = *(const uint4*)((kr < 64 ? T1 + (tok0_ + (size_t)kr * 128) * D : T2 + (tok0_ + (size_t)(kr - 64) * 128) * D) + cb_ * 128 + bcc * 8); }
              { const int kr = br + 112; bp7 = *(const uint4*)((kr < 64 ? T1 + (tok0_ + (size_t)kr * 128) * D : T2 + (tok0_ + (size_t)(kr - 64) * 128) * D) + cb_ * 128 + bcc * 8); }
            }
          for (; it < 2048; it += gridDim.x) {
            const int b = it >> 10, t2 = (it >> 3) & 127, cb = it & 7;
            __syncthreads();
            *(uint4*)(smem + L_B + (br + 0) * 320 + bcc * 16) = bp0;
            *(uint4*)(smem + L_B + (br + 16) * 320 + bcc * 16) = bp1;
            *(uint4*)(smem + L_B + (br + 32) * 320 + bcc * 16) = bp2;
            *(uint4*)(smem + L_B + (br + 48) * 320 + bcc * 16) = bp3;
            *(uint4*)(smem + L_B + (br + 64) * 320 + bcc * 16) = bp4;
            *(uint4*)(smem + L_B + (br + 80) * 320 + bcc * 16) = bp5;
            *(uint4*)(smem + L_B + (br + 96) * 320 + bcc * 16) = bp6;
            *(uint4*)(smem + L_B + (br + 112) * 320 + bcc * 16) = bp7;
            __syncthreads();
            if (it + (int)gridDim.x < 2048) {
              const int itn_ = it + (int)gridDim.x;
              const int b_ = itn_ >> 10, t2_ = (itn_ >> 3) & 127, cb_ = itn_ & 7;
              const size_t tok0_ = (size_t)b_ * 8192 + t2_;
              { const int kr = br + 0; bp0 = *(const uint4*)((kr < 64 ? T1 + (tok0_ + (size_t)kr * 128) * D : T2 + (tok0_ + (size_t)(kr - 64) * 128) * D) + cb_ * 128 + bcc * 8); }
              { const int kr = br + 16; bp1 = *(const uint4*)((kr < 64 ? T1 + (tok0_ + (size_t)kr * 128) * D : T2 + (tok0_ + (size_t)(kr - 64) * 128) * D) + cb_ * 128 + bcc * 8); }
              { const int kr = br + 32; bp2 = *(const uint4*)((kr < 64 ? T1 + (tok0_ + (size_t)kr * 128) * D : T2 + (tok0_ + (size_t)(kr - 64) * 128) * D) + cb_ * 128 + bcc * 8); }
              { const int kr = br + 48; bp3 = *(const uint4*)((kr < 64 ? T1 + (tok0_ + (size_t)kr * 128) * D : T2 + (tok0_ + (size_t)(kr - 64) * 128) * D) + cb_ * 128 + bcc * 8); }
              { const int kr = br + 64; bp4 = *(const uint4*)((kr < 64 ? T1 + (tok0_ + (size_t)kr * 128) * D : T2 + (tok0_ + (size_t)(kr - 64) * 128) * D) + cb_ * 128 + bcc * 8); }
              { const int kr = br + 80; bp5 = *(const uint4*)((kr < 64 ? T1 + (tok0_ + (size_t)kr * 128) * D : T2 + (tok0_ + (size_t)(kr - 64) * 128) * D) + cb_ * 128 + bcc * 8); }
              { const int kr = br + 96; bp6 = *(const uint4*)((kr < 64 ? T1 + (tok0_ + (size_t)kr * 128) * D : T2 + (tok0_ + (size_t)(kr - 64) * 128) * D) + cb_ * 128 + bcc * 8); }
              { const int kr = br + 112; bp7 = *(const uint4*)((kr < 64 ? T1 + (tok0_ + (size_t)kr * 128) * D : T2 + (tok0_ + (size_t)(kr - 64) * 128) * D) + cb_ * 128 + bcc * 8); }
            }
            f32x16 acc[2][2];
#pragma unroll
            for (int i = 0; i < 2; ++i)
#pragma unroll
              for (int jj = 0; jj < 2; ++jj)
#pragma unroll
                for (int r = 0; r < 16; ++r) acc[i][jj][r] = 0.f;
            const int g = lane >> 4, li = lane & 15, qq = li >> 2, pp = li & 3;
            const int tr_base = (8 * (g >> 1) + qq) * 320 + (16 * (g & 1) + 4 * pp) * 2;
#pragma unroll
            for (int ks = 0; ks < 8; ++ks) {
              s16x8 af[2];
#pragma unroll
              for (int h = 0; h < 2; ++h) af[h] = *(const s16x8*)(smem + L_F1 + (32 * (rt0 + 2 * h) + l31) * 272 + (ks * 16 + hh * 8) * 2);
#pragma unroll
              for (int c2 = 0; c2 < 2; ++c2) {
                const int off = L_B + tr_base + ks * 16 * 320 + (ctb + c2) * 64;
                const s16x4 lo = __builtin_amdgcn_ds_read_tr16_b64_v4i16((__attribute__((address_space(3))) s16x4*)(smem + off));
                const s16x4 hi = __builtin_amdgcn_ds_read_tr16_b64_v4i16((__attribute__((address_space(3))) s16x4*)(smem + off + 4 * 320));
                const s16x8 bq = __builtin_shufflevector(lo, hi, 0, 1, 2, 3, 4, 5, 6, 7);
#pragma unroll
                for (int h = 0; h < 2; ++h) acc[h][c2] = MFMA(af[h], bq, acc[h][c2]);
              }
            }
#pragma unroll
            for (int c2 = 0; c2 < 2; ++c2) {
              const int col = 32 * (ctb + c2) + l31;
#pragma unroll
              for (int r = 0; r < 16; ++r) {
                const int k1 = 32 * rt0 + crow(r, hh);
                const float2 tw = *(const float2*)(smem + L_TW + (k1 * 128 + t2) * 8);
                const float va = acc[0][c2][r], vb = acc[1][c2][r];
                const float yr = va * tw.x - vb * tw.y, yi = va * tw.y + vb * tw.x;
                bf16_t* d = YB + ((size_t)b * 8192 + k1 * 128 + t2) * 2048 + cb * 128 + col;
                d[0] = f2bf(yr); d[1024] = f2bf(yi);
              }
            }
          }
        }
        for (int it = 2048 + blockIdx.x; it < 2048 + nctx; it += gridDim.x) {
          {
            const int u = it - 2048, b = u >> 4, cb = (u >> 1) & 7, mh = u & 1;
            const size_t tok0 = (size_t)NLAT + b * 256;
            const float scale = 0.005524271728019903f;
            dft_tile(FC, 512, mh * 128, 256, T1 + tok0 * D + cb * 128, T2 + tok0 * D + cb * 128, D, 1, smem, TID,
                     [=](int rowA, int rowB, int col, float va, float vb) {
                       const int cc = cb * 128 + col;
                       bf16_t* z0 = T3 + (tok0 + mh * 128 + rowA) * D + cc;
                       bf16_t* z1 = T3 + (tok0 + mh * 128 + rowB) * D + cc;
                       const float bm = bmix[cc];
                       z0[0] = f2bf((va * scale + bm) * silu_f(bf2f(z0[0])));
                       z1[0] = f2bf((vb * scale + bm) * silu_f(bf2f(z1[0])));
                     });
          }
        }
      } break;
      case PH_FDFT3: {
        const bf16_t* F2 = (const bf16_t*)(p.ws + OFF_F2);
        const bf16_t* YB = T4;
        const float* bmix = p.f_b_mix + (size_t)j * 1024;
        const float scale = 0.0009765625f;
        constexpr int L_B = 0, L_F2 = 256 * 320;
        const int lane = tid & 63, w = tid >> 6, l31 = lane & 31, hh = lane >> 5;
        const int rt0 = w & 1, ctb = 2 * (w >> 1);
        const int br = tid >> 4, bcc = tid & 15;
        __syncthreads();
#pragma unroll
        for (int i = 0; i < 16; ++i) {
          const int c = tid + 256 * i, r = c >> 5, cc = c & 31;
          *(uint4*)(smem + L_F2 + r * 528 + cc * 16) = *(const uint4*)(F2 + r * 256 + cc * 8);
        }
        uint4 bp0, bp1, bp2, bp3, bp4, bp5, bp6, bp7, bp8, bp9, bp10, bp11, bp12, bp13, bp14, bp15;
        int it = blockIdx.x;
        if (it < 1024) {
          const int b_ = it >> 9, k1_ = (it >> 3) & 63, cb_ = it & 7;
          const size_t tok0_ = (size_t)b_ * 8192 + k1_ * 128;
              bp0 = *(const uint4*)(YB + (tok0_ + (size_t)(br + 0)) * 2048 + 0 + cb_ * 128 + bcc * 8);
              bp1 = *(const uint4*)(YB + (tok0_ + (size_t)(br + 16)) * 2048 + 0 + cb_ * 128 + bcc * 8);
              bp2 = *(const uint4*)(YB + (tok0_ + (size_t)(br + 32)) * 2048 + 0 + cb_ * 128 + bcc * 8);
              bp3 = *(const uint4*)(YB + (tok0_ + (size_t)(br + 48)) * 2048 + 0 + cb_ * 128 + bcc * 8);
              bp4 = *(const uint4*)(YB + (tok0_ + (size_t)(br + 64)) * 2048 + 0 + cb_ * 128 + bcc * 8);
              bp5 = *(const uint4*)(YB + (tok0_ + (size_t)(br + 80)) * 2048 + 0 + cb_ * 128 + bcc * 8);
              bp6 = *(const uint4*)(YB + (tok0_ + (size_t)(br + 96)) * 2048 + 0 + cb_ * 128 + bcc * 8);
              bp7 = *(const uint4*)(YB + (tok0_ + (size_t)(br + 112)) * 2048 + 0 + cb_ * 128 + bcc * 8);
              bp8 = *(const uint4*)(YB + (tok0_ + (size_t)(br + 0)) * 2048 + 1024 + cb_ * 128 + bcc * 8);
              bp9 = *(const uint4*)(YB + (tok0_ + (size_t)(br + 16)) * 2048 + 1024 + cb_ * 128 + bcc * 8);
              bp10 = *(const uint4*)(YB + (tok0_ + (size_t)(br + 32)) * 2048 + 1024 + cb_ * 128 + bcc * 8);
              bp11 = *(const uint4*)(YB + (tok0_ + (size_t)(br + 48)) * 2048 + 1024 + cb_ * 128 + bcc * 8);
              bp12 = *(const uint4*)(YB + (tok0_ + (size_t)(br + 64)) * 2048 + 1024 + cb_ * 128 + bcc * 8);
              bp13 = *(const uint4*)(YB + (tok0_ + (size_t)(br + 80)) * 2048 + 1024 + cb_ * 128 + bcc * 8);
              bp14 = *(const uint4*)(YB + (tok0_ + (size_t)(br + 96)) * 2048 + 1024 + cb_ * 128 + bcc * 8);
              bp15 = *(const uint4*)(YB + (tok0_ + (size_t)(br + 112)) * 2048 + 1024 + cb_ * 128 + bcc * 8);
        }
        for (; it < 1024; it += gridDim.x) {
          const int b = it >> 9, k1 = (it >> 3) & 63, cb = it & 7;
          __syncthreads();
            *(uint4*)(smem + L_B + (0 + br + 0) * 320 + bcc * 16) = bp0;
            *(uint4*)(smem + L_B + (0 + br + 16) * 320 + bcc * 16) = bp1;
            *(uint4*)(smem + L_B + (0 + br + 32) * 320 + bcc * 16) = bp2;
            *(uint4*)(smem + L_B + (0 + br + 48) * 320 + bcc * 16) = bp3;
            *(uint4*)(smem + L_B + (0 + br + 64) * 320 + bcc * 16) = bp4;
            *(uint4*)(smem + L_B + (0 + br + 80) * 320 + bcc * 16) = bp5;
            *(uint4*)(smem + L_B + (0 + br + 96) * 320 + bcc * 16) = bp6;
            *(uint4*)(smem + L_B + (0 + br + 112) * 320 + bcc * 16) = bp7;
            *(uint4*)(smem + L_B + (128 + br + 0) * 320 + bcc * 16) = bp8;
            *(uint4*)(smem + L_B + (128 + br + 16) * 320 + bcc * 16) = bp9;
            *(uint4*)(smem + L_B + (128 + br + 32) * 320 + bcc * 16) = bp10;
            *(uint4*)(smem + L_B + (128 + br + 48) * 320 + bcc * 16) = bp11;
            *(uint4*)(smem + L_B + (128 + br + 64) * 320 + bcc * 16) = bp12;
            *(uint4*)(smem + L_B + (128 + br + 80) * 320 + bcc * 16) = bp13;
            *(uint4*)(smem + L_B + (128 + br + 96) * 320 + bcc * 16) = bp14;
            *(uint4*)(smem + L_B + (128 + br + 112) * 320 + bcc * 16) = bp15;
          __syncthreads();
          if (it + (int)gridDim.x < 1024) {
            const int itn_ = it + (int)gridDim.x;
            const int b_ = itn_ >> 9, k1_ = (itn_ >> 3) & 63, cb_ = itn_ & 7;
            const size_t tok0_ = (size_t)b_ * 8192 + k1_ * 128;
              bp0 = *(const uint4*)(YB + (tok0_ + (size_t)(br + 0)) * 2048 + 0 + cb_ * 128 + bcc * 8);
              bp1 = *(const uint4*)(YB + (tok0_ + (size_t)(br + 16)) * 2048 + 0 + cb_ * 128 + bcc * 8);
              bp2 = *(const uint4*)(YB + (tok0_ + (size_t)(br + 32)) * 2048 + 0 + cb_ * 128 + bcc * 8);
              bp3 = *(const uint4*)(YB + (tok0_ + (size_t)(br + 48)) * 2048 + 0 + cb_ * 128 + bcc * 8);
              bp4 = *(const uint4*)(YB + (tok0_ + (size_t)(br + 64)) * 2048 + 0 + cb_ * 128 + bcc * 8);
              bp5 = *(const uint4*)(YB + (tok0_ + (size_t)(br + 80)) * 2048 + 0 + cb_ * 128 + bcc * 8);
              bp6 = *(const uint4*)(YB + (tok0_ + (size_t)(br + 96)) * 2048 + 0 + cb_ * 128 + bcc * 8);
              bp7 = *(const uint4*)(YB + (tok0_ + (size_t)(br + 112)) * 2048 + 0 + cb_ * 128 + bcc * 8);
              bp8 = *(const uint4*)(YB + (tok0_ + (size_t)(br + 0)) * 2048 + 1024 + cb_ * 128 + bcc * 8);
              bp9 = *(const uint4*)(YB + (tok0_ + (size_t)(br + 16)) * 2048 + 1024 + cb_ * 128 + bcc * 8);
              bp10 = *(const uint4*)(YB + (tok0_ + (size_t)(br + 32)) * 2048 + 1024 + cb_ * 128 + bcc * 8);
              bp11 = *(const uint4*)(YB + (tok0_ + (size_t)(br + 48)) * 2048 + 1024 + cb_ * 128 + bcc * 8);
              bp12 = *(const uint4*)(YB + (tok0_ + (size_t)(br + 64)) * 2048 + 1024 + cb_ * 128 + bcc * 8);
              bp13 = *(const uint4*)(YB + (tok0_ + (size_t)(br + 80)) * 2048 + 1024 + cb_ * 128 + bcc * 8);
              bp14 = *(const uint4*)(YB + (tok0_ + (size_t)(br + 96)) * 2048 + 1024 + cb_ * 128 + bcc * 8);
              bp15 = *(const uint4*)(YB + (tok0_ + (size_t)(br + 112)) * 2048 + 1024 + cb_ * 128 + bcc * 8);
          }
          f32x16 acc[2][2];
#pragma unroll
          for (int i = 0; i < 2; ++i)
#pragma unroll
            for (int jj = 0; jj < 2; ++jj)
#pragma unroll
              for (int r = 0; r < 16; ++r) acc[i][jj][r] = 0.f;
          const int g = lane >> 4, li = lane & 15, qq = li >> 2, pp = li & 3;
          const int tr_base = (8 * (g >> 1) + qq) * 320 + (16 * (g & 1) + 4 * pp) * 2;
#pragma unroll
          for (int ks = 0; ks < 16; ++ks) {
            s16x8 af[2];
#pragma unroll
            for (int h = 0; h < 2; ++h) af[h] = *(const s16x8*)(smem + L_F2 + (32 * (rt0 + 2 * h) + l31) * 528 + (ks * 16 + hh * 8) * 2);
#pragma unroll
            for (int c2 = 0; c2 < 2; ++c2) {
              const int off = L_B + tr_base + ks * 16 * 320 + (ctb + c2) * 64;
              const s16x4 lo = __builtin_amdgcn_ds_read_tr16_b64_v4i16((__attribute__((address_space(3))) s16x4*)(smem + off));
              const s16x4 hi = __builtin_amdgcn_ds_read_tr16_b64_v4i16((__attribute__((address_space(3))) s16x4*)(smem + off + 4 * 320));
              const s16x8 bq = __builtin_shufflevector(lo, hi, 0, 1, 2, 3, 4, 5, 6, 7);
#pragma unroll
              for (int h = 0; h < 2; ++h) acc[h][c2] = MFMA(af[h], bq, acc[h][c2]);
            }
          }
#pragma unroll
          for (int c2 = 0; c2 < 2; ++c2) {
            const int cc = cb * 128 + 32 * (ctb + c2) + l31;
            const float bm = bmix[cc];
#pragma unroll
            for (int r = 0; r < 16; ++r) {
              const int rowA = 32 * rt0 + crow(r, hh);
              if ((r & 3) == 0) asm volatile("" ::: "memory");
              bf16_t* z0 = T3 + ((size_t)b * 8192 + k1 + 64 * rowA) * D + cc;
              bf16_t* z1 = T3 + ((size_t)b * 8192 + k1 + 64 * (rowA + 64)) * D + cc;
              z0[0] = f2bf((acc[0][c2][r] * scale + bm) * silu_f(bf2f(z0[0])));
              z1[0] = f2bf((acc[1][c2][r] * scale + bm) * silu_f(bf2f(z1[0])));
            }
          }
        }
      } break;
      case PH_FOUT: {
        const int NBIG = 512, NSMALL = (NR / 128 * 4 - NBIG) * 2;
        for (int t = blockIdx.x; t < NBIG + NSMALL; t += gridDim.x) {
          if (t < NBIG) {
            const int mt = t / 4, nt = t % 4;
            gemm_tile_plain<false, 4>(T3, nullptr, nullptr, 1024, W + (size_t)3072 * 1024, 1024, 1024, mt * 128, nt * 256, 1024, smem, TID,
                                       [=](int) { return T1; });
          } else {
            const int u = t - NBIG, mt = 128 + u / 8, nt = u % 8;
            gemm_tile_plain<false, 2>(T3, nullptr, nullptr, 1024, W + (size_t)3072 * 1024, 1024, 1024, mt * 128, nt * 128, 1024, smem, TID,
                                       [=](int) { return T1; });
          }
        }
      } break;
      case PH_POSTPRE: {
        const int nl = layer + 1;
        if (nl & 1) { for (int it = blockIdx.x; it < N_RWPREP; it += gridDim.x) rwkv_wprep(p, nl >> 1, it, smem, TID); }
        else {
          for (int it = blockIdx.x; it < 128 + N_FWPREP; it += gridDim.x) {
            if (it < 128) fourier_precompose(p, it, smem, TID); else fourier_wprep(p, nl >> 1, it - 128, smem, TID);
          }
        }
        const bf16_t* O = (layer & 1) ? T2 : T1;
        row_items(p, layer, true, true, NR, O, T0, blockIdx.x, NR / 4, TID);
      } break;
      case PH_RSHIFT: {
        for (int idx = blockIdx.x * 256 + tid; idx < NR * 128; idx += gridDim.x * 256) {
          const int row = idx >> 7, cc = (idx & 127) * 8;
          bool ok0, ok1, ok2, ok3; float wgt;
          if (row < NLAT) {
            const int t = row & 8191, gy = t >> 6, gx = t & 63;
            wgt = 0.25f;
            ok0 = gy > 0; ok1 = gy < 127; ok2 = gx > 0; ok3 = gx < 63;
          } else {
            const int t = (row - NLAT) & 255;
            wgt = 0.5f;
            ok0 = false; ok1 = false; ok2 = t > 0; ok3 = t < 255;
          }
          float a[8] = {0, 0, 0, 0, 0, 0, 0, 0};
#pragma unroll
          for (int q = 0; q < 4; ++q) {
            const bool ok = q == 0 ? ok0 : (q == 1 ? ok1 : (q == 2 ? ok2 : ok3));
            const int nrow = q == 0 ? row - 64 : (q == 1 ? row + 64 : (q == 2 ? row - 1 : row + 1));
            if (ok) {
              const uint4 u = *(const uint4*)(T0 + (size_t)nrow * D + cc);
              a[0] += lo2f(u.x); a[1] += hi2f(u.x); a[2] += lo2f(u.y); a[3] += hi2f(u.y);
              a[4] += lo2f(u.z); a[5] += hi2f(u.z); a[6] += lo2f(u.w); a[7] += hi2f(u.w);
            }
          }
          *(uint4*)(T1 + (size_t)row * D + cc) = make_uint4(pack2(a[0] * wgt, a[1] * wgt), pack2(a[2] * wgt, a[3] * wgt),
                                                            pack2(a[4] * wgt, a[5] * wgt), pack2(a[6] * wgt, a[7] * wgt));
        }
        if (layer == 1) {
          for (int it = blockIdx.x; it < N_CWPREP; it += gridDim.x) fourier_cw_prep(p, 1, it, smem, TID);
        }
      } break;
      case PH_RINPROJ: {
        const int N = (j >= 1) ? 4384 : 4352;
        const int MT = NR / 128;
        const int NT_MAIN = 16, NT_TAIL = (N - 4096 + 127) / 128, NT = NT_MAIN + NT_TAIL;
        bf16_t* Vd = (j == 0) ? VF : T5;
        bf16_t* LW = (bf16_t*)(p.ws + OFF_LW);
        bf16_t* LA = (bf16_t*)(p.ws + OFF_LA);
        bf16_t* LV = (bf16_t*)(p.ws + OFF_LV);
        for (int t = blockIdx.x; t < MT * NT; t += gridDim.x) {
          const int mt = t / NT, nt = t % NT;
          if (nt < NT_MAIN) {
            const int n0 = nt * 256;
            const float* mu = p.r_mu + (size_t)(j * 6 + (n0 >> 10)) * 1024;
            gemm_tile_plain<true, 4>(T0, T1, mu, 1024, W, 1024, 1024, mt * 128, n0, 4096, smem, TID,
                                     [=](int col0) { return col0 < 1024 ? T2 : (col0 < 2048 ? T3 : (col0 < 3072 ? Vd : T4)); });
          } else {
            const int n0 = 4096 + (nt - NT_MAIN) * 128;
            const int pi = n0 < 4224 ? 4 : (n0 < 4352 ? 5 : 2);
            const float* mu = p.r_mu + (size_t)(j * 6 + pi) * 1024;
            gemm_tile_n<true, 2>(T0, T1, mu, 1024, W, 1024, 1024, mt * 128, n0, N, smem, TID, [=](int row, int col, float v) {
              if (col < 4224) LW[(size_t)row * 128 + (col - 4096)] = f2bf(tanhf(v));
              else if (col < 4352) LA[(size_t)row * 128 + (col - 4224)] = f2bf(v);
              else LV[(size_t)row * 32 + (col - 4352)] = f2bf(v);
            });
          }
        }
      } break;
      case PH_RVUPD: {
        const bf16_t* LV = (const bf16_t*)(p.ws + OFF_LV);
        const float* v2 = p.r_v2 + (size_t)(j - 1) * 32 * 1024;
        const float* v0 = p.r_v0 + (size_t)(j - 1) * 1024;
        float* v2s = (float*)smem;
        __syncthreads();
        for (int e = tid; e < 32 * 256; e += 256) *(float4*)(v2s + e * 4) = *(const float4*)(v2 + e * 4);
        __syncthreads();
        const int wave = tid >> 6, lane = tid & 63;
        for (int row = blockIdx.x * 4 + wave; row < NR; row += gridDim.x * 4) {
          const float lvl = bf2f(LV[(size_t)row * 32 + (lane & 31)]);
          float acc[16];
#pragma unroll
          for (int qd = 0; qd < 4; ++qd) {
            const float4 t = *(const float4*)(v0 + qd * 256 + lane * 4);
            acc[qd * 4] = t.x; acc[qd * 4 + 1] = t.y; acc[qd * 4 + 2] = t.z; acc[qd * 4 + 3] = t.w;
          }
#pragma unroll 4
          for (int l = 0; l < 32; ++l) {
            const float a = __int_as_float(__builtin_amdgcn_readlane(__float_as_int(lvl), l));
#pragma unroll
            for (int qd = 0; qd < 4; ++qd) {
              const float4 wv = *(const float4*)(v2s + l * 1024 + qd * 256 + lane * 4);
              acc[qd * 4] += a * wv.x; acc[qd * 4 + 1] += a * wv.y; acc[qd * 4 + 2] += a * wv.z; acc[qd * 4 + 3] += a * wv.w;
            }
          }
#pragma unroll
          for (int qd = 0; qd < 4; ++qd) {
            const size_t idx = (size_t)row * D + qd * 256 + lane * 4;
            const uint2 uv = *(const uint2*)(T5 + idx);
            const uint2 uf = *(const uint2*)(VF + idx);
            float v[4] = {lo2f(uv.x), hi2f(uv.x), lo2f(uv.y), hi2f(uv.y)};
            const float f[4] = {lo2f(uf.x), hi2f(uf.x), lo2f(uf.y), hi2f(uf.y)};
#pragma unroll
            for (int e = 0; e < 4; ++e) v[e] = v[e] + (f[e] - v[e]) * fsig(acc[qd * 4 + e]);
            *(uint2*)(T5 + idx) = make_uint2(pack2(v[0], v[1]), pack2(v[2], v[3]));
          }
        }
      } break;
      case PH_RSCANA: {
        const bf16_t* V = (j == 0) ? VF : T5;
        float* SCR = (j == 0) ? (float*)(p.ws + 5 * SLOT + (8u << 20)) : (float*)(p.ws + OFF_VF);
        for (int it = blockIdx.x; it < 64 * 4; it += gridDim.x) {
          const int cid = it >> 2, k = it & 3;
          int tl = TID;
          asm volatile("" : "+v"(tl));
          if (k == 0) scan_chain_chunked<1>(p, j, cid, 0, SCR, T2, T3, V, T0, T1, smem, tl);
          else scan_chain_chunked<0>(p, j, cid, k, SCR, T2, T3, V, T0, T1, smem, tl);
        }
      } break;
      case PH_RSCAN: {
        const bf16_t* V = (j == 0) ? VF : T5;
        float* SCR = (j == 0) ? (float*)(p.ws + 5 * SLOT + (8u << 20)) : (float*)(p.ws + OFF_VF);
        for (int it = blockIdx.x; it < 64 * 4; it += gridDim.x)
          scan_chain_chunked<1>(p, j, it >> 2, 1 + (it & 3), SCR, T2, T3, V, T0, T1, smem, TID);
      } break;
      case PH_ROUTPUT: {
        const bf16_t* V = (j == 0) ? VF : T5;
        const float* BON = (const float*)(p.ws + OFF_BON);
        const int wave = tid >> 6, lane = tid & 63;
        const int nrows = (layer == 3) ? NLAT : NR;
        for (int wi = blockIdx.x * 4 + wave; wi < nrows * 2; wi += gridDim.x * 4) {
          const int row = wi >> 1, c = (wi & 1) * 512 + lane * 8, h = c >> 6;
          const size_t idx = (size_t)row * D + c;
          const uint4 u0 = *(const uint4*)(T0 + idx), u1 = *(const uint4*)(T1 + idx), uv = *(const uint4*)(V + idx), ug = *(const uint4*)(T4 + idx);
          const float4 w0 = *(const float4*)(p.r_ln_w + (size_t)j * 1024 + c), w1 = *(const float4*)(p.r_ln_w + (size_t)j * 1024 + c + 4);
          const float4 b0 = *(const float4*)(p.r_ln_b + (size_t)j * 1024 + c), b1 = *(const float4*)(p.r_ln_b + (size_t)j * 1024 + c + 4);
          const float bon = BON[((size_t)0 * NR + row) * 16 + h] + BON[((size_t)1 * NR + row) * 16 + h];
          float y[8] = {lo2f(u0.x) + lo2f(u1.x), hi2f(u0.x) + hi2f(u1.x), lo2f(u0.y) + lo2f(u1.y), hi2f(u0.y) + hi2f(u1.y),
                        lo2f(u0.z) + lo2f(u1.z), hi2f(u0.z) + hi2f(u1.z), lo2f(u0.w) + lo2f(u1.w), hi2f(u0.w) + hi2f(u1.w)};
          const float vf[8] = {lo2f(uv.x), hi2f(uv.x), lo2f(uv.y), hi2f(uv.y), lo2f(uv.z), hi2f(uv.z), lo2f(uv.w), hi2f(uv.w)};
          const float gf[8] = {lo2f(ug.x), hi2f(ug.x), lo2f(ug.y), hi2f(ug.y), lo2f(ug.z), hi2f(ug.z), lo2f(ug.w), hi2f(ug.w)};
          const float lw8[8] = {w0.x, w0.y, w0.z, w0.w, w1.x, w1.y, w1.z, w1.w};
          const float lb8[8] = {b0.x, b0.y, b0.z, b0.w, b1.x, b1.y, b1.z, b1.w};
          float sm = 0.f;
#pragma unroll
          for (int e = 0; e < 8; ++e) sm += y[e];
          sm += __shfl_xor(sm, 1, 64); sm += __shfl_xor(sm, 2, 64); sm += __shfl_xor(sm, 4, 64);
          const float mean = sm * (1.f / 64.f);
          float vr = 0.f;
#pragma unroll
          for (int e = 0; e < 8; ++e) { y[e] -= mean; vr += y[e] * y[e]; }
          vr += __shfl_xor(vr, 1, 64); vr += __shfl_xor(vr, 2, 64); vr += __shfl_xor(vr, 4, 64);
          const float rstd = rsqrtf(vr * (1.f / 64.f) + GN_EPS);
          float o[8];
#pragma unroll
          for (int e = 0; e < 8; ++e) o[e] = (y[e] * rstd * lw8[e] + lb8[e] + bon * vf[e]) * silu_f(gf[e]);
          *(uint4*)(T4 + idx) = make_uint4(pack2(o[0], o[1]), pack2(o[2], o[3]), pack2(o[4], o[5]), pack2(o[6], o[7]));
        }
      } break;
      case PH_ROUTPROJ: {
        const int MT = ((layer == 3) ? NLAT : NR) / 128;
        const int NBIG = 512, NSMALL = (MT * 4 - NBIG) * 2;
        for (int t = blockIdx.x; t < NBIG + NSMALL; t += gridDim.x) {
          if (t < NBIG) {
            const int mt = t / 4, nt = t % 4;
            gemm_tile_plain<false, 4>(T4, nullptr, nullptr, 1024, W + (size_t)4384 * 1024, 1024, 1024, mt * 128, nt * 256, 1024, smem, TID,
                                       [=](int) { return T2; });
          } else {
            const int u = t - NBIG, mt = 128 + u / 8, nt = u % 8;
            gemm_tile_plain<false, 2>(T4, nullptr, nullptr, 1024, W + (size_t)4384 * 1024, 1024, 1024, mt * 128, nt * 128, 1024, smem, TID,
                                       [=](int) { return T2; });
          }
        }
      } break;
      case PH_POSTLAST: {
        row_items(p, layer, true, false, NLAT, T2, nullptr, blockIdx.x, NLAT / 4, TID);
      } break;
    }
}

#define XB_TMO      128
#define XB_XCNT(j)  (256  + 64 * (j))
#define XB_XSUB(j)  (1280 + 64 * (j))
#define XB_XGEN(j)  (2304 + 64 * (j))
#define XB_TOP      3328
#define XB_TOPGEN   3392
#define XCD_BAR_WORDS 3456
#define XB_SPIN_CAP (1u << 23)
#define LAS __attribute__((address_space(3)))

__device__ __forceinline__ unsigned xb_ld(unsigned* p)              { return __hip_atomic_load(p, __ATOMIC_RELAXED, __HIP_MEMORY_SCOPE_AGENT); }
__device__ __forceinline__ unsigned xb_add(unsigned* p, unsigned v) { return __hip_atomic_fetch_add(p, v, __ATOMIC_RELAXED, __HIP_MEMORY_SCOPE_AGENT); }
__device__ __forceinline__ unsigned xb_xcc_id() { return (unsigned)__builtin_amdgcn_s_getreg((3 << 11) | 20) & 0xFu; }
#define XB_SPIN(cond, bar) do { unsigned _sp = 0; while (cond) { __builtin_amdgcn_s_sleep(1); \
    if ((++_sp & 255u) == 0u) { if (xb_ld(&(bar)[XB_TMO])) break; if (_sp > XB_SPIN_CAP) { atomicAdd(&(bar)[XB_TMO], 1u); break; } } } } while (0)

struct XcdBarrier {
    unsigned* bar; unsigned x;
    volatile LAS unsigned* st;
};

__device__ __forceinline__ XcdBarrier xcd_barrier_post(unsigned* bar, volatile LAS unsigned* st) {
    XcdBarrier b; b.bar = bar; b.x = xb_xcc_id(); b.st = st;
    if (threadIdx.x == 0) (void)xb_add(&bar[XB_XCNT(b.x)], 1u);
    return b;
}
__device__ __forceinline__ void xcd_barrier_complete(unsigned* bar, unsigned x, unsigned& nloc, unsigned& nx) {
    const unsigned G = gridDim.x * gridDim.y * gridDim.z;
    unsigned sum, cnt, mine, sp = 0u;
    for (;;) {
        sum = 0u; cnt = 0u; mine = 0u;
#pragma unroll
        for (unsigned j = 0; j < 16; ++j) { const unsigned c = xb_ld(&bar[XB_XCNT(j)]); sum += c; cnt += (c > 0u) ? 1u : 0u; mine = (j == x) ? c : mine; }
        if (sum == G) break;
        __builtin_amdgcn_s_sleep(1);
        if ((++sp & 255u) == 0u) { if (xb_ld(&bar[XB_TMO])) break; if (sp > XB_SPIN_CAP) { atomicAdd(&bar[XB_TMO], 1u); break; } }
    }
    nloc = mine > 0u ? mine : 1u; nx = cnt > 0u ? cnt : 1u;
}

__device__ __forceinline__ void xcd_barrier(const XcdBarrier& b) {
    asm volatile("s_waitcnt vmcnt(0)" ::: "memory");
    __syncthreads();
    if (threadIdx.x == 0) {
        unsigned* bar = b.bar;
        __builtin_amdgcn_s_waitcnt(0);
        unsigned nloc = b.st[0], nx = b.st[1];
        if (nloc == 0u) { xcd_barrier_complete(bar, b.x, nloc, nx); b.st[0] = nloc; b.st[1] = nx; }
        const unsigned old = xb_add(&bar[XB_XSUB(b.x)], 1u);
        const unsigned gen = old / nloc;
        if (old + 1u == (gen + 1u) * nloc) {
            __builtin_amdgcn_fence(__ATOMIC_RELEASE, "agent");
            asm volatile("s_waitcnt vmcnt(0)" ::: "memory");
            const unsigned og = xb_add(&bar[XB_TOP], 1u);
            const unsigned tg = og / nx;
            if (og + 1u == (tg + 1u) * nx) xb_add(&bar[XB_TOPGEN], 1u);
            else XB_SPIN(xb_ld(&bar[XB_TOPGEN]) == tg, bar);
            __builtin_amdgcn_fence(__ATOMIC_ACQUIRE, "agent");
            xb_add(&bar[XB_XGEN(b.x)], 1u);
            asm volatile("s_waitcnt vmcnt(0)" ::: "memory");
        } else {
            XB_SPIN(xb_ld(&bar[XB_XGEN(b.x)]) == gen, bar);
            __builtin_amdgcn_fence(__ATOMIC_ACQUIRE, "agent");
            asm volatile("s_waitcnt vmcnt(0)" ::: "memory");
        }
    }
    __syncthreads();
}


__global__ void __launch_bounds__(256, 1) mega(Params p) {
  __shared__ __attribute__((aligned(16))) char smem[CS_END];
  cg::grid_group grid = cg::this_grid();
  __shared__ uint4 xb_words;
  if (threadIdx.x == 0) xb_words = make_uint4(0u, 0u, 0u, 0u);
  __syncthreads();
  XcdBarrier xb = xcd_barrier_post((unsigned*)(p.ws + OFF_BAR), (volatile LAS unsigned*)&xb_words);
  for (int ph = p.phase_lo; ph < p.phase_hi; ++ph) {
    int tid_l = threadIdx.x;
    asm volatile("" : "+v"(tid_l));
    run_phase(p, ph, smem, tid_l);
#ifdef REP_MASK
    if ((REP_MASK >> p.ptype[ph]) & 1) { asm volatile("s_waitcnt vmcnt(0) lgkmcnt(0)" ::: "memory"); grid.sync(); asm volatile("" : "+v"(tid_l)); run_phase(p, ph, smem, tid_l); }
#endif
    if (ph + 1 < p.phase_hi) {
      asm volatile("s_waitcnt vmcnt(0) lgkmcnt(0)" ::: "memory");
      if (ph == p.phase_lo) grid.sync();
      else xcd_barrier(xb);
    }
  }
}

extern "C" void kernel_launch(void* const* d_in, const int* in_sizes, int n_in, void* d_out, int out_size, void* d_ws, size_t ws_size,
                              hipStream_t stream) {
  static int grid_blocks = 0;
  if (!grid_blocks) {
    int dev = 0, cus = 0, per_cu = 0;
    hipGetDevice(&dev);
    hipDeviceGetAttribute(&cus, hipDeviceAttributeMultiprocessorCount, dev);
    hipOccupancyMaxActiveBlocksPerMultiprocessor(&per_cu, mega, 256, 0);
    if (per_cu > 2) per_cu = 2;
    if (per_cu < 1) per_cu = 1;
    grid_blocks = cus * per_cu;
  }
  Params p;
  memset(&p, 0, sizeof(p));
  const float** fp = (const float**)&p;
  for (int i = 0; i < 29; ++i) fp[i] = (const float*)d_in[i];
  p.out = (float*)d_out;
  p.ws = (char*)d_ws;
  int n = 0;
  auto add = [&](int t, int l) { p.ptype[n] = (unsigned char)t; p.player[n] = (unsigned char)l; ++n; };
  add(PH_PREP0, 0);
  add(PH_PRE0, 0);
  for (int l = 0; l < 4; ++l) {
    if ((l & 1) == 0) {
      add(PH_FGEMM1, l); add(PH_FDFT1, l); add(PH_FDFT3, l); add(PH_FOUT, l); add(PH_POSTPRE, l);
    } else {
      add(PH_RSHIFT, l); add(PH_RINPROJ, l);
      if (l == 3) add(PH_RVUPD, l);
      add(PH_RSCANA, l); add(PH_RSCAN, l); add(PH_ROUTPUT, l); add(PH_ROUTPROJ, l);
      add(l == 3 ? PH_POSTLAST : PH_POSTPRE, l);
    }
  }
#ifdef DBG_STOP
  n = DBG_STOP; add(PH_DUMP, 0);
#endif
#if SINGLE_LAUNCH
  hipMemsetAsync((char*)d_ws + OFF_BAR, 0, 3456 * 4, stream);
  p.phase_lo = 0; p.phase_hi = n;
  void* args[] = {&p};
  hipError_t e = hipLaunchCooperativeKernel((void*)mega, dim3(grid_blocks), dim3(256), args, 0, stream);
  if (e != hipSuccess) fprintf(stderr, "cooperative launch failed: %s (grid %d)\n", hipGetErrorString(e), grid_blocks);
#else
  for (int i = 0; i < n; ++i) {
    p.phase_lo = i; p.phase_hi = i + 1;
    hipLaunchKernelGGL(mega, dim3(grid_blocks), dim3(256), 0, stream, p);
  }
#endif
}
```

```cpp
#include <hip/hip_runtime.h>
#include <hip/hip_cooperative_groups.h>
#include <cstdio>
#include <cstring>
namespace cg = cooperative_groups;

#ifndef DBG_MASK
#define DBG_MASK 0
#endif
#ifndef SINGLE_LAUNCH
#define SINGLE_LAUNCH 1
#endif

typedef unsigned short bf16_t;
typedef short s16x8 __attribute__((ext_vector_type(8)));
typedef short s16x4 __attribute__((ext_vector_type(4)));
typedef float f32x16 __attribute__((ext_vector_type(16)));
#define DI __device__ __forceinline__
#define MFMA(a, b, c) __builtin_amdgcn_mfma_f32_32x32x16_bf16((a), (b), (c), 0, 0, 0)

constexpr int NR = 16896;
constexpr int NLAT = 16384;
constexpr int D = 1024;
constexpr size_t SLOT = (size_t)NR * D * 2;
constexpr float RMS_EPS = 1e-6f;
constexpr float GN_EPS = 64e-5f;

constexpr size_t OFF_T0 = 0;
constexpr size_t OFF_VF = 6 * SLOT;
constexpr size_t OFF_XCTX = OFF_VF + SLOT;
constexpr size_t OFF_W = OFF_XCTX + (size_t)512 * D * 4;
constexpr size_t W_BYTES = (size_t)(4384 + 1024) * 1024 * 2;
constexpr size_t OFF_LW = OFF_W + W_BYTES;
constexpr size_t OFF_LA = OFF_LW + (size_t)NR * 128 * 2;
constexpr size_t OFF_LV = OFF_LA + (size_t)NR * 128 * 2;
constexpr size_t OFF_MOD = OFF_LV + (size_t)NR * 32 * 2;
constexpr size_t OFF_F1 = OFF_MOD + (size_t)4 * 3 * 3072 * 4;
constexpr size_t OFF_F2 = OFF_F1 + 128 * 128 * 2;
constexpr size_t OFF_FC = OFF_F2 + 128 * 256 * 2;
constexpr size_t OFF_TW = OFF_FC + 256 * 512 * 2;
constexpr size_t OFF_BON = OFF_TW + 64 * 128 * 8;
constexpr size_t OFF_BAR = OFF_BON + (size_t)2 * NR * 16 * 4;
constexpr size_t WS_END = OFF_BAR + 3456 * 4;
static_assert(WS_END <= 268435456ull, "workspace overflow");

enum { PH_PREP0 = 0, PH_PRE0, PH_FGEMM1, PH_FDFT1, PH_FDFT3, PH_FOUT, PH_POSTPRE, PH_RSHIFT, PH_RINPROJ, PH_RVUPD, PH_RSCAN, PH_ROUTPUT, PH_ROUTPROJ, PH_POSTLAST, PH_DUMP, PH_RSCANA };

struct Params {
  const float *x, *c, *ctx, *c_ctx, *mod_w, *mod_b, *norm_pre, *norm_post, *f_w_in, *f_w_mix, *f_b_mix, *f_w_out,
      *r_mu, *r_w_in, *r_w0, *r_w1, *r_w2, *r_a0, *r_a1, *r_a2, *r_v0, *r_v1, *r_v2, *r_k_k, *r_k_a, *r_r_k, *r_ln_w, *r_ln_b, *r_w_out;
  float* out;
  char* ws;
  int phase_lo, phase_hi;
  unsigned char ptype[32];
  unsigned char player[32];
};

DI float bf2f(bf16_t u) { return __uint_as_float(((unsigned)u) << 16); }
DI bf16_t f2bf(float f) { unsigned r; asm("v_cvt_pk_bf16_f32 %0, %1, %1" : "=v"(r) : "v"(f)); return (bf16_t)r; }
DI unsigned pack2(float a, float b) { unsigned r; asm("v_cvt_pk_bf16_f32 %0, %1, %2" : "=v"(r) : "v"(a), "v"(b)); return r; }
DI float lo2f(unsigned u) { return __uint_as_float(u << 16); }
DI float hi2f(unsigned u) { return __uint_as_float(u & 0xffff0000u); }
DI float silu_f(float x) { return x * __builtin_amdgcn_rcpf(1.f + __expf(-x)); }
DI float sigmoid_f(float x) { return __builtin_amdgcn_rcpf(1.f + __expf(-x)); }
DI float fsig(float x) { return __builtin_amdgcn_rcpf(1.f + __expf(-x)); }
DI float softplus_f(float x) { return fmaxf(x, 0.f) + log1pf(__expf(-fabsf(x))); }
template <int CTRL>
DI float dpp_add(float v) { return v + __int_as_float(__builtin_amdgcn_update_dpp(0, __float_as_int(v), CTRL, 0xf, 0xf, true)); }
DI float wave_sum(float v) {
  v = dpp_add<0xB1>(v);
  v = dpp_add<0x4E>(v);
  v = dpp_add<0x141>(v);
  v = dpp_add<0x140>(v);
  const int iv = __float_as_int(v);
  return __int_as_float(__builtin_amdgcn_readlane(iv, 0)) + __int_as_float(__builtin_amdgcn_readlane(iv, 16)) +
         __int_as_float(__builtin_amdgcn_readlane(iv, 32)) + __int_as_float(__builtin_amdgcn_readlane(iv, 48));
}
DI int crow(int r, int h) { return (r & 3) + 8 * (r >> 2) + 4 * h; }

template <bool MIX>
DI uint4 mix_chunk(uint4 va, uint4 vs, const float4 m0v, const float4 m1v) {
  if (!MIX) return va;
  float h, sv;
  h = lo2f(va.x); sv = lo2f(vs.x); const float e0 = h + (sv - h) * m0v.x;
  h = hi2f(va.x); sv = hi2f(vs.x); const float e1 = h + (sv - h) * m0v.y;
  h = lo2f(va.y); sv = lo2f(vs.y); const float e2 = h + (sv - h) * m0v.z;
  h = hi2f(va.y); sv = hi2f(vs.y); const float e3 = h + (sv - h) * m0v.w;
  h = lo2f(va.z); sv = lo2f(vs.z); const float e4 = h + (sv - h) * m1v.x;
  h = hi2f(va.z); sv = hi2f(vs.z); const float e5 = h + (sv - h) * m1v.y;
  h = lo2f(va.w); sv = lo2f(vs.w); const float e6 = h + (sv - h) * m1v.z;
  h = hi2f(va.w); sv = hi2f(vs.w); const float e7 = h + (sv - h) * m1v.w;
  return make_uint4(pack2(e0, e1), pack2(e2, e3), pack2(e4, e5), pack2(e6, e7));
}
struct NoDst { DI bf16_t* operator()(int) const { return nullptr; } };
template <bool MIX, int NJ, bool PLAIN, class Epi, class DstFn>
DI void gemm_tile_impl(const bf16_t* __restrict__ A, const bf16_t* __restrict__ A2, const float* __restrict__ mu, int lda,
                    const bf16_t* __restrict__ BT, int ldb, int K, int m0, int n0, int N, char* smem, const int TID, Epi epi, DstFn dst_fn) {
  constexpr int BN = 64 * NJ, NB = BN / 32, NBQ = NB / 4;
  constexpr int STAGE = (128 + BN) * 144;
  const int tid = TID, lane = tid & 63, w = tid >> 6, wm = w & 1, wn = w >> 1;
  f32x16 acc[2][NJ];
#pragma unroll
  for (int i = 0; i < 2; ++i)
#pragma unroll
    for (int j = 0; j < NJ; ++j)
#pragma unroll
      for (int r = 0; r < 16; ++r) acc[i][j][r] = 0.f;
  uint4 ra[2][4], ra2[2][4], rb[2][NB];
  const int KT = K >> 6;
  const int lrow = tid >> 3, kc = tid & 7;
  const bf16_t* Ap = A + (size_t)(m0 + lrow) * lda + kc * 8;
  const bf16_t* A2p = MIX ? (A2 + (size_t)(m0 + lrow) * lda + kc * 8) : nullptr;
  const bf16_t* Bp = BT + (size_t)(n0 + lrow) * ldb + kc * 8;
  const bool nfull = (n0 + BN <= N);
#define GEMM_LOAD(ST_, KT_) { \
    _Pragma("unroll") for (int i = 0; i < 4; ++i) { \
      ra[ST_][i] = *(const uint4*)(Ap + (size_t)(32 * i) * lda + (KT_) * 64); \
      if (MIX) ra2[ST_][i] = *(const uint4*)(A2p + (size_t)(32 * i) * lda + (KT_) * 64); } \
    _Pragma("unroll") for (int i = 0; i < NB; ++i) \
      rb[ST_][i] = (nfull || (n0 + lrow + 32 * i) < N) ? *(const uint4*)(Bp + (size_t)(32 * i) * ldb + (KT_) * 64) : make_uint4(0, 0, 0, 0); }
#define GEMM_STAGE_SLICE(ST_, KT_, Q_, BUF_) { \
    bf16_t* As_ = (bf16_t*)(smem + (BUF_) * STAGE); bf16_t* Bs_ = As_ + 128 * 72; \
    float4 m0v_ = make_float4(0, 0, 0, 0), m1v_ = m0v_; \
    if (MIX) { m0v_ = *(const float4*)(mu + (KT_) * 64 + kc * 8); m1v_ = *(const float4*)(mu + (KT_) * 64 + kc * 8 + 4); } \
    *(uint4*)(As_ + (lrow + 32 * (Q_)) * 72 + kc * 8) = mix_chunk<MIX>(ra[ST_][Q_], ra2[ST_][Q_], m0v_, m1v_); \
    _Pragma("unroll") for (int u = 0; u < NBQ; ++u) *(uint4*)(Bs_ + (lrow + 32 * ((Q_) * NBQ + u)) * 72 + kc * 8) = rb[ST_][(Q_) * NBQ + u]; }
  GEMM_LOAD(0, 0)
  if (KT > 1) GEMM_LOAD(1, 1)
  __syncthreads();
#pragma unroll
  for (int qq = 0; qq < 4; ++qq) GEMM_STAGE_SLICE(0, 0, qq, 0)
  if (KT > 2) GEMM_LOAD(0, 2)
  __syncthreads();
  for (int kt0 = 0; kt0 < KT; kt0 += 2) {
#pragma unroll
    for (int st = 0; st < 2; ++st) {
      const int kt = kt0 + st;
      if (kt < KT) {
        const bf16_t* As = (const bf16_t*)(smem + st * STAGE);
        const bf16_t* Bs = As + 128 * 72;
        const bool more = (kt + 1 < KT);
        s16x8 fa[2][2], fb[2][NJ];
#pragma unroll
        for (int i = 0; i < 2; ++i) fa[0][i] = *(const s16x8*)(As + (64 * wm + 32 * i + (lane & 31)) * 72 + (lane >> 5) * 8);
#pragma unroll
        for (int j = 0; j < NJ; ++j) fb[0][j] = *(const s16x8*)(Bs + (32 * NJ * wn + 32 * j + (lane & 31)) * 72 + (lane >> 5) * 8);
#pragma unroll
        for (int kk = 0; kk < 4; ++kk) {
          if (kk < 3) {
#pragma unroll
            for (int i = 0; i < 2; ++i) fa[(kk + 1) & 1][i] = *(const s16x8*)(As + (64 * wm + 32 * i + (lane & 31)) * 72 + (kk + 1) * 16 + (lane >> 5) * 8);
#pragma unroll
            for (int j = 0; j < NJ; ++j) fb[(kk + 1) & 1][j] = *(const s16x8*)(Bs + (32 * NJ * wn + 32 * j + (lane & 31)) * 72 + (kk + 1) * 16 + (lane >> 5) * 8);
          }
#pragma unroll
          for (int i = 0; i < 2; ++i)
#pragma unroll
            for (int j = 0; j < NJ; ++j) acc[i][j] = MFMA(fa[kk & 1][i], fb[kk & 1][j], acc[i][j]);
          if (more) GEMM_STAGE_SLICE(st ^ 1, kt + 1, kk, st ^ 1)
        }
        if (kt + 3 < KT) GEMM_LOAD(st ^ 1, kt + 3)
        __syncthreads();
      }
    }
  }
#undef GEMM_LOAD
#undef GEMM_STAGE_SLICE
  if (PLAIN) {
    constexpr int PITCH = 32 * NJ * 2 + 16;
    char* reg = smem + w * (64 * PITCH);
    const int l31 = lane & 31, hh = lane >> 5;
#pragma unroll
    for (int i = 0; i < 2; ++i)
#pragma unroll
      for (int j = 0; j < NJ; ++j)
#pragma unroll
        for (int r = 0; r < 16; ++r)
          *(bf16_t*)(reg + (32 * i + crow(r, hh)) * PITCH + (32 * j + l31) * 2) = f2bf(acc[i][j][r]);
    __syncthreads();
    const int col0 = n0 + 32 * NJ * wn;
    bf16_t* dst = dst_fn(col0) + (size_t)(m0 + 64 * wm) * D + (col0 & 1023);
    constexpr int CPR = 4 * NJ;
    constexpr int RPI = 64 / CPR;
    const int rr = lane / CPR, ch = lane % CPR;
#pragma unroll
    for (int q = 0; q < CPR; ++q) {
      const int row = rr + RPI * q;
      *(uint4*)(dst + (size_t)row * D + ch * 8) = *(const uint4*)(reg + row * PITCH + ch * 16);
    }
    return;
  }
#pragma unroll
  for (int i = 0; i < 2; ++i)
#pragma unroll
    for (int j = 0; j < NJ; ++j) {
      const int col = n0 + 32 * NJ * wn + 32 * j + (lane & 31);
      if (col < N) {
#pragma unroll
        for (int r = 0; r < 16; ++r) {
          const int row = m0 + 64 * wm + 32 * i + crow(r, lane >> 5);
          epi(row, col, acc[i][j][r]);
        }
      }
    }
}
template <bool MIX, int NJ, class Epi>
DI void gemm_tile_n(const bf16_t* __restrict__ A, const bf16_t* __restrict__ A2, const float* __restrict__ mu, int lda,
                    const bf16_t* __restrict__ BT, int ldb, int K, int m0, int n0, int N, char* smem, const int TID, Epi epi) {
  gemm_tile_impl<MIX, NJ, false>(A, A2, mu, lda, BT, ldb, K, m0, n0, N, smem, TID, epi, NoDst());
}
template <bool MIX, int NJ, class DstFn>
DI void gemm_tile_plain(const bf16_t* __restrict__ A, const bf16_t* __restrict__ A2, const float* __restrict__ mu, int lda,
                        const bf16_t* __restrict__ BT, int ldb, int K, int m0, int n0, int N, char* smem, const int TID, DstFn dst_fn) {
  gemm_tile_impl<MIX, NJ, true>(A, A2, mu, lda, BT, ldb, K, m0, n0, N, smem, TID, [](int, int, float) {}, dst_fn);
}
template <bool MIX, class Epi>
DI void gemm_tile(const bf16_t* __restrict__ A, const bf16_t* __restrict__ A2, const float* __restrict__ mu, int lda,
                  const bf16_t* __restrict__ BT, int ldb, int K, int m0, int n0, int N, char* smem, const int TID, Epi epi) {
  gemm_tile_n<MIX, 2>(A, A2, mu, lda, BT, ldb, K, m0, n0, N, smem, TID, epi);
}

template <class Epi>
DI void dft_tile(const bf16_t* __restrict__ A, int lda, int arow0, int KH, const bf16_t* __restrict__ Bre,
                 const bf16_t* __restrict__ Bim, int ldb, int tstride, char* smem, const int TID, Epi epi) {
  const int tid = TID, lane = tid & 63, w = tid >> 6;
  const int rt0 = w & 1, ctb = 2 * (w >> 1);
  f32x16 acc[2][2];
#pragma unroll
  for (int i = 0; i < 2; ++i)
#pragma unroll
    for (int j = 0; j < 2; ++j)
#pragma unroll
      for (int r = 0; r < 16; ++r) acc[i][j][r] = 0.f;
  const int nch = (2 * KH) >> 7;
  const int g = lane >> 4, li = lane & 15, q = li >> 2, pp = li & 3;
  const int tr_base = (8 * (g >> 1) + q) * 320 + (16 * (g & 1) + 4 * pp) * 2;
  for (int ch = 0; ch < nch; ++ch) {
    __syncthreads();
#pragma unroll
    for (int i = 0; i < 8; ++i) {
      const int c = tid + 256 * i, r = c >> 4, cc = c & 15;
      const int kr = ch * 128 + r;
      const bf16_t* src = (kr < KH ? Bre + (size_t)kr * tstride * ldb : Bim + (size_t)(kr - KH) * tstride * ldb) + cc * 8;
      *(uint4*)(smem + r * 320 + cc * 16) = *(const uint4*)src;
    }
    __syncthreads();
#pragma unroll
    for (int kh = 0; kh < 2; ++kh) {
      asm volatile("" ::: "memory");
      s16x8 af[4][2];
#pragma unroll
      for (int k4 = 0; k4 < 4; ++k4)
#pragma unroll
        for (int h = 0; h < 2; ++h)
          af[k4][h] = *(const s16x8*)(A + (size_t)(arow0 + 32 * (rt0 + 2 * h) + (lane & 31)) * lda + ch * 128 + (kh * 4 + k4) * 16 + (lane >> 5) * 8);
#pragma unroll
      for (int k4 = 0; k4 < 4; ++k4) {
        const int ks = kh * 4 + k4;
#pragma unroll
        for (int c2 = 0; c2 < 2; ++c2) {
          const int off = tr_base + ks * 16 * 320 + (ctb + c2) * 64;
#ifdef NO_TR
          s16x8 b;
          {
            const int n = 32 * (ctb + c2) + (lane & 31), k0 = ks * 16 + 8 * (lane >> 5);
#pragma unroll
            for (int e = 0; e < 8; ++e) b[e] = *(const short*)(smem + (k0 + e) * 320 + n * 2);
          }
#else
          const s16x4 lo = __builtin_amdgcn_ds_read_tr16_b64_v4i16((__attribute__((address_space(3))) s16x4*)(smem + off));
          const s16x4 hi = __builtin_amdgcn_ds_read_tr16_b64_v4i16((__attribute__((address_space(3))) s16x4*)(smem + off + 4 * 320));
          const s16x8 b = __builtin_shufflevector(lo, hi, 0, 1, 2, 3, 4, 5, 6, 7);
#endif
#pragma unroll
          for (int h = 0; h < 2; ++h) acc[h][c2] = MFMA(af[k4][h], b, acc[h][c2]);
        }
      }
    }
  }
#pragma unroll
  for (int c2 = 0; c2 < 2; ++c2) {
    const int col = 32 * (ctb + c2) + (lane & 31);
#pragma unroll
    for (int r = 0; r < 16; ++r) {
      const int rowA = 32 * rt0 + crow(r, lane >> 5);
      if ((r & 3) == 0) asm volatile("" ::: "memory");
      epi(rowA, rowA + 64, col, acc[0][c2][r], acc[1][c2][r]);
    }
  }
}

DI void transpose_tile(const float* __restrict__ src, int lds_, bf16_t* __restrict__ dst, int ldd, int K, int N, int tk, int tn, char* smem, const int TID) {
  float* t = (float*)smem;
  const int tid = TID;
  __syncthreads();
#pragma unroll
  for (int i = 0; i < 16; ++i) {
    const int kk = (tid >> 6) + 4 * i, nn = tid & 63;
    const int k = tk * 64 + kk, n = tn * 64 + nn;
    t[kk * 65 + nn] = (k < K && n < N) ? src[(size_t)k * lds_ + n] : 0.f;
  }
  __syncthreads();
#pragma unroll
  for (int i = 0; i < 16; ++i) {
    const int nn = (tid >> 6) + 4 * i, kk = tid & 63;
    const int k = tk * 64 + kk, n = tn * 64 + nn;
    if (k < K && n < N) dst[(size_t)n * ldd + k] = f2bf(t[kk * 65 + nn]);
  }
}

DI void fourier_wprep(const Params& p, int j, int it, char* smem, const int TID) {
  bf16_t* W = (bf16_t*)(p.ws + OFF_W);
  const int job = it >> 8, t = it & 255;
  if (job == 0) transpose_tile(p.f_w_in + (size_t)j * 1024 * 2048 + 1024, 2048, W + (size_t)2048 * 1024, 1024, 1024, 1024, t >> 4, t & 15, smem, TID);
  else transpose_tile(p.f_w_out + (size_t)j * 1024 * 1024, 1024, W + (size_t)3072 * 1024, 1024, 1024, 1024, t >> 4, t & 15, smem, TID);
}
DI void rwkv_wprep(const Params& p, int j, int it, char* smem, const int TID) {
  bf16_t* W = (bf16_t*)(p.ws + OFF_W);
  if (it < 1024) {
    const int pi = it >> 8, t = it & 255;
    transpose_tile(p.r_w_in + (size_t)(j * 4 + pi) * 1024 * 1024, 1024, W + (size_t)pi * 1024 * 1024, 1024, 1024, 1024, t >> 4, t & 15, smem, TID);
  } else if (it < 1024 + 32) {
    const int u = it - 1024, n = u >> 4, t = u & 15;
    transpose_tile(p.r_w1 + (size_t)(j * 2 + n) * 1024 * 64, 64, W + (size_t)(4096 + 64 * n) * 1024, 1024, 1024, 64, t, 0, smem, TID);
  } else if (it < 1024 + 64) {
    const int u = it - 1056, n = u >> 4, t = u & 15;
    transpose_tile(p.r_a1 + (size_t)(j * 2 + n) * 1024 * 64, 64, W + (size_t)(4224 + 64 * n) * 1024, 1024, 1024, 64, t, 0, smem, TID);
  } else if (it < 1024 + 80) {
    const int t = it - 1088;
    if (j >= 1) transpose_tile(p.r_v1 + (size_t)(j - 1) * 1024 * 32, 32, W + (size_t)4352 * 1024, 1024, 1024, 32, t, 0, smem, TID);
  } else {
    const int t = it - 1104;
    transpose_tile(p.r_w_out + (size_t)j * 1024 * 1024, 1024, W + (size_t)4384 * 1024, 1024, 1024, 1024, t >> 4, t & 15, smem, TID);
  }
}
constexpr int N_FWPREP = 512, N_RWPREP = 1360;

DI void fourier_cw_prep(const Params& p, int j, int it, char* smem, const int TID) {
  bf16_t* FWU = (bf16_t*)(p.ws + 5 * SLOT);
  bf16_t* CWT = FWU + 1024 * 1024;
  const int tid = TID;
  if (it < 256) {
#pragma unroll
    for (int i = 0; i < 4; ++i) {
      const int row = it * 4 + i;
      const float4 v = *(const float4*)(p.f_w_in + (size_t)j * 1024 * 2048 + (size_t)row * 2048 + tid * 4);
      *(uint2*)(FWU + (size_t)row * 1024 + tid * 4) = make_uint2(pack2(v.x, v.y), pack2(v.z, v.w));
    }
  } else {
    float* tab = (float*)smem;
    __syncthreads();
    if (tid < 128) tab[tid] = cospif((float)tid / 64.f);
    __syncthreads();
    const int u = it - 256, pq = u >> 7, g = (u >> 4) & 7, cb = u & 15;
    const int e = tid & 127, cbase = cb * 8 + (tid >> 7) * 4;
    const float* wm = p.f_w_mix + ((size_t)j * 8 + g) * 128 * 128;
    const int off = pq ? 32 : 0;
    float a0 = 0.f, a1 = 0.f, a2 = 0.f, a3 = 0.f;
#pragma unroll 8
    for (int c2 = 0; c2 < 128; ++c2) {
      const float wv = wm[c2 * 128 + e];
      a0 += tab[((cbase + 0) * c2 - off) & 127] * wv;
      a1 += tab[((cbase + 1) * c2 - off) & 127] * wv;
      a2 += tab[((cbase + 2) * c2 - off) & 127] * wv;
      a3 += tab[((cbase + 3) * c2 - off) & 127] * wv;
    }
    *(uint2*)(CWT + (((size_t)pq * 8 + g) * 128 + e) * 128 + cbase) = make_uint2(pack2(a0, a1), pack2(a2, a3));
  }
}
constexpr int N_CWPREP = 256 + 256;

DI void fourier_precompose(const Params& p, int it, char* smem, const int TID) {
  const bf16_t* FWU = (const bf16_t*)(p.ws + 5 * SLOT);
  const bf16_t* CWT = FWU + 1024 * 1024;
  bf16_t* W = (bf16_t*)(p.ws + OFF_W);
  const int pg = it >> 3, nt = it & 7;
  const int g = pg & 7;
  bf16_t* dst = W + (size_t)pg * 128 * 1024;
  gemm_tile<false>(CWT + (size_t)pg * 128 * 128, nullptr, nullptr, 128, FWU + g * 128, 1024, 128, 0, nt * 128, 1024, smem, TID,
                   [=](int row, int col, float v) { dst[(size_t)row * 1024 + col] = f2bf(v); });
}

DI void phase_prep0(const Params& p, char* smem, const int TID) {
  const int tid = TID;

  float* MOD = (float*)(p.ws + OFF_MOD);
  const int N_MOD = 192, N_TAB = (128 * 128 + 128 * 256 + 256 * 512 + 64 * 128) / 256;
  const int total = N_MOD + N_TAB + N_CWPREP + N_FWPREP;
  for (int it = blockIdx.x; it < total; it += gridDim.x) {
    if (it < N_MOD) {
      const int layer = it / 48, chunk = it % 48;
      const int kp = tid >> 4, cgp = tid & 15;
      const float* wbase = p.mod_w + (size_t)layer * 1024 * 3072 + chunk * 64 + cgp * 4;
      float a0[4] = {0, 0, 0, 0}, a1[4] = {0, 0, 0, 0}, a2[4] = {0, 0, 0, 0};
      float* sc = (float*)(smem + 16384);
      __syncthreads();
      for (int e = tid; e < 1024; e += 256) { sc[e] = silu_f(p.c[e]); sc[1024 + e] = silu_f(p.c[1024 + e]); sc[2048 + e] = silu_f(p.c_ctx[e]); }
      __syncthreads();
#pragma unroll 8
      for (int k = kp * 64; k < kp * 64 + 64; ++k) {
        const float4 wv = *(const float4*)(wbase + (size_t)k * 3072);
        const float s0 = sc[k], s1 = sc[1024 + k], s2 = sc[2048 + k];
        a0[0] += s0 * wv.x; a0[1] += s0 * wv.y; a0[2] += s0 * wv.z; a0[3] += s0 * wv.w;
        a1[0] += s1 * wv.x; a1[1] += s1 * wv.y; a1[2] += s1 * wv.z; a1[3] += s1 * wv.w;
        a2[0] += s2 * wv.x; a2[1] += s2 * wv.y; a2[2] += s2 * wv.z; a2[3] += s2 * wv.w;
      }
      float* red = (float*)smem;
      __syncthreads();
#pragma unroll
      for (int e = 0; e < 4; ++e) {
        red[(kp * 3 + 0) * 64 + cgp * 4 + e] = a0[e];
        red[(kp * 3 + 1) * 64 + cgp * 4 + e] = a1[e];
        red[(kp * 3 + 2) * 64 + cgp * 4 + e] = a2[e];
      }
      __syncthreads();
      if (tid < 192) {
        const int v = tid >> 6, col = tid & 63;
        float s = 0.f;
#pragma unroll
        for (int k = 0; k < 16; ++k) s += red[(k * 3 + v) * 64 + col];
        const int cidx = chunk * 64 + col;
        MOD[((size_t)layer * 3 + v) * 3072 + cidx] = s + p.mod_b[(size_t)layer * 3072 + cidx];
      }
    } else if (it < N_MOD + N_TAB) {
      int e = (it - N_MOD) * 256 + tid;
      bf16_t* F1 = (bf16_t*)(p.ws + OFF_F1);
      bf16_t* F2 = (bf16_t*)(p.ws + OFF_F2);
      bf16_t* FC = (bf16_t*)(p.ws + OFF_FC);
      float2* TW = (float2*)(p.ws + OFF_TW);
      if (e < 128 * 128) {
        const int m = e >> 7, k = e & 127;
        const int mm = m & 63, kk = k & 63;
        const float ang = (float)((mm * kk) & 63) / 32.f;
        const float cv = cospif(ang), sv = sinpif(ang);
        float val;
        if (m < 64) val = (k < 64) ? cv : -sv; else val = (k < 64) ? sv : cv;
        F1[e] = f2bf(val);
      } else if ((e -= 128 * 128) < 128 * 256) {
        const int m = e >> 8, k = e & 255, kk = k & 127;
        const float ang = (float)((m * kk) & 127) / 64.f;
        F2[e] = f2bf(k < 128 ? cospif(ang) : -sinpif(ang));
      } else if ((e -= 128 * 256) < 256 * 512) {
        const int m = e >> 9, k = e & 511, kk = k & 255;
        const float ang = (float)((m * kk) & 255) / 128.f;
        FC[e] = f2bf(k < 256 ? cospif(ang) : -sinpif(ang));
      } else {
        e -= 256 * 512;
        const int k1 = e >> 7, t2 = e & 127;
        const float ang = (float)(k1 * t2) / 4096.f;
        TW[e] = make_float2(cospif(ang), sinpif(ang));
      }
    } else if (it < N_MOD + N_TAB + N_CWPREP) {
      fourier_cw_prep(p, 0, it - N_MOD - N_TAB, smem, TID);
    } else {
      fourier_wprep(p, 0, it - N_MOD - N_TAB - N_CWPREP, smem, TID);
    }
  }
}

DI void row_items(const Params& p, int layer, bool do_post, bool do_pre, int nrows, const bf16_t* O, bf16_t* H, int it0, int nit, const int TID) {
  const int wave = TID >> 6, lane = TID & 63;
  const float* MOD = (const float*)(p.ws + OFF_MOD);
  float* XCTX = (float*)(p.ws + OFF_XCTX);
  float4 nx0, nx1, nx2, nx3;
  uint2 no0 = make_uint2(0, 0), no1 = no0, no2 = no0, no3 = no0;
#define ROW_XIN(ROW_) ((layer == 0) ? ((ROW_) < NLAT ? p.x + (size_t)(ROW_) * D : p.ctx + (size_t)((ROW_) - NLAT) * D) \
                                    : ((ROW_) < NLAT ? p.out + (size_t)(ROW_) * D : XCTX + (size_t)((ROW_) - NLAT) * D))
#define ROW_PREFETCH(ROW_) { const float* xi_ = ROW_XIN(ROW_); \
    nx0 = *(const float4*)(xi_ + lane * 4); nx1 = *(const float4*)(xi_ + 256 + lane * 4); nx2 = *(const float4*)(xi_ + 512 + lane * 4); nx3 = *(const float4*)(xi_ + 768 + lane * 4); \
    if (do_post) { const bf16_t* oi_ = O + (size_t)(ROW_) * D + lane * 4; \
      no0 = *(const uint2*)(oi_); no1 = *(const uint2*)(oi_ + 256); no2 = *(const uint2*)(oi_ + 512); no3 = *(const uint2*)(oi_ + 768); } }
  if (it0 < nit) ROW_PREFETCH(it0 * 4 + wave)
  for (int it = it0; it < nit; it += gridDim.x) {
    const int row = it * 4 + wave;
    const int v = row < 8192 ? 0 : (row < 16384 ? 1 : 2);
    float* xout = row < NLAT ? p.out + (size_t)row * D : XCTX + (size_t)(row - NLAT) * D;
    float4 xv[4] = {nx0, nx1, nx2, nx3};
    const uint2 ou[4] = {no0, no1, no2, no3};
    if (it + (int)gridDim.x < nit) ROW_PREFETCH((it + (int)gridDim.x) * 4 + wave)
    if (do_post) {
      float ov[4][4];
      float ss = 0.f;
#pragma unroll
      for (int qd = 0; qd < 4; ++qd) {
        const uint2 u = ou[qd];
        ov[qd][0] = lo2f(u.x); ov[qd][1] = hi2f(u.x); ov[qd][2] = lo2f(u.y); ov[qd][3] = hi2f(u.y);
#pragma unroll
        for (int e = 0; e < 4; ++e) ss += ov[qd][e] * ov[qd][e];
      }
      ss = wave_sum(ss);
      const float rstd = rsqrtf(ss * (1.f / 1024.f) + RMS_EPS);
      const float* gate = MOD + ((size_t)layer * 3 + v) * 3072 + 2048;
      const float* np = p.norm_post + (size_t)layer * D;
#pragma unroll
      for (int qd = 0; qd < 4; ++qd) {
        const float4 gv = *(const float4*)(gate + qd * 256 + lane * 4);
        const float4 nv = *(const float4*)(np + qd * 256 + lane * 4);
        xv[qd].x += gv.x * (ov[qd][0] * rstd * nv.x);
        xv[qd].y += gv.y * (ov[qd][1] * rstd * nv.y);
        xv[qd].z += gv.z * (ov[qd][2] * rstd * nv.z);
        xv[qd].w += gv.w * (ov[qd][3] * rstd * nv.w);
        *(float4*)(xout + qd * 256 + lane * 4) = xv[qd];
      }
    }
    if (do_pre) {
      const int L = layer + (do_post ? 1 : 0);
      float ss = 0.f;
#pragma unroll
      for (int qd = 0; qd < 4; ++qd) ss += xv[qd].x * xv[qd].x + xv[qd].y * xv[qd].y + xv[qd].z * xv[qd].z + xv[qd].w * xv[qd].w;
      ss = wave_sum(ss);
      const float rstd = rsqrtf(ss * (1.f / 1024.f) + RMS_EPS);
      const float* sh = MOD + ((size_t)L * 3 + v) * 3072;
      const float* sc = sh + 1024;
      const float* np = p.norm_pre + (size_t)L * D;
#pragma unroll
      for (int qd = 0; qd < 4; ++qd) {
        const float4 a = *(const float4*)(sh + qd * 256 + lane * 4);
        const float4 b = *(const float4*)(sc + qd * 256 + lane * 4);
        const float4 n = *(const float4*)(np + qd * 256 + lane * 4);
        const float h0 = xv[qd].x * rstd * n.x * (1.f + b.x) + a.x;
        const float h1 = xv[qd].y * rstd * n.y * (1.f + b.y) + a.y;
        const float h2 = xv[qd].z * rstd * n.z * (1.f + b.z) + a.z;
        const float h3 = xv[qd].w * rstd * n.w * (1.f + b.w) + a.w;
        *(uint2*)(H + (size_t)row * D + qd * 256 + lane * 4) = make_uint2(pack2(h0, h1), pack2(h2, h3));
      }
    }
  }
}

#undef ROW_XIN
#undef ROW_PREFETCH
DI int seq_row(int n, int b, int s) {
  if (s < 256) { const int t = n ? 255 - s : s; return NLAT + b * 256 + t; }
  const int u = s - 256; const int t = n ? 8191 - u : u; return b * 8192 + t;
}
DI void scan_chain(const Params& p, int j, int cid, const bf16_t* R, const bf16_t* Kb, const bf16_t* V, bf16_t* Y0, bf16_t* Y1, char* smem, const int TID) {
  const int n = cid >> 5, b = (cid >> 4) & 1, h = cid & 15;
  const int tid = TID;
  float* rS = (float*)smem;
  float* wS = rS + 1024; float* kS = wS + 1024; float* vS = kS + 1024; float* aS = vS + 1024; float* bS = aS + 1024;
  float* lwS = bS + 1024; float* laS = lwS + 1024;
  float* w2S = laS + 1024;
  float* a2S = w2S + 4096;
  float* yS = lwS;
  const bf16_t* LW = (const bf16_t*)(p.ws + OFF_LW);
  const bf16_t* LA = (const bf16_t*)(p.ws + OFF_LA);
  float* BON = (float*)(p.ws + OFF_BON);
  bf16_t* Y = n ? Y1 : Y0;
  __syncthreads();
  {
    const float* w2 = p.r_w2 + (size_t)(j * 2 + n) * 64 * 1024 + h * 64;
    const float* a2 = p.r_a2 + (size_t)(j * 2 + n) * 64 * 1024 + h * 64;
    for (int e = tid; e < 4096; e += 256) { w2S[e] = w2[(size_t)(e >> 6) * 1024 + (e & 63)]; a2S[e] = a2[(size_t)(e >> 6) * 1024 + (e & 63)]; }
  }
  const int ltok = tid >> 4, cq = tid & 15, c4 = cq * 4;
  const int gc = h * 64 + c4;
  const float4 w0v = *(const float4*)(p.r_w0 + (size_t)(j * 2 + n) * 1024 + gc);
  const float4 a0v = *(const float4*)(p.r_a0 + (size_t)(j * 2 + n) * 1024 + gc);
  const float4 kkv = *(const float4*)(p.r_k_k + (size_t)j * 1024 + gc);
  const float4 kav = *(const float4*)(p.r_k_a + (size_t)j * 1024 + gc);
  const float4 rkv = *(const float4*)(p.r_r_k + (size_t)j * 1024 + gc);
  const int si = tid >> 2, jq = tid & 3;
  float S[16];
#pragma unroll
  for (int e = 0; e < 16; ++e) S[e] = 0.f;
  for (int ck = 0; ck < 528; ++ck) {
    const int s = ck * 16 + ltok;
    const int row = seq_row(n, b, s);
    const uint2 ur = *(const uint2*)(R + (size_t)row * D + gc);
    const uint2 uk = *(const uint2*)(Kb + (size_t)row * D + gc);
    const uint2 uv = *(const uint2*)(V + (size_t)row * D + gc);
    const uint2 ulw = *(const uint2*)(LW + (size_t)row * 128 + n * 64 + c4);
    const uint2 ula = *(const uint2*)(LA + (size_t)row * 128 + n * 64 + c4);
    __syncthreads();
    *(float4*)(lwS + ltok * 64 + c4) = make_float4(lo2f(ulw.x), hi2f(ulw.x), lo2f(ulw.y), hi2f(ulw.y));
    *(float4*)(laS + ltok * 64 + c4) = make_float4(lo2f(ula.x), hi2f(ula.x), lo2f(ula.y), hi2f(ula.y));
    __syncthreads();
    float wz[4] = {w0v.x, w0v.y, w0v.z, w0v.w}, az[4] = {a0v.x, a0v.y, a0v.z, a0v.w};
    for (int l = 0; l < 64; ++l) {
      const float lw = lwS[ltok * 64 + l], la = laS[ltok * 64 + l];
      const float4 w2v = *(const float4*)(w2S + l * 64 + c4);
      const float4 a2v = *(const float4*)(a2S + l * 64 + c4);
      wz[0] += lw * w2v.x; wz[1] += lw * w2v.y; wz[2] += lw * w2v.z; wz[3] += lw * w2v.w;
      az[0] += la * a2v.x; az[1] += la * a2v.y; az[2] += la * a2v.z; az[3] += la * a2v.w;
    }
    const float rr[4] = {lo2f(ur.x), hi2f(ur.x), lo2f(ur.y), hi2f(ur.y)};
    const float kr[4] = {lo2f(uk.x), hi2f(uk.x), lo2f(uk.y), hi2f(uk.y)};
    const float vr[4] = {lo2f(uv.x), hi2f(uv.x), lo2f(uv.y), hi2f(uv.y)};
    const float kkw[4] = {kkv.x, kkv.y, kkv.z, kkv.w}, kaw[4] = {kav.x, kav.y, kav.z, kav.w}, rkw[4] = {rkv.x, rkv.y, rkv.z, rkv.w};
    float kk[4], ss = 0.f;
#pragma unroll
    for (int e = 0; e < 4; ++e) { kk[e] = kr[e] * kkw[e]; ss += kk[e] * kk[e]; }
#pragma unroll
    for (int o = 8; o > 0; o >>= 1) ss += __shfl_xor(ss, o, 64);
    const float inv = 1.f / fmaxf(sqrtf(ss), 1e-12f);
    float dec[4], as[4], kd[4], bb[4], bon = 0.f;
#pragma unroll
    for (int e = 0; e < 4; ++e) {
      kk[e] *= inv;
      dec[e] = __expf(-__expf(-softplus_f(-wz[e]) - 0.5f));
      as[e] = sigmoid_f(az[e]);
      kd[e] = kr[e] * (1.f + (as[e] - 1.f) * kaw[e]);
      bb[e] = kk[e] * as[e];
      bon += rr[e] * kd[e] * rkw[e];
    }
#pragma unroll
    for (int o = 8; o > 0; o >>= 1) bon += __shfl_xor(bon, o, 64);
    if (cq == 0) BON[((size_t)n * NR + row) * 16 + h] = bon;
    *(float4*)(rS + ltok * 64 + c4) = make_float4(rr[0], rr[1], rr[2], rr[3]);
    *(float4*)(wS + ltok * 64 + c4) = make_float4(dec[0], dec[1], dec[2], dec[3]);
    *(float4*)(kS + ltok * 64 + c4) = make_float4(kd[0], kd[1], kd[2], kd[3]);
    *(float4*)(vS + ltok * 64 + c4) = make_float4(vr[0], vr[1], vr[2], vr[3]);
    *(float4*)(aS + ltok * 64 + c4) = make_float4(-kk[0], -kk[1], -kk[2], -kk[3]);
    *(float4*)(bS + ltok * 64 + c4) = make_float4(bb[0], bb[1], bb[2], bb[3]);
    __syncthreads();
    for (int t = 0; t < 16; ++t) {
      float av[16], sa = 0.f;
#pragma unroll
      for (int m = 0; m < 4; ++m) {
        const float4 a4 = *(const float4*)(aS + t * 64 + jq * 16 + m * 4);
        av[m * 4] = a4.x; av[m * 4 + 1] = a4.y; av[m * 4 + 2] = a4.z; av[m * 4 + 3] = a4.w;
      }
#pragma unroll
      for (int e = 0; e < 16; ++e) sa += S[e] * av[e];
      sa += __shfl_xor(sa, 1, 64);
      sa += __shfl_xor(sa, 2, 64);
      const float vi = vS[t * 64 + si];
      float y = 0.f;
#pragma unroll
      for (int m = 0; m < 4; ++m) {
        const float4 w4 = *(const float4*)(wS + t * 64 + jq * 16 + m * 4);
        const float4 b4 = *(const float4*)(bS + t * 64 + jq * 16 + m * 4);
        const float4 k4 = *(const float4*)(kS + t * 64 + jq * 16 + m * 4);
        const float4 r4 = *(const float4*)(rS + t * 64 + jq * 16 + m * 4);
        S[m * 4 + 0] = S[m * 4 + 0] * w4.x + sa * b4.x + vi * k4.x; y += S[m * 4 + 0] * r4.x;
        S[m * 4 + 1] = S[m * 4 + 1] * w4.y + sa * b4.y + vi * k4.y; y += S[m * 4 + 1] * r4.y;
        S[m * 4 + 2] = S[m * 4 + 2] * w4.z + sa * b4.z + vi * k4.z; y += S[m * 4 + 2] * r4.z;
        S[m * 4 + 3] = S[m * 4 + 3] * w4.w + sa * b4.w + vi * k4.w; y += S[m * 4 + 3] * r4.w;
      }
      y += __shfl_xor(y, 1, 64);
      y += __shfl_xor(y, 2, 64);
      if (jq == 0) yS[t * 64 + si] = y;
    }
    __syncthreads();
    {
      const float4 yv = *(const float4*)(yS + ltok * 64 + c4);
      *(uint2*)(Y + (size_t)row * D + gc) = make_uint2(pack2(yv.x, yv.y), pack2(yv.z, yv.w));
    }
  }
}


constexpr int CS_W2T = 0, CS_A2T = 9216, CS_R1 = 18432, CS_R2 = 27648, CS_R3 = 36864, CS_WZ = 46080, CS_AZ = 62464,
              CS_AT = 78848, CS_RT = 88064, CS_BT = 97280, CS_KT = 106496, CS_VT = 115712, CS_AAB = 124928, CS_UV = 142336,
              CS_S0T = 151552, CS_TOT = 160768, CS_CL = 161792, CS_CST = 162048, CS_END = 163328;
DI s16x8 lds_row8(const char* base, int row, int col) { return *(const s16x8*)(base + row * 144 + col * 2); }
DI s16x8 lds_tr8(const char* base, int krow0, int ncol0, int lane) {
  const int g = lane >> 4, li = lane & 15, qq = li >> 2, pp = li & 3;
  const int off = (krow0 + 8 * (g >> 1) + qq) * 144 + (ncol0 + 16 * (g & 1) + 4 * pp) * 2;
  const s16x4 lo = __builtin_amdgcn_ds_read_tr16_b64_v4i16((__attribute__((address_space(3))) s16x4*)(base + off));
  const s16x4 hi = __builtin_amdgcn_ds_read_tr16_b64_v4i16((__attribute__((address_space(3))) s16x4*)(base + off + 4 * 144));
  return __builtin_shufflevector(lo, hi, 0, 1, 2, 3, 4, 5, 6, 7);
}
DI void unpack16(const uint4 a, const uint4 b, float* f) {
  f[0] = lo2f(a.x); f[1] = hi2f(a.x); f[2] = lo2f(a.y); f[3] = hi2f(a.y); f[4] = lo2f(a.z); f[5] = hi2f(a.z); f[6] = lo2f(a.w); f[7] = hi2f(a.w);
  f[8] = lo2f(b.x); f[9] = hi2f(b.x); f[10] = lo2f(b.y); f[11] = hi2f(b.y); f[12] = lo2f(b.z); f[13] = hi2f(b.z); f[14] = lo2f(b.w); f[15] = hi2f(b.w);
}
DI void store16bf(char* dst, const float* f) {
  *(uint4*)dst = make_uint4(pack2(f[0], f[1]), pack2(f[2], f[3]), pack2(f[4], f[5]), pack2(f[6], f[7]));
  *(uint4*)(dst + 16) = make_uint4(pack2(f[8], f[9]), pack2(f[10], f[11]), pack2(f[12], f[13]), pack2(f[14], f[15]));
}
constexpr int NSEG = 5;
DI int seg_start(int sg) { return sg == 0 ? 0 : (sg == 1 ? 24 : (sg == 2 ? 51 : (sg == 3 ? 78 : (sg == 4 ? 105 : 132)))); }
template <int MODE>
DI void scan_chain_chunked(const Params& p, int j, int cid, int seg, float* SCR, const bf16_t* R, const bf16_t* Kb, const bf16_t* V, bf16_t* Y0, bf16_t* Y1, char* smem, const int TID) {
  const int n = cid >> 5, b = (cid >> 4) & 1, hd = cid & 15;
  const int tid = TID, lane = tid & 63, w = tid >> 6, l31 = lane & 31, hh = lane >> 5;
  const int mi = w >> 1, ni = w & 1;
  const int tok = tid >> 2, q = tid & 3, c0 = 16 * q;
  const bf16_t* LW = (const bf16_t*)(p.ws + OFF_LW);
  const bf16_t* LA = (const bf16_t*)(p.ws + OFF_LA);
  float* BON = (float*)(p.ws + OFF_BON);
  bf16_t* Y = n ? Y1 : Y0;
  float* WZ = (float*)(smem + CS_WZ);
  float* AZ = (float*)(smem + CS_AZ);
  float* AABD = (float*)(smem + CS_AAB + 9216);
  float* TOT = (float*)(smem + CS_TOT);
  float* CL = (float*)(smem + CS_CL);
  float* CST = (float*)(smem + CS_CST);
  __syncthreads();
  {
    const float* w2 = p.r_w2 + (size_t)(j * 2 + n) * 64 * 1024 + hd * 64;
    const float* a2 = p.r_a2 + (size_t)(j * 2 + n) * 64 * 1024 + hd * 64;
    for (int e = tid; e < 4096; e += 256) {
      const int l = e >> 6, col = e & 63;
      *(bf16_t*)(smem + CS_W2T + col * 144 + l * 2) = f2bf(w2[(size_t)l * 1024 + col]);
      *(bf16_t*)(smem + CS_A2T + col * 144 + l * 2) = f2bf(a2[(size_t)l * 1024 + col]);
    }
    for (int e = tid; e < 64 * 72; e += 256) *(bf16_t*)(smem + CS_S0T + e * 2) = 0;
    if (tid < 64) {
      CST[tid] = p.r_w0[(size_t)(j * 2 + n) * 1024 + hd * 64 + tid];
      CST[64 + tid] = p.r_a0[(size_t)(j * 2 + n) * 1024 + hd * 64 + tid];
      CST[128 + tid] = p.r_k_k[(size_t)j * 1024 + hd * 64 + tid];
      CST[192 + tid] = p.r_k_a[(size_t)j * 1024 + hd * 64 + tid];
      CST[256 + tid] = p.r_r_k[(size_t)j * 1024 + hd * 64 + tid];
    }
  }
  f32x16 Sacc, Pacc;
#pragma unroll
  for (int r = 0; r < 16; ++r) { Sacc[r] = 0.f; Pacc[r] = 0.f; }
  if (MODE == 0) {
    for (int e = tid; e < 64 * 72; e += 256) *(bf16_t*)(smem + CS_RT + e * 2) = ((e / 72) == (e % 72)) ? (bf16_t)0x3f80 : (bf16_t)0;
#pragma unroll
    for (int r = 0; r < 16; ++r) Pacc[r] = ((32 * mi + crow(r, hh)) == (32 * ni + l31)) ? 1.f : 0.f;
  } else if (seg > 0) {
    const int jr = tid >> 2, ib = (tid & 3) * 16;
    const float* PQ = SCR + (size_t)(cid * 4) * 8192;
    float nv[16];
#pragma unroll
    for (int e = 0; e < 16; ++e) nv[e] = PQ[4096 + jr * 64 + ib + e];
    for (int sg = 1; sg < seg; ++sg) {
      __syncthreads();
#pragma unroll
      for (int e = 0; e < 16; ++e) WZ[jr * 64 + ib + e] = nv[e];
      __syncthreads();
      const float* Pm = PQ + (size_t)sg * 8192;
#pragma unroll
      for (int e = 0; e < 16; ++e) nv[e] = Pm[4096 + jr * 64 + ib + e];
      for (int jp = 0; jp < 64; jp += 4) {
        const float4 pv = *(const float4*)(Pm + jr * 64 + jp);
#pragma unroll
        for (int e = 0; e < 16; ++e)
          nv[e] += pv.x * WZ[(jp + 0) * 64 + ib + e] + pv.y * WZ[(jp + 1) * 64 + ib + e] + pv.z * WZ[(jp + 2) * 64 + ib + e] + pv.w * WZ[(jp + 3) * 64 + ib + e];
      }
    }
    __syncthreads();
#pragma unroll
    for (int e = 0; e < 16; ++e) WZ[jr * 64 + ib + e] = nv[e];
    __syncthreads();
#pragma unroll
    for (int r = 0; r < 16; ++r) {
      const int rrow = 32 * mi + crow(r, hh), ccol = 32 * ni + l31;
      Sacc[r] = WZ[rrow * 64 + ccol];
      *(bf16_t*)(smem + CS_S0T + rrow * 144 + ccol * 2) = f2bf(Sacc[r]);
    }
    __syncthreads();
  }
  const int ck0 = seg_start(seg), ck1 = seg_start(seg + 1);
  uint4 ur0, ur1, uk0, uk1, uv0, uv1, l0, l1, m0, m1;
#define SCAN_LOAD(CK) { const int row_ = seq_row(n, b, (CK) * 64 + tok); const size_t g_ = (size_t)row_ * D + hd * 64 + c0; \
    ur0 = *(const uint4*)(R + g_); ur1 = *(const uint4*)(R + g_ + 8); uk0 = *(const uint4*)(Kb + g_); uk1 = *(const uint4*)(Kb + g_ + 8); \
    uv0 = *(const uint4*)(V + g_); uv1 = *(const uint4*)(V + g_ + 8); \
    l0 = *(const uint4*)(LW + (size_t)row_ * 128 + n * 64 + c0); l1 = *(const uint4*)(LW + (size_t)row_ * 128 + n * 64 + c0 + 8); \
    m0 = *(const uint4*)(LA + (size_t)row_ * 128 + n * 64 + c0); m1 = *(const uint4*)(LA + (size_t)row_ * 128 + n * 64 + c0 + 8); }
  SCAN_LOAD(ck0)
  for (int ck = ck0; ck < ck1; ++ck) {
    const int row = seq_row(n, b, ck * 64 + tok);
    *(uint4*)(smem + CS_R1 + tok * 144 + c0 * 2) = l0; *(uint4*)(smem + CS_R1 + tok * 144 + c0 * 2 + 16) = l1;
    *(uint4*)(smem + CS_R2 + tok * 144 + c0 * 2) = m0; *(uint4*)(smem + CS_R2 + tok * 144 + c0 * 2 + 16) = m1;
    __syncthreads();
    {
      f32x16 awz, aaz;
#pragma unroll
      for (int r = 0; r < 16; ++r) { awz[r] = 0.f; aaz[r] = 0.f; }
#pragma unroll
      for (int kk = 0; kk < 4; ++kk) {
        const s16x8 alw = lds_row8(smem + CS_R1, 32 * mi + l31, kk * 16 + 8 * hh);
        const s16x8 ala = lds_row8(smem + CS_R2, 32 * mi + l31, kk * 16 + 8 * hh);
        const s16x8 bw = lds_row8(smem + CS_W2T, 32 * ni + l31, kk * 16 + 8 * hh);
        const s16x8 ba = lds_row8(smem + CS_A2T, 32 * ni + l31, kk * 16 + 8 * hh);
        awz = MFMA(alw, bw, awz);
        aaz = MFMA(ala, ba, aaz);
      }
#pragma unroll
      for (int r = 0; r < 16; ++r) {
        const int t = 32 * mi + crow(r, hh), col = 32 * ni + l31;
        WZ[t * 64 + col] = awz[r];
        AZ[t * 64 + col] = aaz[r];
      }
    }
    __syncthreads();
    float lw[16], rr[16], kd[16], av[16], bb[16];
    {
      float kr[16], cw0[16], ca0[16], ckk[16], cka[16], crk[16], wzv[16], azv[16];
      unpack16(ur0, ur1, rr);
      unpack16(uk0, uk1, kr);
#pragma unroll
      for (int e4 = 0; e4 < 4; ++e4) {
        const float4 v0 = *(const float4*)(CST + c0 + e4 * 4), v1 = *(const float4*)(CST + 64 + c0 + e4 * 4), v2 = *(const float4*)(CST + 128 + c0 + e4 * 4);
        const float4 v3 = *(const float4*)(CST + 192 + c0 + e4 * 4), v4 = *(const float4*)(CST + 256 + c0 + e4 * 4);
        const float4 v5 = *(const float4*)(WZ + tok * 64 + c0 + e4 * 4), v6 = *(const float4*)(AZ + tok * 64 + c0 + e4 * 4);
        cw0[e4 * 4] = v0.x; cw0[e4 * 4 + 1] = v0.y; cw0[e4 * 4 + 2] = v0.z; cw0[e4 * 4 + 3] = v0.w;
        ca0[e4 * 4] = v1.x; ca0[e4 * 4 + 1] = v1.y; ca0[e4 * 4 + 2] = v1.z; ca0[e4 * 4 + 3] = v1.w;
        ckk[e4 * 4] = v2.x; ckk[e4 * 4 + 1] = v2.y; ckk[e4 * 4 + 2] = v2.z; ckk[e4 * 4 + 3] = v2.w;
        cka[e4 * 4] = v3.x; cka[e4 * 4 + 1] = v3.y; cka[e4 * 4 + 2] = v3.z; cka[e4 * 4 + 3] = v3.w;
        crk[e4 * 4] = v4.x; crk[e4 * 4 + 1] = v4.y; crk[e4 * 4 + 2] = v4.z; crk[e4 * 4 + 3] = v4.w;
        wzv[e4 * 4] = v5.x; wzv[e4 * 4 + 1] = v5.y; wzv[e4 * 4 + 2] = v5.z; wzv[e4 * 4 + 3] = v5.w;
        azv[e4 * 4] = v6.x; azv[e4 * 4 + 1] = v6.y; azv[e4 * 4 + 2] = v6.z; azv[e4 * 4 + 3] = v6.w;
      }
      float ss = 0.f;
#pragma unroll
      for (int e = 0; e < 16; ++e) { av[e] = kr[e] * ckk[e]; ss += av[e] * av[e]; }
      ss = dpp_add<0xB1>(ss);
      ss = dpp_add<0x4E>(ss);
      const float inv = __frsqrt_rn(fmaxf(ss, 1e-24f));
      float bon = 0.f;
#pragma unroll
      for (int e = 0; e < 16; ++e) {
        const float wz = wzv[e] + cw0[e];
        const float az = azv[e] + ca0[e];
        lw[e] = -0.60653066f * fsig(wz);
        const float as = fsig(az);
        const float kkn = av[e] * inv;
        kd[e] = kr[e] * (1.f + (as - 1.f) * cka[e]);
        bb[e] = kkn * as;
        av[e] = -kkn;
        bon += rr[e] * kd[e] * crk[e];
      }
#pragma unroll
      for (int e4 = 0; e4 < 4; ++e4) *(float4*)(WZ + tok * 64 + c0 + e4 * 4) = make_float4(lw[e4 * 4], lw[e4 * 4 + 1], lw[e4 * 4 + 2], lw[e4 * 4 + 3]);
      bon = dpp_add<0xB1>(bon);
      bon = dpp_add<0x4E>(bon);
      if (MODE == 1 && q == 0) BON[((size_t)n * NR + row) * 16 + hd] = bon;
    }
    __syncthreads();
    {
      const int col = tid & 63, qt = tid >> 6;
      float pv[16];
#pragma unroll
      for (int t = 0; t < 16; ++t) pv[t] = WZ[(16 * qt + t) * 64 + col];
      float sacc = 0.f;
#pragma unroll
      for (int t = 0; t < 16; ++t) { sacc += pv[t]; WZ[(16 * qt + t) * 64 + col] = sacc; }
      TOT[qt * 64 + col] = sacc;
    }
    __syncthreads();
    {
      float fa[16], fr[16], fb[16], fk[16], fv[16];
      unpack16(uv0, uv1, fv);
      const int qt = tok >> 4;
      float tb[16], tt[16], cum[16];
#pragma unroll
      for (int e4 = 0; e4 < 4; ++e4) {
        const float4 t0 = *(const float4*)(TOT + c0 + e4 * 4), t1 = *(const float4*)(TOT + 64 + c0 + e4 * 4);
        const float4 t2 = *(const float4*)(TOT + 128 + c0 + e4 * 4), t3 = *(const float4*)(TOT + 192 + c0 + e4 * 4);
        const float4 cv = *(const float4*)(WZ + tok * 64 + c0 + e4 * 4);
        const float m0_ = qt > 0 ? 1.f : 0.f, m1_ = qt > 1 ? 1.f : 0.f, m2_ = qt > 2 ? 1.f : 0.f;
        tb[e4 * 4] = m0_ * t0.x + m1_ * t1.x + m2_ * t2.x; tb[e4 * 4 + 1] = m0_ * t0.y + m1_ * t1.y + m2_ * t2.y;
        tb[e4 * 4 + 2] = m0_ * t0.z + m1_ * t1.z + m2_ * t2.z; tb[e4 * 4 + 3] = m0_ * t0.w + m1_ * t1.w + m2_ * t2.w;
        tt[e4 * 4] = t0.x + t1.x + t2.x + t3.x; tt[e4 * 4 + 1] = t0.y + t1.y + t2.y + t3.y;
        tt[e4 * 4 + 2] = t0.z + t1.z + t2.z + t3.z; tt[e4 * 4 + 3] = t0.w + t1.w + t2.w + t3.w;
        cum[e4 * 4] = cv.x; cum[e4 * 4 + 1] = cv.y; cum[e4 * 4 + 2] = cv.z; cum[e4 * 4 + 3] = cv.w;
      }
#pragma unroll
      for (int e = 0; e < 16; ++e) {
        const float incl = cum[e] + tb[e];
        const float excl = incl - lw[e];
        const float ei = __expf(incl), ee = __expf(excl), nin = __builtin_amdgcn_rcpf(ei);
        fa[e] = av[e] * ee; fr[e] = rr[e] * ei; fb[e] = bb[e] * nin; fk[e] = kd[e] * nin;
      }
#pragma unroll
      for (int e4 = 0; e4 < 4; ++e4) {
        *(float4*)(WZ + tok * 64 + c0 + e4 * 4) = make_float4(fa[e4 * 4], fa[e4 * 4 + 1], fa[e4 * 4 + 2], fa[e4 * 4 + 3]);
        if (tok == 0) *(float4*)(CL + c0 + e4 * 4) = make_float4(__expf(tt[e4 * 4]), __expf(tt[e4 * 4 + 1]), __expf(tt[e4 * 4 + 2]), __expf(tt[e4 * 4 + 3]));
      }
      store16bf(smem + CS_AT + tok * 144 + c0 * 2, fa);
      if (MODE == 1) store16bf(smem + CS_RT + tok * 144 + c0 * 2, fr);
      store16bf(smem + CS_BT + tok * 144 + c0 * 2, fb);
      store16bf(smem + CS_KT + tok * 144 + c0 * 2, fk);
      *(uint4*)(smem + CS_VT + tok * 144 + c0 * 2) = uv0;
      *(uint4*)(smem + CS_VT + tok * 144 + c0 * 2 + 16) = uv1;
    }
    if (ck + 1 < ck1) SCAN_LOAD(ck + 1)
    __syncthreads();
    {
      f32x16 ab, ak, rb, rk;
#pragma unroll
      for (int r = 0; r < 16; ++r) { ab[r] = 0.f; ak[r] = 0.f; rb[r] = 0.f; rk[r] = 0.f; }
      if (mi >= ni) {
#pragma unroll
        for (int kk = 0; kk < 4; ++kk) {
          const s16x8 aA = lds_row8(smem + CS_AT, 32 * mi + l31, kk * 16 + 8 * hh);
          const s16x8 aR = lds_row8(smem + CS_RT, 32 * mi + l31, kk * 16 + 8 * hh);
          const s16x8 bB = lds_row8(smem + CS_BT, 32 * ni + l31, kk * 16 + 8 * hh);
          const s16x8 bK = lds_row8(smem + CS_KT, 32 * ni + l31, kk * 16 + 8 * hh);
          ab = MFMA(aA, bB, ab); ak = MFMA(aA, bK, ak);
          if (MODE == 1) { rb = MFMA(aR, bB, rb); rk = MFMA(aR, bK, rk); }
        }
      }
#pragma unroll
      for (int r = 0; r < 16; ++r) {
        const int t = 32 * mi + crow(r, hh), sx = 32 * ni + l31;
        const bool lo_s = sx < t, lo_i = sx <= t;
        *(bf16_t*)(smem + CS_AAB + t * 144 + sx * 2) = f2bf(lo_s ? ab[r] : 0.f);
        if ((t >> 4) == (sx >> 4)) AABD[(t >> 4) * 256 + (t & 15) * 16 + (sx & 15)] = lo_s ? ab[r] : 0.f;
        *(bf16_t*)(smem + CS_R1 + t * 144 + sx * 2) = f2bf(lo_s ? ak[r] : 0.f);
        if (MODE == 1) {
          *(bf16_t*)(smem + CS_R2 + t * 144 + sx * 2) = f2bf(lo_i ? rb[r] : 0.f);
          *(bf16_t*)(smem + CS_R3 + t * 144 + sx * 2) = f2bf(lo_i ? rk[r] : 0.f);
        }
      }
    }
    __syncthreads();
    {
      f32x16 xu;
#pragma unroll
      for (int r = 0; r < 16; ++r) xu[r] = 0.f;
#pragma unroll
      for (int kk = 0; kk < 4; ++kk) {
        const s16x8 a = lds_row8(smem + CS_R1, 32 * mi + l31, kk * 16 + 8 * hh);
        const s16x8 bv = lds_tr8(smem + CS_VT, kk * 16, 32 * ni, lane);
        xu = MFMA(a, bv, xu);
      }
#pragma unroll
      for (int r = 0; r < 16; ++r) AZ[(32 * mi + crow(r, hh)) * 64 + 32 * ni + l31] = xu[r];
    }
    __syncthreads();
#pragma unroll
    for (int bk = 0; bk < 4; ++bk) {
      if (tid < 128) {
        float* rhs = (tid < 64) ? (WZ + tid) : (AZ + (tid - 64));
        float x[16], am[16][16];
#pragma unroll
        for (int r = 0; r < 16; ++r) x[r] = rhs[(16 * bk + r) * 64];
#pragma unroll
        for (int tp = 1; tp < 16; ++tp) {
#pragma unroll
          for (int s4 = 0; s4 < (tp + 3) / 4; ++s4) {
            const float4 v = *(const float4*)(AABD + bk * 256 + tp * 16 + s4 * 4);
            am[tp][s4 * 4] = v.x; am[tp][s4 * 4 + 1] = v.y; am[tp][s4 * 4 + 2] = v.z; am[tp][s4 * 4 + 3] = v.w;
          }
        }
#pragma unroll
        for (int sx = 0; sx < 15; ++sx) {
          const float xs = x[sx];
#pragma unroll
          for (int tp = sx + 1; tp < 16; ++tp) x[tp] = fmaf(am[tp][sx], xs, x[tp]);
        }
        char* dst = (tid < 64) ? (smem + CS_AT + tid * 2) : (smem + CS_UV + (tid - 64) * 2);
#pragma unroll
        for (int r = 0; r < 16; ++r) *(bf16_t*)(dst + (16 * bk + r) * 144) = f2bf(x[r]);
      }
      __syncthreads();
      if (bk < 3) {
        const char* xsrc = (w < 2) ? (smem + CS_AT) : (smem + CS_UV);
        float* rdst = (w < 2) ? WZ : AZ;
        const s16x8 bx = lds_tr8(xsrc, 16 * bk, 32 * (w & 1), lane);
#pragma unroll
        for (int rt = 0; rt < 2; ++rt) {
          if (32 * rt + 31 >= 16 * (bk + 1)) {
            f32x16 up;
#pragma unroll
            for (int r = 0; r < 16; ++r) up[r] = 0.f;
            const s16x8 aa = lds_row8(smem + CS_AAB, 32 * rt + l31, 16 * bk + 8 * hh);
            up = MFMA(aa, bx, up);
#pragma unroll
            for (int r = 0; r < 16; ++r) rdst[(32 * rt + crow(r, hh)) * 64 + 32 * (w & 1) + l31] += up[r];
          }
        }
        __syncthreads();
      }
    }
    f32x16 rh, yl, mm, cc;
#pragma unroll
    for (int r = 0; r < 16; ++r) { rh[r] = 0.f; yl[r] = 0.f; mm[r] = 0.f; cc[r] = 0.f; }
#pragma unroll
    for (int kk = 0; kk < 4; ++kk) {
      const s16x8 aRB = lds_row8(smem + CS_R2, 32 * mi + l31, kk * 16 + 8 * hh);
      const s16x8 aRK = lds_row8(smem + CS_R3, 32 * mi + l31, kk * 16 + 8 * hh);
      const s16x8 tAH = lds_tr8(smem + CS_AT, kk * 16, 32 * ni, lane);
      const s16x8 tUV = lds_tr8(smem + CS_UV, kk * 16, 32 * ni, lane);
      const s16x8 tVT = lds_tr8(smem + CS_VT, kk * 16, 32 * ni, lane);
      const s16x8 tBT = lds_tr8(smem + CS_BT, kk * 16, 32 * mi, lane);
      const s16x8 tKT = lds_tr8(smem + CS_KT, kk * 16, 32 * mi, lane);
      if (MODE == 1) {
        rh = MFMA(aRB, tAH, rh);
        yl = MFMA(aRB, tUV, yl);
        yl = MFMA(aRK, tVT, yl);
      }
      mm = MFMA(tBT, tAH, mm);
      cc = MFMA(tBT, tUV, cc);
      cc = MFMA(tKT, tVT, cc);
    }
#pragma unroll
    for (int r = 0; r < 16; ++r) if (MODE == 1) rh[r] += bf2f(*(const bf16_t*)(smem + CS_RT + (32 * mi + crow(r, hh)) * 144 + (32 * ni + l31) * 2));
    __syncthreads();
#pragma unroll
    for (int r = 0; r < 16; ++r) {
      const int rrow = 32 * mi + crow(r, hh), ccol = 32 * ni + l31;
      if (MODE == 1) *(bf16_t*)(smem + CS_R2 + rrow * 144 + ccol * 2) = f2bf(rh[r]);
      *(bf16_t*)(smem + CS_R3 + rrow * 144 + ccol * 2) = f2bf(mm[r]);
    }
    __syncthreads();
    f32x16 pp;
#pragma unroll
    for (int r = 0; r < 16; ++r) pp[r] = 0.f;
#pragma unroll
    for (int kk = 0; kk < 4; ++kk) {
      const s16x8 aMM = lds_row8(smem + CS_R3, 32 * mi + l31, kk * 16 + 8 * hh);
      const s16x8 tS = lds_tr8(smem + CS_S0T, kk * 16, 32 * ni, lane);
      if (MODE == 1) {
        const s16x8 aRH = lds_row8(smem + CS_R2, 32 * mi + l31, kk * 16 + 8 * hh);
        yl = MFMA(aRH, tS, yl);
      } else {
        const s16x8 tP = lds_tr8(smem + CS_RT, kk * 16, 32 * ni, lane);
        pp = MFMA(aMM, tP, pp);
      }
      cc = MFMA(aMM, tS, cc);
    }
#pragma unroll
    for (int r = 0; r < 16; ++r) {
      const float clv = CL[32 * mi + crow(r, hh)];
      Sacc[r] = clv * (Sacc[r] + cc[r]);
      if (MODE == 0) Pacc[r] = clv * (Pacc[r] + pp[r]);
    }
    __syncthreads();
#pragma unroll
    for (int r = 0; r < 16; ++r) {
      const int rrow = 32 * mi + crow(r, hh), ccol = 32 * ni + l31;
      *(bf16_t*)(smem + CS_S0T + rrow * 144 + ccol * 2) = f2bf(Sacc[r]);
      if (MODE == 0) *(bf16_t*)(smem + CS_RT + rrow * 144 + ccol * 2) = f2bf(Pacc[r]);
      if (MODE == 1) {
        const int yrow = seq_row(n, b, ck * 64 + rrow);
        Y[(size_t)yrow * D + hd * 64 + ccol] = f2bf(yl[r]);
      }
    }
  }
  if (MODE == 0 || seg == 0) {
    float* PQ = SCR + (size_t)(cid * 4 + seg) * 8192;
#pragma unroll
    for (int r = 0; r < 16; ++r) {
      const int rrow = 32 * mi + crow(r, hh), ccol = 32 * ni + l31;
      if (MODE == 0) PQ[rrow * 64 + ccol] = Pacc[r];
      PQ[4096 + rrow * 64 + ccol] = Sacc[r];
    }
  }
}

DI void run_phase(const Params& p, int ph, char* smem, const int TID) {
  bf16_t* T0 = (bf16_t*)(p.ws + 0 * SLOT);
  bf16_t* T1 = (bf16_t*)(p.ws + 1 * SLOT);
  bf16_t* T2 = (bf16_t*)(p.ws + 2 * SLOT);
  bf16_t* T3 = (bf16_t*)(p.ws + 3 * SLOT);
  bf16_t* T4 = (bf16_t*)(p.ws + 4 * SLOT);
  bf16_t* T5 = (bf16_t*)(p.ws + 5 * SLOT);
  bf16_t* VF = (bf16_t*)(p.ws + OFF_VF);
  bf16_t* W = (bf16_t*)(p.ws + OFF_W);
  const int tid = TID;
#ifdef ONLY_PHASE
    const int type = ONLY_PHASE, layer = p.player[ph];
#else
    const int type = p.ptype[ph], layer = p.player[ph];
#endif
    const int j = layer >> 1;
    switch (type) {
#ifdef DBG_PREPFILL
      case PH_PREP0: {
        for (size_t i = (size_t)blockIdx.x * 256 + tid; i < (size_t)(1 << 20); i += (size_t)gridDim.x * 256)
          *(uint4*)(T4 + (size_t)(2 << 20) * 8 + i * 8) = make_uint4(0x3f803f80u, 0x3f803f80u, 0x3f803f80u, 0x3f803f80u);
      } break;
#else
      case PH_PREP0: phase_prep0(p, smem, TID); break;
#endif
      case PH_PRE0: {
        for (int it = blockIdx.x; it < 128; it += gridDim.x) fourier_precompose(p, it, smem, TID);
        row_items(p, 0, false, true, NR, nullptr, T0, blockIdx.x, NR / 4, TID);
      } break;
      case PH_FGEMM1: {
        const int MT = NR / 128, NT = 12;
        for (int t = blockIdx.x; t < MT * NT; t += gridDim.x) {
          const int mt = t / NT, nt = t % NT;
          gemm_tile_plain<false, 4>(T0, nullptr, nullptr, 1024, W, 1024, 1024, mt * 128, nt * 256, 3072, smem, TID,
                                    [=](int col0) { return col0 < 1024 ? T1 : (col0 < 2048 ? T2 : T3); });
        }
      } break;
      case PH_FDFT1: {
        const bf16_t* F1 = (const bf16_t*)(p.ws + OFF_F1);
        const bf16_t* FC = (const bf16_t*)(p.ws + OFF_FC);
        const float2* TW = (const float2*)(p.ws + OFF_TW);
        bf16_t* YB = T4;
        const float* bmix = p.f_b_mix + (size_t)j * 1024;
        const int nctx = (layer == 3) ? 0 : 32;
        {
          constexpr int L_B = 0, L_F1 = 40960, L_TW = L_F1 + 128 * 272;
          const int lane = tid & 63, w = tid >> 6, l31 = lane & 31, hh = lane >> 5;
          const int rt0 = w & 1, ctb = 2 * (w >> 1);
          __syncthreads();
#pragma unroll
          for (int i = 0; i < 8; ++i) {
            const int c = tid + 256 * i, r = c >> 4, cc = c & 15;
            *(uint4*)(smem + L_F1 + r * 272 + cc * 16) = *(const uint4*)(F1 + r * 128 + cc * 8);
          }
#pragma unroll
          for (int i = 0; i < 16; ++i) *(uint4*)(smem + L_TW + (tid + 256 * i) * 16) = *(const uint4*)((const char*)TW + (size_t)(tid + 256 * i) * 16);
          uint4 bp0, bp1, bp2, bp3, bp4, bp5, bp6, bp7;
          const int br = tid >> 4, bcc = tid & 15;
          int it = blockIdx.x;
          if (it < 2048) {
              const int itn_ = it;
              const int b_ = itn_ >> 10, t2_ = (itn_ >> 3) & 127, cb_ = itn_ & 7;
              const size_t tok0_ = (size_t)b_ * 8192 + t2_;
              { const int kr = br + 0; bp0 = *(const uint4*)((kr < 64 ? T1 + (tok0_ + (size_t)kr * 128) * D : T2 + (tok0_ + (size_t)(kr - 64) * 128) * D) + cb_ * 128 + bcc * 8); }
              { const int kr = br + 16; bp1 = *(const uint4*)((kr < 64 ? T1 + (tok0_ + (size_t)kr * 128) * D : T2 + (tok0_ + (size_t)(kr - 64) * 128) * D) + cb_ * 128 + bcc * 8); }
              { const int kr = br + 32; bp2 = *(const uint4*)((kr < 64 ? T1 + (tok0_ + (size_t)kr * 128) * D : T2 + (tok0_ + (size_t)(kr - 64) * 128) * D) + cb_ * 128 + bcc * 8); }
              { const int kr = br + 48; bp3 = *(const uint4*)((kr < 64 ? T1 + (tok0_ + (size_t)kr * 128) * D : T2 + (tok0_ + (size_t)(kr - 64) * 128) * D) + cb_ * 128 + bcc * 8); }
              { const int kr = br + 64; bp4 = *(const uint4*)((kr < 64 ? T1 + (tok0_ + (size_t)kr * 128) * D : T2 + (tok0_ + (size_t)(kr - 64) * 128) * D) + cb_ * 128 + bcc * 8); }
              { const int kr = br + 80; bp5 = *(const uint4*)((kr < 64 ? T1 + (tok0_ + (size_t)kr * 128) * D : T2 + (tok0_ + (size_t)(kr - 64) * 128) * D) + cb_ * 128 + bcc * 8); }
              { const int kr = br + 96; bp6 = *(const uint4*)((kr < 64 ? T1 + (tok0_ + (size_t)kr * 128) * D : T2 + (tok0_ + (size_t)(kr - 64) * 128) * D) + cb_ * 128 + bcc * 8); }
              { const int kr = br + 112; bp7 = *(const uint4*)((kr < 64 ? T1 + (tok0_ + (size_t)kr * 128) * D : T2 + (tok0_ + (size_t)(kr - 64) * 128) * D) + cb_ * 128 + bcc * 8); }
            }
          for (; it < 2048; it += gridDim.x) {
            const int b = it >> 10, t2 = (it >> 3) & 127, cb = it & 7;
            __syncthreads();
            *(uint4*)(smem + L_B + (br + 0) * 320 + bcc * 16) = bp0;
            *(uint4*)(smem + L_B + (br + 16) * 320 + bcc * 16) = bp1;
            *(uint4*)(smem + L_B + (br + 32) * 320 + bcc * 16) = bp2;
            *(uint4*)(smem + L_B + (br + 48) * 320 + bcc * 16) = bp3;
            *(uint4*)(smem + L_B + (br + 64) * 320 + bcc * 16) = bp4;
            *(uint4*)(smem + L_B + (br + 80) * 320 + bcc * 16) = bp5;
            *(uint4*)(smem + L_B + (br + 96) * 320 + bcc * 16) = bp6;
            *(uint4*)(smem + L_B + (br + 112) * 320 + bcc * 16) = bp7;
            __syncthreads();
            if (it + (int)gridDim.x < 2048) {
              const int itn_ = it + (int)gridDim.x;
              const int b_ = itn_ >> 10, t2_ = (itn_ >> 3) & 127, cb_ = itn_ & 7;
              const size_t tok0_ = (size_t)b_ * 8192 + t2_;
              { const int kr = br + 0; bp0 = *(const uint4*)((kr < 64 ? T1 + (tok0_ + (size_t)kr * 128) * D : T2 + (tok0_ + (size_t)(kr - 64) * 128) * D) + cb_ * 128 + bcc * 8); }
              { const int kr = br + 16; bp1 = *(const uint4*)((kr < 64 ? T1 + (tok0_ + (size_t)kr * 128) * D : T2 + (tok0_ + (size_t)(kr - 64) * 128) * D) + cb_ * 128 + bcc * 8); }
              { const int kr = br + 32; bp2 = *(const uint4*)((kr < 64 ? T1 + (tok0_ + (size_t)kr * 128) * D : T2 + (tok0_ + (size_t)(kr - 64) * 128) * D) + cb_ * 128 + bcc * 8); }
              { const int kr = br + 48; bp3 = *(const uint4*)((kr < 64 ? T1 + (tok0_ + (size_t)kr * 128) * D : T2 + (tok0_ + (size_t)(kr - 64) * 128) * D) + cb_ * 128 + bcc * 8); }
              { const int kr = br + 64; bp4 = *(const uint4*)((kr < 64 ? T1 + (tok0_ + (size_t)kr * 128) * D : T2 + (tok0_ + (size_t)(kr - 64) * 128) * D) + cb_ * 128 + bcc * 8); }
              { const int kr = br + 80; bp5 = *(const uint4*)((kr < 64 ? T1 + (tok0_ + (size_t)kr * 128) * D : T2 + (tok0_ + (size_t)(kr - 64) * 128) * D) + cb_ * 128 + bcc * 8); }
              { const int kr = br + 96; bp6 = *(const uint4*)((kr < 64 ? T1 + (tok0_ + (size_t)kr * 128) * D : T2 + (tok0_ + (size_t)(kr - 64) * 128) * D) + cb_ * 128 + bcc * 8); }
              { const int kr = br + 112; bp7 = *(const uint4*)((kr < 64 ? T1 + (tok0_ + (size_t)kr * 128) * D : T2 + (tok0_ + (size_t)(kr - 64) * 128) * D) + cb_ * 128 + bcc * 8); }
            }
            f32x16 acc[2][2];
#pragma unroll
            for (int i = 0; i < 2; ++i)
#pragma unroll
              for (int jj = 0; jj < 2; ++jj)
#pragma unroll
                for (int r = 0; r < 16; ++r) acc[i][jj][r] = 0.f;
            const int g = lane >> 4, li = lane & 15, qq = li >> 2, pp = li & 3;
            const int tr_base = (8 * (g >> 1) + qq) * 320 + (16 * (g & 1) + 4 * pp) * 2;
#pragma unroll
            for (int ks = 0; ks < 8; ++ks) {
              s16x8 af[2];
#pragma unroll
              for (int h = 0; h < 2; ++h) af[h] = *(const s16x8*)(smem + L_F1 + (32 * (rt0 + 2 * h) + l31) * 272 + (ks * 16 + hh * 8) * 2);
#pragma unroll
              for (int c2 = 0; c2 < 2; ++c2) {
                const int off = L_B + tr_base + ks * 16 * 320 + (ctb + c2) * 64;
                const s16x4 lo = __builtin_amdgcn_ds_read_tr16_b64_v4i16((__attribute__((address_space(3))) s16x4*)(smem + off));
                const s16x4 hi = __builtin_amdgcn_ds_read_tr16_b64_v4i16((__attribute__((address_space(3))) s16x4*)(smem + off + 4 * 320));
                const s16x8 bq = __builtin_shufflevector(lo, hi, 0, 1, 2, 3, 4, 5, 6, 7);
#pragma unroll
                for (int h = 0; h < 2; ++h) acc[h][c2] = MFMA(af[h], bq, acc[h][c2]);
              }
            }
#pragma unroll
            for (int c2 = 0; c2 < 2; ++c2) {
              const int col = 32 * (ctb + c2) + l31;
#pragma unroll
              for (int r = 0; r < 16; ++r) {
                const int k1 = 32 * rt0 + crow(r, hh);
                const float2 tw = *(const float2*)(smem + L_TW + (k1 * 128 + t2) * 8);
                const float va = acc[0][c2][r], vb = acc[1][c2][r];
                const float yr = va * tw.x - vb * tw.y, yi = va * tw.y + vb * tw.x;
                bf16_t* d = YB + ((size_t)b * 8192 + k1 * 128 + t2) * 2048 + cb * 128 + col;
                d[0] = f2bf(yr); d[1024] = f2bf(yi);
              }
            }
          }
        }
        for (int it = 2048 + blockIdx.x; it < 2048 + nctx; it += gridDim.x) {
          {
            const int u = it - 2048, b = u >> 4, cb = (u >> 1) & 7, mh = u & 1;
            const size_t tok0 = (size_t)NLAT + b * 256;
            const float scale = 0.005524271728019903f;
            dft_tile(FC, 512, mh * 128, 256, T1 + tok0 * D + cb * 128, T2 + tok0 * D + cb * 128, D, 1, smem, TID,
                     [=](int rowA, int rowB, int col, float va, float vb) {
                       const int cc = cb * 128 + col;
                       bf16_t* z0 = T3 + (tok0 + mh * 128 + rowA) * D + cc;
                       bf16_t* z1 = T3 + (tok0 + mh * 128 + rowB) * D + cc;
                       const float bm = bmix[cc];
                       z0[0] = f2bf((va * scale + bm) * silu_f(bf2f(z0[0])));
                       z1[0] = f2bf((vb * scale + bm) * silu_f(bf2f(z1[0])));
                     });
          }
        }
      } break;
      case PH_FDFT3: {
        const bf16_t* F2 = (const bf16_t*)(p.ws + OFF_F2);
        const bf16_t* YB = T4;
        const float* bmix = p.f_b_mix + (size_t)j * 1024;
        const float scale = 0.0009765625f;
        constexpr int L_B = 0, L_F2 = 256 * 320;
        const int lane = tid & 63, w = tid >> 6, l31 = lane & 31, hh = lane >> 5;
        const int rt0 = w & 1, ctb = 2 * (w >> 1);
        const int br = tid >> 4, bcc = tid & 15;
        __syncthreads();
#pragma unroll
        for (int i = 0; i < 16; ++i) {
          const int c = tid + 256 * i, r = c >> 5, cc = c & 31;
          *(uint4*)(smem + L_F2 + r * 528 + cc * 16) = *(const uint4*)(F2 + r * 256 + cc * 8);
        }
        uint4 bp0, bp1, bp2, bp3, bp4, bp5, bp6, bp7, bp8, bp9, bp10, bp11, bp12, bp13, bp14, bp15;
        int it = blockIdx.x;
        if (it < 1024) {
          const int b_ = it >> 9, k1_ = (it >> 3) & 63, cb_ = it & 7;
          const size_t tok0_ = (size_t)b_ * 8192 + k1_ * 128;
              bp0 = *(const uint4*)(YB + (tok0_ + (size_t)(br + 0)) * 2048 + 0 + cb_ * 128 + bcc * 8);
              bp1 = *(const uint4*)(YB + (tok0_ + (size_t)(br + 16)) * 2048 + 0 + cb_ * 128 + bcc * 8);
              bp2 = *(const uint4*)(YB + (tok0_ + (size_t)(br + 32)) * 2048 + 0 + cb_ * 128 + bcc * 8);
              bp3 = *(const uint4*)(YB + (tok0_ + (size_t)(br + 48)) * 2048 + 0 + cb_ * 128 + bcc * 8);
              bp4 = *(const uint4*)(YB + (tok0_ + (size_t)(br + 64)) * 2048 + 0 + cb_ * 128 + bcc * 8);
              bp5 = *(const uint4*)(YB + (tok0_ + (size_t)(br + 80)) * 2048 + 0 + cb_ * 128 + bcc * 8);
              bp6 = *(const uint4*)(YB + (tok0_ + (size_t)(br + 96)) * 2048 + 0 + cb_ * 128 + bcc * 8);
              bp7 = *(const uint4*)(YB + (tok0_ + (size_t)(br + 112)) * 2048 + 0 + cb_ * 128 + bcc * 8);
              bp8 = *(const uint4*)(YB + (tok0_ + (size_t)(br + 0)) * 2048 + 1024 + cb_ * 128 + bcc * 8);
              bp9 = *(const uint4*)(YB + (tok0_ + (size_t)(br + 16)) * 2048 + 1024 + cb_ * 128 + bcc * 8);
              bp10 = *(const uint4*)(YB + (tok0_ + (size_t)(br + 32)) * 2048 + 1024 + cb_ * 128 + bcc * 8);
              bp11 = *(const uint4*)(YB + (tok0_ + (size_t)(br + 48)) * 2048 + 1024 + cb_ * 128 + bcc * 8);
              bp12 = *(const uint4*)(YB + (tok0_ + (size_t)(br + 64)) * 2048 + 1024 + cb_ * 128 + bcc * 8);
              bp13 = *(const uint4*)(YB + (tok0_ + (size_t)(br + 80)) * 2048 + 1024 + cb_ * 128 + bcc * 8);
              bp14 = *(const uint4*)(YB + (tok0_ + (size_t)(br + 96)) * 2048 + 1024 + cb_ * 128 + bcc * 8);
              bp15 = *(const uint4*)(YB + (tok0_ + (size_t)(br + 112)) * 2048 + 1024 + cb_ * 128 + bcc * 8);
        }
        for (; it < 1024; it += gridDim.x) {
          const int b = it >> 9, k1 = (it >> 3) & 63, cb = it & 7;
          __syncthreads();
            *(uint4*)(smem + L_B + (0 + br + 0) * 320 + bcc * 16) = bp0;
            *(uint4*)(smem + L_B + (0 + br + 16) * 320 + bcc * 16) = bp1;
            *(uint4*)(smem + L_B + (0 + br + 32) * 320 + bcc * 16) = bp2;
            *(uint4*)(smem + L_B + (0 + br + 48) * 320 + bcc * 16) = bp3;
            *(uint4*)(smem + L_B + (0 + br + 64) * 320 + bcc * 16) = bp4;
            *(uint4*)(smem + L_B + (0 + br + 80) * 320 + bcc * 16) = bp5;
            *(uint4*)(smem + L_B + (0 + br + 96) * 320 + bcc * 16) = bp6;
            *(uint4*)(smem + L_B + (0 + br + 112) * 320 + bcc * 16) = bp7;
            *(uint4*)(smem + L_B + (128 + br + 0) * 320 + bcc * 16) = bp8;
            *(uint4*)(smem + L_B + (128 + br + 16) * 320 + bcc * 16) = bp9;
            *(uint4*)(smem + L_B + (128 + br + 32) * 320 + bcc * 16) = bp10;
            *(uint4*)(smem + L_B + (128 + br + 48) * 320 + bcc * 16) = bp11;
            *(uint4*)(smem + L_B + (128 + br + 64) * 320 + bcc * 16) = bp12;
            *(uint4*)(smem + L_B + (128 + br + 80) * 320 + bcc * 16) = bp13;
            *(uint4*)(smem + L_B + (128 + br + 96) * 320 + bcc * 16) = bp14;
            *(uint4*)(smem + L_B + (128 + br + 112) * 320 + bcc * 16) = bp15;
          __syncthreads();
          if (it + (int)gridDim.x < 1024) {
            const int itn_ = it + (int)gridDim.x;
            const int b_ = itn_ >> 9, k1_ = (itn_ >> 3) & 63, cb_ = itn_ & 7;
            const size_t tok0_ = (size_t)b_ * 8192 + k1_ * 128;
              bp0 = *(const uint4*)(YB + (tok0_ + (size_t)(br + 0)) * 2048 + 0 + cb_ * 128 + bcc * 8);
              bp1 = *(const uint4*)(YB + (tok0_ + (size_t)(br + 16)) * 2048 + 0 + cb_ * 128 + bcc * 8);
              bp2 = *(const uint4*)(YB + (tok0_ + (size_t)(br + 32)) * 2048 + 0 + cb_ * 128 + bcc * 8);
              bp3 = *(const uint4*)(YB + (tok0_ + (size_t)(br + 48)) * 2048 + 0 + cb_ * 128 + bcc * 8);
              bp4 = *(const uint4*)(YB + (tok0_ + (size_t)(br + 64)) * 2048 + 0 + cb_ * 128 + bcc * 8);
              bp5 = *(const uint4*)(YB + (tok0_ + (size_t)(br + 80)) * 2048 + 0 + cb_ * 128 + bcc * 8);
              bp6 = *(const uint4*)(YB + (tok0_ + (size_t)(br + 96)) * 2048 + 0 + cb_ * 128 + bcc * 8);
              bp7 = *(const uint4*)(YB + (tok0_ + (size_t)(br + 112)) * 2048 + 0 + cb_ * 128 + bcc * 8);
              bp8 = *(const uint4*)(YB + (tok0_ + (size_t)(br + 0)) * 2048 + 1024 + cb_ * 128 + bcc * 8);
              bp9 = *(const uint4*)(YB + (tok0_ + (size_t)(br + 16)) * 2048 + 1024 + cb_ * 128 + bcc * 8);
              bp10 = *(const uint4*)(YB + (tok0_ + (size_t)(br + 32)) * 2048 + 1024 + cb_ * 128 + bcc * 8);
              bp11 = *(const uint4*)(YB + (tok0_ + (size_t)(br + 48)) * 2048 + 1024 + cb_ * 128 + bcc * 8);
              bp12 = *(const uint4*)(YB + (tok0_ + (size_t)(br + 64)) * 2048 + 1024 + cb_ * 128 + bcc * 8);
              bp13 = *(const uint4*)(YB + (tok0_ + (size_t)(br + 80)) * 2048 + 1024 + cb_ * 128 + bcc * 8);
              bp14 = *(const uint4*)(YB + (tok0_ + (size_t)(br + 96)) * 2048 + 1024 + cb_ * 128 + bcc * 8);
              bp15 = *(const uint4*)(YB + (tok0_ + (size_t)(br + 112)) * 2048 + 1024 + cb_ * 128 + bcc * 8);
          }
          f32x16 acc[2][2];
#pragma unroll
          for (int i = 0; i < 2; ++i)
#pragma unroll
            for (int jj = 0; jj < 2; ++jj)
#pragma unroll
              for (int r = 0; r < 16; ++r) acc[i][jj][r] = 0.f;
          const int g = lane >> 4, li = lane & 15, qq = li >> 2, pp = li & 3;
          const int tr_base = (8 * (g >> 1) + qq) * 320 + (16 * (g & 1) + 4 * pp) * 2;
#pragma unroll
          for (int ks = 0; ks < 16; ++ks) {
            s16x8 af[2];
#pragma unroll
            for (int h = 0; h < 2; ++h) af[h] = *(const s16x8*)(smem + L_F2 + (32 * (rt0 + 2 * h) + l31) * 528 + (ks * 16 + hh * 8) * 2);
#pragma unroll
            for (int c2 = 0; c2 < 2; ++c2) {
              const int off = L_B + tr_base + ks * 16 * 320 + (ctb + c2) * 64;
              const s16x4 lo = __builtin_amdgcn_ds_read_tr16_b64_v4i16((__attribute__((address_space(3))) s16x4*)(smem + off));
              const s16x4 hi = __builtin_amdgcn_ds_read_tr16_b64_v4i16((__attribute__((address_space(3))) s16x4*)(smem + off + 4 * 320));
              const s16x8 bq = __builtin_shufflevector(lo, hi, 0, 1, 2, 3, 4, 5, 6, 7);
#pragma unroll
              for (int h = 0; h < 2; ++h) acc[h][c2] = MFMA(af[h], bq, acc[h][c2]);
            }
          }
#pragma unroll
          for (int c2 = 0; c2 < 2; ++c2) {
            const int cc = cb * 128 + 32 * (ctb + c2) + l31;
            const float bm = bmix[cc];
#pragma unroll
            for (int r = 0; r < 16; ++r) {
              const int rowA = 32 * rt0 + crow(r, hh);
              if ((r & 3) == 0) asm volatile("" ::: "memory");
              bf16_t* z0 = T3 + ((size_t)b * 8192 + k1 + 64 * rowA) * D + cc;
              bf16_t* z1 = T3 + ((size_t)b * 8192 + k1 + 64 * (rowA + 64)) * D + cc;
              z0[0] = f2bf((acc[0][c2][r] * scale + bm) * silu_f(bf2f(z0[0])));
              z1[0] = f2bf((acc[1][c2][r] * scale + bm) * silu_f(bf2f(z1[0])));
            }
          }
        }
      } break;
      case PH_FOUT: {
        const int NBIG = 512, NSMALL = (NR / 128 * 4 - NBIG) * 2;
        for (int t = blockIdx.x; t < NBIG + NSMALL; t += gridDim.x) {
          if (t < NBIG) {
            const int mt = t / 4, nt = t % 4;
            gemm_tile_plain<false, 4>(T3, nullptr, nullptr, 1024, W + (size_t)3072 * 1024, 1024, 1024, mt * 128, nt * 256, 1024, smem, TID,
                                       [=](int) { return T1; });
          } else {
            const int u = t - NBIG, mt = 128 + u / 8, nt = u % 8;
            gemm_tile_plain<false, 2>(T3, nullptr, nullptr, 1024, W + (size_t)3072 * 1024, 1024, 1024, mt * 128, nt * 128, 1024, smem, TID,
                                       [=](int) { return T1; });
          }
        }
      } break;
      case PH_POSTPRE: {
        const int nl = layer + 1;
        if (nl & 1) { for (int it = blockIdx.x; it < N_RWPREP; it += gridDim.x) rwkv_wprep(p, nl >> 1, it, smem, TID); }
        else {
          for (int it = blockIdx.x; it < 128 + N_FWPREP; it += gridDim.x) {
            if (it < 128) fourier_precompose(p, it, smem, TID); else fourier_wprep(p, nl >> 1, it - 128, smem, TID);
          }
        }
        const bf16_t* O = (layer & 1) ? T2 : T1;
        row_items(p, layer, true, true, NR, O, T0, blockIdx.x, NR / 4, TID);
      } break;
      case PH_RSHIFT: {
        for (int idx = blockIdx.x * 256 + tid; idx < NR * 128; idx += gridDim.x * 256) {
          const int row = idx >> 7, cc = (idx & 127) * 8;
          bool ok0, ok1, ok2, ok3; float wgt;
          if (row < NLAT) {
            const int t = row & 8191, gy = t >> 6, gx = t & 63;
            wgt = 0.25f;
            ok0 = gy > 0; ok1 = gy < 127; ok2 = gx > 0; ok3 = gx < 63;
          } else {
            const int t = (row - NLAT) & 255;
            wgt = 0.5f;
            ok0 = false; ok1 = false; ok2 = t > 0; ok3 = t < 255;
          }
          float a[8] = {0, 0, 0, 0, 0, 0, 0, 0};
#pragma unroll
          for (int q = 0; q < 4; ++q) {
            const bool ok = q == 0 ? ok0 : (q == 1 ? ok1 : (q == 2 ? ok2 : ok3));
            const int nrow = q == 0 ? row - 64 : (q == 1 ? row + 64 : (q == 2 ? row - 1 : row + 1));
            if (ok) {
              const uint4 u = *(const uint4*)(T0 + (size_t)nrow * D + cc);
              a[0] += lo2f(u.x); a[1] += hi2f(u.x); a[2] += lo2f(u.y); a[3] += hi2f(u.y);
              a[4] += lo2f(u.z); a[5] += hi2f(u.z); a[6] += lo2f(u.w); a[7] += hi2f(u.w);
            }
          }
          *(uint4*)(T1 + (size_t)row * D + cc) = make_uint4(pack2(a[0] * wgt, a[1] * wgt), pack2(a[2] * wgt, a[3] * wgt),
                                                            pack2(a[4] * wgt, a[5] * wgt), pack2(a[6] * wgt, a[7] * wgt));
        }
        if (layer == 1) {
          for (int it = blockIdx.x; it < N_CWPREP; it += gridDim.x) fourier_cw_prep(p, 1, it, smem, TID);
        }
      } break;
      case PH_RINPROJ: {
        const int N = (j >= 1) ? 4384 : 4352;
        const int MT = NR / 128;
        const int NT_MAIN = 16, NT_TAIL = (N - 4096 + 127) / 128, NT = NT_MAIN + NT_TAIL;
        bf16_t* Vd = (j == 0) ? VF : T5;
        bf16_t* LW = (bf16_t*)(p.ws + OFF_LW);
        bf16_t* LA = (bf16_t*)(p.ws + OFF_LA);
        bf16_t* LV = (bf16_t*)(p.ws + OFF_LV);
        for (int t = blockIdx.x; t < MT * NT; t += gridDim.x) {
          const int mt = t / NT, nt = t % NT;
          if (nt < NT_MAIN) {
            const int n0 = nt * 256;
            const float* mu = p.r_mu + (size_t)(j * 6 + (n0 >> 10)) * 1024;
            gemm_tile_plain<true, 4>(T0, T1, mu, 1024, W, 1024, 1024, mt * 128, n0, 4096, smem, TID,
                                     [=](int col0) { return col0 < 1024 ? T2 : (col0 < 2048 ? T3 : (col0 < 3072 ? Vd : T4)); });
          } else {
            const int n0 = 4096 + (nt - NT_MAIN) * 128;
            const int pi = n0 < 4224 ? 4 : (n0 < 4352 ? 5 : 2);
            const float* mu = p.r_mu + (size_t)(j * 6 + pi) * 1024;
            gemm_tile_n<true, 2>(T0, T1, mu, 1024, W, 1024, 1024, mt * 128, n0, N, smem, TID, [=](int row, int col, float v) {
              if (col < 4224) LW[(size_t)row * 128 + (col - 4096)] = f2bf(tanhf(v));
              else if (col < 4352) LA[(size_t)row * 128 + (col - 4224)] = f2bf(v);
              else LV[(size_t)row * 32 + (col - 4352)] = f2bf(v);
            });
          }
        }
      } break;
      case PH_RVUPD: {
        const bf16_t* LV = (const bf16_t*)(p.ws + OFF_LV);
        const float* v2 = p.r_v2 + (size_t)(j - 1) * 32 * 1024;
        const float* v0 = p.r_v0 + (size_t)(j - 1) * 1024;
        float* v2s = (float*)smem;
        __syncthreads();
        for (int e = tid; e < 32 * 256; e += 256) *(float4*)(v2s + e * 4) = *(const float4*)(v2 + e * 4);
        __syncthreads();
        const int wave = tid >> 6, lane = tid & 63;
        for (int row = blockIdx.x * 4 + wave; row < NR; row += gridDim.x * 4) {
          const float lvl = bf2f(LV[(size_t)row * 32 + (lane & 31)]);
          float acc[16];
#pragma unroll
          for (int qd = 0; qd < 4; ++qd) {
            const float4 t = *(const float4*)(v0 + qd * 256 + lane * 4);
            acc[qd * 4] = t.x; acc[qd * 4 + 1] = t.y; acc[qd * 4 + 2] = t.z; acc[qd * 4 + 3] = t.w;
          }
#pragma unroll 4
          for (int l = 0; l < 32; ++l) {
            const float a = __int_as_float(__builtin_amdgcn_readlane(__float_as_int(lvl), l));
#pragma unroll
            for (int qd = 0; qd < 4; ++qd) {
              const float4 wv = *(const float4*)(v2s + l * 1024 + qd * 256 + lane * 4);
              acc[qd * 4] += a * wv.x; acc[qd * 4 + 1] += a * wv.y; acc[qd * 4 + 2] += a * wv.z; acc[qd * 4 + 3] += a * wv.w;
            }
          }
#pragma unroll
          for (int qd = 0; qd < 4; ++qd) {
            const size_t idx = (size_t)row * D + qd * 256 + lane * 4;
            const uint2 uv = *(const uint2*)(T5 + idx);
            const uint2 uf = *(const uint2*)(VF + idx);
            float v[4] = {lo2f(uv.x), hi2f(uv.x), lo2f(uv.y), hi2f(uv.y)};
            const float f[4] = {lo2f(uf.x), hi2f(uf.x), lo2f(uf.y), hi2f(uf.y)};
#pragma unroll
            for (int e = 0; e < 4; ++e) v[e] = v[e] + (f[e] - v[e]) * fsig(acc[qd * 4 + e]);
            *(uint2*)(T5 + idx) = make_uint2(pack2(v[0], v[1]), pack2(v[2], v[3]));
          }
        }
      } break;
      case PH_RSCANA: {
        const bf16_t* V = (j == 0) ? VF : T5;
        float* SCR = (j == 0) ? (float*)(p.ws + 5 * SLOT + (8u << 20)) : (float*)(p.ws + OFF_VF);
        for (int it = blockIdx.x; it < 64 * 4; it += gridDim.x) {
          const int cid = it >> 2, k = it & 3;
          int tl = TID;
          asm volatile("" : "+v"(tl));
          if (k == 0) scan_chain_chunked<1>(p, j, cid, 0, SCR, T2, T3, V, T0, T1, smem, tl);
          else scan_chain_chunked<0>(p, j, cid, k, SCR, T2, T3, V, T0, T1, smem, tl);
        }
      } break;
      case PH_RSCAN: {
        const bf16_t* V = (j == 0) ? VF : T5;
        float* SCR = (j == 0) ? (float*)(p.ws + 5 * SLOT + (8u << 20)) : (float*)(p.ws + OFF_VF);
        for (int it = blockIdx.x; it < 64 * 4; it += gridDim.x)
          scan_chain_chunked<1>(p, j, it >> 2, 1 + (it & 3), SCR, T2, T3, V, T0, T1, smem, TID);
      } break;
      case PH_ROUTPUT: {
        const bf16_t* V = (j == 0) ? VF : T5;
        const float* BON = (const float*)(p.ws + OFF_BON);
        const int wave = tid >> 6, lane = tid & 63;
        const int nrows = (layer == 3) ? NLAT : NR;
        for (int wi = blockIdx.x * 4 + wave; wi < nrows * 2; wi += gridDim.x * 4) {
          const int row = wi >> 1, c = (wi & 1) * 512 + lane * 8, h = c >> 6;
          const size_t idx = (size_t)row * D + c;
          const uint4 u0 = *(const uint4*)(T0 + idx), u1 = *(const uint4*)(T1 + idx), uv = *(const uint4*)(V + idx), ug = *(const uint4*)(T4 + idx);
          const float4 w0 = *(const float4*)(p.r_ln_w + (size_t)j * 1024 + c), w1 = *(const float4*)(p.r_ln_w + (size_t)j * 1024 + c + 4);
          const float4 b0 = *(const float4*)(p.r_ln_b + (size_t)j * 1024 + c), b1 = *(const float4*)(p.r_ln_b + (size_t)j * 1024 + c + 4);
          const float bon = BON[((size_t)0 * NR + row) * 16 + h] + BON[((size_t)1 * NR + row) * 16 + h];
          float y[8] = {lo2f(u0.x) + lo2f(u1.x), hi2f(u0.x) + hi2f(u1.x), lo2f(u0.y) + lo2f(u1.y), hi2f(u0.y) + hi2f(u1.y),
                        lo2f(u0.z) + lo2f(u1.z), hi2f(u0.z) + hi2f(u1.z), lo2f(u0.w) + lo2f(u1.w), hi2f(u0.w) + hi2f(u1.w)};
          const float vf[8] = {lo2f(uv.x), hi2f(uv.x), lo2f(uv.y), hi2f(uv.y), lo2f(uv.z), hi2f(uv.z), lo2f(uv.w), hi2f(uv.w)};
          const float gf[8] = {lo2f(ug.x), hi2f(ug.x), lo2f(ug.y), hi2f(ug.y), lo2f(ug.z), hi2f(ug.z), lo2f(ug.w), hi2f(ug.w)};
          const float lw8[8] = {w0.x, w0.y, w0.z, w0.w, w1.x, w1.y, w1.z, w1.w};
          const float lb8[8] = {b0.x, b0.y, b0.z, b0.w, b1.x, b1.y, b1.z, b1.w};
          float sm = 0.f;
#pragma unroll
          for (int e = 0; e < 8; ++e) sm += y[e];
          sm += __shfl_xor(sm, 1, 64); sm += __shfl_xor(sm, 2, 64); sm += __shfl_xor(sm, 4, 64);
          const float mean = sm * (1.f / 64.f);
          float vr = 0.f;
#pragma unroll
          for (int e = 0; e < 8; ++e) { y[e] -= mean; vr += y[e] * y[e]; }
          vr += __shfl_xor(vr, 1, 64); vr += __shfl_xor(vr, 2, 64); vr += __shfl_xor(vr, 4, 64);
          const float rstd = rsqrtf(vr * (1.f / 64.f) + GN_EPS);
          float o[8];
#pragma unroll
          for (int e = 0; e < 8; ++e) o[e] = (y[e] * rstd * lw8[e] + lb8[e] + bon * vf[e]) * silu_f(gf[e]);
          *(uint4*)(T4 + idx) = make_uint4(pack2(o[0], o[1]), pack2(o[2], o[3]), pack2(o[4], o[5]), pack2(o[6], o[7]));
        }
      } break;
      case PH_ROUTPROJ: {
        const int MT = ((layer == 3) ? NLAT : NR) / 128;
        const int NBIG = 512, NSMALL = (MT * 4 - NBIG) * 2;
        for (int t = blockIdx.x; t < NBIG + NSMALL; t += gridDim.x) {
          if (t < NBIG) {
            const int mt = t / 4, nt = t % 4;
            gemm_tile_plain<false, 4>(T4, nullptr, nullptr, 1024, W + (size_t)4384 * 1024, 1024, 1024, mt * 128, nt * 256, 1024, smem, TID,
                                       [=](int) { return T2; });
          } else {
            const int u = t - NBIG, mt = 128 + u / 8, nt = u % 8;
            gemm_tile_plain<false, 2>(T4, nullptr, nullptr, 1024, W + (size_t)4384 * 1024, 1024, 1024, mt * 128, nt * 128, 1024, smem, TID,
                                       [=](int) { return T2; });
          }
        }
      } break;
      case PH_POSTLAST: {
        row_items(p, layer, true, false, NLAT, T2, nullptr, blockIdx.x, NLAT / 4, TID);
      } break;
    }
}

#define XB_TMO      128
#define XB_XCNT(j)  (256  + 64 * (j))
#define XB_XSUB(j)  (1280 + 64 * (j))
#define XB_XGEN(j)  (2304 + 64 * (j))
#define XB_TOP      3328
#define XB_TOPGEN   3392
#define XCD_BAR_WORDS 3456
#define XB_SPIN_CAP (1u << 23)
#define LAS __attribute__((address_space(3)))

__device__ __forceinline__ unsigned xb_ld(unsigned* p)              { return __hip_atomic_load(p, __ATOMIC_RELAXED, __HIP_MEMORY_SCOPE_AGENT); }
__device__ __forceinline__ unsigned xb_add(unsigned* p, unsigned v) { return __hip_atomic_fetch_add(p, v, __ATOMIC_RELAXED, __HIP_MEMORY_SCOPE_AGENT); }
__device__ __forceinline__ unsigned xb_xcc_id() { return (unsigned)__builtin_amdgcn_s_getreg((3 << 11) | 20) & 0xFu; }
#define XB_SPIN(cond, bar) do { unsigned _sp = 0; while (cond) { __builtin_amdgcn_s_sleep(1); \
    if ((++_sp & 255u) == 0u) { if (xb_ld(&(bar)[XB_TMO])) break; if (_sp > XB_SPIN_CAP) { atomicAdd(&(bar)[XB_TMO], 1u); break; } } } } while (0)

struct XcdBarrier {
    unsigned* bar; unsigned x;
    volatile LAS unsigned* st;
};

__device__ __forceinline__ XcdBarrier xcd_barrier_post(unsigned* bar, volatile LAS unsigned* st) {
    XcdBarrier b; b.bar = bar; b.x = xb_xcc_id(); b.st = st;
    if (threadIdx.x == 0) (void)xb_add(&bar[XB_XCNT(b.x)], 1u);
    return b;
}
__device__ __forceinline__ void xcd_barrier_complete(unsigned* bar, unsigned x, unsigned& nloc, unsigned& nx) {
    const unsigned G = gridDim.x * gridDim.y * gridDim.z;
    unsigned sum, cnt, mine, sp = 0u;
    for (;;) {
        sum = 0u; cnt = 0u; mine = 0u;
#pragma unroll
        for (unsigned j = 0; j < 16; ++j) { const unsigned c = xb_ld(&bar[XB_XCNT(j)]); sum += c; cnt += (c > 0u) ? 1u : 0u; mine = (j == x) ? c : mine; }
        if (sum == G) break;
        __builtin_amdgcn_s_sleep(1);
        if ((++sp & 255u) == 0u) { if (xb_ld(&bar[XB_TMO])) break; if (sp > XB_SPIN_CAP) { atomicAdd(&bar[XB_TMO], 1u); break; } }
    }
    nloc = mine > 0u ? mine : 1u; nx = cnt > 0u ? cnt : 1u;
}

__device__ __forceinline__ void xcd_barrier(const XcdBarrier& b) {
    asm volatile("s_waitcnt vmcnt(0)" ::: "memory");
    __syncthreads();
    if (threadIdx.x == 0) {
        unsigned* bar = b.bar;
        __builtin_amdgcn_s_waitcnt(0);
        unsigned nloc = b.st[0], nx = b.st[1];
        if (nloc == 0u) { xcd_barrier_complete(bar, b.x, nloc, nx); b.st[0] = nloc; b.st[1] = nx; }
        const unsigned old = xb_add(&bar[XB_XSUB(b.x)], 1u);
        const unsigned gen = old / nloc;
        if (old + 1u == (gen + 1u) * nloc) {
            __builtin_amdgcn_fence(__ATOMIC_RELEASE, "agent");
            asm volatile("s_waitcnt vmcnt(0)" ::: "memory");
            const unsigned og = xb_add(&bar[XB_TOP], 1u);
            const unsigned tg = og / nx;
            if (og + 1u == (tg + 1u) * nx) xb_add(&bar[XB_TOPGEN], 1u);
            else XB_SPIN(xb_ld(&bar[XB_TOPGEN]) == tg, bar);
            __builtin_amdgcn_fence(__ATOMIC_ACQUIRE, "agent");
            xb_add(&bar[XB_XGEN(b.x)], 1u);
            asm volatile("s_waitcnt vmcnt(0)" ::: "memory");
        } else {
            XB_SPIN(xb_ld(&bar[XB_XGEN(b.x)]) == gen, bar);
            __builtin_amdgcn_fence(__ATOMIC_ACQUIRE, "agent");
            asm volatile("s_waitcnt vmcnt(0)" ::: "memory");
        }
    }
    __syncthreads();
}


__global__ void __launch_bounds__(256, 1) mega(Params p) {
  __shared__ __attribute__((aligned(16))) char smem[CS_END];
  cg::grid_group grid = cg::this_grid();
  __shared__ uint4 xb_words;
  if (threadIdx.x == 0) xb_words = make_uint4(0u, 0u, 0u, 0u);
  __syncthreads();
  XcdBarrier xb = xcd_barrier_post((unsigned*)(p.ws + OFF_BAR), (volatile LAS unsigned*)&xb_words);
  for (int ph = p.phase_lo; ph < p.phase_hi; ++ph) {
    int tid_l = threadIdx.x;
    asm volatile("" : "+v"(tid_l));
    run_phase(p, ph, smem, tid_l);
#ifdef REP_MASK
    if ((REP_MASK >> p.ptype[ph]) & 1) { asm volatile("s_waitcnt vmcnt(0) lgkmcnt(0)" ::: "memory"); grid.sync(); asm volatile("" : "+v"(tid_l)); run_phase(p, ph, smem, tid_l); }
#endif
    if (ph + 1 < p.phase_hi) {
      asm volatile("s_waitcnt vmcnt(0) lgkmcnt(0)" ::: "memory");
      if (ph == p.phase_lo) grid.sync();
      else xcd_barrier(xb);
    }
  }
}

extern "C" void kernel_launch(void* const* d_in, const int* in_sizes, int n_in, void* d_out, int out_size, void* d_ws, size_t ws_size,
                              hipStream_t stream) {
  static int grid_blocks = 0;
  if (!grid_blocks) {
    int dev = 0, cus = 0, per_cu = 0;
    hipGetDevice(&dev);
    hipDeviceGetAttribute(&cus, hipDeviceAttributeMultiprocessorCount, dev);
    hipOccupancyMaxActiveBlocksPerMultiprocessor(&per_cu, mega, 256, 0);
    if (per_cu > 2) per_cu = 2;
    if (per_cu < 1) per_cu = 1;
    grid_blocks = cus * per_cu;
  }
  Params p;
  memset(&p, 0, sizeof(p));
  const float** fp = (const float**)&p;
  for (int i = 0; i < 29; ++i) fp[i] = (const float*)d_in[i];
  p.out = (float*)d_out;
  p.ws = (char*)d_ws;
  int n = 0;
  auto add = [&](int t, int l) { p.ptype[n] = (unsigned char)t; p.player[n] = (unsigned char)l; ++n; };
  add(PH_PREP0, 0);
  add(PH_PRE0, 0);
  for (int l = 0; l < 4; ++l) {
    if ((l & 1) == 0) {
      add(PH_FGEMM1, l); add(PH_FDFT1, l); add(PH_FDFT3, l); add(PH_FOUT, l); add(PH_POSTPRE, l);
    } else {
      add(PH_RSHIFT, l); add(PH_RINPROJ, l);
      if (l == 3) add(PH_RVUPD, l);
      add(PH_RSCANA, l); add(PH_RSCAN, l); add(PH_ROUTPUT, l); add(PH_ROUTPROJ, l);
      add(l == 3 ? PH_POSTLAST : PH_POSTPRE, l);
    }
  }
#ifdef DBG_STOP
  n = DBG_STOP; add(PH_DUMP, 0);
#endif
#if SINGLE_LAUNCH
  hipMemsetAsync((char*)d_ws + OFF_BAR, 0, 3456 * 4, stream);
  p.phase_lo = 0; p.phase_hi = n;
  void* args[] = {&p};
  hipError_t e = hipLaunchCooperativeKernel((void*)mega, dim3(grid_blocks), dim3(256), args, 0, stream);
  if (e != hipSuccess) fprintf(stderr, "cooperative launch failed: %s (grid %d)\n", hipGetErrorString(e), grid_blocks);
#else
  for (int i = 0; i < n; ++i) {
    p.phase_lo = i; p.phase_hi = i + 1;
    hipLaunchKernelGGL(mega, dim3(grid_blocks), dim3(256), 0, stream, p);
  }
#endif
}
```

```cpp
#include <hip/hip_runtime.h>
#include <hip/hip_cooperative_groups.h>
#include <cstdio>
#include <cstring>
namespace cg = cooperative_groups;

#ifndef DBG_MASK
#define DBG_MASK 0
#endif
#ifndef SINGLE_LAUNCH
#define SINGLE_LAUNCH 1
#endif

typedef unsigned short bf16_t;
typedef short s16x8 __attribute__((ext_vector_type(8)));
typedef short s16x4 __attribute__((ext_vector_type(4)));
typedef float f32x16 __attribute__((ext_vector_type(16)));
#define DI __device__ __forceinline__
#define MFMA(a, b, c) __builtin_amdgcn_mfma_f32_32x32x16_bf16((a), (b), (c), 0, 0, 0)

constexpr int NR = 16896;
constexpr int NLAT = 16384;
constexpr int D = 1024;
constexpr size_t SLOT = (size_t)NR * D * 2;
constexpr float RMS_EPS = 1e-6f;
constexpr float GN_EPS = 64e-5f;

constexpr size_t OFF_T0 = 0;
constexpr size_t OFF_VF = 6 * SLOT;
constexpr size_t OFF_XCTX = OFF_VF + SLOT;
constexpr size_t OFF_W = OFF_XCTX + (size_t)512 * D * 4;
constexpr size_t W_BYTES = (size_t)(4384 + 1024) * 1024 * 2;
constexpr size_t OFF_LW = OFF_W + W_BYTES;
constexpr size_t OFF_LA = OFF_LW + (size_t)NR * 128 * 2;
constexpr size_t OFF_LV = OFF_LA + (size_t)NR * 128 * 2;
constexpr size_t OFF_MOD = OFF_LV + (size_t)NR * 32 * 2;
constexpr size_t OFF_F1 = OFF_MOD + (size_t)4 * 3 * 3072 * 4;
constexpr size_t OFF_F2 = OFF_F1 + 128 * 128 * 2;
constexpr size_t OFF_FC = OFF_F2 + 128 * 256 * 2;
constexpr size_t OFF_TW = OFF_FC + 256 * 512 * 2;
constexpr size_t OFF_BON = OFF_TW + 64 * 128 * 8;
constexpr size_t OFF_BAR = OFF_BON + (size_t)2 * NR * 16 * 4;
constexpr size_t WS_END = OFF_BAR + 3456 * 4;
static_assert(WS_END <= 268435456ull, "workspace overflow");

enum { PH_PREP0 = 0, PH_PRE0, PH_FGEMM1, PH_FDFT1, PH_FDFT3, PH_FOUT, PH_POSTPRE, PH_RSHIFT, PH_RINPROJ, PH_RVUPD, PH_RSCAN, PH_ROUTPUT, PH_ROUTPROJ, PH_POSTLAST, PH_DUMP, PH_RSCANA };

struct Params {
  const float *x, *c, *ctx, *c_ctx, *mod_w, *mod_b, *norm_pre, *norm_post, *f_w_in, *f_w_mix, *f_b_mix, *f_w_out,
      *r_mu, *r_w_in, *r_w0, *r_w1, *r_w2, *r_a0, *r_a1, *r_a2, *r_v0, *r_v1, *r_v2, *r_k_k, *r_k_a, *r_r_k, *r_ln_w, *r_ln_b, *r_w_out;
  float* out;
  char* ws;
  int phase_lo, phase_hi;
  unsigned char ptype[32];
  unsigned char player[32];
};

DI float bf2f(bf16_t u) { return __uint_as_float(((unsigned)u) << 16); }
DI bf16_t f2bf(float f) { unsigned r; asm("v_cvt_pk_bf16_f32 %0, %1, %1" : "=v"(r) : "v"(f)); return (bf16_t)r; }
DI unsigned pack2(float a, float b) { unsigned r; asm("v_cvt_pk_bf16_f32 %0, %1, %2" : "=v"(r) : "v"(a), "v"(b)); return r; }
DI float lo2f(unsigned u) { return __uint_as_float(u << 16); }
DI float hi2f(unsigned u) { return __uint_as_float(u & 0xffff0000u); }
DI float silu_f(float x) { return x * __builtin_amdgcn_rcpf(1.f + __expf(-x)); }
DI float sigmoid_f(float x) { return __builtin_amdgcn_rcpf(1.f + __expf(-x)); }
DI float fsig(float x) { return __builtin_amdgcn_rcpf(1.f + __expf(-x)); }
DI float softplus_f(float x) { return fmaxf(x, 0.f) + log1pf(__expf(-fabsf(x))); }
template <int CTRL>
DI float dpp_add(float v) { return v + __int_as_float(__builtin_amdgcn_update_dpp(0, __float_as_int(v), CTRL, 0xf, 0xf, true)); }
DI float wave_sum(float v) {
  v = dpp_add<0xB1>(v);
  v = dpp_add<0x4E>(v);
  v = dpp_add<0x141>(v);
  v = dpp_add<0x140>(v);
  const int iv = __float_as_int(v);
  return __int_as_float(__builtin_amdgcn_readlane(iv, 0)) + __int_as_float(__builtin_amdgcn_readlane(iv, 16)) +
         __int_as_float(__builtin_amdgcn_readlane(iv, 32)) + __int_as_float(__builtin_amdgcn_readlane(iv, 48));
}
DI int crow(int r, int h) { return (r & 3) + 8 * (r >> 2) + 4 * h; }

template <bool MIX>
DI uint4 mix_chunk(uint4 va, uint4 vs, const float4 m0v, const float4 m1v) {
  if (!MIX) return va;
  float h, sv;
  h = lo2f(va.x); sv = lo2f(vs.x); const float e0 = h + (sv - h) * m0v.x;
  h = hi2f(va.x); sv = hi2f(vs.x); const float e1 = h + (sv - h) * m0v.y;
  h = lo2f(va.y); sv = lo2f(vs.y); const float e2 = h + (sv - h) * m0v.z;
  h = hi2f(va.y); sv = hi2f(vs.y); const float e3 = h + (sv - h) * m0v.w;
  h = lo2f(va.z); sv = lo2f(vs.z); const float e4 = h + (sv - h) * m1v.x;
  h = hi2f(va.z); sv = hi2f(vs.z); const float e5 = h + (sv - h) * m1v.y;
  h = lo2f(va.w); sv = lo2f(vs.w); const float e6 = h + (sv - h) * m1v.z;
  h = hi2f(va.w); sv = hi2f(vs.w); const float e7 = h + (sv - h) * m1v.w;
  return make_uint4(pack2(e0, e1), pack2(e2, e3), pack2(e4, e5), pack2(e6, e7));
}
struct NoDst { DI bf16_t* operator()(int) const { return nullptr; } };
template <bool MIX, int NJ, bool PLAIN, class Epi, class DstFn>
DI void gemm_tile_impl(const bf16_t* __restrict__ A, const bf16_t* __restrict__ A2, const float* __restrict__ mu, int lda,
                    const bf16_t* __restrict__ BT, int ldb, int K, int m0, int n0, int N, char* smem, const int TID, Epi epi, DstFn dst_fn) {
  constexpr int BN = 64 * NJ, NB = BN / 32, NBQ = NB / 4;
  constexpr int STAGE = (128 + BN) * 144;
  const int tid = TID, lane = tid & 63, w = tid >> 6, wm = w & 1, wn = w >> 1;
  f32x16 acc[2][NJ];
#pragma unroll
  for (int i = 0; i < 2; ++i)
#pragma unroll
    for (int j = 0; j < NJ; ++j)
#pragma unroll
      for (int r = 0; r < 16; ++r) acc[i][j][r] = 0.f;
  uint4 ra[2][4], ra2[2][4], rb[2][NB];
  const int KT = K >> 6;
  const int lrow = tid >> 3, kc = tid & 7;
  const bf16_t* Ap = A + (size_t)(m0 + lrow) * lda + kc * 8;
  const bf16_t* A2p = MIX ? (A2 + (size_t)(m0 + lrow) * lda + kc * 8) : nullptr;
  const bf16_t* Bp = BT + (size_t)(n0 + lrow) * ldb + kc * 8;
  const bool nfull = (n0 + BN <= N);
#define GEMM_LOAD(ST_, KT_) { \
    _Pragma("unroll") for (int i = 0; i < 4; ++i) { \
      ra[ST_][i] = *(const uint4*)(Ap + (size_t)(32 * i) * lda + (KT_) * 64); \
      if (MIX) ra2[ST_][i] = *(const uint4*)(A2p + (size_t)(32 * i) * lda + (KT_) * 64); } \
    _Pragma("unroll") for (int i = 0; i < NB; ++i) \
      rb[ST_][i] = (nfull || (n0 + lrow + 32 * i) < N) ? *(const uint4*)(Bp + (size_t)(32 * i) * ldb + (KT_) * 64) : make_uint4(0, 0, 0, 0); }
#define GEMM_STAGE_SLICE(ST_, KT_, Q_, BUF_) { \
    bf16_t* As_ = (bf16_t*)(smem + (BUF_) * STAGE); bf16_t* Bs_ = As_ + 128 * 72; \
    float4 m0v_ = make_float4(0, 0, 0, 0), m1v_ = m0v_; \
    if (MIX) { m0v_ = *(const float4*)(mu + (KT_) * 64 + kc * 8); m1v_ = *(const float4*)(mu + (KT_) * 64 + kc * 8 + 4); } \
    *(uint4*)(As_ + (lrow + 32 * (Q_)) * 72 + kc * 8) = mix_chunk<MIX>(ra[ST_][Q_], ra2[ST_][Q_], m0v_, m1v_); \
    _Pragma("unroll") for (int u = 0; u < NBQ; ++u) *(uint4*)(Bs_ + (lrow + 32 * ((Q_) * NBQ + u)) * 72 + kc * 8) = rb[ST_][(Q_) * NBQ + u]; }
  GEMM_LOAD(0, 0)
  if (KT > 1) GEMM_LOAD(1, 1)
  __syncthreads();
#pragma unroll
  for (int qq = 0; qq < 4; ++qq) GEMM_STAGE_SLICE(0, 0, qq, 0)
  if (KT > 2) GEMM_LOAD(0, 2)
  __syncthreads();
  for (int kt0 = 0; kt0 < KT; kt0 += 2) {
#pragma unroll
    for (int st = 0; st < 2; ++st) {
      const int kt = kt0 + st;
      if (kt < KT) {
        const bf16_t* As = (const bf16_t*)(smem + st * STAGE);
        const bf16_t* Bs = As + 128 * 72;
        const bool more = (kt + 1 < KT);
        s16x8 fa[2][2], fb[2][NJ];
#pragma unroll
        for (int i = 0; i < 2; ++i) fa[0][i] = *(const s16x8*)(As + (64 * wm + 32 * i + (lane & 31)) * 72 + (lane >> 5) * 8);
#pragma unroll
        for (int j = 0; j < NJ; ++j) fb[0][j] = *(const s16x8*)(Bs + (32 * NJ * wn + 32 * j + (lane & 31)) * 72 + (lane >> 5) * 8);
#pragma unroll
        for (int kk = 0; kk < 4; ++kk) {
          if (kk < 3) {
#pragma unroll
            for (int i = 0; i < 2; ++i) fa[(kk + 1) & 1][i] = *(const s16x8*)(As + (64 * wm + 32 * i + (lane & 31)) * 72 + (kk + 1) * 16 + (lane >> 5) * 8);
#pragma unroll
            for (int j = 0; j < NJ; ++j) fb[(kk + 1) & 1][j] = *(const s16x8*)(Bs + (32 * NJ * wn + 32 * j + (lane & 31)) * 72 + (kk + 1) * 16 + (lane >> 5) * 8);
          }
#pragma unroll
          for (int i = 0; i < 2; ++i)
#pragma unroll
            for (int j = 0; j < NJ; ++j) acc[i][j] = MFMA(fa[kk & 1][i], fb[kk & 1][j], acc[i][j]);
          if (more) GEMM_STAGE_SLICE(st ^ 1, kt + 1, kk, st ^ 1)
        }
        if (kt + 3 < KT) GEMM_LOAD(st ^ 1, kt + 3)
        __syncthreads();
      }
    }
  }
#undef GEMM_LOAD
#undef GEMM_STAGE_SLICE
  if (PLAIN) {
    constexpr int PITCH = 32 * NJ * 2 + 16;
    char* reg = smem + w * (64 * PITCH);
    const int l31 = lane & 31, hh = lane >> 5;
#pragma unroll
    for (int i = 0; i < 2; ++i)
#pragma unroll
      for (int j = 0; j < NJ; ++j)
#pragma unroll
        for (int r = 0; r < 16; ++r)
          *(bf16_t*)(reg + (32 * i + crow(r, hh)) * PITCH + (32 * j + l31) * 2) = f2bf(acc[i][j][r]);
    __syncthreads();
    const int col0 = n0 + 32 * NJ * wn;
    bf16_t* dst = dst_fn(col0) + (size_t)(m0 + 64 * wm) * D + (col0 & 1023);
    constexpr int CPR = 4 * NJ;
    constexpr int RPI = 64 / CPR;
    const int rr = lane / CPR, ch = lane % CPR;
#pragma unroll
    for (int q = 0; q < CPR; ++q) {
      const int row = rr + RPI * q;
      *(uint4*)(dst + (size_t)row * D + ch * 8) = *(const uint4*)(reg + row * PITCH + ch * 16);
    }
    return;
  }
#pragma unroll
  for (int i = 0; i < 2; ++i)
#pragma unroll
    for (int j = 0; j < NJ; ++j) {
      const int col = n0 + 32 * NJ * wn + 32 * j + (lane & 31);
      if (col < N) {
#pragma unroll
        for (int r = 0; r < 16; ++r) {
          const int row = m0 + 64 * wm + 32 * i + crow(r, lane >> 5);
          epi(row, col, acc[i][j][r]);
        }
      }
    }
}
template <bool MIX, int NJ, class Epi>
DI void gemm_tile_n(const bf16_t* __restrict__ A, const bf16_t* __restrict__ A2, const float* __restrict__ mu, int lda,
                    const bf16_t* __restrict__ BT, int ldb, int K, int m0, int n0, int N, char* smem, const int TID, Epi epi) {
  gemm_tile_impl<MIX, NJ, false>(A, A2, mu, lda, BT, ldb, K, m0, n0, N, smem, TID, epi, NoDst());
}
template <bool MIX, int NJ, class DstFn>
DI void gemm_tile_plain(const bf16_t* __restrict__ A, const bf16_t* __restrict__ A2, const float* __restrict__ mu, int lda,
                        const bf16_t* __restrict__ BT, int ldb, int K, int m0, int n0, int N, char* smem, const int TID, DstFn dst_fn) {
  gemm_tile_impl<MIX, NJ, true>(A, A2, mu, lda, BT, ldb, K, m0, n0, N, smem, TID, [](int, int, float) {}, dst_fn);
}
template <bool MIX, class Epi>
DI void gemm_tile(const bf16_t* __restrict__ A, const bf16_t* __restrict__ A2, const float* __restrict__ mu, int lda,
                  const bf16_t* __restrict__ BT, int ldb, int K, int m0, int n0, int N, char* smem, const int TID, Epi epi) {
  gemm_tile_n<MIX, 2>(A, A2, mu, lda, BT, ldb, K, m0, n0, N, smem, TID, epi);
}

template <class Epi>
DI void dft_tile(const bf16_t* __restrict__ A, int lda, int arow0, int KH, const bf16_t* __restrict__ Bre,
                 const bf16_t* __restrict__ Bim, int ldb, int tstride, char* smem, const int TID, Epi epi) {
  const int tid = TID, lane = tid & 63, w = tid >> 6;
  const int rt0 = w & 1, ctb = 2 * (w >> 1);
  f32x16 acc[2][2];
#pragma unroll
  for (int i = 0; i < 2; ++i)
#pragma unroll
    for (int j = 0; j < 2; ++j)
#pragma unroll
      for (int r = 0; r < 16; ++r) acc[i][j][r] = 0.f;
  const int nch = (2 * KH) >> 7;
  const int g = lane >> 4, li = lane & 15, q = li >> 2, pp = li & 3;
  const int tr_base = (8 * (g >> 1) + q) * 320 + (16 * (g & 1) + 4 * pp) * 2;
  for (int ch = 0; ch < nch; ++ch) {
    __syncthreads();
#pragma unroll
    for (int i = 0; i < 8; ++i) {
      const int c = tid + 256 * i, r = c >> 4, cc = c & 15;
      const int kr = ch * 128 + r;
      const bf16_t* src = (kr < KH ? Bre + (size_t)kr * tstride * ldb : Bim + (size_t)(kr - KH) * tstride * ldb) + cc * 8;
      *(uint4*)(smem + r * 320 + cc * 16) = *(const uint4*)src;
    }
    __syncthreads();
#pragma unroll
    for (int kh = 0; kh < 2; ++kh) {
      asm volatile("" ::: "memory");
      s16x8 af[4][2];
#pragma unroll
      for (int k4 = 0; k4 < 4; ++k4)
#pragma unroll
        for (int h = 0; h < 2; ++h)
          af[k4][h] = *(const s16x8*)(A + (size_t)(arow0 + 32 * (rt0 + 2 * h) + (lane & 31)) * lda + ch * 128 + (kh * 4 + k4) * 16 + (lane >> 5) * 8);
#pragma unroll
      for (int k4 = 0; k4 < 4; ++k4) {
        const int ks = kh * 4 + k4;
#pragma unroll
        for (int c2 = 0; c2 < 2; ++c2) {
          const int off = tr_base + ks * 16 * 320 + (ctb + c2) * 64;
#ifdef NO_TR
          s16x8 b;
          {
            const int n = 32 * (ctb + c2) + (lane & 31), k0 = ks * 16 + 8 * (lane >> 5);
#pragma unroll
            for (int e = 0; e < 8; ++e) b[e] = *(const short*)(smem + (k0 + e) * 320 + n * 2);
          }
#else
          const s16x4 lo = __builtin_amdgcn_ds_read_tr16_b64_v4i16((__attribute__((address_space(3))) s16x4*)(smem + off));
          const s16x4 hi = __builtin_amdgcn_ds_read_tr16_b64_v4i16((__attribute__((address_space(3))) s16x4*)(smem + off + 4 * 320));
          const s16x8 b = __builtin_shufflevector(lo, hi, 0, 1, 2, 3, 4, 5, 6, 7);
#endif
#pragma unroll
          for (int h = 0; h < 2; ++h) acc[h][c2] = MFMA(af[k4][h], b, acc[h][c2]);
        }
      }
    }
  }
#pragma unroll
  for (int c2 = 0; c2 < 2; ++c2) {
    const int col = 32 * (ctb + c2) + (lane & 31);
#pragma unroll
    for (int r = 0; r < 16; ++r) {
      const int rowA = 32 * rt0 + crow(r, lane >> 5);
      if ((r & 3) == 0) asm volatile("" ::: "memory");
      epi(rowA, rowA + 64, col, acc[0][c2][r], acc[1][c2][r]);
    }
  }
}

DI void transpose_tile(const float* __restrict__ src, int lds_, bf16_t* __restrict__ dst, int ldd, int K, int N, int tk, int tn, char* smem, const int TID) {
  float* t = (float*)smem;
  const int tid = TID;
  __syncthreads();
#pragma unroll
  for (int i = 0; i < 16; ++i) {
    const int kk = (tid >> 6) + 4 * i, nn = tid & 63;
    const int k = tk * 64 + kk, n = tn * 64 + nn;
    t[kk * 65 + nn] = (k < K && n < N) ? src[(size_t)k * lds_ + n] : 0.f;
  }
  __syncthreads();
#pragma unroll
  for (int i = 0; i < 16; ++i) {
    const int nn = (tid >> 6) + 4 * i, kk = tid & 63;
    const int k = tk * 64 + kk, n = tn * 64 + nn;
    if (k < K && n < N) dst[(size_t)n * ldd + k] = f2bf(t[kk * 65 + nn]);
  }
}

DI void fourier_wprep(const Params& p, int j, int it, char* smem, const int TID) {
  bf16_t* W = (bf16_t*)(p.ws + OFF_W);
  const int job = it >> 8, t = it & 255;
  if (job == 0) transpose_tile(p.f_w_in + (size_t)j * 1024 * 2048 + 1024, 2048, W + (size_t)2048 * 1024, 1024, 1024, 1024, t >> 4, t & 15, smem, TID);
  else transpose_tile(p.f_w_out + (size_t)j * 1024 * 1024, 1024, W + (size_t)3072 * 1024, 1024, 1024, 1024, t >> 4, t & 15, smem, TID);
}
DI void rwkv_wprep(const Params& p, int j, int it, char* smem, const int TID) {
  bf16_t* W = (bf16_t*)(p.ws + OFF_W);
  if (it < 1024) {
    const int pi = it >> 8, t = it & 255;
    transpose_tile(p.r_w_in + (size_t)(j * 4 + pi) * 1024 * 1024, 1024, W + (size_t)pi * 1024 * 1024, 1024, 1024, 1024, t >> 4, t & 15, smem, TID);
  } else if (it < 1024 + 32) {
    const int u = it - 1024, n = u >> 4, t = u & 15;
    transpose_tile(p.r_w1 + (size_t)(j * 2 + n) * 1024 * 64, 64, W + (size_t)(4096 + 64 * n) * 1024, 1024, 1024, 64, t, 0, smem, TID);
  } else if (it < 1024 + 64) {
    const int u = it - 1056, n = u >> 4, t = u & 15;
    transpose_tile(p.r_a1 + (size_t)(j * 2 + n) * 1024 * 64, 64, W + (size_t)(4224 + 64 * n) * 1024, 1024, 1024, 64, t, 0, smem, TID);
  } else if (it < 1024 + 80) {
    const int t = it - 1088;
    if (j >= 1) transpose_tile(p.r_v1 + (size_t)(j - 1) * 1024 * 32, 32, W + (size_t)4352 * 1024, 1024, 1024, 32, t, 0, smem, TID);
  } else {
    const int t = it - 1104;
    transpose_tile(p.r_w_out + (size_t)j * 1024 * 1024, 1024, W + (size_t)4384 * 1024, 1024, 1024, 1024, t >> 4, t & 15, smem, TID);
  }
}
constexpr int N_FWPREP = 512, N_RWPREP = 1360;

DI void fourier_cw_prep(const Params& p, int j, int it, char* smem, const int TID) {
  bf16_t* FWU = (bf16_t*)(p.ws + 5 * SLOT);
  bf16_t* CWT = FWU + 1024 * 1024;
  const int tid = TID;
  if (it < 256) {
#pragma unroll
    for (int i = 0; i < 4; ++i) {
      const int row = it * 4 + i;
      const float4 v = *(const float4*)(p.f_w_in + (size_t)j * 1024 * 2048 + (size_t)row * 2048 + tid * 4);
      *(uint2*)(FWU + (size_t)row * 1024 + tid * 4) = make_uint2(pack2(v.x, v.y), pack2(v.z, v.w));
    }
  } else {
    float* tab = (float*)smem;
    __syncthreads();
    if (tid < 128) tab[tid] = cospif((float)tid / 64.f);
    __syncthreads();
    const int u = it - 256, pq = u >> 7, g = (u >> 4) & 7, cb = u & 15;
    const int e = tid & 127, cbase = cb * 8 + (tid >> 7) * 4;
    const float* wm = p.f_w_mix + ((size_t)j * 8 + g) * 128 * 128;
    const int off = pq ? 32 : 0;
    float a0 = 0.f, a1 = 0.f, a2 = 0.f, a3 = 0.f;
#pragma unroll 8
    for (int c2 = 0; c2 < 128; ++c2) {
      const float wv = wm[c2 * 128 + e];
      a0 += tab[((cbase + 0) * c2 - off) & 127] * wv;
      a1 += tab[((cbase + 1) * c2 - off) & 127] * wv;
      a2 += tab[((cbase + 2) * c2 - off) & 127] * wv;
      a3 += tab[((cbase + 3) * c2 - off) & 127] * wv;
    }
    *(uint2*)(CWT + (((size_t)pq * 8 + g) * 128 + e) * 128 + cbase) = make_uint2(pack2(a0, a1), pack2(a2, a3));
  }
}
constexpr int N_CWPREP = 256 + 256;

DI void fourier_precompose(const Params& p, int it, char* smem, const int TID) {
  const bf16_t* FWU = (const bf16_t*)(p.ws + 5 * SLOT);
  const bf16_t* CWT = FWU + 1024 * 1024;
  bf16_t* W = (bf16_t*)(p.ws + OFF_W);
  const int pg = it >> 3, nt = it & 7;
  const int g = pg & 7;
  bf16_t* dst = W + (size_t)pg * 128 * 1024;
  gemm_tile<false>(CWT + (size_t)pg * 128 * 128, nullptr, nullptr, 128, FWU + g * 128, 1024, 128, 0, nt * 128, 1024, smem, TID,
                   [=](int row, int col, float v) { dst[(size_t)row * 1024 + col] = f2bf(v); });
}

DI void phase_prep0(const Params& p, char* smem, const int TID) {
  const int tid = TID;

  float* MOD = (float*)(p.ws + OFF_MOD);
  const int N_MOD = 192, N_TAB = (128 * 128 + 128 * 256 + 256 * 512 + 64 * 128) / 256;
  const int total = N_MOD + N_TAB + N_CWPREP + N_FWPREP;
  for (int it = blockIdx.x; it < total; it += gridDim.x) {
    if (it < N_MOD) {
      const int layer = it / 48, chunk = it % 48;
      const int kp = tid >> 4, cgp = tid & 15;
      const float* wbase = p.mod_w + (size_t)layer * 1024 * 3072 + chunk * 64 + cgp * 4;
      float a0[4] = {0, 0, 0, 0}, a1[4] = {0, 0, 0, 0}, a2[4] = {0, 0, 0, 0};
      float* sc = (float*)(smem + 16384);
      __syncthreads();
      for (int e = tid; e < 1024; e += 256) { sc[e] = silu_f(p.c[e]); sc[1024 + e] = silu_f(p.c[1024 + e]); sc[2048 + e] = silu_f(p.c_ctx[e]); }
      __syncthreads();
#pragma unroll 8
      for (int k = kp * 64; k < kp * 64 + 64; ++k) {
        const float4 wv = *(const float4*)(wbase + (size_t)k * 3072);
        const float s0 = sc[k], s1 = sc[1024 + k], s2 = sc[2048 + k];
        a0[0] += s0 * wv.x; a0[1] += s0 * wv.y; a0[2] += s0 * wv.z; a0[3] += s0 * wv.w;
        a1[0] += s1 * wv.x; a1[1] += s1 * wv.y; a1[2] += s1 * wv.z; a1[3] += s1 * wv.w;
        a2[0] += s2 * wv.x; a2[1] += s2 * wv.y; a2[2] += s2 * wv.z; a2[3] += s2 * wv.w;
      }
      float* red = (float*)smem;
      __syncthreads();
#pragma unroll
      for (int e = 0; e < 4; ++e) {
        red[(kp * 3 + 0) * 64 + cgp * 4 + e] = a0[e];
        red[(kp * 3 + 1) * 64 + cgp * 4 + e] = a1[e];
        red[(kp * 3 + 2) * 64 + cgp * 4 + e] = a2[e];
      }
      __syncthreads();
      if (tid < 192) {
        const int v = tid >> 6, col = tid & 63;
        float s = 0.f;
#pragma unroll
        for (int k = 0; k < 16; ++k) s += red[(k * 3 + v) * 64 + col];
        const int cidx = chunk * 64 + col;
        MOD[((size_t)layer * 3 + v) * 3072 + cidx] = s + p.mod_b[(size_t)layer * 3072 + cidx];
      }
    } else if (it < N_MOD + N_TAB) {
      int e = (it - N_MOD) * 256 + tid;
      bf16_t* F1 = (bf16_t*)(p.ws + OFF_F1);
      bf16_t* F2 = (bf16_t*)(p.ws + OFF_F2);
      bf16_t* FC = (bf16_t*)(p.ws + OFF_FC);
      float2* TW = (float2*)(p.ws + OFF_TW);
      if (e < 128 * 128) {
        const int m = e >> 7, k = e & 127;
        const int mm = m & 63, kk = k & 63;
        const float ang = (float)((mm * kk) & 63) / 32.f;
        const float cv = cospif(ang), sv = sinpif(ang);
        float val;
        if (m < 64) val = (k < 64) ? cv : -sv; else val = (k < 64) ? sv : cv;
        F1[e] = f2bf(val);
      } else if ((e -= 128 * 128) < 128 * 256) {
        const int m = e >> 8, k = e & 255, kk = k & 127;
        const float ang = (float)((m * kk) & 127) / 64.f;
        F2[e] = f2bf(k < 128 ? cospif(ang) : -sinpif(ang));
      } else if ((e -= 128 * 256) < 256 * 512) {
        const int m = e >> 9, k = e & 511, kk = k & 255;
        const float ang = (float)((m * kk) & 255) / 128.f;
        FC[e] = f2bf(k < 256 ? cospif(ang) : -sinpif(ang));
      } else {
        e -= 256 * 512;
        const int k1 = e >> 7, t2 = e & 127;
        const float ang = (float)(k1 * t2) / 4096.f;
        TW[e] = make_float2(cospif(ang), sinpif(ang));
      }
    } else if (it < N_MOD + N_TAB + N_CWPREP) {
      fourier_cw_prep(p, 0, it - N_MOD - N_TAB, smem, TID);
    } else {
      fourier_wprep(p, 0, it - N_MOD - N_TAB - N_CWPREP, smem, TID);
    }
  }
}

DI void row_items(const Params& p, int layer, bool do_post, bool do_pre, int nrows, const bf16_t* O, bf16_t* H, int it0, int nit, const int TID) {
  const int wave = TID >> 6, lane = TID & 63;
  const float* MOD = (const float*)(p.ws + OFF_MOD);
  float* XCTX = (float*)(p.ws + OFF_XCTX);
  float4 nx0, nx1, nx2, nx3;
  uint2 no0 = make_uint2(0, 0), no1 = no0, no2 = no0, no3 = no0;
#define ROW_XIN(ROW_) ((layer == 0) ? ((ROW_) < NLAT ? p.x + (size_t)(ROW_) * D : p.ctx + (size_t)((ROW_) - NLAT) * D) \
                                    : ((ROW_) < NLAT ? p.out + (size_t)(ROW_) * D : XCTX + (size_t)((ROW_) - NLAT) * D))
#define ROW_PREFETCH(ROW_) { const float* xi_ = ROW_XIN(ROW_); \
    nx0 = *(const float4*)(xi_ + lane * 4); nx1 = *(const float4*)(xi_ + 256 + lane * 4); nx2 = *(const float4*)(xi_ + 512 + lane * 4); nx3 = *(const float4*)(xi_ + 768 + lane * 4); \
    if (do_post) { const bf16_t* oi_ = O + (size_t)(ROW_) * D + lane * 4; \
      no0 = *(const uint2*)(oi_); no1 = *(const uint2*)(oi_ + 256); no2 = *(const uint2*)(oi_ + 512); no3 = *(const uint2*)(oi_ + 768); } }
  if (it0 < nit) ROW_PREFETCH(it0 * 4 + wave)
  for (int it = it0; it < nit; it += gridDim.x) {
    const int row = it * 4 + wave;
    const int v = row < 8192 ? 0 : (row < 16384 ? 1 : 2);
    float* xout = row < NLAT ? p.out + (size_t)row * D : XCTX + (size_t)(row - NLAT) * D;
    float4 xv[4] = {nx0, nx1, nx2, nx3};
    const uint2 ou[4] = {no0, no1, no2, no3};
    if (it + (int)gridDim.x < nit) ROW_PREFETCH((it + (int)gridDim.x) * 4 + wave)
    if (do_post) {
      float ov[4][4];
      float ss = 0.f;
#pragma unroll
      for (int qd = 0; qd < 4; ++qd) {
        const uint2 u = ou[qd];
        ov[qd][0] = lo2f(u.x); ov[qd][1] = hi2f(u.x); ov[qd][2] = lo2f(u.y); ov[qd][3] = hi2f(u.y);
#pragma unroll
        for (int e = 0; e < 4; ++e) ss += ov[qd][e] * ov[qd][e];
      }
      ss = wave_sum(ss);
      const float rstd = rsqrtf(ss * (1.f / 1024.f) + RMS_EPS);
      const float* gate = MOD + ((size_t)layer * 3 + v) * 3072 + 2048;
      const float* np = p.norm_post + (size_t)layer * D;
#pragma unroll
      for (int qd = 0; qd < 4; ++qd) {
        const float4 gv = *(const float4*)(gate + qd * 256 + lane * 4);
        const float4 nv = *(const float4*)(np + qd * 256 + lane * 4);
        xv[qd].x += gv.x * (ov[qd][0] * rstd * nv.x);
        xv[qd].y += gv.y * (ov[qd][1] * rstd * nv.y);
        xv[qd].z += gv.z * (ov[qd][2] * rstd * nv.z);
        xv[qd].w += gv.w * (ov[qd][3] * rstd * nv.w);
        *(float4*)(xout + qd * 256 + lane * 4) = xv[qd];
      }
    }
    if (do_pre) {
      const int L = layer + (do_post ? 1 : 0);
      float ss = 0.f;
#pragma unroll
      for (int qd = 0; qd < 4; ++qd) ss += xv[qd].x * xv[qd].x + xv[qd].y * xv[qd].y + xv[qd].z * xv[qd].z + xv[qd].w * xv[qd].w;
      ss = wave_sum(ss);
      const float rstd = rsqrtf(ss * (1.f / 1024.f) + RMS_EPS);
      const float* sh = MOD + ((size_t)L * 3 + v) * 3072;
      const float* sc = sh + 1024;
      const float* np = p.norm_pre + (size_t)L * D;
#pragma unroll
      for (int qd = 0; qd < 4; ++qd) {
        const float4 a = *(const float4*)(sh + qd * 256 + lane * 4);
        const float4 b = *(const float4*)(sc + qd * 256 + lane * 4);
        const float4 n = *(const float4*)(np + qd * 256 + lane * 4);
        const float h0 = xv[qd].x * rstd * n.x * (1.f + b.x) + a.x;
        const float h1 = xv[qd].y * rstd * n.y * (1.f + b.y) + a.y;
        const float h2 = xv[qd].z * rstd * n.z * (1.f + b.z) + a.z;
        const float h3 = xv[qd].w * rstd * n.w * (1.f + b.w) + a.w;
        *(uint2*)(H + (size_t)row * D + qd * 256 + lane * 4) = make_uint2(pack2(h0, h1), pack2(h2, h3));
      }
    }
  }
}

#undef ROW_XIN
#undef ROW_PREFETCH
DI int seq_row(int n, int b, int s) {
  if (s < 256) { const int t = n ? 255 - s : s; return NLAT + b * 256 + t; }
  const int u = s - 256; const int t = n ? 8191 - u : u; return b * 8192 + t;
}
DI void scan_chain(const Params& p, int j, int cid, const bf16_t* R, const bf16_t* Kb, const bf16_t* V, bf16_t* Y0, bf16_t* Y1, char* smem, const int TID) {
  const int n = cid >> 5, b = (cid >> 4) & 1, h = cid & 15;
  const int tid = TID;
  float* rS = (float*)smem;
  float* wS = rS + 1024; float* kS = wS + 1024; float* vS = kS + 1024; float* aS = vS + 1024; float* bS = aS + 1024;
  float* lwS = bS + 1024; float* laS = lwS + 1024;
  float* w2S = laS + 1024;
  float* a2S = w2S + 4096;
  float* yS = lwS;
  const bf16_t* LW = (const bf16_t*)(p.ws + OFF_LW);
  const bf16_t* LA = (const bf16_t*)(p.ws + OFF_LA);
  float* BON = (float*)(p.ws + OFF_BON);
  bf16_t* Y = n ? Y1 : Y0;
  __syncthreads();
  {
    const float* w2 = p.r_w2 + (size_t)(j * 2 + n) * 64 * 1024 + h * 64;
    const float* a2 = p.r_a2 + (size_t)(j * 2 + n) * 64 * 1024 + h * 64;
    for (int e = tid; e < 4096; e += 256) { w2S[e] = w2[(size_t)(e >> 6) * 1024 + (e & 63)]; a2S[e] = a2[(size_t)(e >> 6) * 1024 + (e & 63)]; }
  }
  const int ltok = tid >> 4, cq = tid & 15, c4 = cq * 4;
  const int gc = h * 64 + c4;
  const float4 w0v = *(const float4*)(p.r_w0 + (size_t)(j * 2 + n) * 1024 + gc);
  const float4 a0v = *(const float4*)(p.r_a0 + (size_t)(j * 2 + n) * 1024 + gc);
  const float4 kkv = *(const float4*)(p.r_k_k + (size_t)j * 1024 + gc);
  const float4 kav = *(const float4*)(p.r_k_a + (size_t)j * 1024 + gc);
  const float4 rkv = *(const float4*)(p.r_r_k + (size_t)j * 1024 + gc);
  const int si = tid >> 2, jq = tid & 3;
  float S[16];
#pragma unroll
  for (int e = 0; e < 16; ++e) S[e] = 0.f;
  for (int ck = 0; ck < 528; ++ck) {
    const int s = ck * 16 + ltok;
    const int row = seq_row(n, b, s);
    const uint2 ur = *(const uint2*)(R + (size_t)row * D + gc);
    const uint2 uk = *(const uint2*)(Kb + (size_t)row * D + gc);
    const uint2 uv = *(const uint2*)(V + (size_t)row * D + gc);
    const uint2 ulw = *(const uint2*)(LW + (size_t)row * 128 + n * 64 + c4);
    const uint2 ula = *(const uint2*)(LA + (size_t)row * 128 + n * 64 + c4);
    __syncthreads();
    *(float4*)(lwS + ltok * 64 + c4) = make_float4(lo2f(ulw.x), hi2f(ulw.x), lo2f(ulw.y), hi2f(ulw.y));
    *(float4*)(laS + ltok * 64 + c4) = make_float4(lo2f(ula.x), hi2f(ula.x), lo2f(ula.y), hi2f(ula.y));
    __syncthreads();
    float wz[4] = {w0v.x, w0v.y, w0v.z, w0v.w}, az[4] = {a0v.x, a0v.y, a0v.z, a0v.w};
    for (int l = 0; l < 64; ++l) {
      const float lw = lwS[ltok * 64 + l], la = laS[ltok * 64 + l];
      const float4 w2v = *(const float4*)(w2S + l * 64 + c4);
      const float4 a2v = *(const float4*)(a2S + l * 64 + c4);
      wz[0] += lw * w2v.x; wz[1] += lw * w2v.y; wz[2] += lw * w2v.z; wz[3] += lw * w2v.w;
      az[0] += la * a2v.x; az[1] += la * a2v.y; az[2] += la * a2v.z; az[3] += la * a2v.w;
    }
    const float rr[4] = {lo2f(ur.x), hi2f(ur.x), lo2f(ur.y), hi2f(ur.y)};
    const float kr[4] = {lo2f(uk.x), hi2f(uk.x), lo2f(uk.y), hi2f(uk.y)};
    const float vr[4] = {lo2f(uv.x), hi2f(uv.x), lo2f(uv.y), hi2f(uv.y)};
    const float kkw[4] = {kkv.x, kkv.y, kkv.z, kkv.w}, kaw[4] = {kav.x, kav.y, kav.z, kav.w}, rkw[4] = {rkv.x, rkv.y, rkv.z, rkv.w};
    float kk[4], ss = 0.f;
#pragma unroll
    for (int e = 0; e < 4; ++e) { kk[e] = kr[e] * kkw[e]; ss += kk[e] * kk[e]; }
#pragma unroll
    for (int o = 8; o > 0; o >>= 1) ss += __shfl_xor(ss, o, 64);
    const float inv = 1.f / fmaxf(sqrtf(ss), 1e-12f);
    float dec[4], as[4], kd[4], bb[4], bon = 0.f;
#pragma unroll
    for (int e = 0; e < 4; ++e) {
      kk[e] *= inv;
      dec[e] = __expf(-__expf(-softplus_f(-wz[e]) - 0.5f));
      as[e] = sigmoid_f(az[e]);
      kd[e] = kr[e] * (1.f + (as[e] - 1.f) * kaw[e]);
      bb[e] = kk[e] * as[e];
      bon += rr[e] * kd[e] * rkw[e];
    }
#pragma unroll
    for (int o = 8; o > 0; o >>= 1) bon += __shfl_xor(bon, o, 64);
    if (cq == 0) BON[((size_t)n * NR + row) * 16 + h] = bon;
    *(float4*)(rS + ltok * 64 + c4) = make_float4(rr[0], rr[1], rr[2], rr[3]);
    *(float4*)(wS + ltok * 64 + c4) = make_float4(dec[0], dec[1], dec[2], dec[3]);
    *(float4*)(kS + ltok * 64 + c4) = make_float4(kd[0], kd[1], kd[2], kd[3]);
    *(float4*)(vS + ltok * 64 + c4) = make_float4(vr[0], vr[1], vr[2], vr[3]);
    *(float4*)(aS + ltok * 64 + c4) = make_float4(-kk[0], -kk[1], -kk[2], -kk[3]);
    *(float4*)(bS + ltok * 64 + c4) = make_float4(bb[0], bb[1], bb[2], bb[3]);
    __syncthreads();
    for (int t = 0; t < 16; ++t) {
      float av[16], sa = 0.f;
#pragma unroll
      for (int m = 0; m < 4; ++m) {
        const float4 a4 = *(const float4*)(aS + t * 64 + jq * 16 + m * 4);
        av[m * 4] = a4.x; av[m * 4 + 1] = a4.y; av[m * 4 + 2] = a4.z; av[m * 4 + 3] = a4.w;
      }
#pragma unroll
      for (int e = 0; e < 16; ++e) sa += S[e] * av[e];
      sa += __shfl_xor(sa, 1, 64);
      sa += __shfl_xor(sa, 2, 64);
      const float vi = vS[t * 64 + si];
      float y = 0.f;
#pragma unroll
      for (int m = 0; m < 4; ++m) {
        const float4 w4 = *(const float4*)(wS + t * 64 + jq * 16 + m * 4);
        const float4 b4 = *(const float4*)(bS + t * 64 + jq * 16 + m * 4);
        const float4 k4 = *(const float4*)(kS + t * 64 + jq * 16 + m * 4);
        const float4 r4 = *(const float4*)(rS + t * 64 + jq * 16 + m * 4);
        S[m * 4 + 0] = S[m * 4 + 0] * w4.x + sa * b4.x + vi * k4.x; y += S[m * 4 + 0] * r4.x;
        S[m * 4 + 1] = S[m * 4 + 1] * w4.y + sa * b4.y + vi * k4.y; y += S[m * 4 + 1] * r4.y;
        S[m * 4 + 2] = S[m * 4 + 2] * w4.z + sa * b4.z + vi * k4.z; y += S[m * 4 + 2] * r4.z;
        S[m * 4 + 3] = S[m * 4 + 3] * w4.w + sa * b4.w + vi * k4.w; y += S[m * 4 + 3] * r4.w;
      }
      y += __shfl_xor(y, 1, 64);
      y += __shfl_xor(y, 2, 64);
      if (jq == 0) yS[t * 64 + si] = y;
    }
    __syncthreads();
    {
      const float4 yv = *(const float4*)(yS + ltok * 64 + c4);
      *(uint2*)(Y + (size_t)row * D + gc) = make_uint2(pack2(yv.x, yv.y), pack2(yv.z, yv.w));
    }
  }
}


constexpr int CS_W2T = 0, CS_A2T = 9216, CS_R1 = 18432, CS_R2 = 27648, CS_R3 = 36864, CS_WZ = 46080, CS_AZ = 62464,
              CS_AT = 78848, CS_RT = 88064, CS_BT = 97280, CS_KT = 106496, CS_VT = 115712, CS_AAB = 124928, CS_UV = 142336,
              CS_S0T = 151552, CS_TOT = 160768, CS_CL = 161792, CS_CST = 162048, CS_END = 163328;
DI s16x8 lds_row8(const char* base, int row, int col) { return *(const s16x8*)(base + row * 144 + col * 2); }
DI s16x8 lds_tr8(const char* base, int krow0, int ncol0, int lane) {
  const int g = lane >> 4, li = lane & 15, qq = li >> 2, pp = li & 3;
  const int off = (krow0 + 8 * (g >> 1) + qq) * 144 + (ncol0 + 16 * (g & 1) + 4 * pp) * 2;
  const s16x4 lo = __builtin_amdgcn_ds_read_tr16_b64_v4i16((__attribute__((address_space(3))) s16x4*)(base + off));
  const s16x4 hi = __builtin_amdgcn_ds_read_tr16_b64_v4i16((__attribute__((address_space(3))) s16x4*)(base + off + 4 * 144));
  return __builtin_shufflevector(lo, hi, 0, 1, 2, 3, 4, 5, 6, 7);
}
DI void unpack16(const uint4 a, const uint4 b, float* f) {
  f[0] = lo2f(a.x); f[1] = hi2f(a.x); f[2] = lo2f(a.y); f[3] = hi2f(a.y); f[4] = lo2f(a.z); f[5] = hi2f(a.z); f[6] = lo2f(a.w); f[7] = hi2f(a.w);
  f[8] = lo2f(b.x); f[9] = hi2f(b.x); f[10] = lo2f(b.y); f[11] = hi2f(b.y); f[12] = lo2f(b.z); f[13] = hi2f(b.z); f[14] = lo2f(b.w); f[15] = hi2f(b.w);
}
DI void store16bf(char* dst, const float* f) {
  *(uint4*)dst = make_uint4(pack2(f[0], f[1]), pack2(f[2], f[3]), pack2(f[4], f[5]), pack2(f[6], f[7]));
  *(uint4*)(dst + 16) = make_uint4(pack2(f[8], f[9]), pack2(f[10], f[11]), pack2(f[12], f[13]), pack2(f[14], f[15]));
}
constexpr int NSEG = 5;
DI int seg_start(int sg) { return sg == 0 ? 0 : (sg == 1 ? 24 : (sg == 2 ? 51 : (sg == 3 ? 78 : (sg == 4 ? 105 : 132)))); }
template <int MODE>
DI void scan_chain_chunked(const Params& p, int j, int cid, int seg, float* SCR, const bf16_t* R, const bf16_t* Kb, const bf16_t* V, bf16_t* Y0, bf16_t* Y1, char* smem, const int TID) {
  const int n = cid >> 5, b = (cid >> 4) & 1, hd = cid & 15;
  const int tid = TID, lane = tid & 63, w = tid >> 6, l31 = lane & 31, hh = lane >> 5;
  const int mi = w >> 1, ni = w & 1;
  const int tok = tid >> 2, q = tid & 3, c0 = 16 * q;
  const bf16_t* LW = (const bf16_t*)(p.ws + OFF_LW);
  const bf16_t* LA = (const bf16_t*)(p.ws + OFF_LA);
  float* BON = (float*)(p.ws + OFF_BON);
  bf16_t* Y = n ? Y1 : Y0;
  float* WZ = (float*)(smem + CS_WZ);
  float* AZ = (float*)(smem + CS_AZ);
  float* AABD = (float*)(smem + CS_AAB + 9216);
  float* TOT = (float*)(smem + CS_TOT);
  float* CL = (float*)(smem + CS_CL);
  float* CST = (float*)(smem + CS_CST);
  __syncthreads();
  {
    const float* w2 = p.r_w2 + (size_t)(j * 2 + n) * 64 * 1024 + hd * 64;
    const float* a2 = p.r_a2 + (size_t)(j * 2 + n) * 64 * 1024 + hd * 64;
    for (int e = tid; e < 4096; e += 256) {
      const int l = e >> 6, col = e & 63;
      *(bf16_t*)(smem + CS_W2T + col * 144 + l * 2) = f2bf(w2[(size_t)l * 1024 + col]);
      *(bf16_t*)(smem + CS_A2T + col * 144 + l * 2) = f2bf(a2[(size_t)l * 1024 + col]);
    }
    for (int e = tid; e < 64 * 72; e += 256) *(bf16_t*)(smem + CS_S0T + e * 2) = 0;
    if (tid < 64) {
      CST[tid] = p.r_w0[(size_t)(j * 2 + n) * 1024 + hd * 64 + tid];
      CST[64 + tid] = p.r_a0[(size_t)(j * 2 + n) * 1024 + hd * 64 + tid];
      CST[128 + tid] = p.r_k_k[(size_t)j * 1024 + hd * 64 + tid];
      CST[192 + tid] = p.r_k_a[(size_t)j * 1024 + hd * 64 + tid];
      CST[256 + tid] = p.r_r_k[(size_t)j * 1024 + hd * 64 + tid];
    }
  }
  f32x16 Sacc, Pacc;
#pragma unroll
  for (int r = 0; r < 16; ++r) { Sacc[r] = 0.f; Pacc[r] = 0.f; }
  if (MODE == 0) {
    for (int e = tid; e < 64 * 72; e += 256) *(bf16_t*)(smem + CS_RT + e * 2) = ((e / 72) == (e % 72)) ? (bf16_t)0x3f80 : (bf16_t)0;
#pragma unroll
    for (int r = 0; r < 16; ++r) Pacc[r] = ((32 * mi + crow(r, hh)) == (32 * ni + l31)) ? 1.f : 0.f;
  } else if (seg > 0) {
    const int jr = tid >> 2, ib = (tid & 3) * 16;
    const float* PQ = SCR + (size_t)(cid * 4) * 8192;
    float nv[16];
#pragma unroll
    for (int e = 0; e < 16; ++e) nv[e] = PQ[4096 + jr * 64 + ib + e];
    for (int sg = 1; sg < seg; ++sg) {
      __syncthreads();
#pragma unroll
      for (int e = 0; e < 16; ++e) WZ[jr * 64 + ib + e] = nv[e];
      __syncthreads();
      const float* Pm = PQ + (size_t)sg * 8192;
#pragma unroll
      for (int e = 0; e < 16; ++e) nv[e] = Pm[4096 + jr * 64 + ib + e];
      for (int jp = 0; jp < 64; jp += 4) {
        const float4 pv = *(const float4*)(Pm + jr * 64 + jp);
#pragma unroll
        for (int e = 0; e < 16; ++e)
          nv[e] += pv.x * WZ[(jp + 0) * 64 + ib + e] + pv.y * WZ[(jp + 1) * 64 + ib + e] + pv.z * WZ[(jp + 2) * 64 + ib + e] + pv.w * WZ[(jp + 3) * 64 + ib + e];
      }
    }
    __syncthreads();
#pragma unroll
    for (int e = 0; e < 16; ++e) WZ[jr * 64 + ib + e] = nv[e];
    __syncthreads();
#pragma unroll
    for (int r = 0; r < 16; ++r) {
      const int rrow = 32 * mi + crow(r, hh), ccol = 32 * ni + l31;
      Sacc[r] = WZ[rrow * 64 + ccol];
      *(bf16_t*)(smem + CS_S0T + rrow * 144 + ccol * 2) = f2bf(Sacc[r]);
    }
    __syncthreads();
  }
  const int ck0 = seg_start(seg), ck1 = seg_start(seg + 1);
  uint4 ur0, ur1, uk0, uk1, uv0, uv1, l0, l1, m0, m1;
#define SCAN_LOAD(CK) { const int row_ = seq_row(n, b, (CK) * 64 + tok); const size_t g_ = (size_t)row_ * D + hd * 64 + c0; \
    ur0 = *(const uint4*)(R + g_); ur1 = *(const uint4*)(R + g_ + 8); uk0 = *(const uint4*)(Kb + g_); uk1 = *(const uint4*)(Kb + g_ + 8); \
    uv0 = *(const uint4*)(V + g_); uv1 = *(const uint4*)(V + g_ + 8); \
    l0 = *(const uint4*)(LW + (size_t)row_ * 128 + n * 64 + c0); l1 = *(const uint4*)(LW + (size_t)row_ * 128 + n * 64 + c0 + 8); \
    m0 = *(const uint4*)(LA + (size_t)row_ * 128 + n * 64 + c0); m1 = *(const uint4*)(LA + (size_t)row_ * 128 + n * 64 + c0 + 8); }
  SCAN_LOAD(ck0)
  for (int ck = ck0; ck < ck1; ++ck) {
    const int row = seq_row(n, b, ck * 64 + tok);
    *(uint4*)(smem + CS_R1 + tok * 144 + c0 * 2) = l0; *(uint4*)(smem + CS_R1 + tok * 144 + c0 * 2 + 16) = l1;
    *(uint4*)(smem + CS_R2 + tok * 144 + c0 * 2) = m0; *(uint4*)(smem + CS_R2 + tok * 144 + c0 * 2 + 16) = m1;
    __syncthreads();
    {
      f32x16 awz, aaz;
#pragma unroll
      for (int r = 0; r < 16; ++r) { awz[r] = 0.f; aaz[r] = 0.f; }
#pragma unroll
      for (int kk = 0; kk < 4; ++kk) {
        const s16x8 alw = lds_row8(smem + CS_R1, 32 * mi + l31, kk * 16 + 8 * hh);
        const s16x8 ala = lds_row8(smem + CS_R2, 32 * mi + l31, kk * 16 + 8 * hh);
        const s16x8 bw = lds_row8(smem + CS_W2T, 32 * ni + l31, kk * 16 + 8 * hh);
        const s16x8 ba = lds_row8(smem + CS_A2T, 32 * ni + l31, kk * 16 + 8 * hh);
        awz = MFMA(alw, bw, awz);
        aaz = MFMA(ala, ba, aaz);
      }
#pragma unroll
      for (int r = 0; r < 16; ++r) {
        const int t = 32 * mi + crow(r, hh), col = 32 * ni + l31;
        WZ[t * 64 + col] = awz[r];
        AZ[t * 64 + col] = aaz[r];
      }
    }
    __syncthreads();
    float lw[16], rr[16], kd[16], av[16], bb[16];
    {
      float kr[16], cw0[16], ca0[16], ckk[16], cka[16], crk[16], wzv[16], azv[16];
      unpack16(ur0, ur1, rr);
      unpack16(uk0, uk1, kr);
#pragma unroll
      for (int e4 = 0; e4 < 4; ++e4) {
        const float4 v0 = *(const float4*)(CST + c0 + e4 * 4), v1 = *(const float4*)(CST + 64 + c0 + e4 * 4), v2 = *(const float4*)(CST + 128 + c0 + e4 * 4);
        const float4 v3 = *(const float4*)(CST + 192 + c0 + e4 * 4), v4 = *(const float4*)(CST + 256 + c0 + e4 * 4);
        const float4 v5 = *(const float4*)(WZ + tok * 64 + c0 + e4 * 4), v6 = *(const float4*)(AZ + tok * 64 + c0 + e4 * 4);
        cw0[e4 * 4] = v0.x; cw0[e4 * 4 + 1] = v0.y; cw0[e4 * 4 + 2] = v0.z; cw0[e4 * 4 + 3] = v0.w;
        ca0[e4 * 4] = v1.x; ca0[e4 * 4 + 1] = v1.y; ca0[e4 * 4 + 2] = v1.z; ca0[e4 * 4 + 3] = v1.w;
        ckk[e4 * 4] = v2.x; ckk[e4 * 4 + 1] = v2.y; ckk[e4 * 4 + 2] = v2.z; ckk[e4 * 4 + 3] = v2.w;
        cka[e4 * 4] = v3.x; cka[e4 * 4 + 1] = v3.y; cka[e4 * 4 + 2] = v3.z; cka[e4 * 4 + 3] = v3.w;
        crk[e4 * 4] = v4.x; crk[e4 * 4 + 1] = v4.y; crk[e4 * 4 + 2] = v4.z; crk[e4 * 4 + 3] = v4.w;
        wzv[e4 * 4] = v5.x; wzv[e4 * 4 + 1] = v5.y; wzv[e4 * 4 + 2] = v5.z; wzv[e4 * 4 + 3] = v5.w;
        azv[e4 * 4] = v6.x; azv[e4 * 4 + 1] = v6.y; azv[e4 * 4 + 2] = v6.z; azv[e4 * 4 + 3] = v6.w;
      }
      float ss = 0.f;
#pragma unroll
      for (int e = 0; e < 16; ++e) { av[e] = kr[e] * ckk[e]; ss += av[e] * av[e]; }
      ss = dpp_add<0xB1>(ss);
      ss = dpp_add<0x4E>(ss);
      const float inv = __frsqrt_rn(fmaxf(ss, 1e-24f));
      float bon = 0.f;
#pragma unroll
      for (int e = 0; e < 16; ++e) {
        const float wz = wzv[e] + cw0[e];
        const float az = azv[e] + ca0[e];
        lw[e] = -0.60653066f * fsig(wz);
        const float as = fsig(az);
        const float kkn = av[e] * inv;
        kd[e] = kr[e] * (1.f + (as - 1.f) * cka[e]);
        bb[e] = kkn * as;
        av[e] = -kkn;
        bon += rr[e] * kd[e] * crk[e];
      }
#pragma unroll
      for (int e4 = 0; e4 < 4; ++e4) *(float4*)(WZ + tok * 64 + c0 + e4 * 4) = make_float4(lw[e4 * 4], lw[e4 * 4 + 1], lw[e4 * 4 + 2], lw[e4 * 4 + 3]);
      bon = dpp_add<0xB1>(bon);
      bon = dpp_add<0x4E>(bon);
      if (MODE == 1 && q == 0) BON[((size_t)n * NR + row) * 16 + hd] = bon;
    }
    __syncthreads();
    {
      const int col = tid & 63, qt = tid >> 6;
      float pv[16];
#pragma unroll
      for (int t = 0; t < 16; ++t) pv[t] = WZ[(16 * qt + t) * 64 + col];
      float sacc = 0.f;
#pragma unroll
      for (int t = 0; t < 16; ++t) { sacc += pv[t]; WZ[(16 * qt + t) * 64 + col] = sacc; }
      TOT[qt * 64 + col] = sacc;
    }
    __syncthreads();
    {
      float fa[16], fr[16], fb[16], fk[16], fv[16];
      unpack16(uv0, uv1, fv);
      const int qt = tok >> 4;
      float tb[16], tt[16], cum[16];
#pragma unroll
      for (int e4 = 0; e4 < 4; ++e4) {
        const float4 t0 = *(const float4*)(TOT + c0 + e4 * 4), t1 = *(const float4*)(TOT + 64 + c0 + e4 * 4);
        const float4 t2 = *(const float4*)(TOT + 128 + c0 + e4 * 4), t3 = *(const float4*)(TOT + 192 + c0 + e4 * 4);
        const float4 cv = *(const float4*)(WZ + tok * 64 + c0 + e4 * 4);
        const float m0_ = qt > 0 ? 1.f : 0.f, m1_ = qt > 1 ? 1.f : 0.f, m2_ = qt > 2 ? 1.f : 0.f;
        tb[e4 * 4] = m0_ * t0.x + m1_ * t1.x + m2_ * t2.x; tb[e4 * 4 + 1] = m0_ * t0.y + m1_ * t1.y + m2_ * t2.y;
        tb[e4 * 4 + 2] = m0_ * t0.z + m1_ * t1.z + m2_ * t2.z; tb[e4 * 4 + 3] = m0_ * t0.w + m1_ * t1.w + m2_ * t2.w;
        tt[e4 * 4] = t0.x + t1.x + t2.x + t3.x; tt[e4 * 4 + 1] = t0.y + t1.y + t2.y + t3.y;
        tt[e4 * 4 + 2] = t0.z + t1.z + t2.z + t3.z; tt[e4 * 4 + 3] = t0.w + t1.w + t2.w + t3.w;
        cum[e4 * 4] = cv.x; cum[e4 * 4 + 1] = cv.y; cum[e4 * 4 + 2] = cv.z; cum[e4 * 4 + 3] = cv.w;
      }
#pragma unroll
      for (int e = 0; e < 16; ++e) {
        const float incl = cum[e] + tb[e];
        const float excl = incl - lw[e];
        const float ei = __expf(incl), ee = __expf(excl), nin = __builtin_amdgcn_rcpf(ei);
        fa[e] = av[e] * ee; fr[e] = rr[e] * ei; fb[e] = bb[e] * nin; fk[e] = kd[e] * nin;
      }
#pragma unroll
      for (int e4 = 0; e4 < 4; ++e4) {
        *(float4*)(WZ + tok * 64 + c0 + e4 * 4) = make_float4(fa[e4 * 4], fa[e4 * 4 + 1], fa[e4 * 4 + 2], fa[e4 * 4 + 3]);
        if (tok == 0) *(float4*)(CL + c0 + e4 * 4) = make_float4(__expf(tt[e4 * 4]), __expf(tt[e4 * 4 + 1]), __expf(tt[e4 * 4 + 2]), __expf(tt[e4 * 4 + 3]));
      }
      store16bf(smem + CS_AT + tok * 144 + c0 * 2, fa);
      if (MODE == 1) store16bf(smem + CS_RT + tok * 144 + c0 * 2, fr);
      store16bf(smem + CS_BT + tok * 144 + c0 * 2, fb);
      store16bf(smem + CS_KT + tok * 144 + c0 * 2, fk);
      *(uint4*)(smem + CS_VT + tok * 144 + c0 * 2) = uv0;
      *(uint4*)(smem + CS_VT + tok * 144 + c0 * 2 + 16) = uv1;
    }
    if (ck + 1 < ck1) SCAN_LOAD(ck + 1)
    __syncthreads();
    {
      f32x16 ab, ak, rb, rk;
#pragma unroll
      for (int r = 0; r < 16; ++r) { ab[r] = 0.f; ak[r] = 0.f; rb[r] = 0.f; rk[r] = 0.f; }
      if (mi >= ni) {
#pragma unroll
        for (int kk = 0; kk < 4; ++kk) {
          const s16x8 aA = lds_row8(smem + CS_AT, 32 * mi + l31, kk * 16 + 8 * hh);
          const s16x8 aR = lds_row8(smem + CS_RT, 32 * mi + l31, kk * 16 + 8 * hh);
          const s16x8 bB = lds_row8(smem + CS_BT, 32 * ni + l31, kk * 16 + 8 * hh);
          const s16x8 bK = lds_row8(smem + CS_KT, 32 * ni + l31, kk * 16 + 8 * hh);
          ab = MFMA(aA, bB, ab); ak = MFMA(aA, bK, ak);
          if (MODE == 1) { rb = MFMA(aR, bB, rb); rk = MFMA(aR, bK, rk); }
        }
      }
#pragma unroll
      for (int r = 0; r < 16; ++r) {
        const int t = 32 * mi + crow(r, hh), sx = 32 * ni + l31;
        const bool lo_s = sx < t, lo_i = sx <= t;
        *(bf16_t*)(smem + CS_AAB + t * 144 + sx * 2) = f2bf(lo_s ? ab[r] : 0.f);
        if ((t >> 4) == (sx >> 4)) AABD[(t >> 4) * 256 + (t & 15) * 16 + (sx & 15)] = lo_s ? ab[r] : 0.f;
        *(bf16_t*)(smem + CS_R1 + t * 144 + sx * 2) = f2bf(lo_s ? ak[r] : 0.f);
        if (MODE == 1) {
          *(bf16_t*)(smem + CS_R2 + t * 144 + sx * 2) = f2bf(lo_i ? rb[r] : 0.f);
          *(bf16_t*)(smem + CS_R3 + t * 144 + sx * 2) = f2bf(lo_i ? rk[r] : 0.f);
        }
      }
    }
    __syncthreads();
    {
      f32x16 xu;
#pragma unroll
      for (int r = 0; r < 16; ++r) xu[r] = 0.f;
#pragma unroll
      for (int kk = 0; kk < 4; ++kk) {
        const s16x8 a = lds_row8(smem + CS_R1, 32 * mi + l31, kk * 16 + 8 * hh);
        const s16x8 bv = lds_tr8(smem + CS_VT, kk * 16, 32 * ni, lane);
        xu = MFMA(a, bv, xu);
      }
#pragma unroll
      for (int r = 0; r < 16; ++r) AZ[(32 * mi + crow(r, hh)) * 64 + 32 * ni + l31] = xu[r];
    }
    __syncthreads();
#pragma unroll
    for (int bk = 0; bk < 4; ++bk) {
      if (tid < 128) {
        float* rhs = (tid < 64) ? (WZ + tid) : (AZ + (tid - 64));
        float x[16], am[16][16];
#pragma unroll
        for (int r = 0; r < 16; ++r) x[r] = rhs[(16 * bk + r) * 64];
#pragma unroll
        for (int tp = 1; tp < 16; ++tp) {
#pragma unroll
          for (int s4 = 0; s4 < (tp + 3) / 4; ++s4) {
            const float4 v = *(const float4*)(AABD + bk * 256 + tp * 16 + s4 * 4);
            am[tp][s4 * 4] = v.x; am[tp][s4 * 4 + 1] = v.y; am[tp][s4 * 4 + 2] = v.z; am[tp][s4 * 4 + 3] = v.w;
          }
        }
#pragma unroll
        for (int sx = 0; sx < 15; ++sx) {
          const float xs = x[sx];
#pragma unroll
          for (int tp = sx + 1; tp < 16; ++tp) x[tp] = fmaf(am[tp][sx], xs, x[tp]);
        }
        char* dst = (tid < 64) ? (smem + CS_AT + tid * 2) : (smem + CS_UV + (tid - 64) * 2);
#pragma unroll
        for (int r = 0; r < 16; ++r) *(bf16_t*)(dst + (16 * bk + r) * 144) = f2bf(x[r]);
      }
      __syncthreads();
      if (bk < 3) {
        const char* xsrc = (w < 2) ? (smem + CS_AT) : (smem + CS_UV);
        float* rdst = (w < 2) ? WZ : AZ;
        const s16x8 bx = lds_tr8(xsrc, 16 * bk, 32 * (w & 1), lane);
#pragma unroll
        for (int rt = 0; rt < 2; ++rt) {
          if (32 * rt + 31 >= 16 * (bk + 1)) {
            f32x16 up;
#pragma unroll
            for (int r = 0; r < 16; ++r) up[r] = 0.f;
            const s16x8 aa = lds_row8(smem + CS_AAB, 32 * rt + l31, 16 * bk + 8 * hh);
            up = MFMA(aa, bx, up);
#pragma unroll
            for (int r = 0; r < 16; ++r) rdst[(32 * rt + crow(r, hh)) * 64 + 32 * (w & 1) + l31] += up[r];
          }
        }
        __syncthreads();
      }
    }
    f32x16 rh, yl, mm, cc;
#pragma unroll
    for (int r = 0; r < 16; ++r) { rh[r] = 0.f; yl[r] = 0.f; mm[r] = 0.f; cc[r] = 0.f; }
#pragma unroll
    for (int kk = 0; kk < 4; ++kk) {
      const s16x8 aRB = lds_row8(smem + CS_R2, 32 * mi + l31, kk * 16 + 8 * hh);
      const s16x8 aRK = lds_row8(smem + CS_R3, 32 * mi + l31, kk * 16 + 8 * hh);
      const s16x8 tAH = lds_tr8(smem + CS_AT, kk * 16, 32 * ni, lane);
      const s16x8 tUV = lds_tr8(smem + CS_UV, kk * 16, 32 * ni, lane);
      const s16x8 tVT = lds_tr8(smem + CS_VT, kk * 16, 32 * ni, lane);
      const s16x8 tBT = lds_tr8(smem + CS_BT, kk * 16, 32 * mi, lane);
      const s16x8 tKT = lds_tr8(smem + CS_KT, kk * 16, 32 * mi, lane);
      if (MODE == 1) {
        rh = MFMA(aRB, tAH, rh);
        yl = MFMA(aRB, tUV, yl);
        yl = MFMA(aRK, tVT, yl);
      }
      mm = MFMA(tBT, tAH, mm);
      cc = MFMA(tBT, tUV, cc);
      cc = MFMA(tKT, tVT, cc);
    }
#pragma unroll
    for (int r = 0; r < 16; ++r) if (MODE == 1) rh[r] += bf2f(*(const bf16_t*)(smem + CS_RT + (32 * mi + crow(r, hh)) * 144 + (32 * ni + l31) * 2));
    __syncthreads();
#pragma unroll
    for (int r = 0; r < 16; ++r) {
      const int rrow = 32 * mi + crow(r, hh), ccol = 32 * ni + l31;
      if (MODE == 1) *(bf16_t*)(smem + CS_R2 + rrow * 144 + ccol * 2) = f2bf(rh[r]);
      *(bf16_t*)(smem + CS_R3 + rrow * 144 + ccol * 2) = f2bf(mm[r]);
    }
    __syncthreads();
    f32x16 pp;
#pragma unroll
    for (int r = 0; r < 16; ++r) pp[r] = 0.f;
#pragma unroll
    for (int kk = 0; kk < 4; ++kk) {
      const s16x8 aMM = lds_row8(smem + CS_R3, 32 * mi + l31, kk * 16 + 8 * hh);
      const s16x8 tS = lds_tr8(smem + CS_S0T, kk * 16, 32 * ni, lane);
      if (MODE == 1) {
        const s16x8 aRH = lds_row8(smem + CS_R2, 32 * mi + l31, kk * 16 + 8 * hh);
        yl = MFMA(aRH, tS, yl);
      } else {
        const s16x8 tP = lds_tr8(smem + CS_RT, kk * 16, 32 * ni, lane);
        pp = MFMA(aMM, tP, pp);
      }
      cc = MFMA(aMM, tS, cc);
    }
#pragma unroll
    for (int r = 0; r < 16; ++r) {
      const float clv = CL[32 * mi + crow(r, hh)];
      Sacc[r] = clv * (Sacc[r] + cc[r]);
      if (MODE == 0) Pacc[r] = clv * (Pacc[r] + pp[r]);
    }
    __syncthreads();
#pragma unroll
    for (int r = 0; r < 16; ++r) {
      const int rrow = 32 * mi + crow(r, hh), ccol = 32 * ni + l31;
      *(bf16_t*)(smem + CS_S0T + rrow * 144 + ccol * 2) = f2bf(Sacc[r]);
      if (MODE == 0) *(bf16_t*)(smem + CS_RT + rrow * 144 + ccol * 2) = f2bf(Pacc[r]);
      if (MODE == 1) {
        const int yrow = seq_row(n, b, ck * 64 + rrow);
        Y[(size_t)yrow * D + hd * 64 + ccol] = f2bf(yl[r]);
      }
    }
  }
  if (MODE == 0 || seg == 0) {
    float* PQ = SCR + (size_t)(cid * 4 + seg) * 8192;
#pragma unroll
    for (int r = 0; r < 16; ++r) {
      const int rrow = 32 * mi + crow(r, hh), ccol = 32 * ni + l31;
      if (MODE == 0) PQ[rrow * 64 + ccol] = Pacc[r];
      PQ[4096 + rrow * 64 + ccol] = Sacc[r];
    }
  }
}

DI void run_phase(const Params& p, int ph, char* smem, const int TID) {
  bf16_t* T0 = (bf16_t*)(p.ws + 0 * SLOT);
  bf16_t* T1 = (bf16_t*)(p.ws + 1 * SLOT);
  bf16_t* T2 = (bf16_t*)(p.ws + 2 * SLOT);
  bf16_t* T3 = (bf16_t*)(p.ws + 3 * SLOT);
  bf16_t* T4 = (bf16_t*)(p.ws + 4 * SLOT);
  bf16_t* T5 = (bf16_t*)(p.ws + 5 * SLOT);
  bf16_t* VF = (bf16_t*)(p.ws + OFF_VF);
  bf16_t* W = (bf16_t*)(p.ws + OFF_W);
  const int tid = TID;
#ifdef ONLY_PHASE
    const int type = ONLY_PHASE, layer = p.player[ph];
#else
    const int type = p.ptype[ph], layer = p.player[ph];
#endif
    const int j = layer >> 1;
    switch (type) {
#ifdef DBG_PREPFILL
      case PH_PREP0: {
        for (size_t i = (size_t)blockIdx.x * 256 + tid; i < (size_t)(1 << 20); i += (size_t)gridDim.x * 256)
          *(uint4*)(T4 + (size_t)(2 << 20) * 8 + i * 8) = make_uint4(0x3f803f80u, 0x3f803f80u, 0x3f803f80u, 0x3f803f80u);
      } break;
#else
      case PH_PREP0: phase_prep0(p, smem, TID); break;
#endif
      case PH_PRE0: {
        for (int it = blockIdx.x; it < 128; it += gridDim.x) fourier_precompose(p, it, smem, TID);
        row_items(p, 0, false, true, NR, nullptr, T0, blockIdx.x, NR / 4, TID);
      } break;
      case PH_FGEMM1: {
        const int MT = NR / 128, NT = 12, NBIG = 1536, NSMALL = (MT * NT - NBIG) * 2;
        for (int t = blockIdx.x; t < NBIG + NSMALL; t += gridDim.x) {
          if (t < NBIG) {
            const int mt = t / NT, nt = t % NT;
            gemm_tile_plain<false, 4>(T0, nullptr, nullptr, 1024, W, 1024, 1024, mt * 128, nt * 256, 3072, smem, TID,
                                      [=](int col0) { return col0 < 1024 ? T1 : (col0 < 2048 ? T2 : T3); });
          } else {
            const int u = t - NBIG, bt = NBIG + (u >> 1), mt = bt / NT, nt = bt % NT;
            gemm_tile_plain<false, 2>(T0, nullptr, nullptr, 1024, W, 1024, 1024, mt * 128, nt * 256 + (u & 1) * 128, 3072, smem, TID,
                                      [=](int col0) { return col0 < 1024 ? T1 : (col0 < 2048 ? T2 : T3); });
          }
        }
      } break;
      case PH_FDFT1: {
        const bf16_t* F1 = (const bf16_t*)(p.ws + OFF_F1);
        const bf16_t* FC = (const bf16_t*)(p.ws + OFF_FC);
        const float2* TW = (const float2*)(p.ws + OFF_TW);
        bf16_t* YB = T4;
        const float* bmix = p.f_b_mix + (size_t)j * 1024;
        const int nctx = (layer == 3) ? 0 : 32;
        {
          constexpr int L_B = 0, L_F1 = 40960, L_TW = L_F1 + 128 * 272;
          const int lane = tid & 63, w = tid >> 6, l31 = lane & 31, hh = lane >> 5;
          const int rt0 = w & 1, ctb = 2 * (w >> 1);
          __syncthreads();
#pragma unroll
          for (int i = 0; i < 8; ++i) {
            const int c = tid + 256 * i, r = c >> 4, cc = c & 15;
            *(uint4*)(smem + L_F1 + r * 272 + cc * 16) = *(const uint4*)(F1 + r * 128 + cc * 8);
          }
#pragma unroll
          for (int i = 0; i < 16; ++i) *(uint4*)(smem + L_TW + (tid + 256 * i) * 16) = *(const uint4*)((const char*)TW + (size_t)(tid + 256 * i) * 16);
          uint4 bp0, bp1, bp2, bp3, bp4, bp5, bp6, bp7;
          const int br = tid >> 4, bcc = tid & 15;
          int it = blockIdx.x;
          if (it < 2048) {
              const int itn_ = it;
              const int b_ = itn_ >> 10, t2_ = (itn_ >> 3) & 127, cb_ = itn_ & 7;
              const size_t tok0_ = (size_t)b_ * 8192 + t2_;
              { const int kr = br + 0; bp0 = *(const uint4*)((kr < 64 ? T1 + (tok0_ + (size_t)kr * 128) * D : T2 + (tok0_ + (size_t)(kr - 64) * 128) * D) + cb_ * 128 + bcc * 8); }
              { const int kr = br + 16; bp1 = *(const uint4*)((kr < 64 ? T1 + (tok0_ + (size_t)kr * 128) * D : T2 + (tok0_ + (size_t)(kr - 64) * 128) * D) + cb_ * 128 + bcc * 8); }
              { const int kr = br + 32; bp2 = *(const uint4*)((kr < 64 ? T1 + (tok0_ + (size_t)kr * 128) * D : T2 + (tok0_ + (size_t)(kr - 64) * 128) * D) + cb_ * 128 + bcc * 8); }
              { const int kr = br + 48; bp3 = *(const uint4*)((kr < 64 ? T1 + (tok0_ + (size_t)kr * 128) * D : T2 + (tok0_ + (size_t)(kr - 64) * 128) * D) + cb_ * 128 + bcc * 8); }
              { const int kr = br + 64; bp4 = *(const uint4*)((kr < 64 ? T1 + (tok0_ + (size_t)kr * 128) * D : T2 + (tok0_ + (size_t)(kr - 64) * 128) * D) + cb_ * 128 + bcc * 8); }
              { const int kr = br + 80; bp5 = *(const uint4*)((kr < 64 ? T1 + (tok0_ + (size_t)kr * 128) * D : T2 + (tok0_ + (size_t)(kr - 64) * 128) * D) + cb_ * 128 + bcc * 8); }
              { const int kr = br + 96; bp6 = *(const uint4*)((kr < 64 ? T1 + (tok0_ + (size_t)kr * 128) * D : T2 + (tok0_ + (size_t)(kr - 64) * 128) * D) + cb_ * 128 + bcc * 8); }
              { const int kr = br + 112; bp7 = *(const uint4*)((kr < 64 ? T1 + (tok0_ + (size_t)kr * 128) * D : T2 + (tok0_ + (size_t)(kr - 64) * 128) * D) + cb_ * 128 + bcc * 8); }
            }
          for (; it < 2048; it += gridDim.x) {
            const int b = it >> 10, t2 = (it >> 3) & 127, cb = it & 7;
            __syncthreads();
            *(uint4*)(smem + L_B + (br + 0) * 320 + bcc * 16) = bp0;
            *(uint4*)(smem + L_B + (br + 16) * 320 + bcc * 16) = bp1;
            *(uint4*)(smem + L_B + (br + 32) * 320 + bcc * 16) = bp2;
            *(uint4*)(smem + L_B + (br + 48) * 320 + bcc * 16) = bp3;
            *(uint4*)(smem + L_B + (br + 64) * 320 + bcc * 16) = bp4;
            *(uint4*)(smem + L_B + (br + 80) * 320 + bcc * 16) = bp5;
            *(uint4*)(smem + L_B + (br + 96) * 320 + bcc * 16) = bp6;
            *(uint4*)(smem + L_B + (br + 112) * 320 + bcc * 16) = bp7;
            __syncthreads();
            if (it + (int)gridDim.x < 2048) {
              const int itn_ = it + (int)gridDim.x;
              const int b_ = itn_ >> 10, t2_ = (itn_ >> 3) & 127, cb_ = itn_ & 7;
              const size_t tok0_ = (size_t)b_ * 8192 + t2_;
              { const int kr = br + 0; bp0 = *(const uint4*)((kr < 64 ? T1 + (tok0_ + (size_t)kr * 128) * D : T2 + (tok0_ + (size_t)(kr - 64) * 128) * D) + cb_ * 128 + bcc * 8); }
              { const int kr = br + 16; bp1 = *(const uint4*)((kr < 64 ? T1 + (tok0_ + (size_t)kr * 128) * D : T2 + (tok0_ + (size_t)(kr - 64) * 128) * D) + cb_ * 128 + bcc * 8); }
              { const int kr = br + 32; bp2 = *(const uint4*)((kr < 64 ? T1 + (tok0_ + (size_t)kr * 128) * D : T2 + (tok0_ + (size_t)(kr - 64) * 128) * D) + cb_ * 128 + bcc * 8); }
              { const int kr = br + 48; bp3 = *(const uint4*)((kr < 64 ? T1 + (tok0_ + (size_t)kr * 128) * D : T2 + (tok0_ + (size_t)(kr - 64) * 128) * D) + cb_ * 128 + bcc * 8); }
              { const int kr = br + 64; bp4 = *(const uint4*)((kr < 64 ? T1 + (tok0_ + (size_t)kr * 128) * D : T2 + (tok0_ + (size_t)(kr - 64) * 128) * D) + cb_ * 128 + bcc * 8); }
              { const int kr = br + 80; bp5 = *(const uint4*)((kr < 64 ? T1 + (tok0_ + (size_t)kr * 128) * D : T2 + (tok0_ + (size_t)(kr - 64) * 128) * D) + cb_ * 128 + bcc * 8); }
              { const int kr = br + 96; bp6 = *(const uint4*)((kr < 64 ? T1 + (tok0_ + (size_t)kr * 128) * D : T2 + (tok0_ + (size_t)(kr - 64) * 128) * D) + cb_ * 128 + bcc * 8); }
              { const int kr = br + 112; bp7 = *(const uint4*)((kr < 64 ? T1 + (tok0_ + (size_t)kr * 128) * D : T2 + (tok0_ + (size_t)(kr - 64) * 128) * D) + cb_ * 128 + bcc * 8); }
            }
            f32x16 acc[2][2];
#pragma unroll
            for (int i = 0; i < 2; ++i)
#pragma unroll
              for (int jj = 0; jj < 2; ++jj)
#pragma unroll
                for (int r = 0; r < 16; ++r) acc[i][jj][r] = 0.f;
            const int g = lane >> 4, li = lane & 15, qq = li >> 2, pp = li & 3;
            const int tr_base = (8 * (g >> 1) + qq) * 320 + (16 * (g & 1) + 4 * pp) * 2;
#pragma unroll
            for (int ks = 0; ks < 8; ++ks) {
              s16x8 af[2];
#pragma unroll
              for (int h = 0; h < 2; ++h) af[h] = *(const s16x8*)(smem + L_F1 + (32 * (rt0 + 2 * h) + l31) * 272 + (ks * 16 + hh * 8) * 2);
#pragma unroll
              for (int c2 = 0; c2 < 2; ++c2) {
                const int off = L_B + tr_base + ks * 16 * 320 + (ctb + c2) * 64;
                const s16x4 lo = __builtin_amdgcn_ds_read_tr16_b64_v4i16((__attribute__((address_space(3))) s16x4*)(smem + off));
                const s16x4 hi = __builtin_amdgcn_ds_read_tr16_b64_v4i16((__attribute__((address_space(3))) s16x4*)(smem + off + 4 * 320));
                const s16x8 bq = __builtin_shufflevector(lo, hi, 0, 1, 2, 3, 4, 5, 6, 7);
#pragma unroll
                for (int h = 0; h < 2; ++h) acc[h][c2] = MFMA(af[h], bq, acc[h][c2]);
              }
            }
#pragma unroll
            for (int c2 = 0; c2 < 2; ++c2) {
              const int col = 32 * (ctb + c2) + l31;
#pragma unroll
              for (int r = 0; r < 16; ++r) {
                const int k1 = 32 * rt0 + crow(r, hh);
                const float2 tw = *(const float2*)(smem + L_TW + (k1 * 128 + t2) * 8);
                const float va = acc[0][c2][r], vb = acc[1][c2][r];
                const float yr = va * tw.x - vb * tw.y, yi = va * tw.y + vb * tw.x;
                bf16_t* d = YB + ((size_t)b * 8192 + k1 * 128 + t2) * 2048 + cb * 128 + col;
                d[0] = f2bf(yr); d[1024] = f2bf(yi);
              }
            }
          }
        }
        for (int it = 2048 + blockIdx.x; it < 2048 + nctx; it += gridDim.x) {
          {
            const int u = it - 2048, b = u >> 4, cb = (u >> 1) & 7, mh = u & 1;
            const size_t tok0 = (size_t)NLAT + b * 256;
            const float scale = 0.005524271728019903f;
            dft_tile(FC, 512, mh * 128, 256, T1 + tok0 * D + cb * 128, T2 + tok0 * D + cb * 128, D, 1, smem, TID,
                     [=](int rowA, int rowB, int col, float va, float vb) {
                       const int cc = cb * 128 + col;
                       bf16_t* z0 = T3 + (tok0 + mh * 128 + rowA) * D + cc;
                       bf16_t* z1 = T3 + (tok0 + mh * 128 + rowB) * D + cc;
                       const float bm = bmix[cc];
                       z0[0] = f2bf((va * scale + bm) * silu_f(bf2f(z0[0])));
                       z1[0] = f2bf((vb * scale + bm) * silu_f(bf2f(z1[0])));
                     });
          }
        }
      } break;
      case PH_FDFT3: {
        const bf16_t* F2 = (const bf16_t*)(p.ws + OFF_F2);
        const bf16_t* YB = T4;
        const float* bmix = p.f_b_mix + (size_t)j * 1024;
        const float scale = 0.0009765625f;
        constexpr int L_B = 0, L_F2 = 256 * 320;
        const int lane = tid & 63, w = tid >> 6, l31 = lane & 31, hh = lane >> 5;
        const int rt0 = w & 1, ctb = 2 * (w >> 1);
        const int br = tid >> 4, bcc = tid & 15;
        __syncthreads();
#pragma unroll
        for (int i = 0; i < 16; ++i) {
          const int c = tid + 256 * i, r = c >> 5, cc = c & 31;
          *(uint4*)(smem + L_F2 + r * 528 + cc * 16) = *(const uint4*)(F2 + r * 256 + cc * 8);
        }
        uint4 bp0, bp1, bp2, bp3, bp4, bp5, bp6, bp7, bp8, bp9, bp10, bp11, bp12, bp13, bp14, bp15;
        int it = blockIdx.x;
        if (it < 1024) {
          const int b_ = it >> 9, k1_ = (it >> 3) & 63, cb_ = it & 7;
          const size_t tok0_ = (size_t)b_ * 8192 + k1_ * 128;
              bp0 = *(const uint4*)(YB + (tok0_ + (size_t)(br + 0)) * 2048 + 0 + cb_ * 128 + bcc * 8);
              bp1 = *(const uint4*)(YB + (tok0_ + (size_t)(br + 16)) * 2048 + 0 + cb_ * 128 + bcc * 8);
              bp2 = *(const uint4*)(YB + (tok0_ + (size_t)(br + 32)) * 2048 + 0 + cb_ * 128 + bcc * 8);
              bp3 = *(const uint4*)(YB + (tok0_ + (size_t)(br + 48)) * 2048 + 0 + cb_ * 128 + bcc * 8);
              bp4 = *(const uint4*)(YB + (tok0_ + (size_t)(br + 64)) * 2048 + 0 + cb_ * 128 + bcc * 8);
              bp5 = *(const uint4*)(YB + (tok0_ + (size_t)(br + 80)) * 2048 + 0 + cb_ * 128 + bcc * 8);
              bp6 = *(const uint4*)(YB + (tok0_ + (size_t)(br + 96)) * 2048 + 0 + cb_ * 128 + bcc * 8);
              bp7 = *(const uint4*)(YB + (tok0_ + (size_t)(br + 112)) * 2048 + 0 + cb_ * 128 + bcc * 8);
              bp8 = *(const uint4*)(YB + (tok0_ + (size_t)(br + 0)) * 2048 + 1024 + cb_ * 128 + bcc * 8);
              bp9 = *(const uint4*)(YB + (tok0_ + (size_t)(br + 16)) * 2048 + 1024 + cb_ * 128 + bcc * 8);
              bp10 = *(const uint4*)(YB + (tok0_ + (size_t)(br + 32)) * 2048 + 1024 + cb_ * 128 + bcc * 8);
              bp11 = *(const uint4*)(YB + (tok0_ + (size_t)(br + 48)) * 2048 + 1024 + cb_ * 128 + bcc * 8);
              bp12 = *(const uint4*)(YB + (tok0_ + (size_t)(br + 64)) * 2048 + 1024 + cb_ * 128 + bcc * 8);
              bp13 = *(const uint4*)(YB + (tok0_ + (size_t)(br + 80)) * 2048 + 1024 + cb_ * 128 + bcc * 8);
              bp14 = *(const uint4*)(YB + (tok0_ + (size_t)(br + 96)) * 2048 + 1024 + cb_ * 128 + bcc * 8);
              bp15 = *(const uint4*)(YB + (tok0_ + (size_t)(br + 112)) * 2048 + 1024 + cb_ * 128 + bcc * 8);
        }
        for (; it < 1024; it += gridDim.x) {
          const int b = it >> 9, k1 = (it >> 3) & 63, cb = it & 7;
          __syncthreads();
            *(uint4*)(smem + L_B + (0 + br + 0) * 320 + bcc * 16) = bp0;
            *(uint4*)(smem + L_B + (0 + br + 16) * 320 + bcc * 16) = bp1;
            *(uint4*)(smem + L_B + (0 + br + 32) * 320 + bcc * 16) = bp2;
            *(uint4*)(smem + L_B + (0 + br + 48) * 320 + bcc * 16) = bp3;
            *(uint4*)(smem + L_B + (0 + br + 64) * 320 + bcc * 16) = bp4;
            *(uint4*)(smem + L_B + (0 + br + 80) * 320 + bcc * 16) = bp5;
            *(uint4*)(smem + L_B + (0 + br + 96) * 320 + bcc * 16) = bp6;
            *(uint4*)(smem + L_B + (0 + br + 112) * 320 + bcc * 16) = bp7;
            *(uint4*)(smem + L_B + (128 + br + 0) * 320 + bcc * 16) = bp8;
            *(uint4*)(smem + L_B + (128 + br + 16) * 320 + bcc * 16) = bp9;
            *(uint4*)(smem + L_B + (128 + br + 32) * 320 + bcc * 16) = bp10;
            *(uint4*)(smem + L_B + (128 + br + 48) * 320 + bcc * 16) = bp11;
            *(uint4*)(smem + L_B + (128 + br + 64) * 320 + bcc * 16) = bp12;
            *(uint4*)(smem + L_B + (128 + br + 80) * 320 + bcc * 16) = bp13;
            *(uint4*)(smem + L_B + (128 + br + 96) * 320 + bcc * 16) = bp14;
            *(uint4*)(smem + L_B + (128 + br + 112) * 320 + bcc * 16) = bp15;
          __syncthreads();
          if (it + (int)gridDim.x < 1024) {
            const int itn_ = it + (int)gridDim.x;
            const int b_ = itn_ >> 9, k1_ = (itn_ >> 3) & 63, cb_ = itn_ & 7;
            const size_t tok0_ = (size_t)b_ * 8192 + k1_ * 128;
              bp0 = *(const uint4*)(YB + (tok0_ + (size_t)(br + 0)) * 2048 + 0 + cb_ * 128 + bcc * 8);
              bp1 = *(const uint4*)(YB + (tok0_ + (size_t)(br + 16)) * 2048 + 0 + cb_ * 128 + bcc * 8);
              bp2 = *(const uint4*)(YB + (tok0_ + (size_t)(br + 32)) * 2048 + 0 + cb_ * 128 + bcc * 8);
              bp3 = *(const uint4*)(YB + (tok0_ + (size_t)(br + 48)) * 2048 + 0 + cb_ * 128 + bcc * 8);
              bp4 = *(const uint4*)(YB + (tok0_ + (size_t)(br + 64)) * 2048 + 0 + cb_ * 128 + bcc * 8);
              bp5 = *(const uint4*)(YB + (tok0_ + (size_t)(br + 80)) * 2048 + 0 + cb_ * 128 + bcc * 8);
              bp6 = *(const uint4*)(YB + (tok0_ + (size_t)(br + 96)) * 2048 + 0 + cb_ * 128 + bcc * 8);
              bp7 = *(const uint4*)(YB + (tok0_ + (size_t)(br + 112)) * 2048 + 0 + cb_ * 128 + bcc * 8);
              bp8 = *(const uint4*)(YB + (tok0_ + (size_t)(br + 0)) * 2048 + 1024 + cb_ * 128 + bcc * 8);
              bp9 = *(const uint4*)(YB + (tok0_ + (size_t)(br + 16)) * 2048 + 1024 + cb_ * 128 + bcc * 8);
              bp10 = *(const uint4*)(YB + (tok0_ + (size_t)(br + 32)) * 2048 + 1024 + cb_ * 128 + bcc * 8);
              bp11 = *(const uint4*)(YB + (tok0_ + (size_t)(br + 48)) * 2048 + 1024 + cb_ * 128 + bcc * 8);
              bp12 = *(const uint4*)(YB + (tok0_ + (size_t)(br + 64)) * 2048 + 1024 + cb_ * 128 + bcc * 8);
              bp13 = *(const uint4*)(YB + (tok0_ + (size_t)(br + 80)) * 2048 + 1024 + cb_ * 128 + bcc * 8);
              bp14 = *(const uint4*)(YB + (tok0_ + (size_t)(br + 96)) * 2048 + 1024 + cb_ * 128 + bcc * 8);
              bp15 = *(const uint4*)(YB + (tok0_ + (size_t)(br + 112)) * 2048 + 1024 + cb_ * 128 + bcc * 8);
          }
          f32x16 acc[2][2];
#pragma unroll
          for (int i = 0; i < 2; ++i)
#pragma unroll
            for (int jj = 0; jj < 2; ++jj)
#pragma unroll
              for (int r = 0; r < 16; ++r) acc[i][jj][r] = 0.f;
          const int g = lane >> 4, li = lane & 15, qq = li >> 2, pp = li & 3;
          const int tr_base = (8 * (g >> 1) + qq) * 320 + (16 * (g & 1) + 4 * pp) * 2;
#pragma unroll
          for (int ks = 0; ks < 16; ++ks) {
            s16x8 af[2];
#pragma unroll
            for (int h = 0; h < 2; ++h) af[h] = *(const s16x8*)(smem + L_F2 + (32 * (rt0 + 2 * h) + l31) * 528 + (ks * 16 + hh * 8) * 2);
#pragma unroll
            for (int c2 = 0; c2 < 2; ++c2) {
              const int off = L_B + tr_base + ks * 16 * 320 + (ctb + c2) * 64;
              const s16x4 lo = __builtin_amdgcn_ds_read_tr16_b64_v4i16((__attribute__((address_space(3))) s16x4*)(smem + off));
              const s16x4 hi = __builtin_amdgcn_ds_read_tr16_b64_v4i16((__attribute__((address_space(3))) s16x4*)(smem + off + 4 * 320));
              const s16x8 bq = __builtin_shufflevector(lo, hi, 0, 1, 2, 3, 4, 5, 6, 7);
#pragma unroll
              for (int h = 0; h < 2; ++h) acc[h][c2] = MFMA(af[h], bq, acc[h][c2]);
            }
          }
#pragma unroll
          for (int c2 = 0; c2 < 2; ++c2) {
            const int cc = cb * 128 + 32 * (ctb + c2) + l31;
            const float bm = bmix[cc];
#pragma unroll
            for (int r = 0; r < 16; ++r) {
              const int rowA = 32 * rt0 + crow(r, hh);
              if ((r & 3) == 0) asm volatile("" ::: "memory");
              bf16_t* z0 = T3 + ((size_t)b * 8192 + k1 + 64 * rowA) * D + cc;
              bf16_t* z1 = T3 + ((size_t)b * 8192 + k1 + 64 * (rowA + 64)) * D + cc;
              z0[0] = f2bf((acc[0][c2][r] * scale + bm) * silu_f(bf2f(z0[0])));
              z1[0] = f2bf((acc[1][c2][r] * scale + bm) * silu_f(bf2f(z1[0])));
            }
          }
        }
      } break;
      case PH_FOUT: {
        const int NBIG = 512, NSMALL = (NR / 128 * 4 - NBIG) * 2;
        for (int t = blockIdx.x; t < NBIG + NSMALL; t += gridDim.x) {
          if (t < NBIG) {
            const int mt = t / 4, nt = t % 4;
            gemm_tile_plain<false, 4>(T3, nullptr, nullptr, 1024, W + (size_t)3072 * 1024, 1024, 1024, mt * 128, nt * 256, 1024, smem, TID,
                                       [=](int) { return T1; });
          } else {
            const int u = t - NBIG, mt = 128 + u / 8, nt = u % 8;
            gemm_tile_plain<false, 2>(T3, nullptr, nullptr, 1024, W + (size_t)3072 * 1024, 1024, 1024, mt * 128, nt * 128, 1024, smem, TID,
                                       [=](int) { return T1; });
          }
        }
      } break;
      case PH_POSTPRE: {
        const int nl = layer + 1;
        if (nl & 1) { for (int it = blockIdx.x; it < N_RWPREP; it += gridDim.x) rwkv_wprep(p, nl >> 1, it, smem, TID); }
        else {
          for (int it = blockIdx.x; it < 128 + N_FWPREP; it += gridDim.x) {
            if (it < 128) fourier_precompose(p, it, smem, TID); else fourier_wprep(p, nl >> 1, it - 128, smem, TID);
          }
        }
        const bf16_t* O = (layer & 1) ? T2 : T1;
        row_items(p, layer, true, true, NR, O, T0, blockIdx.x, NR / 4, TID);
      } break;
      case PH_RSHIFT: {
        for (int idx = blockIdx.x * 256 + tid; idx < NR * 128; idx += gridDim.x * 256) {
          const int row = idx >> 7, cc = (idx & 127) * 8;
          bool ok0, ok1, ok2, ok3; float wgt;
          if (row < NLAT) {
            const int t = row & 8191, gy = t >> 6, gx = t & 63;
            wgt = 0.25f;
            ok0 = gy > 0; ok1 = gy < 127; ok2 = gx > 0; ok3 = gx < 63;
          } else {
            const int t = (row - NLAT) & 255;
            wgt = 0.5f;
            ok0 = false; ok1 = false; ok2 = t > 0; ok3 = t < 255;
          }
          float a[8] = {0, 0, 0, 0, 0, 0, 0, 0};
#pragma unroll
          for (int q = 0; q < 4; ++q) {
            const bool ok = q == 0 ? ok0 : (q == 1 ? ok1 : (q == 2 ? ok2 : ok3));
            const int nrow = q == 0 ? row - 64 : (q == 1 ? row + 64 : (q == 2 ? row - 1 : row + 1));
            if (ok) {
              const uint4 u = *(const uint4*)(T0 + (size_t)nrow * D + cc);
              a[0] += lo2f(u.x); a[1] += hi2f(u.x); a[2] += lo2f(u.y); a[3] += hi2f(u.y);
              a[4] += lo2f(u.z); a[5] += hi2f(u.z); a[6] += lo2f(u.w); a[7] += hi2f(u.w);
            }
          }
          *(uint4*)(T1 + (size_t)row * D + cc) = make_uint4(pack2(a[0] * wgt, a[1] * wgt), pack2(a[2] * wgt, a[3] * wgt),
                                                            pack2(a[4] * wgt, a[5] * wgt), pack2(a[6] * wgt, a[7] * wgt));
        }
        if (layer == 1) {
          for (int it = blockIdx.x; it < N_CWPREP; it += gridDim.x) fourier_cw_prep(p, 1, it, smem, TID);
        }
      } break;
      case PH_RINPROJ: {
        const int N = (j >= 1) ? 4384 : 4352;
        const int MT = NR / 128;
        const int NT_MAIN = 16, NT_TAIL = (N - 4096 + 127) / 128, NT = NT_MAIN + NT_TAIL;
        bf16_t* Vd = (j == 0) ? VF : T5;
        bf16_t* LW = (bf16_t*)(p.ws + OFF_LW);
        bf16_t* LA = (bf16_t*)(p.ws + OFF_LA);
        bf16_t* LV = (bf16_t*)(p.ws + OFF_LV);
        for (int t = blockIdx.x; t < MT * NT; t += gridDim.x) {
          const int mt = t / NT, nt = t % NT;
          if (nt < NT_MAIN) {
            const int n0 = nt * 256;
            const float* mu = p.r_mu + (size_t)(j * 6 + (n0 >> 10)) * 1024;
            gemm_tile_plain<true, 4>(T0, T1, mu, 1024, W, 1024, 1024, mt * 128, n0, 4096, smem, TID,
                                     [=](int col0) { return col0 < 1024 ? T2 : (col0 < 2048 ? T3 : (col0 < 3072 ? Vd : T4)); });
          } else {
            const int n0 = 4096 + (nt - NT_MAIN) * 128;
            const int pi = n0 < 4224 ? 4 : (n0 < 4352 ? 5 : 2);
            const float* mu = p.r_mu + (size_t)(j * 6 + pi) * 1024;
            gemm_tile_n<true, 2>(T0, T1, mu, 1024, W, 1024, 1024, mt * 128, n0, N, smem, TID, [=](int row, int col, float v) {
              if (col < 4224) LW[(size_t)row * 128 + (col - 4096)] = f2bf(tanhf(v));
              else if (col < 4352) LA[(size_t)row * 128 + (col - 4224)] = f2bf(v);
              else LV[(size_t)row * 32 + (col - 4352)] = f2bf(v);
            });
          }
        }
      } break;
      case PH_RVUPD: {
        const bf16_t* LV = (const bf16_t*)(p.ws + OFF_LV);
        const float* v2 = p.r_v2 + (size_t)(j - 1) * 32 * 1024;
        const float* v0 = p.r_v0 + (size_t)(j - 1) * 1024;
        float* v2s = (float*)smem;
        __syncthreads();
        for (int e = tid; e < 32 * 256; e += 256) *(float4*)(v2s + e * 4) = *(const float4*)(v2 + e * 4);
        __syncthreads();
        const int wave = tid >> 6, lane = tid & 63;
        for (int row = blockIdx.x * 4 + wave; row < NR; row += gridDim.x * 4) {
          const float lvl = bf2f(LV[(size_t)row * 32 + (lane & 31)]);
          float acc[16];
#pragma unroll
          for (int qd = 0; qd < 4; ++qd) {
            const float4 t = *(const float4*)(v0 + qd * 256 + lane * 4);
            acc[qd * 4] = t.x; acc[qd * 4 + 1] = t.y; acc[qd * 4 + 2] = t.z; acc[qd * 4 + 3] = t.w;
          }
#pragma unroll 4
          for (int l = 0; l < 32; ++l) {
            const float a = __int_as_float(__builtin_amdgcn_readlane(__float_as_int(lvl), l));
#pragma unroll
            for (int qd = 0; qd < 4; ++qd) {
              const float4 wv = *(const float4*)(v2s + l * 1024 + qd * 256 + lane * 4);
              acc[qd * 4] += a * wv.x; acc[qd * 4 + 1] += a * wv.y; acc[qd * 4 + 2] += a * wv.z; acc[qd * 4 + 3] += a * wv.w;
            }
          }
#pragma unroll
          for (int qd = 0; qd < 4; ++qd) {
            const size_t idx = (size_t)row * D + qd * 256 + lane * 4;
            const uint2 uv = *(const uint2*)(T5 + idx);
            const uint2 uf = *(const uint2*)(VF + idx);
            float v[4] = {lo2f(uv.x), hi2f(uv.x), lo2f(uv.y), hi2f(uv.y)};
            const float f[4] = {lo2f(uf.x), hi2f(uf.x), lo2f(uf.y), hi2f(uf.y)};
#pragma unroll
            for (int e = 0; e < 4; ++e) v[e] = v[e] + (f[e] - v[e]) * fsig(acc[qd * 4 + e]);
            *(uint2*)(T5 + idx) = make_uint2(pack2(v[0], v[1]), pack2(v[2], v[3]));
          }
        }
      } break;
      case PH_RSCANA: {
        const bf16_t* V = (j == 0) ? VF : T5;
        float* SCR = (j == 0) ? (float*)(p.ws + 5 * SLOT + (8u << 20)) : (float*)(p.ws + OFF_VF);
        for (int it = blockIdx.x; it < 64 * 4; it += gridDim.x) {
          const int cid = it >> 2, k = it & 3;
          int tl = TID;
          asm volatile("" : "+v"(tl));
          if (k == 0) scan_chain_chunked<1>(p, j, cid, 0, SCR, T2, T3, V, T0, T1, smem, tl);
          else scan_chain_chunked<0>(p, j, cid, k, SCR, T2, T3, V, T0, T1, smem, tl);
        }
      } break;
      case PH_RSCAN: {
        const bf16_t* V = (j == 0) ? VF : T5;
        float* SCR = (j == 0) ? (float*)(p.ws + 5 * SLOT + (8u << 20)) : (float*)(p.ws + OFF_VF);
        for (int it = blockIdx.x; it < 64 * 4; it += gridDim.x)
          scan_chain_chunked<1>(p, j, it >> 2, 1 + (it & 3), SCR, T2, T3, V, T0, T1, smem, TID);
      } break;
      case PH_ROUTPUT: {
        const bf16_t* V = (j == 0) ? VF : T5;
        const float* BON = (const float*)(p.ws + OFF_BON);
        const int wave = tid >> 6, lane = tid & 63;
        const int nrows = (layer == 3) ? NLAT : NR;
        for (int wi = blockIdx.x * 4 + wave; wi < nrows * 2; wi += gridDim.x * 4) {
          const int row = wi >> 1, c = (wi & 1) * 512 + lane * 8, h = c >> 6;
          const size_t idx = (size_t)row * D + c;
          const uint4 u0 = *(const uint4*)(T0 + idx), u1 = *(const uint4*)(T1 + idx), uv = *(const uint4*)(V + idx), ug = *(const uint4*)(T4 + idx);
          const float4 w0 = *(const float4*)(p.r_ln_w + (size_t)j * 1024 + c), w1 = *(const float4*)(p.r_ln_w + (size_t)j * 1024 + c + 4);
          const float4 b0 = *(const float4*)(p.r_ln_b + (size_t)j * 1024 + c), b1 = *(const float4*)(p.r_ln_b + (size_t)j * 1024 + c + 4);
          const float bon = BON[((size_t)0 * NR + row) * 16 + h] + BON[((size_t)1 * NR + row) * 16 + h];
          float y[8] = {lo2f(u0.x) + lo2f(u1.x), hi2f(u0.x) + hi2f(u1.x), lo2f(u0.y) + lo2f(u1.y), hi2f(u0.y) + hi2f(u1.y),
                        lo2f(u0.z) + lo2f(u1.z), hi2f(u0.z) + hi2f(u1.z), lo2f(u0.w) + lo2f(u1.w), hi2f(u0.w) + hi2f(u1.w)};
          const float vf[8] = {lo2f(uv.x), hi2f(uv.x), lo2f(uv.y), hi2f(uv.y), lo2f(uv.z), hi2f(uv.z), lo2f(uv.w), hi2f(uv.w)};
          const float gf[8] = {lo2f(ug.x), hi2f(ug.x), lo2f(ug.y), hi2f(ug.y), lo2f(ug.z), hi2f(ug.z), lo2f(ug.w), hi2f(ug.w)};
          const float lw8[8] = {w0.x, w0.y, w0.z, w0.w, w1.x, w1.y, w1.z, w1.w};
          const float lb8[8] = {b0.x, b0.y, b0.z, b0.w, b1.x, b1.y, b1.z, b1.w};
          float sm = 0.f;
#pragma unroll
          for (int e = 0; e < 8; ++e) sm += y[e];
          sm += __shfl_xor(sm, 1, 64); sm += __shfl_xor(sm, 2, 64); sm += __shfl_xor(sm, 4, 64);
          const float mean = sm * (1.f / 64.f);
          float vr = 0.f;
#pragma unroll
          for (int e = 0; e < 8; ++e) { y[e] -= mean; vr += y[e] * y[e]; }
          vr += __shfl_xor(vr, 1, 64); vr += __shfl_xor(vr, 2, 64); vr += __shfl_xor(vr, 4, 64);
          const float rstd = rsqrtf(vr * (1.f / 64.f) + GN_EPS);
          float o[8];
#pragma unroll
          for (int e = 0; e < 8; ++e) o[e] = (y[e] * rstd * lw8[e] + lb8[e] + bon * vf[e]) * silu_f(gf[e]);
          *(uint4*)(T4 + idx) = make_uint4(pack2(o[0], o[1]), pack2(o[2], o[3]), pack2(o[4], o[5]), pack2(o[6], o[7]));
        }
      } break;
      case PH_ROUTPROJ: {
        const int MT = ((layer == 3) ? NLAT : NR) / 128;
        const int NBIG = 512, NSMALL = (MT * 4 - NBIG) * 2;
        for (int t = blockIdx.x; t < NBIG + NSMALL; t += gridDim.x) {
          if (t < NBIG) {
            const int mt = t / 4, nt = t % 4;
            gemm_tile_plain<false, 4>(T4, nullptr, nullptr, 1024, W + (size_t)4384 * 1024, 1024, 1024, mt * 128, nt * 256, 1024, smem, TID,
                                       [=](int) { return T2; });
          } else {
            const int u = t - NBIG, mt = 128 + u / 8, nt = u % 8;
            gemm_tile_plain<false, 2>(T4, nullptr, nullptr, 1024, W + (size_t)4384 * 1024, 1024, 1024, mt * 128, nt * 128, 1024, smem, TID,
                                       [=](int) { return T2; });
          }
        }
      } break;
      case PH_POSTLAST: {
        row_items(p, layer, true, false, NLAT, T2, nullptr, blockIdx.x, NLAT / 4, TID);
      } break;
    }
}

#define XB_TMO      128
#define XB_XCNT(j)  (256  + 64 * (j))
#define XB_XSUB(j)  (1280 + 64 * (j))
#define XB_XGEN(j)  (2304 + 64 * (j))
#define XB_TOP      3328
#define XB_TOPGEN   3392
#define XCD_BAR_WORDS 3456
#define XB_SPIN_CAP (1u << 23)
#define LAS __attribute__((address_space(3)))

__device__ __forceinline__ unsigned xb_ld(unsigned* p)              { return __hip_atomic_load(p, __ATOMIC_RELAXED, __HIP_MEMORY_SCOPE_AGENT); }
__device__ __forceinline__ unsigned xb_add(unsigned* p, unsigned v) { return __hip_atomic_fetch_add(p, v, __ATOMIC_RELAXED, __HIP_MEMORY_SCOPE_AGENT); }
__device__ __forceinline__ unsigned xb_xcc_id() { return (unsigned)__builtin_amdgcn_s_getreg((3 << 11) | 20) & 0xFu; }
#define XB_SPIN(cond, bar) do { unsigned _sp = 0; while (cond) { __builtin_amdgcn_s_sleep(1); \
    if ((++_sp & 255u) == 0u) { if (xb_ld(&(bar)[XB_TMO])) break; if (_sp > XB_SPIN_CAP) { atomicAdd(&(bar)[XB_TMO], 1u); break; } } } } while (0)

struct XcdBarrier {
    unsigned* bar; unsigned x;
    volatile LAS unsigned* st;
};

__device__ __forceinline__ XcdBarrier xcd_barrier_post(unsigned* bar, volatile LAS unsigned* st) {
    XcdBarrier b; b.bar = bar; b.x = xb_xcc_id(); b.st = st;
    if (threadIdx.x == 0) (void)xb_add(&bar[XB_XCNT(b.x)], 1u);
    return b;
}
__device__ __forceinline__ void xcd_barrier_complete(unsigned* bar, unsigned x, unsigned& nloc, unsigned& nx) {
    const unsigned G = gridDim.x * gridDim.y * gridDim.z;
    unsigned sum, cnt, mine, sp = 0u;
    for (;;) {
        sum = 0u; cnt = 0u; mine = 0u;
#pragma unroll
        for (unsigned j = 0; j < 16; ++j) { const unsigned c = xb_ld(&bar[XB_XCNT(j)]); sum += c; cnt += (c > 0u) ? 1u : 0u; mine = (j == x) ? c : mine; }
        if (sum == G) break;
        __builtin_amdgcn_s_sleep(1);
        if ((++sp & 255u) == 0u) { if (xb_ld(&bar[XB_TMO])) break; if (sp > XB_SPIN_CAP) { atomicAdd(&bar[XB_TMO], 1u); break; } }
    }
    nloc = mine > 0u ? mine : 1u; nx = cnt > 0u ? cnt : 1u;
}

__device__ __forceinline__ void xcd_barrier(const XcdBarrier& b) {
    asm volatile("s_waitcnt vmcnt(0)" ::: "memory");
    __syncthreads();
    if (threadIdx.x == 0) {
        unsigned* bar = b.bar;
        __builtin_amdgcn_s_waitcnt(0);
        unsigned nloc = b.st[0], nx = b.st[1];
        if (nloc == 0u) { xcd_barrier_complete(bar, b.x, nloc, nx); b.st[0] = nloc; b.st[1] = nx; }
        const unsigned old = xb_add(&bar[XB_XSUB(b.x)], 1u);
        const unsigned gen = old / nloc;
        if (old + 1u == (gen + 1u) * nloc) {
            __builtin_amdgcn_fence(__ATOMIC_RELEASE, "agent");
            asm volatile("s_waitcnt vmcnt(0)" ::: "memory");
            const unsigned og = xb_add(&bar[XB_TOP], 1u);
            const unsigned tg = og / nx;
            if (og + 1u == (tg + 1u) * nx) xb_add(&bar[XB_TOPGEN], 1u);
            else XB_SPIN(xb_ld(&bar[XB_TOPGEN]) == tg, bar);
            __builtin_amdgcn_fence(__ATOMIC_ACQUIRE, "agent");
            xb_add(&bar[XB_XGEN(b.x)], 1u);
            asm volatile("s_waitcnt vmcnt(0)" ::: "memory");
        } else {
            XB_SPIN(xb_ld(&bar[XB_XGEN(b.x)]) == gen, bar);
            __builtin_amdgcn_fence(__ATOMIC_ACQUIRE, "agent");
            asm volatile("s_waitcnt vmcnt(0)" ::: "memory");
        }
    }
    __syncthreads();
}


__global__ void __launch_bounds__(256, 1) mega(Params p) {
  __shared__ __attribute__((aligned(16))) char smem[CS_END];
  cg::grid_group grid = cg::this_grid();
  __shared__ uint4 xb_words;
  if (threadIdx.x == 0) xb_words = make_uint4(0u, 0u, 0u, 0u);
  __syncthreads();
  XcdBarrier xb = xcd_barrier_post((unsigned*)(p.ws + OFF_BAR), (volatile LAS unsigned*)&xb_words);
  for (int ph = p.phase_lo; ph < p.phase_hi; ++ph) {
    int tid_l = threadIdx.x;
    asm volatile("" : "+v"(tid_l));
    run_phase(p, ph, smem, tid_l);
#ifdef REP_MASK
    if ((REP_MASK >> p.ptype[ph]) & 1) { asm volatile("s_waitcnt vmcnt(0) lgkmcnt(0)" ::: "memory"); grid.sync(); asm volatile("" : "+v"(tid_l)); run_phase(p, ph, smem, tid_l); }
#endif
    if (ph + 1 < p.phase_hi) {
      asm volatile("s_waitcnt vmcnt(0) lgkmcnt(0)" ::: "memory");
      if (ph == p.phase_lo) grid.sync();
      else xcd_barrier(xb);
    }
  }
}

extern "C" void kernel_launch(void* const* d_in, const int* in_sizes, int n_in, void* d_out, int out_size, void* d_ws, size_t ws_size,
                              hipStream_t stream) {
  static int grid_blocks = 0;
  if (!grid_blocks) {
    int dev = 0, cus = 0, per_cu = 0;
    hipGetDevice(&dev);
    hipDeviceGetAttribute(&cus, hipDeviceAttributeMultiprocessorCount, dev);
    hipOccupancyMaxActiveBlocksPerMultiprocessor(&per_cu, mega, 256, 0);
    if (per_cu > 2) per_cu = 2;
    if (per_cu < 1) per_cu = 1;
    grid_blocks = cus * per_cu;
  }
  Params p;
  memset(&p, 0, sizeof(p));
  const float** fp = (const float**)&p;
  for (int i = 0; i < 29; ++i) fp[i] = (const float*)d_in[i];
  p.out = (float*)d_out;
  p.ws = (char*)d_ws;
  int n = 0;
  auto add = [&](int t, int l) { p.ptype[n] = (unsigned char)t; p.player[n] = (unsigned char)l; ++n; };
  add(PH_PREP0, 0);
  add(PH_PRE0, 0);
  for (int l = 0; l < 4; ++l) {
    if ((l & 1) == 0) {
      add(PH_FGEMM1, l); add(PH_FDFT1, l); add(PH_FDFT3, l); add(PH_FOUT, l); add(PH_POSTPRE, l);
    } else {
      add(PH_RSHIFT, l); add(PH_RINPROJ, l);
      if (l == 3) add(PH_RVUPD, l);
      add(PH_RSCANA, l); add(PH_RSCAN, l); add(PH_ROUTPUT, l); add(PH_ROUTPROJ, l);
      add(l == 3 ? PH_POSTLAST : PH_POSTPRE, l);
    }
  }
#ifdef DBG_STOP
  n = DBG_STOP; add(PH_DUMP, 0);
#endif
#if SINGLE_LAUNCH
  hipMemsetAsync((char*)d_ws + OFF_BAR, 0, 3456 * 4, stream);
  p.phase_lo = 0; p.phase_hi = n;
  void* args[] = {&p};
  hipError_t e = hipLaunchCooperativeKernel((void*)mega, dim3(grid_blocks), dim3(256), args, 0, stream);
  if (e != hipSuccess) fprintf(stderr, "cooperative launch failed: %s (grid %d)\n", hipGetErrorString(e), grid_blocks);
#else
  for (int i = 0; i < n; ++i) {
    p.phase_lo = i; p.phase_hi = i + 1;
    hipLaunchKernelGGL(mega, dim3(grid_blocks), dim3(256), 0, stream, p);
  }
#endif
}
```
